# Optimizing an MI355X kernel written in HIP

```python
import jax, jax.numpy as jnp
from jax import lax
import numpy as np

D_MODEL = 2048
BATCH = 1
SEQ = 16384
DEPTH = 1

HEAD_DIM = 128
HEADS_PER_GROUP = 8
DILATION_GROUPS = ((128, 1), (512, 4), (2048, 16))
N_GROUPS = len(DILATION_GROUPS)
N_QKV_HEADS = N_GROUPS * HEADS_PER_GROUP
ATTN_QKV_WIDTH = N_QKV_HEADS * HEAD_DIM
ATTN_OUT_WIDTH = HEADS_PER_GROUP * HEAD_DIM
ROT_DIM = HEAD_DIM // 4
ROPE_THETA = 500000.0
CONV_WIDTH = D_MODEL
CONV_K = 3
EPS = 1e-6
SPLIT_SIZES = (ATTN_QKV_WIDTH, ATTN_QKV_WIDTH, ATTN_QKV_WIDTH, ATTN_OUT_WIDTH,
               CONV_WIDTH, CONV_WIDTH, CONV_WIDTH, CONV_WIDTH,
               D_MODEL, D_MODEL)
PROJ_WIDTH = sum(SPLIT_SIZES)
SPLIT_POINTS = tuple(int(s) for s in np.cumsum(SPLIT_SIZES)[:-1])
NEG_INF = -1e30

kernel_name = "hybrid_dilated_attn_shortconv_gated_merge"


def rms_norm(x, g):
    xf = x.astype(jnp.float32)
    y = xf * lax.rsqrt(jnp.mean(xf * xf, axis=-1, keepdims=True) + EPS)
    return (y * g.astype(jnp.float32)).astype(x.dtype)


def rope_tables(positions, dtype):
    inv_freq = ROPE_THETA ** (-jnp.arange(0, ROT_DIM, 2, dtype=jnp.float32) / ROT_DIM)
    ang = positions.astype(jnp.float32)[..., None] * inv_freq
    return jnp.cos(ang)[:, :, None, :].astype(dtype), jnp.sin(ang)[:, :, None, :].astype(dtype)


def apply_partial_rope(t, cos, sin):
    half = ROT_DIM // 2
    t1, t2, rest = t[..., :half], t[..., half:ROT_DIM], t[..., ROT_DIM:]
    return jnp.concatenate([t1 * cos - t2 * sin, t1 * sin + t2 * cos, rest], axis=-1)


def dilated_window_attention(q, k, v, dilation, w_sub):
    B, S, H, Dh = q.shape
    span = dilation * w_sub
    Sp = ((S + span - 1) // span) * span
    L = Sp // dilation
    nb = L // w_sub

    def to_sub(t):
        t = jnp.pad(t, ((0, 0), (0, Sp - S), (0, 0), (0, 0)))
        t = t.reshape(B, L, dilation, H, Dh).transpose(0, 3, 2, 1, 4)
        return t.reshape(B, H, dilation, nb, w_sub, Dh)

    def with_prev(t):
        prev = jnp.pad(t[:, :, :, :-1], ((0, 0), (0, 0), (0, 0), (1, 0), (0, 0), (0, 0)))
        return jnp.concatenate([prev, t], axis=4)

    qs = to_sub(q)
    kk = with_prev(to_sub(k))
    vv = with_prev(to_sub(v))
    scores = jnp.einsum('bhrnqd,bhrnkd->bhrnqk', qs, kk).astype(jnp.float32) * (Dh ** -0.5)
    qi = jnp.arange(w_sub)[:, None]
    ki = jnp.arange(2 * w_sub)[None, :]
    dist = qi + w_sub - ki
    band = (dist >= 0) & (dist <= w_sub)
    first = (jnp.arange(nb)[:, None, None] > 0) | (ki[None] >= w_sub)
    mask = band[None] & first
    scores = jnp.where(mask, scores, NEG_INF)
    lse = jax.nn.logsumexp(scores, axis=-1)
    p = jnp.exp(scores - lse[..., None])
    out = jnp.einsum('bhrnqk,bhrnkd->bhrnqd', p, vv.astype(jnp.float32))
    out = out.reshape(B, H, dilation, L, Dh).transpose(0, 3, 2, 1, 4).reshape(B, Sp, H, Dh)[:, :S]
    lse = lse.reshape(B, H, dilation, L).transpose(0, 3, 2, 1).reshape(B, Sp, H)[:, :S]
    return out, lse


def causal_depthwise_conv(u, w):
    return lax.conv_general_dilated(
        u, w[:, None, :].astype(u.dtype), window_strides=(1,), padding=[(CONV_K - 1, 0)],
        dimension_numbers=('NWC', 'WIO', 'NWC'), feature_group_count=u.shape[-1])


def setup_inputs(seed: int = 0) -> dict:
    key = jax.random.key(seed)
    ks = jax.random.split(key, 13)
    f32 = jnp.float32
    x = jax.random.normal(ks[0], (BATCH, SEQ, D_MODEL), f32)
    c = jax.random.normal(ks[1], (BATCH, D_MODEL), f32)
    offset = jax.random.randint(ks[2], (BATCH, 1), 0, 1024, dtype=jnp.int32)
    positions = (jnp.arange(SEQ, dtype=jnp.int32)[None, :] + offset).astype(jnp.int32)
    g_pre = 1.0 + 0.05 * jax.random.normal(ks[3], (DEPTH, D_MODEL), f32)
    w_ada = 0.5 * D_MODEL ** -0.5 * jax.random.normal(ks[4], (DEPTH, D_MODEL, 3 * D_MODEL), f32)
    b_ada = 0.02 * jax.random.normal(ks[5], (DEPTH, 3 * D_MODEL), f32)
    w_in = D_MODEL ** -0.5 * jax.random.normal(ks[6], (DEPTH, D_MODEL, PROJ_WIDTH), f32)
    conv_w = CONV_K ** -0.5 * jax.random.normal(ks[7], (DEPTH, CONV_K, CONV_WIDTH), f32)
    w_attn_o = ATTN_OUT_WIDTH ** -0.5 * jax.random.normal(ks[8], (DEPTH, ATTN_OUT_WIDTH, D_MODEL), f32)
    w_conv_o = CONV_WIDTH ** -0.5 * jax.random.normal(ks[9], (DEPTH, CONV_WIDTH, D_MODEL), f32)
    w_o = D_MODEL ** -0.5 * jax.random.normal(ks[10], (DEPTH, D_MODEL, D_MODEL), f32)
    g_post = 1.0 + 0.05 * jax.random.normal(ks[11], (DEPTH, D_MODEL), f32)
    return {"x": x, "c": c, "positions": positions, "g_pre": g_pre, "w_ada": w_ada,
            "b_ada": b_ada, "w_in": w_in, "conv_w": conv_w, "w_attn_o": w_attn_o,
            "w_conv_o": w_conv_o, "w_o": w_o, "g_post": g_post}


def reference(x, c, positions, g_pre, w_ada, b_ada, w_in, conv_w, w_attn_o, w_conv_o, w_o, g_post):
    B, S, _ = x.shape
    cos, sin = rope_tables(positions, x.dtype)
    for l in range(DEPTH):
        mod = (c @ w_ada[l] + b_ada[l])[:, None, :]
        shift, scale, gate = jnp.split(mod, 3, axis=-1)
        h = rms_norm(x, g_pre[l]) * (1.0 + scale) + shift

        proj = h @ w_in[l]
        q, k, v, z_attn, cb, cc, cx, z_conv, g_attn, g_conv = jnp.split(proj, SPLIT_POINTS, axis=-1)

        q = apply_partial_rope(q.reshape(B, S, N_QKV_HEADS, HEAD_DIM), cos, sin)
        k = apply_partial_rope(k.reshape(B, S, N_QKV_HEADS, HEAD_DIM), cos, sin)
        q = q.reshape(B, S, N_GROUPS, HEADS_PER_GROUP, HEAD_DIM)
        k = k.reshape(B, S, N_GROUPS, HEADS_PER_GROUP, HEAD_DIM)
        v = v.reshape(B, S, N_GROUPS, HEADS_PER_GROUP, HEAD_DIM)
        outs, lses = [], []
        for g, (window, dilation) in enumerate(DILATION_GROUPS):
            o_g, lse_g = dilated_window_attention(q[:, :, g], k[:, :, g], v[:, :, g],
                                                  dilation, window // dilation)
            outs.append(o_g)
            lses.append(lse_g)
        alpha = jax.nn.softmax(jnp.stack(lses, axis=0), axis=0)
        o = jnp.sum(alpha[..., None] * jnp.stack(outs, axis=0), axis=0)
        o = o.astype(x.dtype).reshape(B, S, ATTN_OUT_WIDTH)
        y_attn = (o * jax.nn.silu(z_attn)) @ w_attn_o[l]

        u = causal_depthwise_conv(cc * cx, conv_w[l])
        y_conv = (cb * u * jax.nn.silu(z_conv)) @ w_conv_o[l]

        merged = jax.nn.sigmoid(g_attn) * y_attn + jax.nn.sigmoid(g_conv) * y_conv
        y = merged @ w_o[l]
        x = x + gate * rms_norm(y, g_post[l])
    return x
```

```cpp
#include <hip/hip_runtime.h>
#include <cstdio>
#include <cstdint>

#define GAS __attribute__((address_space(1)))
#define LAS __attribute__((address_space(3)))
typedef unsigned short bf16_t;
typedef short bf16x8 __attribute__((ext_vector_type(8)));
typedef short s16x4 __attribute__((ext_vector_type(4)));
typedef float f32x4 __attribute__((ext_vector_type(4)));
typedef float f32x2 __attribute__((ext_vector_type(2)));
typedef unsigned u32x4 __attribute__((ext_vector_type(4)));
typedef unsigned u32x2 __attribute__((ext_vector_type(2)));

constexpr int M = 16384, D = 2048, NQKV = 3072, NZA = 1024, NCV = 2048, PROJ = 22528, NMOD = 6144;
constexpr float EPS = 1e-6f;
constexpr float LOG2E = 1.4426950408889634f;
constexpr float QSCALE = 0.08838834764831845f * 1.4426950408889634f;

__constant__ float INVF[16] = {1.0f, 0.44036659598350525f, 0.1939227432012558f, 0.08539710193872452f, 0.03760603070259094f, 0.016560440883040428f,
    0.007292664609849453f, 0.0032114461064338684f, 0.0014142135623842478f, 0.0006227724370546639f, 0.00027424818836152554f, 0.00012076973507646471f,
    5.3182957344688475e-05f, 2.34199997066753e-05f, 1.0313385246263351e-05f, 4.541670477919979e-06f};

__device__ __forceinline__ unsigned cvt_pk_bf16(float lo, float hi) { unsigned r; asm volatile("v_cvt_pk_bf16_f32 %0, %1, %2" : "=v"(r) : "v"(lo), "v"(hi)); return r; }
__device__ __forceinline__ float bf_lo(unsigned w) { return __builtin_bit_cast(float, w << 16); }
__device__ __forceinline__ float bf_hi(unsigned w) { return __builtin_bit_cast(float, w & 0xffff0000u); }
__device__ __forceinline__ float silu_f(float v) { return v * __builtin_amdgcn_rcpf(1.0f + __builtin_amdgcn_exp2f(-v * LOG2E)); }
__device__ __forceinline__ float sigm_f(float v) { return __builtin_amdgcn_rcpf(1.0f + __builtin_amdgcn_exp2f(-v * LOG2E)); }

namespace pg8 {
constexpr int BM = 256, BK = 64, HALF = 128, HTB = HALF * BK * 2, STAGE_BYTES = 8 * HTB, NXCD = 8, WGM = 8;
__host__ __device__ __forceinline__ int lds_byte(int r, int c) { const int st = (r >> 4) * 2 + (c >> 5), rr = r & 15, cc = c & 31, ob = rr * 64 + cc * 2; return st * 1024 + (ob ^ (((ob >> 9) & 1) << 5)); }
__host__ __device__ __forceinline__ void stage_rc(int b, int& R, int& C) { const int st = b / 1024, sb = b % 1024, swz = sb ^ (((sb >> 9) & 1) << 5); R = (st >> 1) * 16 + swz / 64; C = (st & 1) * 32 + (swz % 64) / 2; }
__host__ __device__ __forceinline__ int perm32(int rho) { const int n = rho >> 4, i = rho & 15; return 8 * (i >> 2) + 4 * n + (i & 3); }

struct Unit { int pm, pn; };
struct Gemm { const bf16_t* A; const bf16_t* Bt; int M, N, K; };

struct StaticOrder {
    int nM, nN, nwg, G, c;
    __host__ __device__ void init(int M_, int N_, int G_, int c_) { nM = M_ / BM; nN = N_ / BM; nwg = nM * nN; G = G_; c = c_; }
    __host__ __device__ bool next(int i, Unit& u) const {
        const long L = (long)i * G + c; if (L >= nwg) return false;
        int wgid = (int)L; { const int q = nwg / NXCD, r = nwg % NXCD, xcd = wgid % NXCD, off = wgid / NXCD; wgid = (xcd < r ? xcd * (q + 1) : r * (q + 1) + (xcd - r) * q) + off; }
        const int nig = WGM * nN, gid = wgid / nig, fm = gid * WGM, gsz = (nM - fm) < WGM ? (nM - fm) : WGM;
        u.pm = fm + ((wgid % nig) % gsz); u.pn = (wgid % nig) / gsz; return true;
    }
    __device__ __forceinline__ void a_ready(const Unit&) const {}
    __device__ __forceinline__ void done(const Unit&) const {}
};


template <class Epi, class Sched, bool ALIGN_EPI = false, bool SP2 = false>
__device__ __forceinline__ void gemm_phase(LAS unsigned char* lds, const Gemm g, const Sched& S, const Epi& E) {
    const int tid = threadIdx.x, wid = __builtin_amdgcn_readfirstlane(tid >> 6), lane = tid & 63, wr = wid >> 2, wc = wid & 3, fr = lane & 15, fq = lane >> 4;
    const int K = g.K, nt = K / BK;
    unsigned voffA[2], voffB[2];
#pragma unroll
    for (int i = 0; i < 2; ++i) { int R, C; stage_rc(tid * 16 + i * 8192, R, C); const int Rb = Epi::PERM ? ((R & ~31) + perm32(R & 31)) : R;
        voffA[i] = (unsigned)(R * K + C) * 2u; voffB[i] = (unsigned)(Rb * K + C) * 2u; }
    const size_t kstep = (size_t)(BK * 2);
    const size_t hstep = (size_t)HALF * K * 2;
    const size_t tstep = 2 * hstep;
    const unsigned ldsw = (unsigned)wid * 1024u;
    const int aoff = lds_byte(wr * 64 + fr, fq * 8), boff = lds_byte(wc * 32 + fr, fq * 8);
#define PG8_SA(b, h) (((b) * 2 + (h)) * HTB)
#define PG8_SB(b, h) ((4 + (b) * 2 + (h)) * HTB)
#define PG8_STAGE(bufoff, gbase, voff) do { _Pragma("unroll") for (int _i = 0; _i < 2; ++_i) \
        __builtin_amdgcn_global_load_lds((const unsigned*)((const char*)(gbase) + (voff)[_i]), (LAS unsigned*)(lds + (bufoff) + ldsw + _i * 8192), 16, 0, 0); } while (0)
#define PG8_LDA(dst, b, h) do { _Pragma("unroll") for (int m = 0; m < 4; ++m) _Pragma("unroll") for (int k = 0; k < 2; ++k) dst[m][k] = *(const LAS bf16x8*)(lds + PG8_SA(b, h) + aoff + m * 2048 + k * 1024); } while (0)
#define PG8_LDB(dst, b, h) do { _Pragma("unroll") for (int n = 0; n < 2; ++n) _Pragma("unroll") for (int k = 0; k < 2; ++k) dst[n][k] = *(const LAS bf16x8*)(lds + PG8_SB(b, h) + boff + n * 2048 + k * 1024); } while (0)
#define PG8_MMA(ai, bj, At, Bt) do { __builtin_amdgcn_s_setprio(1); _Pragma("unroll") for (int m = 0; m < 4; ++m) _Pragma("unroll") for (int n = 0; n < 2; ++n) _Pragma("unroll") for (int k = 0; k < 2; ++k) \
        acc[ai][bj][m][n] = __builtin_amdgcn_mfma_f32_16x16x32_bf16(Bt[n][k], At[m][k], acc[ai][bj][m][n], 0, 0, 0); __builtin_amdgcn_s_setprio(0); } while (0)
#define PG8_WAIT_V(n) asm volatile("s_waitcnt vmcnt(" #n ")" ::: "memory")
#define PG8_WAIT_L(n) asm volatile("s_waitcnt lgkmcnt(" #n ")" ::: "memory")
#define PG8_BAR __builtin_amdgcn_s_barrier()
#define PG8_SCHED __builtin_amdgcn_sched_barrier(0)
    Unit cur, nxt; int ui = 0;
    if (!S.next(0, cur)) return;
    f32x4 acc[2][2][4][2];
#pragma unroll
    for (int a = 0; a < 2; ++a)
#pragma unroll
        for (int b = 0; b < 2; ++b)
#pragma unroll
            for (int m = 0; m < 4; ++m)
#pragma unroll
                for (int n = 0; n < 2; ++n) acc[a][b][m][n] = (f32x4){0.f, 0.f, 0.f, 0.f};
    bf16x8 At[4][2], B0[2][2], B1[2][2];
    const char* cA = (const char*)g.A + (size_t)cur.pm * tstep; const char* cB = (const char*)g.Bt + (size_t)cur.pn * tstep;
    S.a_ready(cur);
    if constexpr (SP2) {
        PG8_STAGE(PG8_SB(0, 0), cB, voffB); PG8_STAGE(PG8_SB(0, 1), cB + hstep, voffB); PG8_STAGE(PG8_SA(0, 0), cA, voffA); PG8_STAGE(PG8_SA(0, 1), cA + hstep, voffA);
        if (wr == 1) PG8_BAR;
        PG8_WAIT_V(2); PG8_BAR;
        PG8_STAGE(PG8_SB(1, 0), cB + kstep, voffB); PG8_STAGE(PG8_SA(1, 0), cA + kstep, voffA); PG8_STAGE(PG8_SB(1, 1), cB + hstep + kstep, voffB);
        PG8_WAIT_V(6); PG8_BAR;
    } else {
        PG8_STAGE(PG8_SB(0, 0), cB, voffB); PG8_STAGE(PG8_SA(0, 0), cA, voffA); PG8_STAGE(PG8_SB(0, 1), cB + hstep, voffB); PG8_STAGE(PG8_SA(0, 1), cA + hstep, voffA);
        if (wr == 1) PG8_BAR;
        PG8_WAIT_V(4); PG8_BAR;
        PG8_STAGE(PG8_SB(1, 0), cB + kstep, voffB); PG8_STAGE(PG8_SA(1, 0), cA + kstep, voffA); PG8_STAGE(PG8_SB(1, 1), cB + hstep + kstep, voffB);
        PG8_WAIT_V(6); PG8_BAR;
    }
    for (;;) {
        const bool has_next = S.next(ui + 1, nxt);
        const char* nA = has_next ? (const char*)g.A + (size_t)nxt.pm * tstep : cA; const char* nB = has_next ? (const char*)g.Bt + (size_t)nxt.pn * tstep : cB;
        for (int t = 0; t < nt; t += 2) {
            const bool last = (t == nt - 2);
            const char* a1 = cA + (size_t)(t + 1) * kstep;
            const char* a2 = last ? nA : cA + (size_t)(t + 2) * kstep; const char* b2 = last ? nB : cB + (size_t)(t + 2) * kstep;
            const char* a3 = a2 + kstep; const char* b3 = b2 + kstep;
            if (last && has_next) S.a_ready(nxt);
            if constexpr (SP2) {
            PG8_LDB(B0, 0, 0); PG8_LDB(B1, 0, 1); PG8_SCHED; PG8_LDA(At, 0, 0); PG8_STAGE(PG8_SA(1, 1), a1 + hstep, voffA);
            PG8_WAIT_V(8); PG8_WAIT_L(0); PG8_BAR; PG8_MMA(0, 0, At, B0); PG8_MMA(0, 1, At, B1); PG8_BAR; PG8_SCHED;
            PG8_LDA(At, 0, 1); PG8_STAGE(PG8_SB(0, 0), b2, voffB); PG8_STAGE(PG8_SB(0, 1), b2 + hstep, voffB); PG8_STAGE(PG8_SA(0, 0), a2, voffA);
            PG8_WAIT_V(8); PG8_WAIT_L(0); PG8_BAR; PG8_MMA(1, 0, At, B0); PG8_MMA(1, 1, At, B1); PG8_BAR; PG8_SCHED;
            PG8_LDB(B0, 1, 0); PG8_LDB(B1, 1, 1); PG8_SCHED; PG8_LDA(At, 1, 0); PG8_STAGE(PG8_SA(0, 1), a2 + hstep, voffA);
            PG8_WAIT_V(8); PG8_WAIT_L(0); PG8_BAR; PG8_MMA(0, 0, At, B0); PG8_MMA(0, 1, At, B1); PG8_BAR; PG8_SCHED;
            PG8_LDA(At, 1, 1); PG8_STAGE(PG8_SB(1, 0), b3, voffB); PG8_STAGE(PG8_SB(1, 1), b3 + hstep, voffB); PG8_STAGE(PG8_SA(1, 0), a3, voffA);
            PG8_WAIT_V(8); PG8_WAIT_L(0); PG8_BAR; PG8_MMA(1, 0, At, B0); PG8_MMA(1, 1, At, B1); PG8_BAR; PG8_SCHED;
            } else {
            PG8_LDB(B0, 0, 0); PG8_SCHED; PG8_LDA(At, 0, 0); PG8_STAGE(PG8_SA(1, 1), a1 + hstep, voffA);
            PG8_WAIT_L(8); PG8_BAR; PG8_WAIT_L(0); PG8_MMA(0, 0, At, B0); PG8_BAR; PG8_SCHED;
            PG8_LDB(B1, 0, 1); PG8_STAGE(PG8_SB(0, 0), b2, voffB);
            PG8_BAR; PG8_WAIT_L(0); PG8_MMA(0, 1, At, B1); PG8_BAR;
            PG8_LDA(At, 0, 1); PG8_STAGE(PG8_SA(0, 0), a2, voffA);
            PG8_BAR; PG8_WAIT_L(0); PG8_MMA(1, 0, At, B0); PG8_BAR; PG8_SCHED;
            PG8_STAGE(PG8_SB(0, 1), b2 + hstep, voffB);
            PG8_WAIT_V(6); PG8_BAR; PG8_MMA(1, 1, At, B1); PG8_BAR;
            PG8_LDB(B0, 1, 0); PG8_SCHED; PG8_LDA(At, 1, 0); PG8_STAGE(PG8_SA(0, 1), a2 + hstep, voffA);
            PG8_WAIT_L(8); PG8_BAR; PG8_WAIT_L(0); PG8_MMA(0, 0, At, B0); PG8_BAR; PG8_SCHED;
            PG8_LDB(B1, 1, 1); PG8_STAGE(PG8_SB(1, 0), b3, voffB);
            PG8_BAR; PG8_WAIT_L(0); PG8_MMA(0, 1, At, B1); PG8_BAR;
            PG8_LDA(At, 1, 1); PG8_STAGE(PG8_SA(1, 0), a3, voffA);
            PG8_BAR; PG8_WAIT_L(0); PG8_MMA(1, 0, At, B0); PG8_BAR; PG8_SCHED;
            PG8_STAGE(PG8_SB(1, 1), b3 + hstep, voffB);
            PG8_WAIT_V(6); PG8_BAR; PG8_MMA(1, 1, At, B1); PG8_BAR;
            }
        }
        if constexpr (ALIGN_EPI) { if (wr == 0) PG8_BAR; }
        E(acc, cur, wr, wc, fr, fq); S.done(cur);
        if (!has_next) break;
#pragma unroll
        for (int a = 0; a < 2; ++a)
#pragma unroll
            for (int b = 0; b < 2; ++b)
#pragma unroll
                for (int m = 0; m < 4; ++m)
#pragma unroll
                    for (int n = 0; n < 2; ++n) acc[a][b][m][n] = (f32x4){0.f, 0.f, 0.f, 0.f};
        cur = nxt; cA = nA; cB = nB; ++ui;
        if constexpr (ALIGN_EPI) { if (wr == 1) PG8_BAR; }
    }
    PG8_WAIT_V(0);
    if constexpr (!ALIGN_EPI) { if (wr == 0) PG8_BAR; }
    PG8_BAR;
#undef PG8_SA
#undef PG8_SB
#undef PG8_STAGE
#undef PG8_LDA
#undef PG8_LDB
#undef PG8_MMA
#undef PG8_WAIT_V
#undef PG8_WAIT_L
#undef PG8_BAR
#undef PG8_SCHED
}

__device__ __forceinline__ u32x4 pack8(const f32x4 v0, const f32x4 v1) { u32x4 w; w.x = cvt_pk_bf16(v0[0], v0[1]); w.y = cvt_pk_bf16(v0[2], v0[3]); w.z = cvt_pk_bf16(v1[0], v1[1]); w.w = cvt_pk_bf16(v1[2], v1[3]); return w; }
__device__ __forceinline__ void unpack8(const u32x4 w, f32x4& v0, f32x4& v1) { v0 = (f32x4){bf_lo(w.x), bf_hi(w.x), bf_lo(w.y), bf_hi(w.y)}; v1 = (f32x4){bf_lo(w.z), bf_hi(w.z), bf_lo(w.w), bf_hi(w.w)}; }

struct EpiProj {
    static constexpr bool PERM = true;
    bf16_t *Q, *Kb, *V, *SZ, *P, *QC, *SGA, *SGC; const float* cs;
    __device__ __forceinline__ void operator()(const f32x4 (&acc)[2][2][4][2], const Unit& u, int wr, int wc, int fr, int fq) const {
        const int pn = u.pn; const int row0 = u.pm * BM + wr * 64 + fr; const int lc = wc * 32 + 8 * fq;
        if (pn < 24) {
            const bool isq = pn < 12; bf16_t* base = isq ? Q : Kb; const int colt = (isq ? pn : pn - 12) * BM; const float sc = isq ? QSCALE : 1.0f;
#pragma unroll
            for (int ai = 0; ai < 2; ++ai)
#pragma unroll
                for (int m = 0; m < 4; ++m) {
                    const int row = row0 + ai * HALF + m * 16;
                    f32x4 v[2][2];
#pragma unroll
                    for (int bj = 0; bj < 2; ++bj)
#pragma unroll
                        for (int n = 0; n < 2; ++n) v[bj][n] = acc[ai][bj][m][n];
                    if (wc == 0) {
                        const float* cr = cs + (size_t)row * 32 + 8 * (fq & 1);
                        f32x4 c0 = *(const f32x4*)cr, c1 = *(const f32x4*)(cr + 4), s0 = *(const f32x4*)(cr + 16), s1 = *(const f32x4*)(cr + 20);
                        if (fq < 2) { s0 = -s0; s1 = -s1; }
#pragma unroll
                        for (int bj = 0; bj < 2; ++bj) {
                            f32x4 o0, o1;
#pragma unroll
                            for (int j = 0; j < 4; ++j) { o0[j] = __shfl_xor(v[bj][0][j], 32); o1[j] = __shfl_xor(v[bj][1][j], 32); }
                            v[bj][0] = v[bj][0] * c0 + o0 * s0; v[bj][1] = v[bj][1] * c1 + o1 * s1;
                        }
                    }
                    bf16_t* rowp = base + (size_t)row * NQKV + colt + lc;
#pragma unroll
                    for (int bj = 0; bj < 2; ++bj) *(u32x4*)(rowp + bj * HALF) = pack8(v[bj][0] * sc, v[bj][1] * sc);
                    asm volatile("" ::: "memory");
                }
        } else if (pn < 36) {
            const int colt = (pn - 24) * BM;
#pragma unroll
            for (int ai = 0; ai < 2; ++ai)
#pragma unroll
                for (int m = 0; m < 4; ++m) { bf16_t* rowp = V + (size_t)(row0 + ai * HALF + m * 16) * NQKV + colt + lc;
#pragma unroll
                    for (int bj = 0; bj < 2; ++bj) *(u32x4*)(rowp + bj * HALF) = pack8(acc[ai][bj][m][0], acc[ai][bj][m][1]); }
        } else if (pn < 40) {
            const int colt = (pn - 36) * BM;
#pragma unroll
            for (int ai = 0; ai < 2; ++ai)
#pragma unroll
                for (int m = 0; m < 4; ++m) { bf16_t* rowp = SZ + (size_t)(row0 + ai * HALF + m * 16) * NZA + colt + lc;
#pragma unroll
                    for (int bj = 0; bj < 2; ++bj) { f32x4 a = acc[ai][bj][m][0], b = acc[ai][bj][m][1];
#pragma unroll
                        for (int j = 0; j < 4; ++j) { a[j] = silu_f(a[j]); b[j] = silu_f(b[j]); }
                        *(u32x4*)(rowp + bj * HALF) = pack8(a, b); } }
        } else if (pn < 72) {
            const int chb = 64 * (pn - 40) + 16 * wc + 4 * fq;
#pragma unroll
            for (int ai = 0; ai < 2; ++ai)
#pragma unroll
                for (int m = 0; m < 4; ++m) { const size_t ro = (size_t)(row0 + ai * HALF + m * 16) * NCV + chb;
                    const f32x4 cb = acc[ai][0][m][0], cc = acc[ai][0][m][1], cx = acc[ai][1][m][0], z = acc[ai][1][m][1];
                    f32x4 pv = cc * cx, qv;
#pragma unroll
                    for (int j = 0; j < 4; ++j) qv[j] = cb[j] * silu_f(z[j]);
                    u32x2 pw, qw; pw.x = cvt_pk_bf16(pv[0], pv[1]); pw.y = cvt_pk_bf16(pv[2], pv[3]); qw.x = cvt_pk_bf16(qv[0], qv[1]); qw.y = cvt_pk_bf16(qv[2], qv[3]);
                    *(u32x2*)(P + ro) = pw; *(u32x2*)(QC + ro) = qw; }
        } else {
            const bool isa = pn < 80; bf16_t* base = isa ? SGA : SGC; const int colt = (isa ? pn - 72 : pn - 80) * BM;
#pragma unroll
            for (int ai = 0; ai < 2; ++ai)
#pragma unroll
                for (int m = 0; m < 4; ++m) { bf16_t* rowp = base + (size_t)(row0 + ai * HALF + m * 16) * D + colt + lc;
#pragma unroll
                    for (int bj = 0; bj < 2; ++bj) { f32x4 a = acc[ai][bj][m][0], b = acc[ai][bj][m][1];
#pragma unroll
                        for (int j = 0; j < 4; ++j) { a[j] = sigm_f(a[j]); b[j] = sigm_f(b[j]); }
                        *(u32x4*)(rowp + bj * HALF) = pack8(a, b); } }
        }
    }
};
template <bool ADD> struct EpiGate {
    static constexpr bool PERM = true;
    bf16_t* O; const bf16_t* G1; const bf16_t* T; int ldc;
    __device__ __forceinline__ void operator()(const f32x4 (&acc)[2][2][4][2], const Unit& u, int wr, int wc, int fr, int fq) const {
        const int row0 = u.pm * BM + wr * 64 + fr, col0 = u.pn * BM + wc * 32 + 8 * fq;
#pragma unroll
        for (int ai = 0; ai < 2; ++ai)
#pragma unroll
            for (int m = 0; m < 4; ++m) { const size_t ro = (size_t)(row0 + ai * HALF + m * 16) * ldc + col0;
#pragma unroll
                for (int bj = 0; bj < 2; ++bj) {
                    const u32x4 gw = *(const u32x4*)(G1 + ro + bj * HALF); f32x4 g0, g1; unpack8(gw, g0, g1);
                    f32x4 v0 = acc[ai][bj][m][0] * g0, v1 = acc[ai][bj][m][1] * g1;
                    if (ADD) { const u32x4 tw = *(const u32x4*)(T + ro + bj * HALF); f32x4 t0, t1; unpack8(tw, t0, t1); v0 += t0; v1 += t1; }
                    *(u32x4*)(O + ro + bj * HALF) = pack8(v0, v1); }
                asm volatile("" ::: "memory"); }
    }
};
struct EpiF32 {
    static constexpr bool PERM = false;
    float* C; int ldc;
    __device__ __forceinline__ void operator()(const f32x4 (&acc)[2][2][4][2], const Unit& u, int wr, int wc, int fr, int fq) const {
        const int row0 = u.pm * BM + wr * 64 + fr, col0 = u.pn * BM + wc * 32 + 4 * fq;
#pragma unroll
        for (int ai = 0; ai < 2; ++ai)
#pragma unroll
            for (int m = 0; m < 4; ++m) { float* rowp = C + (size_t)(row0 + ai * HALF + m * 16) * ldc + col0;
#pragma unroll
                for (int bj = 0; bj < 2; ++bj)
#pragma unroll
                    for (int n = 0; n < 2; ++n) *(f32x4*)(rowp + bj * HALF + n * 16) = acc[ai][bj][m][n]; }
    }
};
}

#ifndef PG8_SP2
#define PG8_SP2 true
#endif
#ifndef PG8_ALIGN
#define PG8_ALIGN true
#endif

constexpr int NWAVES = 8;
#ifndef MK_N_LAUNCHES
#define MK_N_LAUNCHES 1
#endif
constexpr int NPHASES = 9;
constexpr int N_LAUNCHES = MK_N_LAUNCHES;

constexpr size_t MiB = 1u << 20;
constexpr size_t WS_CTL = 0, CTL_ZERO_BYTES = 1 * MiB;
constexpr size_t WS_MOD = 1 * MiB;
constexpr size_t WS_CS = 2 * MiB;
constexpr size_t WS_WIN = 4 * MiB;
constexpr size_t WS_WA = 92 * MiB, WS_WC = 96 * MiB, WS_WO = 104 * MiB;
constexpr size_t WS_H = 112 * MiB;
constexpr size_t WS_Q = 176 * MiB, WS_K = 272 * MiB, WS_V = 368 * MiB;
constexpr size_t WS_SZ = 464 * MiB;
constexpr size_t WS_P = 496 * MiB, WS_QC = 560 * MiB;
constexpr size_t WS_O2 = 624 * MiB;
constexpr size_t WS_LSE = 656 * MiB;
constexpr size_t WS_END = 658 * MiB;
constexpr size_t WS_O0 = 112 * MiB, WS_O1 = 144 * MiB;
constexpr size_t WS_AATT = 176 * MiB, WS_R = 208 * MiB, WS_T = 272 * MiB, WS_MG = 336 * MiB;
constexpr int CW_BAR = 4096;
#define XCD_BAR_WORDS 3456

constexpr int RING_BYTES = 131072;
constexpr int LDSCTL_OFF = RING_BYTES, MISC_OFF = LDSCTL_OFF + 320;
constexpr int LDS_BYTES = 147456;

typedef GAS unsigned gu32;
#define RLX_AGENT __ATOMIC_RELAXED, __HIP_MEMORY_SCOPE_AGENT

#define XB_TMO      128
#define XB_XCNT(j)  (256  + 64 * (j))
#define XB_XSUB(j)  (1280 + 64 * (j))
#define XB_XGEN(j)  (2304 + 64 * (j))
#define XB_TOP      3328
#define XB_TOPGEN   3392
#define XB_SPIN_CAP (1u << 18)

__device__ __forceinline__ unsigned xb_ld(unsigned* p)              { return __hip_atomic_load(p, __ATOMIC_RELAXED, __HIP_MEMORY_SCOPE_AGENT); }
__device__ __forceinline__ unsigned xb_add(unsigned* p, unsigned v) { return __hip_atomic_fetch_add(p, v, __ATOMIC_RELAXED, __HIP_MEMORY_SCOPE_AGENT); }
__device__ __forceinline__ unsigned xb_xcc_id() { return (unsigned)__builtin_amdgcn_s_getreg((3 << 11) | 20) & 0xFu; }
#define XB_SPIN(cond, bar) do { unsigned _sp = 0; while (cond) { __builtin_amdgcn_s_sleep(1); \
    if ((++_sp & 255u) == 0u) { if (xb_ld(&(bar)[XB_TMO])) break; if (_sp > XB_SPIN_CAP) { atomicAdd(&(bar)[XB_TMO], 1u); break; } } } } while (0)

struct XcdBarrier { unsigned* bar; unsigned x; volatile LAS unsigned* st; };

__device__ __forceinline__ XcdBarrier xcd_barrier_post(unsigned* bar, volatile LAS unsigned* st) {
    XcdBarrier b; b.bar = bar; b.x = xb_xcc_id(); b.st = st;
    if (threadIdx.x == 0) (void)xb_add(&bar[XB_XCNT(b.x)], 1u);
    return b;
}
__device__ __forceinline__ void xcd_barrier_complete(unsigned* bar, unsigned x, unsigned& nloc, unsigned& nx) {
    const unsigned G = gridDim.x * gridDim.y * gridDim.z;
    unsigned sum, cnt, mine, sp = 0u;
    for (;;) {
        sum = 0u; cnt = 0u; mine = 0u;
#pragma unroll
        for (unsigned j = 0; j < 16; ++j) { const unsigned c = xb_ld(&bar[XB_XCNT(j)]); sum += c; cnt += (c > 0u) ? 1u : 0u; mine = (j == x) ? c : mine; }
        if (sum == G) break;
        __builtin_amdgcn_s_sleep(1);
        if ((++sp & 255u) == 0u) { if (xb_ld(&bar[XB_TMO])) break; if (sp > XB_SPIN_CAP) { atomicAdd(&bar[XB_TMO], 1u); break; } }
    }
    nloc = mine > 0u ? mine : 1u; nx = cnt > 0u ? cnt : 1u;
}
__device__ __forceinline__ void xcd_barrier(const XcdBarrier& b) {
    asm volatile("s_waitcnt vmcnt(0)" ::: "memory");
    __syncthreads();
    if (threadIdx.x == 0) {
        unsigned* bar = b.bar;
        __builtin_amdgcn_s_waitcnt(0);
        unsigned nloc = b.st[0], nx = b.st[1];
        if (nloc == 0u) { xcd_barrier_complete(bar, b.x, nloc, nx); b.st[0] = nloc; b.st[1] = nx; }
        const unsigned old = xb_add(&bar[XB_XSUB(b.x)], 1u);
        const unsigned gen = old / nloc;
        if (old + 1u == (gen + 1u) * nloc) {
            __builtin_amdgcn_fence(__ATOMIC_RELEASE, "agent");
            asm volatile("s_waitcnt vmcnt(0)" ::: "memory");
            const unsigned og = xb_add(&bar[XB_TOP], 1u);
            const unsigned tg = og / nx;
            if (og + 1u == (tg + 1u) * nx) xb_add(&bar[XB_TOPGEN], 1u);
            else XB_SPIN(xb_ld(&bar[XB_TOPGEN]) == tg, bar);
            __builtin_amdgcn_fence(__ATOMIC_ACQUIRE, "agent");
            xb_add(&bar[XB_XGEN(b.x)], 1u);
            asm volatile("s_waitcnt vmcnt(0)" ::: "memory");
        } else {
            XB_SPIN(xb_ld(&bar[XB_XGEN(b.x)]) == gen, bar);
            __builtin_amdgcn_fence(__ATOMIC_ACQUIRE, "agent");
            asm volatile("s_waitcnt vmcnt(0)" ::: "memory");
        }
    }
    __syncthreads();
}

#define LDS_WAIT() asm volatile("s_waitcnt lgkmcnt(0)" ::: "memory")
__device__ __forceinline__ float wave_sum(float v) {
#pragma unroll
    for (int o = 1; o < 64; o <<= 1) v += __shfl_xor(v, o);
    return v;
}
__device__ __forceinline__ unsigned f2bf(float f) { unsigned u = __builtin_bit_cast(unsigned, f); return (u + 0x7fffu + ((u >> 16) & 1u)) >> 16; }
__device__ __forceinline__ unsigned pk2(float lo, float hi) { return f2bf(lo) | (f2bf(hi) << 16); }

__device__ __forceinline__ int proj_orig_col(int n) {
    const int tile = n >> 8, c = n & 255;
    if (tile < 40) return n;
    if (tile < 72) { const int kind = 2 * (c >> 7) + ((c >> 2) & 1), chl = 16 * ((c >> 5) & 3) + 4 * ((c >> 3) & 3) + (c & 3); return 10240 + kind * 2048 + 64 * (tile - 40) + chl; }
    return 18432 + (n - 72 * 256);
}
template <bool REMAP>
__device__ __forceinline__ void p0_transpose_item(const float* W, int K, int N, bf16_t* WT, LAS float* scr, int item, int lane) {
    const int nblk = N / 32, kb = item / nblk, nb = item % nblk, k0 = 64 * kb, n0 = 32 * nb;
    const int ncol = REMAP ? proj_orig_col(n0 + (lane & 31)) : n0 + (lane & 31);
#pragma unroll 8
    for (int i = 0; i < 32; ++i) { const int kk = 2 * i + (lane >> 5); scr[kk * 33 + (lane & 31)] = W[(size_t)(k0 + kk) * N + ncol]; }
    LDS_WAIT(); asm volatile("" ::: "memory");
    const int c = lane & 7;
#pragma unroll
    for (int j = 0; j < 4; ++j) { const int n = (lane >> 3) + 8 * j; const LAS float* s = scr + (8 * c) * 33 + n;
        u32x4 o; o.x = pk2(s[0 * 33], s[1 * 33]); o.y = pk2(s[2 * 33], s[3 * 33]); o.z = pk2(s[4 * 33], s[5 * 33]); o.w = pk2(s[6 * 33], s[7 * 33]);
        *(u32x4*)(WT + (size_t)(n0 + n) * K + k0 + 8 * c) = o; }
    LDS_WAIT(); asm volatile("" ::: "memory");
}

__device__ __forceinline__ void sincos_f64(float ang, float& s, float& c) {
    const double x = (double)ang;
    const double n = __builtin_rint(x * 0.15915494309189535);
    double r = __builtin_fma(-n, 6.283185307179586, x); r = __builtin_fma(-n, 2.4492935982947064e-16, r);
    const double r2 = r * r;
    double ps = 1.0 / 51090942171709440000.0;
    ps = __builtin_fma(ps, r2, -1.0 / 121645100408832000.0);
    ps = __builtin_fma(ps, r2, 1.0 / 355687428096000.0);
    ps = __builtin_fma(ps, r2, -1.0 / 1307674368000.0);
    ps = __builtin_fma(ps, r2, 1.0 / 6227020800.0);
    ps = __builtin_fma(ps, r2, -1.0 / 39916800.0);
    ps = __builtin_fma(ps, r2, 1.0 / 362880.0);
    ps = __builtin_fma(ps, r2, -1.0 / 5040.0);
    ps = __builtin_fma(ps, r2, 1.0 / 120.0);
    ps = __builtin_fma(ps, r2, -1.0 / 6.0);
    ps = __builtin_fma(ps, r2, 1.0);
    double pc = -1.0 / 1124000727777607680000.0;
    pc = __builtin_fma(pc, r2, 1.0 / 2432902008176640000.0);
    pc = __builtin_fma(pc, r2, -1.0 / 6402373705728000.0);
    pc = __builtin_fma(pc, r2, 1.0 / 20922789888000.0);
    pc = __builtin_fma(pc, r2, -1.0 / 87178291200.0);
    pc = __builtin_fma(pc, r2, 1.0 / 479001600.0);
    pc = __builtin_fma(pc, r2, -1.0 / 3628800.0);
    pc = __builtin_fma(pc, r2, 1.0 / 40320.0);
    pc = __builtin_fma(pc, r2, -1.0 / 720.0);
    pc = __builtin_fma(pc, r2, 1.0 / 24.0);
    pc = __builtin_fma(pc, r2, -0.5);
    pc = __builtin_fma(pc, r2, 1.0);
    s = (float)(r * ps); c = (float)pc;
}

__device__ __forceinline__ unsigned attn_offk(unsigned row, unsigned ch) { return 256u * row + 16u * (ch ^ (row & 15u)); }
__device__ __forceinline__ unsigned attn_offv(unsigned row, unsigned ch) { return 256u * row + 16u * (ch ^ (((row & 3u) << 2) | ((row >> 2) & 3u))); }
__device__ __forceinline__ unsigned attn_lrow(unsigned k) { return (k & ~31u) | (((k >> 2) & 3u) << 3) | (((k >> 4) & 1u) << 2) | (k & 3u); }

__device__ __forceinline__ void attn_phase(LAS unsigned char* lds, const bf16_t* Qb, const bf16_t* Kb, const bf16_t* Vb, bf16_t* O0, bf16_t* O1, bf16_t* O2, float* LSE, int G, int vcu) {
    const int tid = threadIdx.x, lane = tid & 63, wid = __builtin_amdgcn_readfirstlane(tid >> 6), fr = lane & 15, fq = lane >> 4;
    LAS unsigned char* ldsK = lds; LAS unsigned char* ldsV = lds + 65536;
    const int NU = 3072, per = (NU + G - 1) / G;
    const int u_lo = vcu * per, u_hi = (u_lo + per) < NU ? (u_lo + per) : NU;
    for (int uid = u_lo; uid < u_hi; ++uid) {
        const int g = uid >> 10, rem = uid & 1023, hh = rem >> 7, rem2 = rem & 127;
        const int dsh = 2 * g, d = 1 << dsh;
        const int nbs = 7 - dsh;
        const int r = rem2 >> nbs, n = rem2 & ((1 << nbs) - 1);
        const size_t colb = (size_t)(g * 1024 + hh * 128) * 2;
        {
            const int ch = tid & 15, rb = tid >> 4;
            u32x4 kreg[8], vreg[8];
#pragma unroll
            for (int i = 0; i < 8; ++i) { const int kr = rb + 32 * i; int lp = 128 * (n - 1) + kr; lp = lp < 0 ? 0 : lp; const size_t p = ((size_t)lp << dsh) + r;
                const size_t off = p * (size_t)(NQKV * 2) + colb + ch * 16;
                kreg[i] = *(const u32x4*)((const char*)Kb + off); vreg[i] = *(const u32x4*)((const char*)Vb + off); }
#pragma unroll
            for (int i = 0; i < 8; ++i) { const unsigned kr = rb + 32 * i;
                *(LAS u32x4*)(ldsK + attn_offk(kr, ch)) = kreg[i]; *(LAS u32x4*)(ldsV + attn_offv(attn_lrow(kr), ch)) = vreg[i]; }
        }
        const int lq = 128 * n + 16 * wid + fr; const size_t pq = ((size_t)lq << dsh) + r;
        bf16x8 qf[4];
        { const bf16x8* qp = (const bf16x8*)((const char*)Qb + pq * (size_t)(NQKV * 2) + colb + fq * 16);
#pragma unroll
          for (int s = 0; s < 4; ++s) qf[s] = qp[4 * s]; }
        __syncthreads();
        f32x4 S[9];
#pragma unroll
        for (int t = 0; t < 9; ++t) {
            S[t] = (f32x4){0.f, 0.f, 0.f, 0.f};
            const unsigned row = 16 * wid + 16 * t + fr;
#pragma unroll
            for (int s = 0; s < 4; ++s) { const bf16x8 kf = *(const LAS bf16x8*)(ldsK + attn_offk(row, 4 * s + fq)); S[t] = __builtin_amdgcn_mfma_f32_16x16x32_bf16(kf, qf[s], S[t], 0, 0, 0); }
        }
        const float NEG = -1e30f;
#pragma unroll
        for (int j = 0; j < 4; ++j) { const int ko0 = 4 * fq + j; if (ko0 < fr) S[0][j] = NEG; if (ko0 > fr) S[8][j] = NEG; }
        if (n == 0) {
#pragma unroll
            for (int t = 0; t < 9; ++t)
#pragma unroll
                for (int j = 0; j < 4; ++j) { if (16 * wid + 16 * t + 4 * fq + j < 128) S[t][j] = NEG; }
        }
        float mx = NEG;
#pragma unroll
        for (int t = 0; t < 9; ++t) mx = fmaxf(mx, fmaxf(fmaxf(S[t][0], S[t][1]), fmaxf(S[t][2], S[t][3])));
        mx = fmaxf(mx, __shfl_xor(mx, 16)); mx = fmaxf(mx, __shfl_xor(mx, 32));
        float sum = 0.f;
#pragma unroll
        for (int t = 0; t < 9; ++t)
#pragma unroll
            for (int j = 0; j < 4; ++j) { const float p = __builtin_amdgcn_exp2f(S[t][j] - mx); S[t][j] = p; sum += p; }
        sum += __shfl_xor(sum, 16); sum += __shfl_xor(sum, 32);
        f32x4 O[8];
#pragma unroll
        for (int c = 0; c < 8; ++c) O[c] = (f32x4){0.f, 0.f, 0.f, 0.f};
        const unsigned q4 = (unsigned)(lane & 15) >> 2, p4 = (unsigned)lane & 3u;
#pragma unroll
        for (int u = 0; u < 5; ++u) {
            u32x4 pw; pw.x = cvt_pk_bf16(S[2 * u][0], S[2 * u][1]); pw.y = cvt_pk_bf16(S[2 * u][2], S[2 * u][3]);
            if (u < 4) { pw.z = cvt_pk_bf16(S[2 * u + 1][0], S[2 * u + 1][1]); pw.w = cvt_pk_bf16(S[2 * u + 1][2], S[2 * u + 1][3]); } else { pw.z = 0u; pw.w = 0u; }
            const bf16x8 pf = __builtin_bit_cast(bf16x8, pw);
            const unsigned kba = 16 * wid + 32 * u, kbb = (u < 4) ? kba + 16 : kba;
            const unsigned lra = (kba & ~31u) | ((unsigned)fq << 3) | (((kba >> 4) & 1u) << 2) | q4;
            const unsigned lrb = (kbb & ~31u) | ((unsigned)fq << 3) | (((kbb >> 4) & 1u) << 2) | q4;
#pragma unroll
            for (int c = 0; c < 8; ++c) {
                const s16x4 va = __builtin_amdgcn_ds_read_tr16_b64_v4i16((LAS s16x4*)(ldsV + attn_offv(lra, 2 * c + (p4 >> 1)) + 8 * (p4 & 1)));
                const s16x4 vb = __builtin_amdgcn_ds_read_tr16_b64_v4i16((LAS s16x4*)(ldsV + attn_offv(lrb, 2 * c + (p4 >> 1)) + 8 * (p4 & 1)));
                const bf16x8 vf = __builtin_shufflevector(va, vb, 0, 1, 2, 3, 4, 5, 6, 7);
                O[c] = __builtin_amdgcn_mfma_f32_16x16x32_bf16(vf, pf, O[c], 0, 0, 0);
            }
        }
        const float inv = 1.0f / sum;
        bf16_t* Og = (g == 0) ? O0 : ((g == 1) ? O1 : O2);
        bf16_t* op = Og + pq * NZA + hh * 128 + 4 * fq;
#pragma unroll
        for (int c = 0; c < 8; ++c) { u32x2 w; w.x = cvt_pk_bf16(O[c][0] * inv, O[c][1] * inv); w.y = cvt_pk_bf16(O[c][2] * inv, O[c][3] * inv); *(u32x2*)(op + 16 * c) = w; }
        if (fq == 0) LSE[((size_t)g * M + pq) * 8 + hh] = mx + __builtin_amdgcn_logf(sum);
        __syncthreads();
    }
}

struct Args { const float* x; const float* c; const int* pos; const float* g_pre; const float* w_ada; const float* b_ada; const float* w_in; const float* conv_w;
              const float* w_attn_o; const float* w_conv_o; const float* w_o; const float* g_post; float* out; unsigned char* ws; int ph_lo, ph_hi, li, pad; };

__global__ void __launch_bounds__(NWAVES * 64, 2) mk_fwd(Args args) {
    extern __shared__ __attribute__((aligned(16))) unsigned char lds_raw[];
    LAS unsigned char* lds = (LAS unsigned char*)lds_raw;
    volatile LAS unsigned* MISC = (volatile LAS unsigned*)(lds + MISC_OFF);
    const int tid = threadIdx.x, lane = tid & 63, wave = __builtin_amdgcn_readfirstlane(tid >> 6);
    const int G = gridDim.x; const int bx = blockIdx.x; const int vcu = (G % 8 == 0) ? (bx % 8) * (G / 8) + bx / 8 : bx;
    unsigned char* ws = args.ws;
    gu32* ctl = (gu32*)(ws + WS_CTL);
    float* mod = (float*)(ws + WS_MOD); float* cs = (float*)(ws + WS_CS);
    bf16_t* WinT = (bf16_t*)(ws + WS_WIN); bf16_t* WaT = (bf16_t*)(ws + WS_WA); bf16_t* WcT = (bf16_t*)(ws + WS_WC); bf16_t* WoT = (bf16_t*)(ws + WS_WO);
    bf16_t* Hb = (bf16_t*)(ws + WS_H); bf16_t* Qb = (bf16_t*)(ws + WS_Q); bf16_t* Kb = (bf16_t*)(ws + WS_K); bf16_t* Vb = (bf16_t*)(ws + WS_V);
    bf16_t* SZ = (bf16_t*)(ws + WS_SZ); bf16_t* Pb = (bf16_t*)(ws + WS_P); bf16_t* QCb = (bf16_t*)(ws + WS_QC);
    bf16_t* SGA = (bf16_t*)args.out; bf16_t* SGC = SGA + (size_t)M * D;
    bf16_t* O0 = (bf16_t*)(ws + WS_O0); bf16_t* O1 = (bf16_t*)(ws + WS_O1); bf16_t* O2 = (bf16_t*)(ws + WS_O2); float* LSE = (float*)(ws + WS_LSE);
    bf16_t* AATT = (bf16_t*)(ws + WS_AATT); bf16_t* Rb = (bf16_t*)(ws + WS_R); bf16_t* Tb = (bf16_t*)(ws + WS_T); bf16_t* MG = (bf16_t*)(ws + WS_MG);
    float* Y = args.out;

    for (int u = tid; u < (LDS_BYTES - LDSCTL_OFF) / 4; u += NWAVES * 64) ((LAS unsigned*)(lds + LDSCTL_OFF))[u] = 0u;
    __syncthreads();
    const int bli = (N_LAUNCHES == 1) ? 0 : args.li;
    XcdBarrier bar; bar.bar = (unsigned*)(ctl + CW_BAR) + bli * XCD_BAR_WORDS; bar.x = 0; bar.st = nullptr;
    if (N_LAUNCHES == 1) bar = xcd_barrier_post((unsigned*)(ctl + CW_BAR), MISC + 8);
    const int lo = args.ph_lo, hi = args.ph_hi;
#define IN(k) (lo <= (k) && (k) < hi)
#define BOTH(k) (IN(k) && IN((k) + 1))
#define GRID_BAR() xcd_barrier(bar)
    const int gw = vcu * NWAVES + wave, NGW = G * NWAVES;
    const int gtid = vcu * (NWAVES * 64) + tid, NT = G * NWAVES * 64;

    if (IN(0)) {
        {
            LAS float* red = (LAS float*)lds;
            for (int cbk = bx; cbk < 256; cbk += G) {
                const int c4 = tid % 6, rg = tid / 6;
                f32x4 a = (f32x4){0.f, 0.f, 0.f, 0.f};
                if (rg < 85) { for (int k = rg; k < D; k += 85) { const float cv = args.c[k]; const f32x4 w = *(const f32x4*)(args.w_ada + (size_t)k * NMOD + cbk * 24 + c4 * 4); a += w * cv; }
                    *(LAS f32x4*)(red + (rg * 6 + c4) * 4) = a; }
                __syncthreads();
                if (tid < 24) { float s = 0.f; for (int i = 0; i < 85; ++i) s += red[(i * 6 + (tid >> 2)) * 4 + (tid & 3)]; mod[cbk * 24 + tid] = s + args.b_ada[cbk * 24 + tid]; }
                __syncthreads();
            }
        }
        for (int idx = gtid; idx < M * 16; idx += NT) { const int m = idx >> 4, i = idx & 15; const float ang = (float)args.pos[m] * INVF[i]; float s, c; sincos_f64(ang, s, c); cs[m * 32 + i] = c; cs[m * 32 + 16 + i] = s; }
        {
            LAS float* scr = (LAS float*)(lds + wave * 16384);
            constexpr int I_IN = (D / 64) * (PROJ / 32), I_A = (NZA / 64) * (D / 32), I_C = (NCV / 64) * (D / 32), I_O = (D / 64) * (D / 32);
            constexpr int NITEMS = I_IN + I_A + I_C + I_O;
            for (int it = gw; it < NITEMS; it += NGW) {
                int r = it;
                if (r < I_IN) { p0_transpose_item<true>(args.w_in, D, PROJ, WinT, scr, r, lane); continue; } r -= I_IN;
                if (r < I_A) { p0_transpose_item<false>(args.w_attn_o, NZA, D, WaT, scr, r, lane); continue; } r -= I_A;
                if (r < I_C) { p0_transpose_item<false>(args.w_conv_o, NCV, D, WcT, scr, r, lane); continue; } r -= I_C;
                p0_transpose_item<false>(args.w_o, D, D, WoT, scr, r, lane);
            }
        }
        if (BOTH(0)) GRID_BAR();
    }
    if (IN(1)) {
        f32x4 av[4][2], bv[4][2];
#pragma unroll
        for (int j = 0; j < 4; ++j)
#pragma unroll
            for (int h = 0; h < 2; ++h) { const int k = 512 * j + 8 * lane + 4 * h; const f32x4 gp = *(const f32x4*)(args.g_pre + k), sc = *(const f32x4*)(mod + D + k); av[j][h] = gp * (sc + 1.0f); bv[j][h] = *(const f32x4*)(mod + k); }
        for (int m = gw; m < M; m += NGW) {
            const float* xr = args.x + (size_t)m * D + 8 * lane;
            f32x4 v[4][2]; float ss = 0.f;
#pragma unroll
            for (int j = 0; j < 4; ++j)
#pragma unroll
                for (int h = 0; h < 2; ++h) { v[j][h] = *(const f32x4*)(xr + 512 * j + 4 * h); const f32x4 q = v[j][h] * v[j][h]; ss += (q[0] + q[1]) + (q[2] + q[3]); }
            const float rstd = 1.0f / sqrtf(wave_sum(ss) * (1.0f / D) + EPS);
            bf16_t* hr = Hb + (size_t)m * D + 8 * lane;
#pragma unroll
            for (int j = 0; j < 4; ++j) { const f32x4 h0 = v[j][0] * rstd * av[j][0] + bv[j][0], h1 = v[j][1] * rstd * av[j][1] + bv[j][1]; *(u32x4*)(hr + 512 * j) = pg8::pack8(h0, h1); }
        }
        if (BOTH(1)) GRID_BAR();
    }
    if (IN(2)) {
        pg8::Gemm g{Hb, WinT, M, PROJ, D}; pg8::StaticOrder S; S.init(M, PROJ, G, bx);
        pg8::EpiProj E{Qb, Kb, Vb, SZ, Pb, QCb, SGA, SGC, cs};
        pg8::gemm_phase<pg8::EpiProj, pg8::StaticOrder, PG8_ALIGN, PG8_SP2>(lds, g, S, E);
        if (BOTH(2)) GRID_BAR();
    }
    if (IN(3)) {
        attn_phase(lds, Qb, Kb, Vb, O0, O1, O2, LSE, G, vcu);
        if (BOTH(3)) GRID_BAR();
    }
    if (IN(4)) {
        for (int it = gtid; it < M * 128; it += NT) {
            const int p = it >> 7, c8 = it & 127, hh = c8 >> 4;
            const float l0 = LSE[((size_t)0 * M + p) * 8 + hh], l1 = LSE[((size_t)1 * M + p) * 8 + hh], l2 = LSE[((size_t)2 * M + p) * 8 + hh];
            const float mx = fmaxf(l0, fmaxf(l1, l2));
            float w0 = __builtin_amdgcn_exp2f(l0 - mx), w1 = __builtin_amdgcn_exp2f(l1 - mx), w2 = __builtin_amdgcn_exp2f(l2 - mx);
            const float inv = 1.0f / (w0 + w1 + w2); w0 *= inv; w1 *= inv; w2 *= inv;
            const size_t off = (size_t)p * NZA + c8 * 8;
            f32x4 a0, a1, b0, b1, c0, c1, z0, z1;
            pg8::unpack8(*(const u32x4*)(O0 + off), a0, a1); pg8::unpack8(*(const u32x4*)(O1 + off), b0, b1); pg8::unpack8(*(const u32x4*)(O2 + off), c0, c1); pg8::unpack8(*(const u32x4*)(SZ + off), z0, z1);
            const f32x4 r0 = (a0 * w0 + b0 * w1 + c0 * w2) * z0, r1 = (a1 * w0 + b1 * w1 + c1 * w2) * z1;
            *(u32x4*)(AATT + off) = pg8::pack8(r0, r1);
        }
        for (int bk = vcu; bk < 256; bk += G) {
            const int chunk = tid & 255, half = tid >> 8, c0 = 8 * chunk, t0 = 64 * bk + 32 * half;
            f32x4 wa[3][2];
#pragma unroll
            for (int k = 0; k < 3; ++k) { wa[k][0] = *(const f32x4*)(args.conv_w + k * NCV + c0); wa[k][1] = *(const f32x4*)(args.conv_w + k * NCV + c0 + 4); }
            f32x4 pm2[2], pm1[2];
            if (t0 >= 2) { pg8::unpack8(*(const u32x4*)(Pb + (size_t)(t0 - 2) * NCV + c0), pm2[0], pm2[1]); pg8::unpack8(*(const u32x4*)(Pb + (size_t)(t0 - 1) * NCV + c0), pm1[0], pm1[1]); }
            else { pm2[0] = pm2[1] = pm1[0] = pm1[1] = (f32x4){0.f, 0.f, 0.f, 0.f}; }
#pragma unroll 4
            for (int t = t0; t < t0 + 32; ++t) {
                f32x4 pc[2], qc[2]; pg8::unpack8(*(const u32x4*)(Pb + (size_t)t * NCV + c0), pc[0], pc[1]); pg8::unpack8(*(const u32x4*)(QCb + (size_t)t * NCV + c0), qc[0], qc[1]);
                const f32x4 r0 = qc[0] * (wa[0][0] * pm2[0] + wa[1][0] * pm1[0] + wa[2][0] * pc[0]), r1 = qc[1] * (wa[0][1] * pm2[1] + wa[1][1] * pm1[1] + wa[2][1] * pc[1]);
                *(u32x4*)(Rb + (size_t)t * NCV + c0) = pg8::pack8(r0, r1);
                pm2[0] = pm1[0]; pm2[1] = pm1[1]; pm1[0] = pc[0]; pm1[1] = pc[1];
            }
        }
        if (BOTH(4)) GRID_BAR();
    }
    if (IN(5)) {
        pg8::Gemm g{AATT, WaT, M, D, NZA}; pg8::StaticOrder S; S.init(M, D, G, bx);
        pg8::EpiGate<false> E{Tb, SGA, nullptr, D};
        pg8::gemm_phase<pg8::EpiGate<false>, pg8::StaticOrder, PG8_ALIGN, PG8_SP2>(lds, g, S, E);
        if (BOTH(5)) GRID_BAR();
    }
    if (IN(6)) {
        pg8::Gemm g{Rb, WcT, M, D, NCV}; pg8::StaticOrder S; S.init(M, D, G, bx);
        pg8::EpiGate<true> E{MG, SGC, Tb, D};
        pg8::gemm_phase<pg8::EpiGate<true>, pg8::StaticOrder, PG8_ALIGN, PG8_SP2>(lds, g, S, E);
        if (BOTH(6)) GRID_BAR();
    }
    if (IN(7)) {
        pg8::Gemm g{MG, WoT, M, D, D}; pg8::StaticOrder S; S.init(M, D, G, bx);
        pg8::EpiF32 E{Y, D};
        pg8::gemm_phase<pg8::EpiF32, pg8::StaticOrder, PG8_ALIGN, PG8_SP2>(lds, g, S, E);
        if (BOTH(7)) GRID_BAR();
    }
    if (IN(8)) {
        f32x4 gv[4][2];
#pragma unroll
        for (int j = 0; j < 4; ++j)
#pragma unroll
            for (int h = 0; h < 2; ++h) { const int k = 512 * j + 8 * lane + 4 * h; gv[j][h] = *(const f32x4*)(mod + 2 * D + k) * *(const f32x4*)(args.g_post + k); }
        for (int m = gw; m < M; m += NGW) {
            float* yr = Y + (size_t)m * D + 8 * lane; const float* xr = args.x + (size_t)m * D + 8 * lane;
            f32x4 v[4][2]; float ss = 0.f;
#pragma unroll
            for (int j = 0; j < 4; ++j)
#pragma unroll
                for (int h = 0; h < 2; ++h) { v[j][h] = *(const f32x4*)(yr + 512 * j + 4 * h); const f32x4 q = v[j][h] * v[j][h]; ss += (q[0] + q[1]) + (q[2] + q[3]); }
            const float rstd = 1.0f / sqrtf(wave_sum(ss) * (1.0f / D) + EPS);
#pragma unroll
            for (int j = 0; j < 4; ++j)
#pragma unroll
                for (int h = 0; h < 2; ++h) { const f32x4 xv = *(const f32x4*)(xr + 512 * j + 4 * h); *(f32x4*)(yr + 512 * j + 4 * h) = xv + gv[j][h] * (v[j][h] * rstd); }
        }
    }
#undef IN
#undef BOTH
#undef GRID_BAR
}

extern "C" void kernel_launch(void* const* d_in, const int* in_sizes, int n_in, void* d_out, int out_size, void* d_ws, size_t ws_size, hipStream_t stream) {
    static int grid = 0;
    if (grid == 0) {
        if (n_in != 12 || in_sizes[0] != M * D || out_size != M * D || ws_size < WS_END) { fprintf(stderr, "kernel_launch: unexpected shapes (n_in %d, in0 %d, out %d, ws %zu); nothing launched\n", n_in, n_in > 0 ? in_sizes[0] : -1, out_size, ws_size); grid = -1; return; }
        int dev = 0, cus = 0;
        if (hipGetDevice(&dev) != hipSuccess || hipDeviceGetAttribute(&cus, hipDeviceAttributeMultiprocessorCount, dev) != hipSuccess) { grid = -1; return; }
        if (hipFuncSetAttribute((const void*)mk_fwd, hipFuncAttributeMaxDynamicSharedMemorySize, LDS_BYTES) != hipSuccess) { fprintf(stderr, "kernel_launch: hipFuncSetAttribute failed\n"); grid = -1; return; }
        (void)hipGetLastError();
        grid = cus;
    }
    if (grid < 0) return;
    if (hipMemsetAsync((char*)d_ws + WS_CTL, 0, CTL_ZERO_BYTES, stream) != hipSuccess) return;
    Args a{};
    a.x = (const float*)d_in[0]; a.c = (const float*)d_in[1]; a.pos = (const int*)d_in[2]; a.g_pre = (const float*)d_in[3]; a.w_ada = (const float*)d_in[4]; a.b_ada = (const float*)d_in[5];
    a.w_in = (const float*)d_in[6]; a.conv_w = (const float*)d_in[7]; a.w_attn_o = (const float*)d_in[8]; a.w_conv_o = (const float*)d_in[9]; a.w_o = (const float*)d_in[10]; a.g_post = (const float*)d_in[11];
    a.out = (float*)d_out; a.ws = (unsigned char*)d_ws;
    for (int li = 0; li < N_LAUNCHES; ++li) {
        a.ph_lo = (N_LAUNCHES == 1) ? 0 : li; a.ph_hi = (N_LAUNCHES == 1) ? NPHASES : li + 1; a.li = li;
        hipLaunchKernelGGL(mk_fwd, dim3(grid), dim3(NWAVES * 64), LDS_BYTES, stream, a);
        if (hipPeekAtLastError() != hipSuccess) break;
    }
}
```

```cpp
#include <hip/hip_runtime.h>
#include <cstdio>
#include <cstdint>

#define GAS __attribute__((address_space(1)))
#define LAS __attribute__((address_space(3)))
typedef unsigned short bf16_t;
typedef short bf16x8 __attribute__((ext_vector_type(8)));
typedef short s16x4 __attribute__((ext_vector_type(4)));
typedef float f32x4 __attribute__((ext_vector_type(4)));
typedef float f32x2 __attribute__((ext_vector_type(2)));
typedef unsigned u32x4 __attribute__((ext_vector_type(4)));
typedef unsigned u32x2 __attribute__((ext_vector_type(2)));

constexpr int M = 16384, D = 2048, NQKV = 3072, NZA = 1024, NCV = 2048, PROJ = 22528, NMOD = 6144;
constexpr float EPS = 1e-6f;
constexpr float LOG2E = 1.4426950408889634f;
constexpr float QSCALE = 0.08838834764831845f * 1.4426950408889634f;

__constant__ float INVF[16] = {1.0f, 0.44036659598350525f, 0.1939227432012558f, 0.08539710193872452f, 0.03760603070259094f, 0.016560440883040428f,
    0.007292664609849453f, 0.0032114461064338684f, 0.0014142135623842478f, 0.0006227724370546639f, 0.00027424818836152554f, 0.00012076973507646471f,
    5.3182957344688475e-05f, 2.34199997066753e-05f, 1.0313385246263351e-05f, 4.541670477919979e-06f};

__device__ __forceinline__ unsigned cvt_pk_bf16(float lo, float hi) { unsigned r; asm volatile("v_cvt_pk_bf16_f32 %0, %1, %2" : "=v"(r) : "v"(lo), "v"(hi)); return r; }
__device__ __forceinline__ float bf_lo(unsigned w) { return __builtin_bit_cast(float, w << 16); }
__device__ __forceinline__ float bf_hi(unsigned w) { return __builtin_bit_cast(float, w & 0xffff0000u); }
__device__ __forceinline__ float silu_f(float v) { return v * __builtin_amdgcn_rcpf(1.0f + __builtin_amdgcn_exp2f(-v * LOG2E)); }
__device__ __forceinline__ float sigm_f(float v) { return __builtin_amdgcn_rcpf(1.0f + __builtin_amdgcn_exp2f(-v * LOG2E)); }

namespace pg8 {
constexpr int BM = 256, BK = 64, HALF = 128, HTB = HALF * BK * 2, STAGE_BYTES = 8 * HTB, NXCD = 8, WGM = 8;
__host__ __device__ __forceinline__ int lds_byte(int r, int c) { const int st = (r >> 4) * 2 + (c >> 5), rr = r & 15, cc = c & 31, ob = rr * 64 + cc * 2; return st * 1024 + (ob ^ (((ob >> 9) & 1) << 5)); }
__host__ __device__ __forceinline__ void stage_rc(int b, int& R, int& C) { const int st = b / 1024, sb = b % 1024, swz = sb ^ (((sb >> 9) & 1) << 5); R = (st >> 1) * 16 + swz / 64; C = (st & 1) * 32 + (swz % 64) / 2; }
__host__ __device__ __forceinline__ int perm32(int rho) { const int n = rho >> 4, i = rho & 15; return 8 * (i >> 2) + 4 * n + (i & 3); }

struct Unit { int pm, pn; };
struct Gemm { const bf16_t* A; const bf16_t* Bt; int M, N, K; };

struct StaticOrder {
    int nM, nN, nwg, G, c, rounds, rep;
    __host__ __device__ void init(int M_, int N_, int G_, int c_, int rep_ = 1) { nM = M_ / BM; nN = N_ / BM; nwg = nM * nN; G = G_; c = c_; rounds = (nwg + G - 1) / G; rep = rep_; }
    __host__ __device__ bool next(int i, Unit& u) const {
        if (i >= rounds * rep) return false;
        i = i % rounds;
        const long L = (long)i * G + c; if (L >= nwg) return false;
        int wgid = (int)L; { const int q = nwg / NXCD, r = nwg % NXCD, xcd = wgid % NXCD, off = wgid / NXCD; wgid = (xcd < r ? xcd * (q + 1) : r * (q + 1) + (xcd - r) * q) + off; }
        const int nig = WGM * nN, gid = wgid / nig, fm = gid * WGM, gsz = (nM - fm) < WGM ? (nM - fm) : WGM;
        u.pm = fm + ((wgid % nig) % gsz); u.pn = (wgid % nig) / gsz; return true;
    }
    __device__ __forceinline__ void a_ready(const Unit&) const {}
    __device__ __forceinline__ void done(const Unit&) const {}
};


template <class Epi, class Sched, bool ALIGN_EPI = false, bool SP2 = false>
__device__ __forceinline__ void gemm_phase(LAS unsigned char* lds, const Gemm g, const Sched& S, const Epi& E, unsigned long long* stamps = nullptr) {
    const int tid = threadIdx.x, wid = __builtin_amdgcn_readfirstlane(tid >> 6), lane = tid & 63, wr = wid >> 2, wc = wid & 3, fr = lane & 15, fq = lane >> 4;
    const int K = g.K, nt = K / BK;
    unsigned voffA[2], voffB[2];
#pragma unroll
    for (int i = 0; i < 2; ++i) { int R, C; stage_rc(tid * 16 + i * 8192, R, C); const int Rb = Epi::PERM ? ((R & ~31) + perm32(R & 31)) : R;
        voffA[i] = (unsigned)(R * K + C) * 2u; voffB[i] = (unsigned)(Rb * K + C) * 2u; }
    const size_t kstep = (size_t)(BK * 2);
    const size_t hstep = (size_t)HALF * K * 2;
    const size_t tstep = 2 * hstep;
    const unsigned ldsw = (unsigned)wid * 1024u;
    const int aoff = lds_byte(wr * 64 + fr, fq * 8), boff = lds_byte(wc * 32 + fr, fq * 8);
#define PG8_SA(b, h) (((b) * 2 + (h)) * HTB)
#define PG8_SB(b, h) ((4 + (b) * 2 + (h)) * HTB)
#define PG8_STAGE(bufoff, gbase, voff) do { _Pragma("unroll") for (int _i = 0; _i < 2; ++_i) \
        __builtin_amdgcn_global_load_lds((const unsigned*)((const char*)(gbase) + (voff)[_i]), (LAS unsigned*)(lds + (bufoff) + ldsw + _i * 8192), 16, 0, 0); } while (0)
#define PG8_LDA(dst, b, h) do { _Pragma("unroll") for (int m = 0; m < 4; ++m) _Pragma("unroll") for (int k = 0; k < 2; ++k) dst[m][k] = *(const LAS bf16x8*)(lds + PG8_SA(b, h) + aoff + m * 2048 + k * 1024); } while (0)
#define PG8_LDB(dst, b, h) do { _Pragma("unroll") for (int n = 0; n < 2; ++n) _Pragma("unroll") for (int k = 0; k < 2; ++k) dst[n][k] = *(const LAS bf16x8*)(lds + PG8_SB(b, h) + boff + n * 2048 + k * 1024); } while (0)
#define PG8_MMA(ai, bj, At, Bt) do { __builtin_amdgcn_s_setprio(1); _Pragma("unroll") for (int m = 0; m < 4; ++m) _Pragma("unroll") for (int n = 0; n < 2; ++n) _Pragma("unroll") for (int k = 0; k < 2; ++k) \
        acc[ai][bj][m][n] = __builtin_amdgcn_mfma_f32_16x16x32_bf16(Bt[n][k], At[m][k], acc[ai][bj][m][n], 0, 0, 0); __builtin_amdgcn_s_setprio(0); } while (0)
#define PG8_WAIT_V(n) asm volatile("s_waitcnt vmcnt(" #n ")" ::: "memory")
#define PG8_WAIT_L(n) asm volatile("s_waitcnt lgkmcnt(" #n ")" ::: "memory")
#define PG8_BAR __builtin_amdgcn_s_barrier()
#define PG8_SCHED __builtin_amdgcn_sched_barrier(0)
    Unit cur, nxt; int ui = 0;
    if (!S.next(0, cur)) return;
#ifdef PROBE_STAMP
    const bool stamper = (stamps != nullptr) && (wid == 0);
    if (stamper && lane == 0) { stamps[0] = __builtin_amdgcn_s_memrealtime(); stamps[1] = __builtin_amdgcn_s_memtime(); }
#endif
    f32x4 acc[2][2][4][2];
#pragma unroll
    for (int a = 0; a < 2; ++a)
#pragma unroll
        for (int b = 0; b < 2; ++b)
#pragma unroll
            for (int m = 0; m < 4; ++m)
#pragma unroll
                for (int n = 0; n < 2; ++n) acc[a][b][m][n] = (f32x4){0.f, 0.f, 0.f, 0.f};
    bf16x8 At[4][2], B0[2][2], B1[2][2];
    const char* cA = (const char*)g.A + (size_t)cur.pm * tstep; const char* cB = (const char*)g.Bt + (size_t)cur.pn * tstep;
    S.a_ready(cur);
    if constexpr (SP2) {
        PG8_STAGE(PG8_SB(0, 0), cB, voffB); PG8_STAGE(PG8_SB(0, 1), cB + hstep, voffB); PG8_STAGE(PG8_SA(0, 0), cA, voffA); PG8_STAGE(PG8_SA(0, 1), cA + hstep, voffA);
        if (wr == 1) PG8_BAR;
        PG8_WAIT_V(2); PG8_BAR;
        PG8_STAGE(PG8_SB(1, 0), cB + kstep, voffB); PG8_STAGE(PG8_SA(1, 0), cA + kstep, voffA); PG8_STAGE(PG8_SB(1, 1), cB + hstep + kstep, voffB);
        PG8_WAIT_V(6); PG8_BAR;
    } else {
        PG8_STAGE(PG8_SB(0, 0), cB, voffB); PG8_STAGE(PG8_SA(0, 0), cA, voffA); PG8_STAGE(PG8_SB(0, 1), cB + hstep, voffB); PG8_STAGE(PG8_SA(0, 1), cA + hstep, voffA);
        if (wr == 1) PG8_BAR;
        PG8_WAIT_V(4); PG8_BAR;
        PG8_STAGE(PG8_SB(1, 0), cB + kstep, voffB); PG8_STAGE(PG8_SA(1, 0), cA + kstep, voffA); PG8_STAGE(PG8_SB(1, 1), cB + hstep + kstep, voffB);
        PG8_WAIT_V(6); PG8_BAR;
    }
    for (;;) {
        const bool has_next = S.next(ui + 1, nxt);
        const char* nA = has_next ? (const char*)g.A + (size_t)nxt.pm * tstep : cA; const char* nB = has_next ? (const char*)g.Bt + (size_t)nxt.pn * tstep : cB;
#ifdef PROBE_STAMP
        if (stamper && lane == 0 && ui == 5) stamps[4] = __builtin_amdgcn_s_memtime();
#endif
        for (int t = 0; t < nt; t += 2) {
            const bool last = (t == nt - 2);
            const char* a1 = cA + (size_t)(t + 1) * kstep;
            const char* a2 = last ? nA : cA + (size_t)(t + 2) * kstep; const char* b2 = last ? nB : cB + (size_t)(t + 2) * kstep;
            const char* a3 = a2 + kstep; const char* b3 = b2 + kstep;
            if (last && has_next) S.a_ready(nxt);
            if constexpr (SP2) {
            PG8_LDB(B0, 0, 0); PG8_LDB(B1, 0, 1); PG8_SCHED; PG8_LDA(At, 0, 0); PG8_STAGE(PG8_SA(1, 1), a1 + hstep, voffA);
            PG8_WAIT_V(8); PG8_WAIT_L(0); PG8_BAR; PG8_MMA(0, 0, At, B0); PG8_MMA(0, 1, At, B1); PG8_BAR; PG8_SCHED;
            PG8_LDA(At, 0, 1); PG8_STAGE(PG8_SB(0, 0), b2, voffB); PG8_STAGE(PG8_SB(0, 1), b2 + hstep, voffB); PG8_STAGE(PG8_SA(0, 0), a2, voffA);
            PG8_WAIT_V(8); PG8_WAIT_L(0); PG8_BAR; PG8_MMA(1, 0, At, B0); PG8_MMA(1, 1, At, B1); PG8_BAR; PG8_SCHED;
            PG8_LDB(B0, 1, 0); PG8_LDB(B1, 1, 1); PG8_SCHED; PG8_LDA(At, 1, 0); PG8_STAGE(PG8_SA(0, 1), a2 + hstep, voffA);
            PG8_WAIT_V(8); PG8_WAIT_L(0); PG8_BAR; PG8_MMA(0, 0, At, B0); PG8_MMA(0, 1, At, B1); PG8_BAR; PG8_SCHED;
            PG8_LDA(At, 1, 1); PG8_STAGE(PG8_SB(1, 0), b3, voffB); PG8_STAGE(PG8_SB(1, 1), b3 + hstep, voffB); PG8_STAGE(PG8_SA(1, 0), a3, voffA);
            PG8_WAIT_V(8); PG8_WAIT_L(0); PG8_BAR; PG8_MMA(1, 0, At, B0); PG8_MMA(1, 1, At, B1); PG8_BAR; PG8_SCHED;
            } else {
            PG8_LDB(B0, 0, 0); PG8_SCHED; PG8_LDA(At, 0, 0); PG8_STAGE(PG8_SA(1, 1), a1 + hstep, voffA);
            PG8_WAIT_L(8); PG8_BAR; PG8_WAIT_L(0); PG8_MMA(0, 0, At, B0); PG8_BAR; PG8_SCHED;
            PG8_LDB(B1, 0, 1); PG8_STAGE(PG8_SB(0, 0), b2, voffB);
            PG8_BAR; PG8_WAIT_L(0); PG8_MMA(0, 1, At, B1); PG8_BAR;
            PG8_LDA(At, 0, 1); PG8_STAGE(PG8_SA(0, 0), a2, voffA);
            PG8_BAR; PG8_WAIT_L(0); PG8_MMA(1, 0, At, B0); PG8_BAR; PG8_SCHED;
            PG8_STAGE(PG8_SB(0, 1), b2 + hstep, voffB);
            PG8_WAIT_V(6); PG8_BAR; PG8_MMA(1, 1, At, B1); PG8_BAR;
            PG8_LDB(B0, 1, 0); PG8_SCHED; PG8_LDA(At, 1, 0); PG8_STAGE(PG8_SA(0, 1), a2 + hstep, voffA);
            PG8_WAIT_L(8); PG8_BAR; PG8_WAIT_L(0); PG8_MMA(0, 0, At, B0); PG8_BAR; PG8_SCHED;
            PG8_LDB(B1, 1, 1); PG8_STAGE(PG8_SB(1, 0), b3, voffB);
            PG8_BAR; PG8_WAIT_L(0); PG8_MMA(0, 1, At, B1); PG8_BAR;
            PG8_LDA(At, 1, 1); PG8_STAGE(PG8_SA(1, 0), a3, voffA);
            PG8_BAR; PG8_WAIT_L(0); PG8_MMA(1, 0, At, B0); PG8_BAR; PG8_SCHED;
            PG8_STAGE(PG8_SB(1, 1), b3 + hstep, voffB);
            PG8_WAIT_V(6); PG8_BAR; PG8_MMA(1, 1, At, B1); PG8_BAR;
            }
        }
#ifdef PROBE_STAMP
        if (stamper && lane == 0 && ui == 5) stamps[5] = __builtin_amdgcn_s_memtime();
        if (stamper && lane == 0 && ui == 6) stamps[7] = __builtin_amdgcn_s_memtime();
#endif
        if constexpr (ALIGN_EPI) { if (wr == 0) PG8_BAR; }
        E(acc, cur, wr, wc, fr, fq); S.done(cur);
#ifdef PROBE_STAMP
        if (stamper && lane == 0 && ui == 5) stamps[6] = __builtin_amdgcn_s_memtime();
#endif
        if (!has_next) break;
#pragma unroll
        for (int a = 0; a < 2; ++a)
#pragma unroll
            for (int b = 0; b < 2; ++b)
#pragma unroll
                for (int m = 0; m < 4; ++m)
#pragma unroll
                    for (int n = 0; n < 2; ++n) acc[a][b][m][n] = (f32x4){0.f, 0.f, 0.f, 0.f};
        cur = nxt; cA = nA; cB = nB; ++ui;
        if constexpr (ALIGN_EPI) { if (wr == 1) PG8_BAR; }
    }
    PG8_WAIT_V(0);
    if constexpr (!ALIGN_EPI) { if (wr == 0) PG8_BAR; }
    PG8_BAR;
#ifdef PROBE_STAMP
    if (stamper && lane == 0) { stamps[2] = __builtin_amdgcn_s_memrealtime(); stamps[3] = __builtin_amdgcn_s_memtime(); }
#endif
#undef PG8_SA
#undef PG8_SB
#undef PG8_STAGE
#undef PG8_LDA
#undef PG8_LDB
#undef PG8_MMA
#undef PG8_WAIT_V
#undef PG8_WAIT_L
#undef PG8_BAR
#undef PG8_SCHED
}

__device__ __forceinline__ u32x4 pack8(const f32x4 v0, const f32x4 v1) { u32x4 w; w.x = cvt_pk_bf16(v0[0], v0[1]); w.y = cvt_pk_bf16(v0[2], v0[3]); w.z = cvt_pk_bf16(v1[0], v1[1]); w.w = cvt_pk_bf16(v1[2], v1[3]); return w; }
__device__ __forceinline__ void unpack8(const u32x4 w, f32x4& v0, f32x4& v1) { v0 = (f32x4){bf_lo(w.x), bf_hi(w.x), bf_lo(w.y), bf_hi(w.y)}; v1 = (f32x4){bf_lo(w.z), bf_hi(w.z), bf_lo(w.w), bf_hi(w.w)}; }

struct EpiProj {
    static constexpr bool PERM = true;
    bf16_t *Q, *Kb, *V, *SZ, *P, *QC, *SGA, *SGC; const float* cs;
    __device__ __forceinline__ void operator()(const f32x4 (&acc)[2][2][4][2], const Unit& u, int wr, int wc, int fr, int fq) const {
        const int pn = u.pn; const int row0 = u.pm * BM + wr * 64 + fr; const int lc = wc * 32 + 8 * fq;
        if (pn < 24) {
            const bool isq = pn < 12; bf16_t* base = isq ? Q : Kb; const int colt = (isq ? pn : pn - 12) * BM; const float sc = isq ? QSCALE : 1.0f;
            f32x4 cv[2][4], sv[2][4];
#pragma unroll
            for (int ai = 0; ai < 2; ++ai)
#pragma unroll
                for (int m = 0; m < 4; ++m) { const float* cr = cs + (size_t)(row0 + ai * HALF + m * 16) * 32 + 4 * wc; cv[ai][m] = *(const f32x4*)cr; sv[ai][m] = *(const f32x4*)(cr + 16); }
            const bool rot = (fq == 0);
#pragma unroll
            for (int ai = 0; ai < 2; ++ai)
#pragma unroll
                for (int m = 0; m < 4; ++m) {
                    const f32x4 c = rot ? cv[ai][m] * sc : (f32x4){sc, sc, sc, sc}, sn = rot ? sv[ai][m] * sc : (f32x4){0.f, 0.f, 0.f, 0.f};
                    bf16_t* rowp = base + (size_t)(row0 + ai * HALF + m * 16) * NQKV + colt + lc;
#pragma unroll
                    for (int bj = 0; bj < 2; ++bj) { const f32x4 v0 = acc[ai][bj][m][0], v1 = acc[ai][bj][m][1];
                        *(u32x4*)(rowp + bj * HALF) = pack8(v0 * c - v1 * sn, v0 * sn + v1 * c); }
                }
        } else if (pn < 36) {
            const int colt = (pn - 24) * BM;
#pragma unroll
            for (int ai = 0; ai < 2; ++ai)
#pragma unroll
                for (int m = 0; m < 4; ++m) { bf16_t* rowp = V + (size_t)(row0 + ai * HALF + m * 16) * NQKV + colt + lc;
#pragma unroll
                    for (int bj = 0; bj < 2; ++bj) *(u32x4*)(rowp + bj * HALF) = pack8(acc[ai][bj][m][0], acc[ai][bj][m][1]); }
        } else if (pn < 40) {
            const int colt = (pn - 36) * BM;
#pragma unroll
            for (int ai = 0; ai < 2; ++ai)
#pragma unroll
                for (int m = 0; m < 4; ++m) { bf16_t* rowp = SZ + (size_t)(row0 + ai * HALF + m * 16) * NZA + colt + lc;
#pragma unroll
                    for (int bj = 0; bj < 2; ++bj) { f32x4 a = acc[ai][bj][m][0], b = acc[ai][bj][m][1];
#pragma unroll
                        for (int j = 0; j < 4; ++j) { a[j] = silu_f(a[j]); b[j] = silu_f(b[j]); }
                        *(u32x4*)(rowp + bj * HALF) = pack8(a, b); } }
        } else if (pn < 72) {
            const int chb = 64 * (pn - 40) + 16 * wc + 4 * fq;
#pragma unroll
            for (int ai = 0; ai < 2; ++ai)
#pragma unroll
                for (int m = 0; m < 4; ++m) { const size_t ro = (size_t)(row0 + ai * HALF + m * 16) * NCV + chb;
                    const f32x4 cb = acc[ai][0][m][0], cc = acc[ai][0][m][1], cx = acc[ai][1][m][0], z = acc[ai][1][m][1];
                    f32x4 pv = cc * cx, qv;
#pragma unroll
                    for (int j = 0; j < 4; ++j) qv[j] = cb[j] * silu_f(z[j]);
                    u32x2 pw, qw; pw.x = cvt_pk_bf16(pv[0], pv[1]); pw.y = cvt_pk_bf16(pv[2], pv[3]); qw.x = cvt_pk_bf16(qv[0], qv[1]); qw.y = cvt_pk_bf16(qv[2], qv[3]);
                    *(u32x2*)(P + ro) = pw; *(u32x2*)(QC + ro) = qw; }
        } else {
            const bool isa = pn < 80; bf16_t* base = isa ? SGA : SGC; const int colt = (isa ? pn - 72 : pn - 80) * BM;
#pragma unroll
            for (int ai = 0; ai < 2; ++ai)
#pragma unroll
                for (int m = 0; m < 4; ++m) { bf16_t* rowp = base + (size_t)(row0 + ai * HALF + m * 16) * D + colt + lc;
#pragma unroll
                    for (int bj = 0; bj < 2; ++bj) { f32x4 a = acc[ai][bj][m][0], b = acc[ai][bj][m][1];
#pragma unroll
                        for (int j = 0; j < 4; ++j) { a[j] = sigm_f(a[j]); b[j] = sigm_f(b[j]); }
                        *(u32x4*)(rowp + bj * HALF) = pack8(a, b); } }
        }
    }
};
template <bool ADD> struct EpiGate {
    static constexpr bool PERM = true;
    bf16_t* O; const bf16_t* G1; const bf16_t* T; int ldc;
    __device__ __forceinline__ void operator()(const f32x4 (&acc)[2][2][4][2], const Unit& u, int wr, int wc, int fr, int fq) const {
        const int row0 = u.pm * BM + wr * 64 + fr, col0 = u.pn * BM + wc * 32 + 8 * fq;
#pragma unroll
        for (int ai = 0; ai < 2; ++ai) {
            u32x4 gw[4][2], tw[4][2];
#pragma unroll
            for (int m = 0; m < 4; ++m)
#pragma unroll
                for (int bj = 0; bj < 2; ++bj) { const size_t ro = (size_t)(row0 + ai * HALF + m * 16) * ldc + col0 + bj * HALF; gw[m][bj] = *(const u32x4*)(G1 + ro); if (ADD) tw[m][bj] = *(const u32x4*)(T + ro); }
#pragma unroll
            for (int m = 0; m < 4; ++m)
#pragma unroll
                for (int bj = 0; bj < 2; ++bj) { const size_t ro = (size_t)(row0 + ai * HALF + m * 16) * ldc + col0 + bj * HALF;
                    f32x4 g0, g1; unpack8(gw[m][bj], g0, g1);
                    f32x4 v0 = acc[ai][bj][m][0] * g0, v1 = acc[ai][bj][m][1] * g1;
                    if (ADD) { f32x4 t0, t1; unpack8(tw[m][bj], t0, t1); v0 += t0; v1 += t1; }
                    *(u32x4*)(O + ro) = pack8(v0, v1); }
            asm volatile("" ::: "memory");
        }
    }
};
struct EpiF32 {
    static constexpr bool PERM = false;
    float* C; int ldc;
    __device__ __forceinline__ void operator()(const f32x4 (&acc)[2][2][4][2], const Unit& u, int wr, int wc, int fr, int fq) const {
        const int row0 = u.pm * BM + wr * 64 + fr, col0 = u.pn * BM + wc * 32 + 4 * fq;
#pragma unroll
        for (int ai = 0; ai < 2; ++ai)
#pragma unroll
            for (int m = 0; m < 4; ++m) { float* rowp = C + (size_t)(row0 + ai * HALF + m * 16) * ldc + col0;
#pragma unroll
                for (int bj = 0; bj < 2; ++bj)
#pragma unroll
                    for (int n = 0; n < 2; ++n) *(f32x4*)(rowp + bj * HALF + n * 16) = acc[ai][bj][m][n]; }
    }
};
}

#ifndef PG8_SP2
#define PG8_SP2 true
#endif
#ifndef PG8_ALIGN
#define PG8_ALIGN true
#endif

constexpr int NWAVES = 8;
#ifndef MK_N_LAUNCHES
#define MK_N_LAUNCHES 1
#endif
constexpr int NPHASES = 9;
constexpr int N_LAUNCHES = MK_N_LAUNCHES;

constexpr size_t MiB = 1u << 20;
constexpr size_t WS_CTL = 0, CTL_ZERO_BYTES = 1 * MiB;
constexpr size_t WS_MOD = 1 * MiB;
constexpr size_t WS_CS = 2 * MiB;
constexpr size_t WS_WIN = 4 * MiB;
constexpr size_t WS_WA = 92 * MiB, WS_WC = 96 * MiB, WS_WO = 104 * MiB;
constexpr size_t WS_H = 112 * MiB;
constexpr size_t WS_Q = 176 * MiB, WS_K = 272 * MiB, WS_V = 368 * MiB;
constexpr size_t WS_SZ = 464 * MiB;
constexpr size_t WS_P = 496 * MiB, WS_QC = 560 * MiB;
constexpr size_t WS_O2 = 624 * MiB;
constexpr size_t WS_LSE = 656 * MiB;
constexpr size_t WS_END = 658 * MiB;
constexpr size_t WS_O0 = 112 * MiB, WS_O1 = 144 * MiB;
constexpr size_t WS_AATT = 176 * MiB, WS_R = 208 * MiB, WS_T = 272 * MiB, WS_MG = 336 * MiB;
constexpr int CW_BAR = 4096;
#define XCD_BAR_WORDS 3456

constexpr int RING_BYTES = 131072;
constexpr int LDSCTL_OFF = RING_BYTES, MISC_OFF = LDSCTL_OFF + 320;
constexpr int LDS_BYTES = 147456;

typedef GAS unsigned gu32;
#define RLX_AGENT __ATOMIC_RELAXED, __HIP_MEMORY_SCOPE_AGENT

#define XB_TMO      128
#define XB_XCNT(j)  (256  + 64 * (j))
#define XB_XSUB(j)  (1280 + 64 * (j))
#define XB_XGEN(j)  (2304 + 64 * (j))
#define XB_TOP      3328
#define XB_TOPGEN   3392
#define XB_SPIN_CAP (1u << 18)

__device__ __forceinline__ unsigned xb_ld(unsigned* p)              { return __hip_atomic_load(p, __ATOMIC_RELAXED, __HIP_MEMORY_SCOPE_AGENT); }
__device__ __forceinline__ unsigned xb_add(unsigned* p, unsigned v) { return __hip_atomic_fetch_add(p, v, __ATOMIC_RELAXED, __HIP_MEMORY_SCOPE_AGENT); }
__device__ __forceinline__ unsigned xb_xcc_id() { return (unsigned)__builtin_amdgcn_s_getreg((3 << 11) | 20) & 0xFu; }
#define XB_SPIN(cond, bar) do { unsigned _sp = 0; while (cond) { __builtin_amdgcn_s_sleep(1); \
    if ((++_sp & 255u) == 0u) { if (xb_ld(&(bar)[XB_TMO])) break; if (_sp > XB_SPIN_CAP) { atomicAdd(&(bar)[XB_TMO], 1u); break; } } } } while (0)

struct XcdBarrier { unsigned* bar; unsigned x; volatile LAS unsigned* st; };

__device__ __forceinline__ XcdBarrier xcd_barrier_post(unsigned* bar, volatile LAS unsigned* st) {
    XcdBarrier b; b.bar = bar; b.x = xb_xcc_id(); b.st = st;
    if (threadIdx.x == 0) (void)xb_add(&bar[XB_XCNT(b.x)], 1u);
    return b;
}
__device__ __forceinline__ void xcd_barrier_complete(unsigned* bar, unsigned x, unsigned& nloc, unsigned& nx) {
    const unsigned G = gridDim.x * gridDim.y * gridDim.z;
    unsigned sum, cnt, mine, sp = 0u;
    for (;;) {
        sum = 0u; cnt = 0u; mine = 0u;
#pragma unroll
        for (unsigned j = 0; j < 16; ++j) { const unsigned c = xb_ld(&bar[XB_XCNT(j)]); sum += c; cnt += (c > 0u) ? 1u : 0u; mine = (j == x) ? c : mine; }
        if (sum == G) break;
        __builtin_amdgcn_s_sleep(1);
        if ((++sp & 255u) == 0u) { if (xb_ld(&bar[XB_TMO])) break; if (sp > XB_SPIN_CAP) { atomicAdd(&bar[XB_TMO], 1u); break; } }
    }
    nloc = mine > 0u ? mine : 1u; nx = cnt > 0u ? cnt : 1u;
}
__device__ __forceinline__ void xcd_barrier(const XcdBarrier& b) {
    asm volatile("s_waitcnt vmcnt(0)" ::: "memory");
    __syncthreads();
    if (threadIdx.x == 0) {
        unsigned* bar = b.bar;
        __builtin_amdgcn_s_waitcnt(0);
        unsigned nloc = b.st[0], nx = b.st[1];
        if (nloc == 0u) { xcd_barrier_complete(bar, b.x, nloc, nx); b.st[0] = nloc; b.st[1] = nx; }
        const unsigned old = xb_add(&bar[XB_XSUB(b.x)], 1u);
        const unsigned gen = old / nloc;
        if (old + 1u == (gen + 1u) * nloc) {
            __builtin_amdgcn_fence(__ATOMIC_RELEASE, "agent");
            asm volatile("s_waitcnt vmcnt(0)" ::: "memory");
            const unsigned og = xb_add(&bar[XB_TOP], 1u);
            const unsigned tg = og / nx;
            if (og + 1u == (tg + 1u) * nx) xb_add(&bar[XB_TOPGEN], 1u);
            else XB_SPIN(xb_ld(&bar[XB_TOPGEN]) == tg, bar);
            __builtin_amdgcn_fence(__ATOMIC_ACQUIRE, "agent");
            xb_add(&bar[XB_XGEN(b.x)], 1u);
            asm volatile("s_waitcnt vmcnt(0)" ::: "memory");
        } else {
            XB_SPIN(xb_ld(&bar[XB_XGEN(b.x)]) == gen, bar);
            __builtin_amdgcn_fence(__ATOMIC_ACQUIRE, "agent");
            asm volatile("s_waitcnt vmcnt(0)" ::: "memory");
        }
    }
    __syncthreads();
}

#define LDS_WAIT() asm volatile("s_waitcnt lgkmcnt(0)" ::: "memory")
__device__ __forceinline__ float wave_sum(float v) {
#pragma unroll
    for (int o = 1; o < 64; o <<= 1) v += __shfl_xor(v, o);
    return v;
}
__device__ __forceinline__ unsigned f2bf(float f) { unsigned u = __builtin_bit_cast(unsigned, f); return (u + 0x7fffu + ((u >> 16) & 1u)) >> 16; }
__device__ __forceinline__ unsigned pk2(float lo, float hi) { return f2bf(lo) | (f2bf(hi) << 16); }

__device__ __forceinline__ int proj_orig_col(int n) {
    const int tile = n >> 8, c = n & 255;
    if (tile < 24) { const int c7 = n & 127, wc = c7 >> 5, fq = (c7 >> 3) & 3, nn = (c7 >> 2) & 1, j = c7 & 3;
        const int dim = (fq == 0) ? (4 * wc + j + 16 * nn) : (32 + wc * 24 + (fq - 1) * 8 + 4 * nn + j); return (n & ~127) + dim; }
    if (tile < 40) return n;
    if (tile < 72) { const int kind = 2 * (c >> 7) + ((c >> 2) & 1), chl = 16 * ((c >> 5) & 3) + 4 * ((c >> 3) & 3) + (c & 3); return 10240 + kind * 2048 + 64 * (tile - 40) + chl; }
    return 18432 + (n - 72 * 256);
}
template <bool REMAP>
__device__ __forceinline__ void p0_transpose_item(const float* W, int K, int N, bf16_t* WT, LAS float* scr, int item, int lane) {
    const int nblk = N / 32, kb = item / nblk, nb = item % nblk, k0 = 64 * kb, n0 = 32 * nb;
    const int ncol = REMAP ? proj_orig_col(n0 + (lane & 31)) : n0 + (lane & 31);
#pragma unroll 8
    for (int i = 0; i < 32; ++i) { const int kk = 2 * i + (lane >> 5); scr[kk * 33 + (lane & 31)] = W[(size_t)(k0 + kk) * N + ncol]; }
    LDS_WAIT(); asm volatile("" ::: "memory");
    const int c = lane & 7;
#pragma unroll
    for (int j = 0; j < 4; ++j) { const int n = (lane >> 3) + 8 * j; const LAS float* s = scr + (8 * c) * 33 + n;
        u32x4 o; o.x = pk2(s[0 * 33], s[1 * 33]); o.y = pk2(s[2 * 33], s[3 * 33]); o.z = pk2(s[4 * 33], s[5 * 33]); o.w = pk2(s[6 * 33], s[7 * 33]);
        *(u32x4*)(WT + (size_t)(n0 + n) * K + k0 + 8 * c) = o; }
    LDS_WAIT(); asm volatile("" ::: "memory");
}

__device__ __forceinline__ void sincos_f64(float ang, float& s, float& c) {
    const double x = (double)ang;
    const double n = __builtin_rint(x * 0.15915494309189535);
    double r = __builtin_fma(-n, 6.283185307179586, x); r = __builtin_fma(-n, 2.4492935982947064e-16, r);
    const double r2 = r * r;
    double ps = 1.0 / 51090942171709440000.0;
    ps = __builtin_fma(ps, r2, -1.0 / 121645100408832000.0);
    ps = __builtin_fma(ps, r2, 1.0 / 355687428096000.0);
    ps = __builtin_fma(ps, r2, -1.0 / 1307674368000.0);
    ps = __builtin_fma(ps, r2, 1.0 / 6227020800.0);
    ps = __builtin_fma(ps, r2, -1.0 / 39916800.0);
    ps = __builtin_fma(ps, r2, 1.0 / 362880.0);
    ps = __builtin_fma(ps, r2, -1.0 / 5040.0);
    ps = __builtin_fma(ps, r2, 1.0 / 120.0);
    ps = __builtin_fma(ps, r2, -1.0 / 6.0);
    ps = __builtin_fma(ps, r2, 1.0);
    double pc = -1.0 / 1124000727777607680000.0;
    pc = __builtin_fma(pc, r2, 1.0 / 2432902008176640000.0);
    pc = __builtin_fma(pc, r2, -1.0 / 6402373705728000.0);
    pc = __builtin_fma(pc, r2, 1.0 / 20922789888000.0);
    pc = __builtin_fma(pc, r2, -1.0 / 87178291200.0);
    pc = __builtin_fma(pc, r2, 1.0 / 479001600.0);
    pc = __builtin_fma(pc, r2, -1.0 / 3628800.0);
    pc = __builtin_fma(pc, r2, 1.0 / 40320.0);
    pc = __builtin_fma(pc, r2, -1.0 / 720.0);
    pc = __builtin_fma(pc, r2, 1.0 / 24.0);
    pc = __builtin_fma(pc, r2, -0.5);
    pc = __builtin_fma(pc, r2, 1.0);
    s = (float)(r * ps); c = (float)pc;
}

__device__ __forceinline__ unsigned attn_offk(unsigned row, unsigned ch) { return 256u * row + 16u * (ch ^ (row & 15u)); }
__device__ __forceinline__ unsigned attn_offv(unsigned row, unsigned ch) { return 256u * row + 16u * (ch ^ (((row & 3u) << 2) | ((row >> 2) & 3u))); }
__device__ __forceinline__ unsigned attn_lrow(unsigned k) { return (k & ~31u) | (((k >> 2) & 3u) << 3) | (((k >> 4) & 1u) << 2) | (k & 3u); }

__device__ __forceinline__ void attn_phase(LAS unsigned char* lds, const bf16_t* Qb, const bf16_t* Kb, const bf16_t* Vb, bf16_t* O0, bf16_t* O1, bf16_t* O2, float* LSE, int G, int vcu) {
    const int tid = threadIdx.x, lane = tid & 63, wid = __builtin_amdgcn_readfirstlane(tid >> 6), fr = lane & 15, fq = lane >> 4;
    LAS unsigned char* ldsK = lds; LAS unsigned char* ldsV = lds + 65536;
    const int NU = 3072, per = (NU + G - 1) / G;
    const int u_lo = vcu * per, u_hi = (u_lo + per) < NU ? (u_lo + per) : NU;
    for (int uid = u_lo; uid < u_hi; ++uid) {
        const int g = uid >> 10, rem = uid & 1023, hh = rem >> 7, rem2 = rem & 127;
        const int dsh = 2 * g, d = 1 << dsh;
        const int nbs = 7 - dsh;
        const int r = rem2 >> nbs, n = rem2 & ((1 << nbs) - 1);
        const size_t colb = (size_t)(g * 1024 + hh * 128) * 2;
        {
            const int ch = tid & 15, rb = tid >> 4;
            u32x4 kreg[8], vreg[8];
#pragma unroll
            for (int i = 0; i < 8; ++i) { const int kr = rb + 32 * i; int lp = 128 * (n - 1) + kr; lp = lp < 0 ? 0 : lp; const size_t p = ((size_t)lp << dsh) + r;
                const size_t off = p * (size_t)(NQKV * 2) + colb + ch * 16;
                kreg[i] = *(const u32x4*)((const char*)Kb + off); vreg[i] = *(const u32x4*)((const char*)Vb + off); }
#pragma unroll
            for (int i = 0; i < 8; ++i) { const unsigned kr = rb + 32 * i;
                *(LAS u32x4*)(ldsK + attn_offk(kr, ch)) = kreg[i]; *(LAS u32x4*)(ldsV + attn_offv(attn_lrow(kr), ch)) = vreg[i]; }
        }
        const int lq = 128 * n + 16 * wid + fr; const size_t pq = ((size_t)lq << dsh) + r;
        bf16x8 qf[4];
        { const bf16x8* qp = (const bf16x8*)((const char*)Qb + pq * (size_t)(NQKV * 2) + colb + fq * 16);
#pragma unroll
          for (int s = 0; s < 4; ++s) qf[s] = qp[4 * s]; }
        __syncthreads();
        f32x4 S[9];
#pragma unroll
        for (int t = 0; t < 9; ++t) {
            S[t] = (f32x4){0.f, 0.f, 0.f, 0.f};
            const unsigned row = 16 * wid + 16 * t + fr;
#pragma unroll
            for (int s = 0; s < 4; ++s) { const bf16x8 kf = *(const LAS bf16x8*)(ldsK + attn_offk(row, 4 * s + fq)); S[t] = __builtin_amdgcn_mfma_f32_16x16x32_bf16(kf, qf[s], S[t], 0, 0, 0); }
        }
        const float NEG = -1e30f;
#pragma unroll
        for (int j = 0; j < 4; ++j) { const int ko0 = 4 * fq + j; if (ko0 < fr) S[0][j] = NEG; if (ko0 > fr) S[8][j] = NEG; }
        if (n == 0) {
#pragma unroll
            for (int t = 0; t < 9; ++t)
#pragma unroll
                for (int j = 0; j < 4; ++j) { if (16 * wid + 16 * t + 4 * fq + j < 128) S[t][j] = NEG; }
        }
        float mx = NEG;
#pragma unroll
        for (int t = 0; t < 9; ++t) mx = fmaxf(mx, fmaxf(fmaxf(S[t][0], S[t][1]), fmaxf(S[t][2], S[t][3])));
        mx = fmaxf(mx, __shfl_xor(mx, 16)); mx = fmaxf(mx, __shfl_xor(mx, 32));
        float sum = 0.f;
#pragma unroll
        for (int t = 0; t < 9; ++t)
#pragma unroll
            for (int j = 0; j < 4; ++j) { const float p = __builtin_amdgcn_exp2f(S[t][j] - mx); S[t][j] = p; sum += p; }
        sum += __shfl_xor(sum, 16); sum += __shfl_xor(sum, 32);
        f32x4 O[8];
#pragma unroll
        for (int c = 0; c < 8; ++c) O[c] = (f32x4){0.f, 0.f, 0.f, 0.f};
        const unsigned q4 = (unsigned)(lane & 15) >> 2, p4 = (unsigned)lane & 3u;
#pragma unroll
        for (int u = 0; u < 5; ++u) {
            u32x4 pw; pw.x = cvt_pk_bf16(S[2 * u][0], S[2 * u][1]); pw.y = cvt_pk_bf16(S[2 * u][2], S[2 * u][3]);
            if (u < 4) { pw.z = cvt_pk_bf16(S[2 * u + 1][0], S[2 * u + 1][1]); pw.w = cvt_pk_bf16(S[2 * u + 1][2], S[2 * u + 1][3]); } else { pw.z = 0u; pw.w = 0u; }
            const bf16x8 pf = __builtin_bit_cast(bf16x8, pw);
            const unsigned kba = 16 * wid + 32 * u, kbb = (u < 4) ? kba + 16 : kba;
            const unsigned lra = (kba & ~31u) | ((unsigned)fq << 3) | (((kba >> 4) & 1u) << 2) | q4;
            const unsigned lrb = (kbb & ~31u) | ((unsigned)fq << 3) | (((kbb >> 4) & 1u) << 2) | q4;
#pragma unroll
            for (int c = 0; c < 8; ++c) {
                const s16x4 va = __builtin_amdgcn_ds_read_tr16_b64_v4i16((LAS s16x4*)(ldsV + attn_offv(lra, 2 * c + (p4 >> 1)) + 8 * (p4 & 1)));
                const s16x4 vb = __builtin_amdgcn_ds_read_tr16_b64_v4i16((LAS s16x4*)(ldsV + attn_offv(lrb, 2 * c + (p4 >> 1)) + 8 * (p4 & 1)));
                const bf16x8 vf = __builtin_shufflevector(va, vb, 0, 1, 2, 3, 4, 5, 6, 7);
                O[c] = __builtin_amdgcn_mfma_f32_16x16x32_bf16(vf, pf, O[c], 0, 0, 0);
            }
        }
        const float inv = 1.0f / sum;
        bf16_t* Og = (g == 0) ? O0 : ((g == 1) ? O1 : O2);
        bf16_t* op = Og + pq * NZA + hh * 128 + 4 * fq;
#pragma unroll
        for (int c = 0; c < 8; ++c) { u32x2 w; w.x = cvt_pk_bf16(O[c][0] * inv, O[c][1] * inv); w.y = cvt_pk_bf16(O[c][2] * inv, O[c][3] * inv); *(u32x2*)(op + 16 * c) = w; }
        if (fq == 0) LSE[((size_t)g * M + pq) * 8 + hh] = mx + __builtin_amdgcn_logf(sum);
        __syncthreads();
    }
}

struct Args { const float* x; const float* c; const int* pos; const float* g_pre; const float* w_ada; const float* b_ada; const float* w_in; const float* conv_w;
              const float* w_attn_o; const float* w_conv_o; const float* w_o; const float* g_post; float* out; unsigned char* ws; int ph_lo, ph_hi, li, pad; };

__global__ void __launch_bounds__(NWAVES * 64, 2) mk_fwd(Args args) {
    extern __shared__ __attribute__((aligned(16))) unsigned char lds_raw[];
    LAS unsigned char* lds = (LAS unsigned char*)lds_raw;
    volatile LAS unsigned* MISC = (volatile LAS unsigned*)(lds + MISC_OFF);
    const int tid = threadIdx.x, lane = tid & 63, wave = __builtin_amdgcn_readfirstlane(tid >> 6);
    const int G = gridDim.x; const int bx = blockIdx.x; const int vcu = (G % 8 == 0) ? (bx % 8) * (G / 8) + bx / 8 : bx;
    unsigned char* ws = args.ws;
    gu32* ctl = (gu32*)(ws + WS_CTL);
    float* mod = (float*)(ws + WS_MOD); float* cs = (float*)(ws + WS_CS);
    bf16_t* WinT = (bf16_t*)(ws + WS_WIN); bf16_t* WaT = (bf16_t*)(ws + WS_WA); bf16_t* WcT = (bf16_t*)(ws + WS_WC); bf16_t* WoT = (bf16_t*)(ws + WS_WO);
    bf16_t* Hb = (bf16_t*)(ws + WS_H); bf16_t* Qb = (bf16_t*)(ws + WS_Q); bf16_t* Kb = (bf16_t*)(ws + WS_K); bf16_t* Vb = (bf16_t*)(ws + WS_V);
    bf16_t* SZ = (bf16_t*)(ws + WS_SZ); bf16_t* Pb = (bf16_t*)(ws + WS_P); bf16_t* QCb = (bf16_t*)(ws + WS_QC);
    bf16_t* SGA = (bf16_t*)args.out; bf16_t* SGC = SGA + (size_t)M * D;
    bf16_t* O0 = (bf16_t*)(ws + WS_O0); bf16_t* O1 = (bf16_t*)(ws + WS_O1); bf16_t* O2 = (bf16_t*)(ws + WS_O2); float* LSE = (float*)(ws + WS_LSE);
    bf16_t* AATT = (bf16_t*)(ws + WS_AATT); bf16_t* Rb = (bf16_t*)(ws + WS_R); bf16_t* Tb = (bf16_t*)(ws + WS_T); bf16_t* MG = (bf16_t*)(ws + WS_MG);
    float* Y = args.out;

    for (int u = tid; u < (LDS_BYTES - LDSCTL_OFF) / 4; u += NWAVES * 64) ((LAS unsigned*)(lds + LDSCTL_OFF))[u] = 0u;
    __syncthreads();
    const int bli = (N_LAUNCHES == 1) ? 0 : args.li;
    XcdBarrier bar; bar.bar = (unsigned*)(ctl + CW_BAR) + bli * XCD_BAR_WORDS; bar.x = 0; bar.st = nullptr;
    if (N_LAUNCHES == 1) bar = xcd_barrier_post((unsigned*)(ctl + CW_BAR), MISC + 8);
    const int lo = args.ph_lo, hi = args.ph_hi;
#define IN(k) (lo <= (k) && (k) < hi)
#define BOTH(k) (IN(k) && IN((k) + 1))
#define GRID_BAR() xcd_barrier(bar)
#ifndef PROBE_REPEAT_MASK
#define PROBE_REPEAT_MASK 0
#endif
#define NREP(k) ((((PROBE_REPEAT_MASK) >> (k)) & 1) + 1)
    const int gw = vcu * NWAVES + wave, NGW = G * NWAVES;
    const int gtid = vcu * (NWAVES * 64) + tid, NT = G * NWAVES * 64;

    if (IN(0)) for (int rep = 0; rep < NREP(0); ++rep) {
        {
            LAS float* red = (LAS float*)lds;
            for (int cbk = bx; cbk < 256; cbk += G) {
                const int c4 = tid % 6, rg = tid / 6;
                f32x4 a = (f32x4){0.f, 0.f, 0.f, 0.f};
                if (rg < 85) { for (int k = rg; k < D; k += 85) { const float cv = args.c[k]; const f32x4 w = *(const f32x4*)(args.w_ada + (size_t)k * NMOD + cbk * 24 + c4 * 4); a += w * cv; }
                    *(LAS f32x4*)(red + (rg * 6 + c4) * 4) = a; }
                __syncthreads();
                if (tid < 24) { float s = 0.f; for (int i = 0; i < 85; ++i) s += red[(i * 6 + (tid >> 2)) * 4 + (tid & 3)]; mod[cbk * 24 + tid] = s + args.b_ada[cbk * 24 + tid]; }
                __syncthreads();
            }
        }
        for (int idx = gtid; idx < M * 16; idx += NT) { const int m = idx >> 4, i = idx & 15; const float ang = (float)args.pos[m] * INVF[i]; float s, c; sincos_f64(ang, s, c); cs[m * 32 + i] = c; cs[m * 32 + 16 + i] = s; }
        {
            LAS float* scr = (LAS float*)(lds + wave * 16384);
            constexpr int I_IN = (D / 64) * (PROJ / 32), I_A = (NZA / 64) * (D / 32), I_C = (NCV / 64) * (D / 32), I_O = (D / 64) * (D / 32);
            constexpr int NITEMS = I_IN + I_A + I_C + I_O;
            for (int it = gw; it < NITEMS; it += NGW) {
                int r = it;
                if (r < I_IN) { p0_transpose_item<true>(args.w_in, D, PROJ, WinT, scr, r, lane); continue; } r -= I_IN;
                if (r < I_A) { p0_transpose_item<false>(args.w_attn_o, NZA, D, WaT, scr, r, lane); continue; } r -= I_A;
                if (r < I_C) { p0_transpose_item<false>(args.w_conv_o, NCV, D, WcT, scr, r, lane); continue; } r -= I_C;
                p0_transpose_item<false>(args.w_o, D, D, WoT, scr, r, lane);
            }
        }
        if (BOTH(0) || rep + 1 < NREP(0)) GRID_BAR();
    }
    if (IN(1)) for (int rep = 0; rep < NREP(1); ++rep) {
        f32x4 av[4][2], bv[4][2];
#pragma unroll
        for (int j = 0; j < 4; ++j)
#pragma unroll
            for (int h = 0; h < 2; ++h) { const int k = 512 * j + 8 * lane + 4 * h; const f32x4 gp = *(const f32x4*)(args.g_pre + k), sc = *(const f32x4*)(mod + D + k); av[j][h] = gp * (sc + 1.0f); bv[j][h] = *(const f32x4*)(mod + k); }
        for (int m = gw; m < M; m += NGW) {
            const float* xr = args.x + (size_t)m * D + 8 * lane;
            f32x4 v[4][2]; float ss = 0.f;
#pragma unroll
            for (int j = 0; j < 4; ++j)
#pragma unroll
                for (int h = 0; h < 2; ++h) { v[j][h] = *(const f32x4*)(xr + 512 * j + 4 * h); const f32x4 q = v[j][h] * v[j][h]; ss += (q[0] + q[1]) + (q[2] + q[3]); }
            const float rstd = 1.0f / sqrtf(wave_sum(ss) * (1.0f / D) + EPS);
            bf16_t* hr = Hb + (size_t)m * D + 8 * lane;
#pragma unroll
            for (int j = 0; j < 4; ++j) { const f32x4 h0 = v[j][0] * rstd * av[j][0] + bv[j][0], h1 = v[j][1] * rstd * av[j][1] + bv[j][1]; *(u32x4*)(hr + 512 * j) = pg8::pack8(h0, h1); }
        }
        if (BOTH(1) || rep + 1 < NREP(1)) GRID_BAR();
    }
    if (IN(2)) {
        pg8::Gemm g{Hb, WinT, M, PROJ, D}; pg8::StaticOrder S; S.init(M, PROJ, G, bx, NREP(2));
        pg8::EpiProj E{Qb, Kb, Vb, SZ, Pb, QCb, SGA, SGC, cs};
#ifdef PROBE_STAMP
        pg8::gemm_phase<pg8::EpiProj, pg8::StaticOrder, PG8_ALIGN, PG8_SP2>(lds, g, S, E, bx == 0 ? (unsigned long long*)(ws + WS_MOD + 65536) : nullptr);
#else
        pg8::gemm_phase<pg8::EpiProj, pg8::StaticOrder, PG8_ALIGN, PG8_SP2>(lds, g, S, E);
#endif
        if (BOTH(2)) GRID_BAR();
    }
    if (IN(3)) for (int rep = 0; rep < NREP(3); ++rep) {
        attn_phase(lds, Qb, Kb, Vb, O0, O1, O2, LSE, G, vcu);
        if (BOTH(3) || rep + 1 < NREP(3)) GRID_BAR();
    }
    if (IN(4)) for (int rep = 0; rep < NREP(4); ++rep) {
        for (int it = gtid; it < M * 128; it += NT) {
            const int p = it >> 7, c8 = it & 127, hh = c8 >> 4;
            const float l0 = LSE[((size_t)0 * M + p) * 8 + hh], l1 = LSE[((size_t)1 * M + p) * 8 + hh], l2 = LSE[((size_t)2 * M + p) * 8 + hh];
            const float mx = fmaxf(l0, fmaxf(l1, l2));
            float w0 = __builtin_amdgcn_exp2f(l0 - mx), w1 = __builtin_amdgcn_exp2f(l1 - mx), w2 = __builtin_amdgcn_exp2f(l2 - mx);
            const float inv = 1.0f / (w0 + w1 + w2); w0 *= inv; w1 *= inv; w2 *= inv;
            const size_t off = (size_t)p * NZA + c8 * 8;
            f32x4 a0, a1, b0, b1, c0, c1, z0, z1;
            pg8::unpack8(*(const u32x4*)(O0 + off), a0, a1); pg8::unpack8(*(const u32x4*)(O1 + off), b0, b1); pg8::unpack8(*(const u32x4*)(O2 + off), c0, c1); pg8::unpack8(*(const u32x4*)(SZ + off), z0, z1);
            const f32x4 r0 = (a0 * w0 + b0 * w1 + c0 * w2) * z0, r1 = (a1 * w0 + b1 * w1 + c1 * w2) * z1;
            *(u32x4*)(AATT + off) = pg8::pack8(r0, r1);
        }
        for (int bk = vcu; bk < 256; bk += G) {
            const int chunk = tid & 255, half = tid >> 8, c0 = 8 * chunk, t0 = 64 * bk + 32 * half;
            f32x4 wa[3][2];
#pragma unroll
            for (int k = 0; k < 3; ++k) { wa[k][0] = *(const f32x4*)(args.conv_w + k * NCV + c0); wa[k][1] = *(const f32x4*)(args.conv_w + k * NCV + c0 + 4); }
            f32x4 pm2[2], pm1[2];
            if (t0 >= 2) { pg8::unpack8(*(const u32x4*)(Pb + (size_t)(t0 - 2) * NCV + c0), pm2[0], pm2[1]); pg8::unpack8(*(const u32x4*)(Pb + (size_t)(t0 - 1) * NCV + c0), pm1[0], pm1[1]); }
            else { pm2[0] = pm2[1] = pm1[0] = pm1[1] = (f32x4){0.f, 0.f, 0.f, 0.f}; }
#pragma unroll 4
            for (int t = t0; t < t0 + 32; ++t) {
                f32x4 pc[2], qc[2]; pg8::unpack8(*(const u32x4*)(Pb + (size_t)t * NCV + c0), pc[0], pc[1]); pg8::unpack8(*(const u32x4*)(QCb + (size_t)t * NCV + c0), qc[0], qc[1]);
                const f32x4 r0 = qc[0] * (wa[0][0] * pm2[0] + wa[1][0] * pm1[0] + wa[2][0] * pc[0]), r1 = qc[1] * (wa[0][1] * pm2[1] + wa[1][1] * pm1[1] + wa[2][1] * pc[1]);
                *(u32x4*)(Rb + (size_t)t * NCV + c0) = pg8::pack8(r0, r1);
                pm2[0] = pm1[0]; pm2[1] = pm1[1]; pm1[0] = pc[0]; pm1[1] = pc[1];
            }
        }
        if (BOTH(4) || rep + 1 < NREP(4)) GRID_BAR();
    }
    if (IN(5)) {
        pg8::Gemm g{AATT, WaT, M, D, NZA}; pg8::StaticOrder S; S.init(M, D, G, bx, NREP(5));
        pg8::EpiGate<false> E{Tb, SGA, nullptr, D};
        pg8::gemm_phase<pg8::EpiGate<false>, pg8::StaticOrder, PG8_ALIGN, PG8_SP2>(lds, g, S, E);
        if (BOTH(5)) GRID_BAR();
    }
    if (IN(6)) {
        pg8::Gemm g{Rb, WcT, M, D, NCV}; pg8::StaticOrder S; S.init(M, D, G, bx, NREP(6));
        pg8::EpiGate<true> E{MG, SGC, Tb, D};
        pg8::gemm_phase<pg8::EpiGate<true>, pg8::StaticOrder, PG8_ALIGN, PG8_SP2>(lds, g, S, E);
        if (BOTH(6)) GRID_BAR();
    }
    if (IN(7)) {
        pg8::Gemm g{MG, WoT, M, D, D}; pg8::StaticOrder S; S.init(M, D, G, bx, NREP(7));
        pg8::EpiF32 E{Y, D};
        pg8::gemm_phase<pg8::EpiF32, pg8::StaticOrder, PG8_ALIGN, PG8_SP2>(lds, g, S, E);
        if (BOTH(7)) GRID_BAR();
    }
    if (IN(8)) {
        f32x4 gv[4][2];
#pragma unroll
        for (int j = 0; j < 4; ++j)
#pragma unroll
            for (int h = 0; h < 2; ++h) { const int k = 512 * j + 8 * lane + 4 * h; gv[j][h] = *(const f32x4*)(mod + 2 * D + k) * *(const f32x4*)(args.g_post + k); }
        for (int m = gw; m < M; m += NGW) {
            float* yr = Y + (size_t)m * D + 8 * lane; const float* xr = args.x + (size_t)m * D + 8 * lane;
            f32x4 v[4][2]; float ss = 0.f;
#pragma unroll
            for (int j = 0; j < 4; ++j)
#pragma unroll
                for (int h = 0; h < 2; ++h) { v[j][h] = *(const f32x4*)(yr + 512 * j + 4 * h); const f32x4 q = v[j][h] * v[j][h]; ss += (q[0] + q[1]) + (q[2] + q[3]); }
            const float rstd = 1.0f / sqrtf(wave_sum(ss) * (1.0f / D) + EPS);
#pragma unroll
            for (int j = 0; j < 4; ++j)
#pragma unroll
                for (int h = 0; h < 2; ++h) { const f32x4 xv = *(const f32x4*)(xr + 512 * j + 4 * h); *(f32x4*)(yr + 512 * j + 4 * h) = xv + gv[j][h] * (v[j][h] * rstd); }
        }
    }
#ifdef PROBE_STAMP
    if (bx == 0 && tid == 0) {
        unsigned long long* st = (unsigned long long*)(ws + WS_MOD + 65536);
        unsigned long long v[8];
#pragma unroll
        for (int i = 0; i < 8; ++i) v[i] = __hip_atomic_load(st + i, __ATOMIC_RELAXED, __HIP_MEMORY_SCOPE_AGENT);
        long long val[4];
        val[0] = ((long long)(v[5] - v[4]) / 32 - 2000) / 10;
        val[1] = (long long)((v[3] - v[1]) * 4 / (v[2] - v[0]));
        val[2] = ((long long)(v[7] - v[5]) - (long long)(v[5] - v[4])) / 100;
        val[3] = (long long)(v[6] - v[5]) / 100;
        long long a = val[PROBE_STAMP & 3], b = val[(PROBE_STAMP >> 2) & 3];
        a = a < 0 ? 0 : (a > 99 ? 99 : a); b = b < 0 ? 0 : (b > 99 ? 99 : b);
        const unsigned long long ticks = (unsigned long long)(10 * a + 1000 * b) * 100ull;
        const unsigned long long t0 = __builtin_amdgcn_s_memrealtime();
        while (__builtin_amdgcn_s_memrealtime() - t0 < ticks) __builtin_amdgcn_s_sleep(32);
    }
#endif
#undef IN
#undef BOTH
#undef GRID_BAR
}

extern "C" void kernel_launch(void* const* d_in, const int* in_sizes, int n_in, void* d_out, int out_size, void* d_ws, size_t ws_size, hipStream_t stream) {
    static int grid = 0;
    if (grid == 0) {
        if (n_in != 12 || in_sizes[0] != M * D || out_size != M * D || ws_size < WS_END) { fprintf(stderr, "kernel_launch: unexpected shapes (n_in %d, in0 %d, out %d, ws %zu); nothing launched\n", n_in, n_in > 0 ? in_sizes[0] : -1, out_size, ws_size); grid = -1; return; }
        int dev = 0, cus = 0;
        if (hipGetDevice(&dev) != hipSuccess || hipDeviceGetAttribute(&cus, hipDeviceAttributeMultiprocessorCount, dev) != hipSuccess) { grid = -1; return; }
        if (hipFuncSetAttribute((const void*)mk_fwd, hipFuncAttributeMaxDynamicSharedMemorySize, LDS_BYTES) != hipSuccess) { fprintf(stderr, "kernel_launch: hipFuncSetAttribute failed\n"); grid = -1; return; }
        (void)hipGetLastError();
        grid = cus;
    }
    if (grid < 0) return;
    if (hipMemsetAsync((char*)d_ws + WS_CTL, 0, CTL_ZERO_BYTES, stream) != hipSuccess) return;
    Args a{};
    a.x = (const float*)d_in[0]; a.c = (const float*)d_in[1]; a.pos = (const int*)d_in[2]; a.g_pre = (const float*)d_in[3]; a.w_ada = (const float*)d_in[4]; a.b_ada = (const float*)d_in[5];
    a.w_in = (const float*)d_in[6]; a.conv_w = (const float*)d_in[7]; a.w_attn_o = (const float*)d_in[8]; a.w_conv_o = (const float*)d_in[9]; a.w_o = (const float*)d_in[10]; a.g_post = (const float*)d_in[11];
    a.out = (float*)d_out; a.ws = (unsigned char*)d_ws;
    for (int li = 0; li < N_LAUNCHES; ++li) {
        a.ph_lo = (N_LAUNCHES == 1) ? 0 : li; a.ph_hi = (N_LAUNCHES == 1) ? NPHASES : li + 1; a.li = li;
        hipLaunchKernelGGL(mk_fwd, dim3(grid), dim3(NWAVES * 64), LDS_BYTES, stream, a);
        if (hipPeekAtLastError() != hipSuccess) break;
    }
}
```

```cpp
#include <hip/hip_runtime.h>
#include <cstdio>
#include <cstdint>

#define GAS __attribute__((address_space(1)))
#define LAS __attribute__((address_space(3)))
typedef unsigned short bf16_t;
typedef short bf16x8 __attribute__((ext_vector_type(8)));
typedef short s16x4 __attribute__((ext_vector_type(4)));
typedef float f32x4 __attribute__((ext_vector_type(4)));
typedef float f32x2 __attribute__((ext_vector_type(2)));
typedef unsigned u32x4 __attribute__((ext_vector_type(4)));
typedef unsigned u32x2 __attribute__((ext_vector_type(2)));

constexpr int M = 16384, D = 2048, NQKV = 3072, NZA = 1024, NCV = 2048, PROJ = 22528, NMOD = 6144;
constexpr float EPS = 1e-6f;
constexpr float LOG2E = 1.4426950408889634f;
constexpr float QSCALE = 0.08838834764831845f * 1.4426950408889634f;

__constant__ float INVF[16] = {1.0f, 0.44036659598350525f, 0.1939227432012558f, 0.08539710193872452f, 0.03760603070259094f, 0.016560440883040428f,
    0.007292664609849453f, 0.0032114461064338684f, 0.0014142135623842478f, 0.0006227724370546639f, 0.00027424818836152554f, 0.00012076973507646471f,
    5.3182957344688475e-05f, 2.34199997066753e-05f, 1.0313385246263351e-05f, 4.541670477919979e-06f};

__device__ __forceinline__ unsigned cvt_pk_bf16(float lo, float hi) { unsigned r; asm volatile("v_cvt_pk_bf16_f32 %0, %1, %2" : "=v"(r) : "v"(lo), "v"(hi)); return r; }
__device__ __forceinline__ float bf_lo(unsigned w) { return __builtin_bit_cast(float, w << 16); }
__device__ __forceinline__ float bf_hi(unsigned w) { return __builtin_bit_cast(float, w & 0xffff0000u); }
__device__ __forceinline__ float silu_f(float v) { return v * __builtin_amdgcn_rcpf(1.0f + __builtin_amdgcn_exp2f(-v * LOG2E)); }
__device__ __forceinline__ float sigm_f(float v) { return __builtin_amdgcn_rcpf(1.0f + __builtin_amdgcn_exp2f(-v * LOG2E)); }

namespace pg8 {
constexpr int BM = 256, BK = 64, HALF = 128, HTB = HALF * BK * 2, STAGE_BYTES = 8 * HTB, NXCD = 8, WGM = 8;
__host__ __device__ __forceinline__ int lds_byte(int r, int c) { const int st = (r >> 4) * 2 + (c >> 5), rr = r & 15, cc = c & 31, ob = rr * 64 + cc * 2; return st * 1024 + (ob ^ (((ob >> 9) & 1) << 5)); }
__host__ __device__ __forceinline__ void stage_rc(int b, int& R, int& C) { const int st = b / 1024, sb = b % 1024, swz = sb ^ (((sb >> 9) & 1) << 5); R = (st >> 1) * 16 + swz / 64; C = (st & 1) * 32 + (swz % 64) / 2; }
__host__ __device__ __forceinline__ int perm32(int rho) { const int n = rho >> 4, i = rho & 15; return 8 * (i >> 2) + 4 * n + (i & 3); }

struct Unit { int pm, pn; };
struct Gemm { const bf16_t* A; const bf16_t* Bt; int M, N, K; };

struct StaticOrder {
    int nM, nN, nwg, G, c, rounds, rep;
    __host__ __device__ void init(int M_, int N_, int G_, int c_, int rep_ = 1) { nM = M_ / BM; nN = N_ / BM; nwg = nM * nN; G = G_; c = c_; rounds = (nwg + G - 1) / G; rep = rep_; }
    __host__ __device__ bool next(int i, Unit& u) const {
        if (i >= rounds * rep) return false;
        i = i % rounds;
        const long L = (long)i * G + c; if (L >= nwg) return false;
        int wgid = (int)L; { const int q = nwg / NXCD, r = nwg % NXCD, xcd = wgid % NXCD, off = wgid / NXCD; wgid = (xcd < r ? xcd * (q + 1) : r * (q + 1) + (xcd - r) * q) + off; }
        const int nig = WGM * nN, gid = wgid / nig, fm = gid * WGM, gsz = (nM - fm) < WGM ? (nM - fm) : WGM;
        u.pm = fm + ((wgid % nig) % gsz); u.pn = (wgid % nig) / gsz; return true;
    }
    __device__ __forceinline__ void a_ready(const Unit&) const {}
    __device__ __forceinline__ void done(const Unit&) const {}
};


template <class Epi, class Sched, bool ALIGN_EPI = false, bool SP2 = false>
__device__ __forceinline__ void gemm_phase(LAS unsigned char* lds, const Gemm g, const Sched& S, const Epi& E, unsigned long long* stamps = nullptr) {
    const int tid = threadIdx.x, wid = __builtin_amdgcn_readfirstlane(tid >> 6), lane = tid & 63, wr = wid >> 2, wc = wid & 3, fr = lane & 15, fq = lane >> 4;
    const int K = g.K, nt = K / BK;
    unsigned voffA[2], voffB[2];
#pragma unroll
    for (int i = 0; i < 2; ++i) { int R, C; stage_rc(tid * 16 + i * 8192, R, C); const int Rb = Epi::PERM ? ((R & ~31) + perm32(R & 31)) : R;
        voffA[i] = (unsigned)(R * K + C) * 2u; voffB[i] = (unsigned)(Rb * K + C) * 2u; }
    const size_t kstep = (size_t)(BK * 2);
    const size_t hstep = (size_t)HALF * K * 2;
    const size_t tstep = 2 * hstep;
    const unsigned ldsw = (unsigned)wid * 1024u;
    const int aoff = lds_byte(wr * 64 + fr, fq * 8), boff = lds_byte(wc * 32 + fr, fq * 8);
#define PG8_SA(b, h) (((b) * 2 + (h)) * HTB)
#define PG8_SB(b, h) ((4 + (b) * 2 + (h)) * HTB)
#define PG8_STAGE(bufoff, gbase, voff) do { _Pragma("unroll") for (int _i = 0; _i < 2; ++_i) \
        __builtin_amdgcn_global_load_lds((const unsigned*)((const char*)(gbase) + (voff)[_i]), (LAS unsigned*)(lds + (bufoff) + ldsw + _i * 8192), 16, 0, 0); } while (0)
#define PG8_LDA(dst, b, h) do { _Pragma("unroll") for (int m = 0; m < 4; ++m) _Pragma("unroll") for (int k = 0; k < 2; ++k) dst[m][k] = *(const LAS bf16x8*)(lds + PG8_SA(b, h) + aoff + m * 2048 + k * 1024); } while (0)
#define PG8_LDB(dst, b, h) do { _Pragma("unroll") for (int n = 0; n < 2; ++n) _Pragma("unroll") for (int k = 0; k < 2; ++k) dst[n][k] = *(const LAS bf16x8*)(lds + PG8_SB(b, h) + boff + n * 2048 + k * 1024); } while (0)
#define PG8_MMA(ai, bj, At, Bt) do { __builtin_amdgcn_s_setprio(1); _Pragma("unroll") for (int m = 0; m < 4; ++m) _Pragma("unroll") for (int n = 0; n < 2; ++n) _Pragma("unroll") for (int k = 0; k < 2; ++k) \
        acc[ai][bj][m][n] = __builtin_amdgcn_mfma_f32_16x16x32_bf16(Bt[n][k], At[m][k], acc[ai][bj][m][n], 0, 0, 0); __builtin_amdgcn_s_setprio(0); } while (0)
#define PG8_WAIT_V(n) asm volatile("s_waitcnt vmcnt(" #n ")" ::: "memory")
#define PG8_WAIT_L(n) asm volatile("s_waitcnt lgkmcnt(" #n ")" ::: "memory")
#define PG8_BAR __builtin_amdgcn_s_barrier()
#define PG8_SCHED __builtin_amdgcn_sched_barrier(0)
    Unit cur, nxt; int ui = 0;
    if (!S.next(0, cur)) return;
#ifdef PROBE_STAMP
    const bool stamper = (stamps != nullptr) && (wid == 0);
    unsigned sumK = 0, sumE = 0, tprev = 0; unsigned long long rt0 = 0, mt0 = 0;
    if (stamper) { rt0 = __builtin_amdgcn_s_memrealtime(); mt0 = __builtin_amdgcn_s_memtime(); }
#endif
    f32x4 acc[2][2][4][2];
#pragma unroll
    for (int a = 0; a < 2; ++a)
#pragma unroll
        for (int b = 0; b < 2; ++b)
#pragma unroll
            for (int m = 0; m < 4; ++m)
#pragma unroll
                for (int n = 0; n < 2; ++n) acc[a][b][m][n] = (f32x4){0.f, 0.f, 0.f, 0.f};
    bf16x8 At[4][2], B0[2][2], B1[2][2];
    const char* cA = (const char*)g.A + (size_t)cur.pm * tstep; const char* cB = (const char*)g.Bt + (size_t)cur.pn * tstep;
    S.a_ready(cur);
    if constexpr (SP2) {
        PG8_STAGE(PG8_SB(0, 0), cB, voffB); PG8_STAGE(PG8_SB(0, 1), cB + hstep, voffB); PG8_STAGE(PG8_SA(0, 0), cA, voffA); PG8_STAGE(PG8_SA(0, 1), cA + hstep, voffA);
        if (wr == 1) PG8_BAR;
        PG8_WAIT_V(2); PG8_BAR;
        PG8_STAGE(PG8_SB(1, 0), cB + kstep, voffB); PG8_STAGE(PG8_SA(1, 0), cA + kstep, voffA); PG8_STAGE(PG8_SB(1, 1), cB + hstep + kstep, voffB);
        PG8_WAIT_V(6); PG8_BAR;
    } else {
        PG8_STAGE(PG8_SB(0, 0), cB, voffB); PG8_STAGE(PG8_SA(0, 0), cA, voffA); PG8_STAGE(PG8_SB(0, 1), cB + hstep, voffB); PG8_STAGE(PG8_SA(0, 1), cA + hstep, voffA);
        if (wr == 1) PG8_BAR;
        PG8_WAIT_V(4); PG8_BAR;
        PG8_STAGE(PG8_SB(1, 0), cB + kstep, voffB); PG8_STAGE(PG8_SA(1, 0), cA + kstep, voffA); PG8_STAGE(PG8_SB(1, 1), cB + hstep + kstep, voffB);
        PG8_WAIT_V(6); PG8_BAR;
    }
    for (;;) {
        const bool has_next = S.next(ui + 1, nxt);
        const char* nA = has_next ? (const char*)g.A + (size_t)nxt.pm * tstep : cA; const char* nB = has_next ? (const char*)g.Bt + (size_t)nxt.pn * tstep : cB;
#ifdef PROBE_STAMP
        unsigned tka = 0; if (stamper) { tka = (unsigned)__builtin_amdgcn_s_memtime(); if (ui > 0) sumE += tka - tprev; }
#endif
        for (int t = 0; t < nt; t += 2) {
            const bool last = (t == nt - 2);
            const char* a1 = cA + (size_t)(t + 1) * kstep;
            const char* a2 = last ? nA : cA + (size_t)(t + 2) * kstep; const char* b2 = last ? nB : cB + (size_t)(t + 2) * kstep;
            const char* a3 = a2 + kstep; const char* b3 = b2 + kstep;
            if (last && has_next) S.a_ready(nxt);
            if constexpr (SP2) {
            PG8_LDB(B0, 0, 0); PG8_LDB(B1, 0, 1); PG8_SCHED; PG8_LDA(At, 0, 0); PG8_STAGE(PG8_SA(1, 1), a1 + hstep, voffA);
            PG8_WAIT_V(8); PG8_WAIT_L(0); PG8_BAR; PG8_MMA(0, 0, At, B0); PG8_MMA(0, 1, At, B1); PG8_BAR; PG8_SCHED;
            PG8_LDA(At, 0, 1); PG8_STAGE(PG8_SB(0, 0), b2, voffB); PG8_STAGE(PG8_SB(0, 1), b2 + hstep, voffB); PG8_STAGE(PG8_SA(0, 0), a2, voffA);
            PG8_WAIT_V(8); PG8_WAIT_L(0); PG8_BAR; PG8_MMA(1, 0, At, B0); PG8_MMA(1, 1, At, B1); PG8_BAR; PG8_SCHED;
            PG8_LDB(B0, 1, 0); PG8_LDB(B1, 1, 1); PG8_SCHED; PG8_LDA(At, 1, 0); PG8_STAGE(PG8_SA(0, 1), a2 + hstep, voffA);
            PG8_WAIT_V(8); PG8_WAIT_L(0); PG8_BAR; PG8_MMA(0, 0, At, B0); PG8_MMA(0, 1, At, B1); PG8_BAR; PG8_SCHED;
            PG8_LDA(At, 1, 1); PG8_STAGE(PG8_SB(1, 0), b3, voffB); PG8_STAGE(PG8_SB(1, 1), b3 + hstep, voffB); PG8_STAGE(PG8_SA(1, 0), a3, voffA);
            PG8_WAIT_V(8); PG8_WAIT_L(0); PG8_BAR; PG8_MMA(1, 0, At, B0); PG8_MMA(1, 1, At, B1); PG8_BAR; PG8_SCHED;
            } else {
            PG8_LDB(B0, 0, 0); PG8_SCHED; PG8_LDA(At, 0, 0); PG8_STAGE(PG8_SA(1, 1), a1 + hstep, voffA);
            PG8_WAIT_L(8); PG8_BAR; PG8_WAIT_L(0); PG8_MMA(0, 0, At, B0); PG8_BAR; PG8_SCHED;
            PG8_LDB(B1, 0, 1); PG8_STAGE(PG8_SB(0, 0), b2, voffB);
            PG8_BAR; PG8_WAIT_L(0); PG8_MMA(0, 1, At, B1); PG8_BAR;
            PG8_LDA(At, 0, 1); PG8_STAGE(PG8_SA(0, 0), a2, voffA);
            PG8_BAR; PG8_WAIT_L(0); PG8_MMA(1, 0, At, B0); PG8_BAR; PG8_SCHED;
            PG8_STAGE(PG8_SB(0, 1), b2 + hstep, voffB);
            PG8_WAIT_V(6); PG8_BAR; PG8_MMA(1, 1, At, B1); PG8_BAR;
            PG8_LDB(B0, 1, 0); PG8_SCHED; PG8_LDA(At, 1, 0); PG8_STAGE(PG8_SA(0, 1), a2 + hstep, voffA);
            PG8_WAIT_L(8); PG8_BAR; PG8_WAIT_L(0); PG8_MMA(0, 0, At, B0); PG8_BAR; PG8_SCHED;
            PG8_LDB(B1, 1, 1); PG8_STAGE(PG8_SB(1, 0), b3, voffB);
            PG8_BAR; PG8_WAIT_L(0); PG8_MMA(0, 1, At, B1); PG8_BAR;
            PG8_LDA(At, 1, 1); PG8_STAGE(PG8_SA(1, 0), a3, voffA);
            PG8_BAR; PG8_WAIT_L(0); PG8_MMA(1, 0, At, B0); PG8_BAR; PG8_SCHED;
            PG8_STAGE(PG8_SB(1, 1), b3 + hstep, voffB);
            PG8_WAIT_V(6); PG8_BAR; PG8_MMA(1, 1, At, B1); PG8_BAR;
            }
        }
#ifdef PROBE_STAMP
        if (stamper) { tprev = (unsigned)__builtin_amdgcn_s_memtime(); sumK += tprev - tka; }
#endif
        if constexpr (ALIGN_EPI) { if (wr == 0) PG8_BAR; }
        E(acc, cur, wr, wc, fr, fq); S.done(cur);
        if (!has_next) break;
#pragma unroll
        for (int a = 0; a < 2; ++a)
#pragma unroll
            for (int b = 0; b < 2; ++b)
#pragma unroll
                for (int m = 0; m < 4; ++m)
#pragma unroll
                    for (int n = 0; n < 2; ++n) acc[a][b][m][n] = (f32x4){0.f, 0.f, 0.f, 0.f};
        cur = nxt; cA = nA; cB = nB; ++ui;
        if constexpr (ALIGN_EPI) { if (wr == 1) PG8_BAR; }
    }
    PG8_WAIT_V(0);
    if constexpr (!ALIGN_EPI) { if (wr == 0) PG8_BAR; }
    PG8_BAR;
#ifdef PROBE_STAMP
    if (stamper && lane == 0) { stamps[0] = __builtin_amdgcn_s_memrealtime() - rt0; stamps[1] = __builtin_amdgcn_s_memtime() - mt0; stamps[2] = sumK; stamps[3] = sumE; stamps[4] = (unsigned)(ui + 1); }
#endif
#undef PG8_SA
#undef PG8_SB
#undef PG8_STAGE
#undef PG8_LDA
#undef PG8_LDB
#undef PG8_MMA
#undef PG8_WAIT_V
#undef PG8_WAIT_L
#undef PG8_BAR
#undef PG8_SCHED
}

__device__ __forceinline__ u32x4 pack8(const f32x4 v0, const f32x4 v1) { u32x4 w; w.x = cvt_pk_bf16(v0[0], v0[1]); w.y = cvt_pk_bf16(v0[2], v0[3]); w.z = cvt_pk_bf16(v1[0], v1[1]); w.w = cvt_pk_bf16(v1[2], v1[3]); return w; }
__device__ __forceinline__ void unpack8(const u32x4 w, f32x4& v0, f32x4& v1) { v0 = (f32x4){bf_lo(w.x), bf_hi(w.x), bf_lo(w.y), bf_hi(w.y)}; v1 = (f32x4){bf_lo(w.z), bf_hi(w.z), bf_lo(w.w), bf_hi(w.w)}; }

struct EpiProj {
    static constexpr bool PERM = true;
    bf16_t *Q, *Kb, *V, *SZ, *P, *QC, *SGA, *SGC; const float* cs;
    __device__ __forceinline__ void operator()(const f32x4 (&acc)[2][2][4][2], const Unit& u, int wr, int wc, int fr, int fq) const {
        const int pn = u.pn; const int row0 = u.pm * BM + wr * 64 + fr; const int lc = wc * 32 + 8 * fq;
        if (pn < 24) {
            const bool isq = pn < 12; bf16_t* base = isq ? Q : Kb; const int colt = (isq ? pn : pn - 12) * BM; const float sc = isq ? QSCALE : 1.0f;
            f32x4 cv[2][4], sv[2][4];
#pragma unroll
            for (int ai = 0; ai < 2; ++ai)
#pragma unroll
                for (int m = 0; m < 4; ++m) { const float* cr = cs + (size_t)(row0 + ai * HALF + m * 16) * 32 + 4 * wc; cv[ai][m] = *(const f32x4*)cr; sv[ai][m] = *(const f32x4*)(cr + 16); }
            const bool rot = (fq == 0);
#pragma unroll
            for (int ai = 0; ai < 2; ++ai)
#pragma unroll
                for (int m = 0; m < 4; ++m) {
                    const f32x4 c = rot ? cv[ai][m] * sc : (f32x4){sc, sc, sc, sc}, sn = rot ? sv[ai][m] * sc : (f32x4){0.f, 0.f, 0.f, 0.f};
                    bf16_t* rowp = base + (size_t)(row0 + ai * HALF + m * 16) * NQKV + colt + lc;
#pragma unroll
                    for (int bj = 0; bj < 2; ++bj) { const f32x4 v0 = acc[ai][bj][m][0], v1 = acc[ai][bj][m][1];
                        *(u32x4*)(rowp + bj * HALF) = pack8(v0 * c - v1 * sn, v0 * sn + v1 * c); }
                }
        } else if (pn < 36) {
            const int colt = (pn - 24) * BM;
#pragma unroll
            for (int ai = 0; ai < 2; ++ai)
#pragma unroll
                for (int m = 0; m < 4; ++m) { bf16_t* rowp = V + (size_t)(row0 + ai * HALF + m * 16) * NQKV + colt + lc;
#pragma unroll
                    for (int bj = 0; bj < 2; ++bj) *(u32x4*)(rowp + bj * HALF) = pack8(acc[ai][bj][m][0], acc[ai][bj][m][1]); }
        } else if (pn < 40) {
            const int colt = (pn - 36) * BM;
#pragma unroll
            for (int ai = 0; ai < 2; ++ai)
#pragma unroll
                for (int m = 0; m < 4; ++m) { bf16_t* rowp = SZ + (size_t)(row0 + ai * HALF + m * 16) * NZA + colt + lc;
#pragma unroll
                    for (int bj = 0; bj < 2; ++bj) { f32x4 a = acc[ai][bj][m][0], b = acc[ai][bj][m][1];
#pragma unroll
                        for (int j = 0; j < 4; ++j) { a[j] = silu_f(a[j]); b[j] = silu_f(b[j]); }
                        *(u32x4*)(rowp + bj * HALF) = pack8(a, b); } }
        } else if (pn < 72) {
            const int chb = 64 * (pn - 40) + 16 * wc + 4 * fq;
#pragma unroll
            for (int ai = 0; ai < 2; ++ai)
#pragma unroll
                for (int m = 0; m < 4; ++m) { const size_t ro = (size_t)(row0 + ai * HALF + m * 16) * NCV + chb;
                    const f32x4 cb = acc[ai][0][m][0], cc = acc[ai][0][m][1], cx = acc[ai][1][m][0], z = acc[ai][1][m][1];
                    f32x4 pv = cc * cx, qv;
#pragma unroll
                    for (int j = 0; j < 4; ++j) qv[j] = cb[j] * silu_f(z[j]);
                    u32x2 pw, qw; pw.x = cvt_pk_bf16(pv[0], pv[1]); pw.y = cvt_pk_bf16(pv[2], pv[3]); qw.x = cvt_pk_bf16(qv[0], qv[1]); qw.y = cvt_pk_bf16(qv[2], qv[3]);
                    *(u32x2*)(P + ro) = pw; *(u32x2*)(QC + ro) = qw; }
        } else {
            const bool isa = pn < 80; bf16_t* base = isa ? SGA : SGC; const int colt = (isa ? pn - 72 : pn - 80) * BM;
#pragma unroll
            for (int ai = 0; ai < 2; ++ai)
#pragma unroll
                for (int m = 0; m < 4; ++m) { bf16_t* rowp = base + (size_t)(row0 + ai * HALF + m * 16) * D + colt + lc;
#pragma unroll
                    for (int bj = 0; bj < 2; ++bj) { f32x4 a = acc[ai][bj][m][0], b = acc[ai][bj][m][1];
#pragma unroll
                        for (int j = 0; j < 4; ++j) { a[j] = sigm_f(a[j]); b[j] = sigm_f(b[j]); }
                        *(u32x4*)(rowp + bj * HALF) = pack8(a, b); } }
        }
    }
};
template <bool ADD> struct EpiGate {
    static constexpr bool PERM = true;
    bf16_t* O; const bf16_t* G1; const bf16_t* T; int ldc;
    __device__ __forceinline__ void operator()(const f32x4 (&acc)[2][2][4][2], const Unit& u, int wr, int wc, int fr, int fq) const {
        const int row0 = u.pm * BM + wr * 64 + fr, col0 = u.pn * BM + wc * 32 + 8 * fq;
#pragma unroll
        for (int ai = 0; ai < 2; ++ai) {
            u32x4 gw[4][2], tw[4][2];
#pragma unroll
            for (int m = 0; m < 4; ++m)
#pragma unroll
                for (int bj = 0; bj < 2; ++bj) { const size_t ro = (size_t)(row0 + ai * HALF + m * 16) * ldc + col0 + bj * HALF; gw[m][bj] = *(const u32x4*)(G1 + ro); if (ADD) tw[m][bj] = *(const u32x4*)(T + ro); }
#pragma unroll
            for (int m = 0; m < 4; ++m)
#pragma unroll
                for (int bj = 0; bj < 2; ++bj) { const size_t ro = (size_t)(row0 + ai * HALF + m * 16) * ldc + col0 + bj * HALF;
                    f32x4 g0, g1; unpack8(gw[m][bj], g0, g1);
                    f32x4 v0 = acc[ai][bj][m][0] * g0, v1 = acc[ai][bj][m][1] * g1;
                    if (ADD) { f32x4 t0, t1; unpack8(tw[m][bj], t0, t1); v0 += t0; v1 += t1; }
                    *(u32x4*)(O + ro) = pack8(v0, v1); }
            asm volatile("" ::: "memory");
        }
    }
};
struct EpiBf16 {
    static constexpr bool PERM = true;
    bf16_t* O; int ldc;
    __device__ __forceinline__ void operator()(const f32x4 (&acc)[2][2][4][2], const Unit& u, int wr, int wc, int fr, int fq) const {
        const int row0 = u.pm * BM + wr * 64 + fr, col0 = u.pn * BM + wc * 32 + 8 * fq;
#pragma unroll
        for (int ai = 0; ai < 2; ++ai)
#pragma unroll
            for (int m = 0; m < 4; ++m) { bf16_t* rowp = O + (size_t)(row0 + ai * HALF + m * 16) * ldc + col0;
#pragma unroll
                for (int bj = 0; bj < 2; ++bj) *(u32x4*)(rowp + bj * HALF) = pack8(acc[ai][bj][m][0], acc[ai][bj][m][1]); }
    }
};
}

#ifndef PG8_SP2
#define PG8_SP2 true
#endif
#ifndef PG8_ALIGN
#define PG8_ALIGN true
#endif

constexpr int NWAVES = 8;
#ifndef MK_N_LAUNCHES
#define MK_N_LAUNCHES 1
#endif
constexpr int NPHASES = 9;
constexpr int N_LAUNCHES = MK_N_LAUNCHES;

constexpr size_t MiB = 1u << 20;
constexpr size_t WS_CTL = 0, CTL_ZERO_BYTES = 1 * MiB;
constexpr size_t WS_MOD = 1 * MiB;
constexpr size_t WS_CS = 2 * MiB;
constexpr size_t WS_WIN = 4 * MiB;
constexpr size_t WS_WA = 92 * MiB, WS_WC = 96 * MiB, WS_WO = 104 * MiB;
constexpr size_t WS_H = 112 * MiB;
constexpr size_t WS_Q = 176 * MiB, WS_K = 272 * MiB, WS_V = 368 * MiB;
constexpr size_t WS_SZ = 464 * MiB;
constexpr size_t WS_P = 496 * MiB, WS_QC = 560 * MiB;
constexpr size_t WS_O2 = 624 * MiB;
constexpr size_t WS_LSE = 656 * MiB;
constexpr size_t WS_END = 658 * MiB;
constexpr size_t WS_O0 = 112 * MiB, WS_O1 = 144 * MiB;
constexpr size_t WS_AATT = 176 * MiB, WS_R = 208 * MiB, WS_T = 272 * MiB, WS_MG = 336 * MiB;
constexpr int CW_BAR = 4096;
#define XCD_BAR_WORDS 3456

constexpr int RING_BYTES = 131072;
constexpr int LDSCTL_OFF = RING_BYTES, MISC_OFF = LDSCTL_OFF + 320;
constexpr int LDS_BYTES = 147456;

typedef GAS unsigned gu32;
#define RLX_AGENT __ATOMIC_RELAXED, __HIP_MEMORY_SCOPE_AGENT

#define XB_TMO      128
#define XB_XCNT(j)  (256  + 64 * (j))
#define XB_XSUB(j)  (1280 + 64 * (j))
#define XB_XGEN(j)  (2304 + 64 * (j))
#define XB_TOP      3328
#define XB_TOPGEN   3392
#define XB_SPIN_CAP (1u << 18)

__device__ __forceinline__ unsigned xb_ld(unsigned* p)              { return __hip_atomic_load(p, __ATOMIC_RELAXED, __HIP_MEMORY_SCOPE_AGENT); }
__device__ __forceinline__ unsigned xb_add(unsigned* p, unsigned v) { return __hip_atomic_fetch_add(p, v, __ATOMIC_RELAXED, __HIP_MEMORY_SCOPE_AGENT); }
__device__ __forceinline__ unsigned xb_xcc_id() { return (unsigned)__builtin_amdgcn_s_getreg((3 << 11) | 20) & 0xFu; }
#define XB_SPIN(cond, bar) do { unsigned _sp = 0; while (cond) { __builtin_amdgcn_s_sleep(1); \
    if ((++_sp & 255u) == 0u) { if (xb_ld(&(bar)[XB_TMO])) break; if (_sp > XB_SPIN_CAP) { atomicAdd(&(bar)[XB_TMO], 1u); break; } } } } while (0)

struct XcdBarrier { unsigned* bar; unsigned x; volatile LAS unsigned* st; };

__device__ __forceinline__ XcdBarrier xcd_barrier_post(unsigned* bar, volatile LAS unsigned* st) {
    XcdBarrier b; b.bar = bar; b.x = xb_xcc_id(); b.st = st;
    if (threadIdx.x == 0) (void)xb_add(&bar[XB_XCNT(b.x)], 1u);
    return b;
}
__device__ __forceinline__ void xcd_barrier_complete(unsigned* bar, unsigned x, unsigned& nloc, unsigned& nx) {
    const unsigned G = gridDim.x * gridDim.y * gridDim.z;
    unsigned sum, cnt, mine, sp = 0u;
    for (;;) {
        sum = 0u; cnt = 0u; mine = 0u;
#pragma unroll
        for (unsigned j = 0; j < 16; ++j) { const unsigned c = xb_ld(&bar[XB_XCNT(j)]); sum += c; cnt += (c > 0u) ? 1u : 0u; mine = (j == x) ? c : mine; }
        if (sum == G) break;
        __builtin_amdgcn_s_sleep(1);
        if ((++sp & 255u) == 0u) { if (xb_ld(&bar[XB_TMO])) break; if (sp > XB_SPIN_CAP) { atomicAdd(&bar[XB_TMO], 1u); break; } }
    }
    nloc = mine > 0u ? mine : 1u; nx = cnt > 0u ? cnt : 1u;
}
__device__ __forceinline__ void xcd_barrier(const XcdBarrier& b) {
    asm volatile("s_waitcnt vmcnt(0)" ::: "memory");
    __syncthreads();
    if (threadIdx.x == 0) {
        unsigned* bar = b.bar;
        __builtin_amdgcn_s_waitcnt(0);
        unsigned nloc = b.st[0], nx = b.st[1];
        if (nloc == 0u) { xcd_barrier_complete(bar, b.x, nloc, nx); b.st[0] = nloc; b.st[1] = nx; }
        const unsigned old = xb_add(&bar[XB_XSUB(b.x)], 1u);
        const unsigned gen = old / nloc;
        if (old + 1u == (gen + 1u) * nloc) {
            __builtin_amdgcn_fence(__ATOMIC_RELEASE, "agent");
            asm volatile("s_waitcnt vmcnt(0)" ::: "memory");
            const unsigned og = xb_add(&bar[XB_TOP], 1u);
            const unsigned tg = og / nx;
            if (og + 1u == (tg + 1u) * nx) xb_add(&bar[XB_TOPGEN], 1u);
            else XB_SPIN(xb_ld(&bar[XB_TOPGEN]) == tg, bar);
            __builtin_amdgcn_fence(__ATOMIC_ACQUIRE, "agent");
            xb_add(&bar[XB_XGEN(b.x)], 1u);
            asm volatile("s_waitcnt vmcnt(0)" ::: "memory");
        } else {
            XB_SPIN(xb_ld(&bar[XB_XGEN(b.x)]) == gen, bar);
            __builtin_amdgcn_fence(__ATOMIC_ACQUIRE, "agent");
            asm volatile("s_waitcnt vmcnt(0)" ::: "memory");
        }
    }
    __syncthreads();
}

#define LDS_WAIT() asm volatile("s_waitcnt lgkmcnt(0)" ::: "memory")
__device__ __forceinline__ float wave_sum(float v) {
#pragma unroll
    for (int o = 1; o < 64; o <<= 1) v += __shfl_xor(v, o);
    return v;
}
__device__ __forceinline__ unsigned f2bf(float f) { unsigned u = __builtin_bit_cast(unsigned, f); return (u + 0x7fffu + ((u >> 16) & 1u)) >> 16; }
__device__ __forceinline__ unsigned pk2(float lo, float hi) { return f2bf(lo) | (f2bf(hi) << 16); }

__device__ __forceinline__ int proj_orig_col(int n) {
    const int tile = n >> 8, c = n & 255;
    if (tile < 24) { const int c7 = n & 127, wc = c7 >> 5, fq = (c7 >> 3) & 3, nn = (c7 >> 2) & 1, j = c7 & 3;
        const int dim = (fq == 0) ? (4 * wc + j + 16 * nn) : (32 + wc * 24 + (fq - 1) * 8 + 4 * nn + j); return (n & ~127) + dim; }
    if (tile < 40) return n;
    if (tile < 72) { const int kind = 2 * (c >> 7) + ((c >> 2) & 1), chl = 16 * ((c >> 5) & 3) + 4 * ((c >> 3) & 3) + (c & 3); return 10240 + kind * 2048 + 64 * (tile - 40) + chl; }
    return 18432 + (n - 72 * 256);
}
template <bool REMAP>
__device__ __forceinline__ void p0_transpose_item(const float* W, int K, int N, bf16_t* WT, LAS float* scr, int item, int lane) {
    const int nblk = N / 32, kb = item / nblk, nb = item % nblk, k0 = 64 * kb, n0 = 32 * nb;
    const int ncol = REMAP ? proj_orig_col(n0 + (lane & 31)) : n0 + (lane & 31);
#pragma unroll 8
    for (int i = 0; i < 32; ++i) { const int kk = 2 * i + (lane >> 5); scr[kk * 33 + (lane & 31)] = W[(size_t)(k0 + kk) * N + ncol]; }
    LDS_WAIT(); asm volatile("" ::: "memory");
    const int c = lane & 7;
#pragma unroll
    for (int j = 0; j < 4; ++j) { const int n = (lane >> 3) + 8 * j; const LAS float* s = scr + (8 * c) * 33 + n;
        u32x4 o; o.x = pk2(s[0 * 33], s[1 * 33]); o.y = pk2(s[2 * 33], s[3 * 33]); o.z = pk2(s[4 * 33], s[5 * 33]); o.w = pk2(s[6 * 33], s[7 * 33]);
        *(u32x4*)(WT + (size_t)(n0 + n) * K + k0 + 8 * c) = o; }
    LDS_WAIT(); asm volatile("" ::: "memory");
}

__device__ __forceinline__ void sincos_f64(float ang, float& s, float& c) {
    const double x = (double)ang;
    const double n = __builtin_rint(x * 0.15915494309189535);
    double r = __builtin_fma(-n, 6.283185307179586, x); r = __builtin_fma(-n, 2.4492935982947064e-16, r);
    const double r2 = r * r;
    double ps = 1.0 / 51090942171709440000.0;
    ps = __builtin_fma(ps, r2, -1.0 / 121645100408832000.0);
    ps = __builtin_fma(ps, r2, 1.0 / 355687428096000.0);
    ps = __builtin_fma(ps, r2, -1.0 / 1307674368000.0);
    ps = __builtin_fma(ps, r2, 1.0 / 6227020800.0);
    ps = __builtin_fma(ps, r2, -1.0 / 39916800.0);
    ps = __builtin_fma(ps, r2, 1.0 / 362880.0);
    ps = __builtin_fma(ps, r2, -1.0 / 5040.0);
    ps = __builtin_fma(ps, r2, 1.0 / 120.0);
    ps = __builtin_fma(ps, r2, -1.0 / 6.0);
    ps = __builtin_fma(ps, r2, 1.0);
    double pc = -1.0 / 1124000727777607680000.0;
    pc = __builtin_fma(pc, r2, 1.0 / 2432902008176640000.0);
    pc = __builtin_fma(pc, r2, -1.0 / 6402373705728000.0);
    pc = __builtin_fma(pc, r2, 1.0 / 20922789888000.0);
    pc = __builtin_fma(pc, r2, -1.0 / 87178291200.0);
    pc = __builtin_fma(pc, r2, 1.0 / 479001600.0);
    pc = __builtin_fma(pc, r2, -1.0 / 3628800.0);
    pc = __builtin_fma(pc, r2, 1.0 / 40320.0);
    pc = __builtin_fma(pc, r2, -1.0 / 720.0);
    pc = __builtin_fma(pc, r2, 1.0 / 24.0);
    pc = __builtin_fma(pc, r2, -0.5);
    pc = __builtin_fma(pc, r2, 1.0);
    s = (float)(r * ps); c = (float)pc;
}

__device__ __forceinline__ unsigned attn_offk(unsigned row, unsigned ch) { return 256u * row + 16u * (ch ^ (row & 15u)); }
__device__ __forceinline__ unsigned attn_offv(unsigned row, unsigned ch) { return 256u * row + 16u * (ch ^ (((row & 3u) << 2) | ((row >> 2) & 3u))); }
__device__ __forceinline__ unsigned attn_lrow(unsigned k) { return (k & ~31u) | (((k >> 2) & 3u) << 3) | (((k >> 4) & 1u) << 2) | (k & 3u); }

__device__ __forceinline__ void attn_phase(LAS unsigned char* lds, const bf16_t* Qb, const bf16_t* Kb, const bf16_t* Vb, bf16_t* O0, bf16_t* O1, bf16_t* O2, float* LSE, int G, int vcu) {
    const int tid = threadIdx.x, lane = tid & 63, wid = __builtin_amdgcn_readfirstlane(tid >> 6), fr = lane & 15, fq = lane >> 4;
    LAS unsigned char* ldsK = lds; LAS unsigned char* ldsV = lds + 65536;
    const int NU = 3072, per = (NU + G - 1) / G;
    const int u_lo = vcu * per, u_hi = (u_lo + per) < NU ? (u_lo + per) : NU;
    for (int uid = u_lo; uid < u_hi; ++uid) {
        const int g = uid >> 10, rem = uid & 1023, hh = rem >> 7, rem2 = rem & 127;
        const int dsh = 2 * g, d = 1 << dsh;
        const int nbs = 7 - dsh;
        const int r = rem2 >> nbs, n = rem2 & ((1 << nbs) - 1);
        const size_t colb = (size_t)(g * 1024 + hh * 128) * 2;
        {
            const int ch = tid & 15, rb = tid >> 4;
            u32x4 kreg[8], vreg[8];
#pragma unroll
            for (int i = 0; i < 8; ++i) { const int kr = rb + 32 * i; int lp = 128 * (n - 1) + kr; lp = lp < 0 ? 0 : lp; const size_t p = ((size_t)lp << dsh) + r;
                const size_t off = p * (size_t)(NQKV * 2) + colb + ch * 16;
                kreg[i] = *(const u32x4*)((const char*)Kb + off); vreg[i] = *(const u32x4*)((const char*)Vb + off); }
#pragma unroll
            for (int i = 0; i < 8; ++i) { const unsigned kr = rb + 32 * i;
                *(LAS u32x4*)(ldsK + attn_offk(kr, ch)) = kreg[i]; *(LAS u32x4*)(ldsV + attn_offv(attn_lrow(kr), ch)) = vreg[i]; }
        }
        const int lq = 128 * n + 16 * wid + fr; const size_t pq = ((size_t)lq << dsh) + r;
        bf16x8 qf[4];
        { const bf16x8* qp = (const bf16x8*)((const char*)Qb + pq * (size_t)(NQKV * 2) + colb + fq * 16);
#pragma unroll
          for (int s = 0; s < 4; ++s) qf[s] = qp[4 * s]; }
        __syncthreads();
        f32x4 S[9];
#pragma unroll
        for (int t = 0; t < 9; ++t) {
            S[t] = (f32x4){0.f, 0.f, 0.f, 0.f};
            const unsigned row = 16 * wid + 16 * t + fr;
#pragma unroll
            for (int s = 0; s < 4; ++s) { const bf16x8 kf = *(const LAS bf16x8*)(ldsK + attn_offk(row, 4 * s + fq)); S[t] = __builtin_amdgcn_mfma_f32_16x16x32_bf16(kf, qf[s], S[t], 0, 0, 0); }
        }
        const float NEG = -1e30f;
#pragma unroll
        for (int j = 0; j < 4; ++j) { const int ko0 = 4 * fq + j; if (ko0 < fr) S[0][j] = NEG; if (ko0 > fr) S[8][j] = NEG; }
        if (n == 0) {
#pragma unroll
            for (int t = 0; t < 9; ++t)
#pragma unroll
                for (int j = 0; j < 4; ++j) { if (16 * wid + 16 * t + 4 * fq + j < 128) S[t][j] = NEG; }
        }
        float mx = NEG;
#pragma unroll
        for (int t = 0; t < 9; ++t) mx = fmaxf(mx, fmaxf(fmaxf(S[t][0], S[t][1]), fmaxf(S[t][2], S[t][3])));
        mx = fmaxf(mx, __shfl_xor(mx, 16)); mx = fmaxf(mx, __shfl_xor(mx, 32));
        float sum = 0.f;
#pragma unroll
        for (int t = 0; t < 9; ++t)
#pragma unroll
            for (int j = 0; j < 4; ++j) { const float p = __builtin_amdgcn_exp2f(S[t][j] - mx); S[t][j] = p; sum += p; }
        sum += __shfl_xor(sum, 16); sum += __shfl_xor(sum, 32);
        f32x4 O[8];
#pragma unroll
        for (int c = 0; c < 8; ++c) O[c] = (f32x4){0.f, 0.f, 0.f, 0.f};
        const unsigned q4 = (unsigned)(lane & 15) >> 2, p4 = (unsigned)lane & 3u;
#pragma unroll
        for (int u = 0; u < 5; ++u) {
            u32x4 pw; pw.x = cvt_pk_bf16(S[2 * u][0], S[2 * u][1]); pw.y = cvt_pk_bf16(S[2 * u][2], S[2 * u][3]);
            if (u < 4) { pw.z = cvt_pk_bf16(S[2 * u + 1][0], S[2 * u + 1][1]); pw.w = cvt_pk_bf16(S[2 * u + 1][2], S[2 * u + 1][3]); } else { pw.z = 0u; pw.w = 0u; }
            const bf16x8 pf = __builtin_bit_cast(bf16x8, pw);
            const unsigned kba = 16 * wid + 32 * u, kbb = (u < 4) ? kba + 16 : kba;
            const unsigned lra = (kba & ~31u) | ((unsigned)fq << 3) | (((kba >> 4) & 1u) << 2) | q4;
            const unsigned lrb = (kbb & ~31u) | ((unsigned)fq << 3) | (((kbb >> 4) & 1u) << 2) | q4;
#pragma unroll
            for (int c = 0; c < 8; ++c) {
                const s16x4 va = __builtin_amdgcn_ds_read_tr16_b64_v4i16((LAS s16x4*)(ldsV + attn_offv(lra, 2 * c + (p4 >> 1)) + 8 * (p4 & 1)));
                const s16x4 vb = __builtin_amdgcn_ds_read_tr16_b64_v4i16((LAS s16x4*)(ldsV + attn_offv(lrb, 2 * c + (p4 >> 1)) + 8 * (p4 & 1)));
                const bf16x8 vf = __builtin_shufflevector(va, vb, 0, 1, 2, 3, 4, 5, 6, 7);
                O[c] = __builtin_amdgcn_mfma_f32_16x16x32_bf16(vf, pf, O[c], 0, 0, 0);
            }
        }
        const float inv = 1.0f / sum;
        bf16_t* Og = (g == 0) ? O0 : ((g == 1) ? O1 : O2);
        bf16_t* op = Og + pq * NZA + hh * 128 + 4 * fq;
#pragma unroll
        for (int c = 0; c < 8; ++c) { u32x2 w; w.x = cvt_pk_bf16(O[c][0] * inv, O[c][1] * inv); w.y = cvt_pk_bf16(O[c][2] * inv, O[c][3] * inv); *(u32x2*)(op + 16 * c) = w; }
        if (fq == 0) LSE[((size_t)g * M + pq) * 8 + hh] = mx + __builtin_amdgcn_logf(sum);
        __syncthreads();
    }
}

struct Args { const float* x; const float* c; const int* pos; const float* g_pre; const float* w_ada; const float* b_ada; const float* w_in; const float* conv_w;
              const float* w_attn_o; const float* w_conv_o; const float* w_o; const float* g_post; float* out; unsigned char* ws; int ph_lo, ph_hi, li, pad; };

__global__ void __launch_bounds__(NWAVES * 64, 2) mk_fwd(Args args) {
    extern __shared__ __attribute__((aligned(16))) unsigned char lds_raw[];
    LAS unsigned char* lds = (LAS unsigned char*)lds_raw;
    volatile LAS unsigned* MISC = (volatile LAS unsigned*)(lds + MISC_OFF);
    const int tid = threadIdx.x, lane = tid & 63, wave = __builtin_amdgcn_readfirstlane(tid >> 6);
    const int G = gridDim.x; const int bx = blockIdx.x; const int vcu = (G % 8 == 0) ? (bx % 8) * (G / 8) + bx / 8 : bx;
    unsigned char* ws = args.ws;
    gu32* ctl = (gu32*)(ws + WS_CTL);
    float* mod = (float*)(ws + WS_MOD); float* cs = (float*)(ws + WS_CS);
    bf16_t* WinT = (bf16_t*)(ws + WS_WIN); bf16_t* WaT = (bf16_t*)(ws + WS_WA); bf16_t* WcT = (bf16_t*)(ws + WS_WC); bf16_t* WoT = (bf16_t*)(ws + WS_WO);
    bf16_t* Hb = (bf16_t*)(ws + WS_H); bf16_t* Qb = (bf16_t*)(ws + WS_Q); bf16_t* Kb = (bf16_t*)(ws + WS_K); bf16_t* Vb = (bf16_t*)(ws + WS_V);
    bf16_t* SZ = (bf16_t*)(ws + WS_SZ); bf16_t* Pb = (bf16_t*)(ws + WS_P); bf16_t* QCb = (bf16_t*)(ws + WS_QC);
    bf16_t* SGA = (bf16_t*)args.out; bf16_t* SGC = SGA + (size_t)M * D;
    bf16_t* O0 = (bf16_t*)(ws + WS_O0); bf16_t* O1 = (bf16_t*)(ws + WS_O1); bf16_t* O2 = (bf16_t*)(ws + WS_O2); float* LSE = (float*)(ws + WS_LSE);
    bf16_t* AATT = (bf16_t*)(ws + WS_AATT); bf16_t* Rb = (bf16_t*)(ws + WS_R); bf16_t* Tb = (bf16_t*)(ws + WS_T); bf16_t* MG = (bf16_t*)(ws + WS_MG);
    bf16_t* Yb = (bf16_t*)(ws + WS_T);

    for (int u = tid; u < (LDS_BYTES - LDSCTL_OFF) / 4; u += NWAVES * 64) ((LAS unsigned*)(lds + LDSCTL_OFF))[u] = 0u;
    __syncthreads();
    const int bli = (N_LAUNCHES == 1) ? 0 : args.li;
    XcdBarrier bar; bar.bar = (unsigned*)(ctl + CW_BAR) + bli * XCD_BAR_WORDS; bar.x = 0; bar.st = nullptr;
    if (N_LAUNCHES == 1) bar = xcd_barrier_post((unsigned*)(ctl + CW_BAR), MISC + 8);
    const int lo = args.ph_lo, hi = args.ph_hi;
#define IN(k) (lo <= (k) && (k) < hi)
#define BOTH(k) (IN(k) && IN((k) + 1))
#define GRID_BAR() xcd_barrier(bar)
#ifndef PROBE_REPEAT_MASK
#define PROBE_REPEAT_MASK 0
#endif
#define NREP(k) ((((PROBE_REPEAT_MASK) >> (k)) & 1) + 1)
#ifdef PROBE_PH
#define PHSTAMP(k) do { if (bx == 0 && tid == 0) ((unsigned long long*)(ws + WS_MOD + 65536))[16 + (k)] = __builtin_amdgcn_s_memrealtime(); } while (0)
#else
#define PHSTAMP(k) do {} while (0)
#endif
    PHSTAMP(0);
    const int gw = vcu * NWAVES + wave, NGW = G * NWAVES;
    const int gtid = vcu * (NWAVES * 64) + tid, NT = G * NWAVES * 64;

    if (IN(0)) for (int rep = 0; rep < NREP(0); ++rep) {
        {
            LAS float* red = (LAS float*)lds;
            for (int cbk = bx; cbk < 256; cbk += G) {
                const int c4 = tid % 6, rg = tid / 6;
                f32x4 a = (f32x4){0.f, 0.f, 0.f, 0.f};
                if (rg < 85) { for (int k = rg; k < D; k += 85) { const float cv = args.c[k]; const f32x4 w = *(const f32x4*)(args.w_ada + (size_t)k * NMOD + cbk * 24 + c4 * 4); a += w * cv; }
                    *(LAS f32x4*)(red + (rg * 6 + c4) * 4) = a; }
                __syncthreads();
                if (tid < 24) { float s = 0.f; for (int i = 0; i < 85; ++i) s += red[(i * 6 + (tid >> 2)) * 4 + (tid & 3)]; mod[cbk * 24 + tid] = s + args.b_ada[cbk * 24 + tid]; }
                __syncthreads();
            }
        }
        for (int idx = gtid; idx < M * 16; idx += NT) { const int m = idx >> 4, i = idx & 15; const float ang = (float)args.pos[m] * INVF[i]; float s, c; sincos_f64(ang, s, c); cs[m * 32 + i] = c; cs[m * 32 + 16 + i] = s; }
        {
            LAS float* scr = (LAS float*)(lds + wave * 16384);
            constexpr int I_IN = (D / 64) * (PROJ / 32), I_A = (NZA / 64) * (D / 32), I_C = (NCV / 64) * (D / 32), I_O = (D / 64) * (D / 32);
            constexpr int NITEMS = I_IN + I_A + I_C + I_O;
            for (int it = gw; it < NITEMS; it += NGW) {
                int r = it;
                if (r < I_IN) { p0_transpose_item<true>(args.w_in, D, PROJ, WinT, scr, r, lane); continue; } r -= I_IN;
                if (r < I_A) { p0_transpose_item<false>(args.w_attn_o, NZA, D, WaT, scr, r, lane); continue; } r -= I_A;
                if (r < I_C) { p0_transpose_item<false>(args.w_conv_o, NCV, D, WcT, scr, r, lane); continue; } r -= I_C;
                p0_transpose_item<false>(args.w_o, D, D, WoT, scr, r, lane);
            }
        }
        if (BOTH(0) || rep + 1 < NREP(0)) GRID_BAR();
    }
    PHSTAMP(1);
    if (IN(1)) for (int rep = 0; rep < NREP(1); ++rep) {
        f32x4 av[4][2], bv[4][2];
#pragma unroll
        for (int j = 0; j < 4; ++j)
#pragma unroll
            for (int h = 0; h < 2; ++h) { const int k = 512 * j + 8 * lane + 4 * h; const f32x4 gp = *(const f32x4*)(args.g_pre + k), sc = *(const f32x4*)(mod + D + k); av[j][h] = gp * (sc + 1.0f); bv[j][h] = *(const f32x4*)(mod + k); }
        for (int m = gw; m < M; m += NGW) {
            const float* xr = args.x + (size_t)m * D + 8 * lane;
            f32x4 v[4][2]; float ss = 0.f;
#pragma unroll
            for (int j = 0; j < 4; ++j)
#pragma unroll
                for (int h = 0; h < 2; ++h) { v[j][h] = *(const f32x4*)(xr + 512 * j + 4 * h); const f32x4 q = v[j][h] * v[j][h]; ss += (q[0] + q[1]) + (q[2] + q[3]); }
            const float rstd = 1.0f / sqrtf(wave_sum(ss) * (1.0f / D) + EPS);
            bf16_t* hr = Hb + (size_t)m * D + 8 * lane;
#pragma unroll
            for (int j = 0; j < 4; ++j) { const f32x4 h0 = v[j][0] * rstd * av[j][0] + bv[j][0], h1 = v[j][1] * rstd * av[j][1] + bv[j][1]; *(u32x4*)(hr + 512 * j) = pg8::pack8(h0, h1); }
        }
        if (BOTH(1) || rep + 1 < NREP(1)) GRID_BAR();
    }
    PHSTAMP(2);
    if (IN(2)) {
        pg8::Gemm g{Hb, WinT, M, PROJ, D}; pg8::StaticOrder S; S.init(M, PROJ, G, bx, NREP(2));
        pg8::EpiProj E{Qb, Kb, Vb, SZ, Pb, QCb, SGA, SGC, cs};
#ifdef PROBE_STAMP
        pg8::gemm_phase<pg8::EpiProj, pg8::StaticOrder, PG8_ALIGN, PG8_SP2>(lds, g, S, E, bx == 0 ? (unsigned long long*)(ws + WS_MOD + 65536) : nullptr);
#else
        pg8::gemm_phase<pg8::EpiProj, pg8::StaticOrder, PG8_ALIGN, PG8_SP2>(lds, g, S, E);
#endif
        if (BOTH(2)) GRID_BAR();
    }
    PHSTAMP(3);
    if (IN(3)) for (int rep = 0; rep < NREP(3); ++rep) {
        attn_phase(lds, Qb, Kb, Vb, O0, O1, O2, LSE, G, vcu);
        if (BOTH(3) || rep + 1 < NREP(3)) GRID_BAR();
    }
    PHSTAMP(4);
    if (IN(4)) for (int rep = 0; rep < NREP(4); ++rep) {
        for (int it = gtid; it < M * 128; it += NT) {
            const int p = it >> 7, c8 = it & 127, hh = c8 >> 4;
            const float l0 = LSE[((size_t)0 * M + p) * 8 + hh], l1 = LSE[((size_t)1 * M + p) * 8 + hh], l2 = LSE[((size_t)2 * M + p) * 8 + hh];
            const float mx = fmaxf(l0, fmaxf(l1, l2));
            float w0 = __builtin_amdgcn_exp2f(l0 - mx), w1 = __builtin_amdgcn_exp2f(l1 - mx), w2 = __builtin_amdgcn_exp2f(l2 - mx);
            const float inv = 1.0f / (w0 + w1 + w2); w0 *= inv; w1 *= inv; w2 *= inv;
            const size_t off = (size_t)p * NZA + c8 * 8;
            f32x4 a0, a1, b0, b1, c0, c1, z0, z1;
            pg8::unpack8(*(const u32x4*)(O0 + off), a0, a1); pg8::unpack8(*(const u32x4*)(O1 + off), b0, b1); pg8::unpack8(*(const u32x4*)(O2 + off), c0, c1); pg8::unpack8(*(const u32x4*)(SZ + off), z0, z1);
            const f32x4 r0 = (a0 * w0 + b0 * w1 + c0 * w2) * z0, r1 = (a1 * w0 + b1 * w1 + c1 * w2) * z1;
            *(u32x4*)(AATT + off) = pg8::pack8(r0, r1);
        }
        for (int bk = vcu; bk < 256; bk += G) {
            const int chunk = tid & 255, half = tid >> 8, c0 = 8 * chunk, t0 = 64 * bk + 32 * half;
            f32x4 wa[3][2];
#pragma unroll
            for (int k = 0; k < 3; ++k) { wa[k][0] = *(const f32x4*)(args.conv_w + k * NCV + c0); wa[k][1] = *(const f32x4*)(args.conv_w + k * NCV + c0 + 4); }
            f32x4 pm2[2], pm1[2];
            if (t0 >= 2) { pg8::unpack8(*(const u32x4*)(Pb + (size_t)(t0 - 2) * NCV + c0), pm2[0], pm2[1]); pg8::unpack8(*(const u32x4*)(Pb + (size_t)(t0 - 1) * NCV + c0), pm1[0], pm1[1]); }
            else { pm2[0] = pm2[1] = pm1[0] = pm1[1] = (f32x4){0.f, 0.f, 0.f, 0.f}; }
#pragma unroll 4
            for (int t = t0; t < t0 + 32; ++t) {
                f32x4 pc[2], qc[2]; pg8::unpack8(*(const u32x4*)(Pb + (size_t)t * NCV + c0), pc[0], pc[1]); pg8::unpack8(*(const u32x4*)(QCb + (size_t)t * NCV + c0), qc[0], qc[1]);
                const f32x4 r0 = qc[0] * (wa[0][0] * pm2[0] + wa[1][0] * pm1[0] + wa[2][0] * pc[0]), r1 = qc[1] * (wa[0][1] * pm2[1] + wa[1][1] * pm1[1] + wa[2][1] * pc[1]);
                *(u32x4*)(Rb + (size_t)t * NCV + c0) = pg8::pack8(r0, r1);
                pm2[0] = pm1[0]; pm2[1] = pm1[1]; pm1[0] = pc[0]; pm1[1] = pc[1];
            }
        }
        if (BOTH(4) || rep + 1 < NREP(4)) GRID_BAR();
    }
    PHSTAMP(5);
    if (IN(5)) {
        pg8::Gemm g{AATT, WaT, M, D, NZA}; pg8::StaticOrder S; S.init(M, D, G, bx, NREP(5));
        pg8::EpiGate<false> E{Tb, SGA, nullptr, D};
        pg8::gemm_phase<pg8::EpiGate<false>, pg8::StaticOrder, PG8_ALIGN, PG8_SP2>(lds, g, S, E);
        if (BOTH(5)) GRID_BAR();
    }
    PHSTAMP(6);
    if (IN(6)) {
        pg8::Gemm g{Rb, WcT, M, D, NCV}; pg8::StaticOrder S; S.init(M, D, G, bx, NREP(6));
        pg8::EpiGate<true> E{MG, SGC, Tb, D};
        pg8::gemm_phase<pg8::EpiGate<true>, pg8::StaticOrder, PG8_ALIGN, PG8_SP2>(lds, g, S, E);
        if (BOTH(6)) GRID_BAR();
    }
    PHSTAMP(7);
    if (IN(7)) {
        pg8::Gemm g{MG, WoT, M, D, D}; pg8::StaticOrder S; S.init(M, D, G, bx, NREP(7));
        pg8::EpiBf16 E{Yb, D};
        pg8::gemm_phase<pg8::EpiBf16, pg8::StaticOrder, PG8_ALIGN, PG8_SP2>(lds, g, S, E);
        if (BOTH(7)) GRID_BAR();
    }
    PHSTAMP(8);
    if (IN(8)) {
        f32x4 gv[4][2];
#pragma unroll
        for (int j = 0; j < 4; ++j)
#pragma unroll
            for (int h = 0; h < 2; ++h) { const int k = 512 * j + 8 * lane + 4 * h; gv[j][h] = *(const f32x4*)(mod + 2 * D + k) * *(const f32x4*)(args.g_post + k); }
        for (int m = gw; m < M; m += NGW) {
            const bf16_t* yr = Yb + (size_t)m * D + 8 * lane; const float* xr = args.x + (size_t)m * D + 8 * lane; float* orow = args.out + (size_t)m * D + 8 * lane;
            f32x4 v[4][2]; float ss = 0.f;
#pragma unroll
            for (int j = 0; j < 4; ++j) { pg8::unpack8(*(const u32x4*)(yr + 512 * j), v[j][0], v[j][1]);
#pragma unroll
                for (int h = 0; h < 2; ++h) { const f32x4 q = v[j][h] * v[j][h]; ss += (q[0] + q[1]) + (q[2] + q[3]); } }
            const float rstd = 1.0f / sqrtf(wave_sum(ss) * (1.0f / D) + EPS);
#pragma unroll
            for (int j = 0; j < 4; ++j)
#pragma unroll
                for (int h = 0; h < 2; ++h) { const f32x4 xv = *(const f32x4*)(xr + 512 * j + 4 * h); *(f32x4*)(orow + 512 * j + 4 * h) = xv + gv[j][h] * (v[j][h] * rstd); }
        }
    }
    PHSTAMP(9);
#ifdef PROBE_PH
    if (bx == 0 && tid == 0) {
        asm volatile("s_waitcnt vmcnt(0)" ::: "memory");
        unsigned long long* st = (unsigned long long*)(ws + WS_MOD + 65536) + 16;
        const int ia = (PROBE_PH) & 15, ua = ((PROBE_PH) >> 4) & 255, ib = ((PROBE_PH) >> 12) & 15, ub = ((PROBE_PH) >> 16) & 255;
        long long a = (long long)(__hip_atomic_load(st + ia + 1, __ATOMIC_RELAXED, __HIP_MEMORY_SCOPE_AGENT) - __hip_atomic_load(st + ia, __ATOMIC_RELAXED, __HIP_MEMORY_SCOPE_AGENT)) / (100 * ua);
        long long b = (long long)(__hip_atomic_load(st + ib + 1, __ATOMIC_RELAXED, __HIP_MEMORY_SCOPE_AGENT) - __hip_atomic_load(st + ib, __ATOMIC_RELAXED, __HIP_MEMORY_SCOPE_AGENT)) / (100 * ub);
        a = a < 0 ? 0 : (a > 99 ? 99 : a); b = b < 0 ? 0 : (b > 99 ? 99 : b);
        const unsigned long long ticks = (unsigned long long)(10 * a + 1000 * b) * 100ull;
        const unsigned long long t0 = __builtin_amdgcn_s_memrealtime();
        while (__builtin_amdgcn_s_memrealtime() - t0 < ticks) __builtin_amdgcn_s_sleep(32);
    }
#endif
#ifdef PROBE_STAMP
    if (bx == 0 && tid == 0) {
        unsigned long long* st = (unsigned long long*)(ws + WS_MOD + 65536);
        unsigned long long v[8];
#pragma unroll
        for (int i = 0; i < 8; ++i) v[i] = __hip_atomic_load(st + i, __ATOMIC_RELAXED, __HIP_MEMORY_SCOPE_AGENT);
        long long val[4];
        val[0] = ((long long)(v[2] / v[4]) / PROBE_NT - 2000) / 10;
        val[1] = (long long)(v[1] * 4 / v[0]);
        val[2] = (long long)(v[3] / (v[4] - 1)) / 100;
        val[3] = (long long)(v[0] / 100) / PROBE_TUNIT;
        long long a = val[PROBE_STAMP & 3], b = val[(PROBE_STAMP >> 2) & 3];
        a = a < 0 ? 0 : (a > 99 ? 99 : a); b = b < 0 ? 0 : (b > 99 ? 99 : b);
        const unsigned long long ticks = (unsigned long long)(10 * a + 1000 * b) * 100ull;
        const unsigned long long t0 = __builtin_amdgcn_s_memrealtime();
        while (__builtin_amdgcn_s_memrealtime() - t0 < ticks) __builtin_amdgcn_s_sleep(32);
    }
#endif
#undef IN
#undef BOTH
#undef GRID_BAR
}

extern "C" void kernel_launch(void* const* d_in, const int* in_sizes, int n_in, void* d_out, int out_size, void* d_ws, size_t ws_size, hipStream_t stream) {
    static int grid = 0;
    if (grid == 0) {
        if (n_in != 12 || in_sizes[0] != M * D || out_size != M * D || ws_size < WS_END) { fprintf(stderr, "kernel_launch: unexpected shapes (n_in %d, in0 %d, out %d, ws %zu); nothing launched\n", n_in, n_in > 0 ? in_sizes[0] : -1, out_size, ws_size); grid = -1; return; }
        int dev = 0, cus = 0;
        if (hipGetDevice(&dev) != hipSuccess || hipDeviceGetAttribute(&cus, hipDeviceAttributeMultiprocessorCount, dev) != hipSuccess) { grid = -1; return; }
        if (hipFuncSetAttribute((const void*)mk_fwd, hipFuncAttributeMaxDynamicSharedMemorySize, LDS_BYTES) != hipSuccess) { fprintf(stderr, "kernel_launch: hipFuncSetAttribute failed\n"); grid = -1; return; }
        (void)hipGetLastError();
        grid = cus;
    }
    if (grid < 0) return;
    if (hipMemsetAsync((char*)d_ws + WS_CTL, 0, CTL_ZERO_BYTES, stream) != hipSuccess) return;
    Args a{};
    a.x = (const float*)d_in[0]; a.c = (const float*)d_in[1]; a.pos = (const int*)d_in[2]; a.g_pre = (const float*)d_in[3]; a.w_ada = (const float*)d_in[4]; a.b_ada = (const float*)d_in[5];
    a.w_in = (const float*)d_in[6]; a.conv_w = (const float*)d_in[7]; a.w_attn_o = (const float*)d_in[8]; a.w_conv_o = (const float*)d_in[9]; a.w_o = (const float*)d_in[10]; a.g_post = (const float*)d_in[11];
    a.out = (float*)d_out; a.ws = (unsigned char*)d_ws;
    for (int li = 0; li < N_LAUNCHES; ++li) {
        a.ph_lo = (N_LAUNCHES == 1) ? 0 : li; a.ph_hi = (N_LAUNCHES == 1) ? NPHASES : li + 1; a.li = li;
        hipLaunchKernelGGL(mk_fwd, dim3(grid), dim3(NWAVES * 64), LDS_BYTES, stream, a);
        if (hipPeekAtLastError() != hipSuccess) break;
    }
}
```

```cpp
#include <hip/hip_runtime.h>
#include <cstdio>
#include <cstdint>

#define GAS __attribute__((address_space(1)))
#define LAS __attribute__((address_space(3)))
typedef unsigned short bf16_t;
typedef short bf16x8 __attribute__((ext_vector_type(8)));
typedef short s16x4 __attribute__((ext_vector_type(4)));
typedef float f32x4 __attribute__((ext_vector_type(4)));
typedef float f32x2 __attribute__((ext_vector_type(2)));
typedef unsigned u32x4 __attribute__((ext_vector_type(4)));
typedef unsigned u32x2 __attribute__((ext_vector_type(2)));

constexpr int M = 16384, D = 2048, NQKV = 3072, NZA = 1024, NCV = 2048, PROJ = 22528, NMOD = 6144;
constexpr float EPS = 1e-6f;
constexpr float LOG2E = 1.4426950408889634f;
constexpr float QSCALE = 0.08838834764831845f * 1.4426950408889634f;

__constant__ float INVF[16] = {1.0f, 0.44036659598350525f, 0.1939227432012558f, 0.08539710193872452f, 0.03760603070259094f, 0.016560440883040428f,
    0.007292664609849453f, 0.0032114461064338684f, 0.0014142135623842478f, 0.0006227724370546639f, 0.00027424818836152554f, 0.00012076973507646471f,
    5.3182957344688475e-05f, 2.34199997066753e-05f, 1.0313385246263351e-05f, 4.541670477919979e-06f};

typedef __bf16 bf16x2_t __attribute__((ext_vector_type(2)));
__device__ __forceinline__ unsigned cvt_pk_bf16(float lo, float hi) { const f32x2 v = {lo, hi}; return __builtin_bit_cast(unsigned, __builtin_convertvector(v, bf16x2_t)); }
__device__ __forceinline__ float bf_lo(unsigned w) { return __builtin_bit_cast(float, w << 16); }
__device__ __forceinline__ float bf_hi(unsigned w) { return __builtin_bit_cast(float, w & 0xffff0000u); }
__device__ __forceinline__ float silu_f(float v) { return v * __builtin_amdgcn_rcpf(1.0f + __builtin_amdgcn_exp2f(-v * LOG2E)); }
__device__ __forceinline__ float sigm_f(float v) { return __builtin_amdgcn_rcpf(1.0f + __builtin_amdgcn_exp2f(-v * LOG2E)); }

namespace pg8 {
constexpr int BM = 256, BK = 64, HALF = 128, HTB = HALF * BK * 2, STAGE_BYTES = 8 * HTB, NXCD = 8, WGM = 8;
__host__ __device__ __forceinline__ int lds_byte(int r, int c) { const int st = (r >> 4) * 2 + (c >> 5), rr = r & 15, cc = c & 31, ob = rr * 64 + cc * 2; return st * 1024 + (ob ^ (((ob >> 9) & 1) << 5)); }
__host__ __device__ __forceinline__ void stage_rc(int b, int& R, int& C) { const int st = b / 1024, sb = b % 1024, swz = sb ^ (((sb >> 9) & 1) << 5); R = (st >> 1) * 16 + swz / 64; C = (st & 1) * 32 + (swz % 64) / 2; }
__host__ __device__ __forceinline__ int perm32(int rho) { const int n = rho >> 4, i = rho & 15; return 8 * (i >> 2) + 4 * n + (i & 3); }

struct Unit { int pm, pn; };
struct Gemm { const bf16_t* A; const bf16_t* Bt; int M, N, K; };

struct StaticOrder {
    int nM, nN, nwg, G, c, rounds, rep;
    __host__ __device__ void init(int M_, int N_, int G_, int c_, int rep_ = 1) { nM = M_ / BM; nN = N_ / BM; nwg = nM * nN; G = G_; c = c_; rounds = (nwg + G - 1) / G; rep = rep_; }
    __host__ __device__ bool next(int i, Unit& u) const {
        if (i >= rounds * rep) return false;
        i = i % rounds;
        const long L = (long)i * G + c; if (L >= nwg) return false;
        int wgid = (int)L; { const int q = nwg / NXCD, r = nwg % NXCD, xcd = wgid % NXCD, off = wgid / NXCD; wgid = (xcd < r ? xcd * (q + 1) : r * (q + 1) + (xcd - r) * q) + off; }
        const int nig = WGM * nN, gid = wgid / nig, fm = gid * WGM, gsz = (nM - fm) < WGM ? (nM - fm) : WGM;
        u.pm = fm + ((wgid % nig) % gsz); u.pn = (wgid % nig) / gsz; return true;
    }
    __device__ __forceinline__ void a_ready(const Unit&) const {}
    __device__ __forceinline__ void done(const Unit&) const {}
};


struct Seg { const char* A; const char* B; int nt; int mid; Unit u; };
__device__ __forceinline__ const char* rfl_ptr(const char* p) { const unsigned long long v = (unsigned long long)p; const unsigned lo = __builtin_amdgcn_readfirstlane((unsigned)v), hi = __builtin_amdgcn_readfirstlane((unsigned)(v >> 32)); return (const char*)(((unsigned long long)hi << 32) | lo); }
__device__ __forceinline__ void rfl_seg(Seg& o) { o.A = rfl_ptr(o.A); o.B = rfl_ptr(o.B); o.nt = __builtin_amdgcn_readfirstlane(o.nt); o.mid = __builtin_amdgcn_readfirstlane(o.mid); o.u.pm = __builtin_amdgcn_readfirstlane(o.u.pm); o.u.pn = __builtin_amdgcn_readfirstlane(o.u.pn); }
constexpr int NSTORE = 16;
template <class Epi, class Sched, bool DUAL = false>
__device__ __forceinline__ void gemm_stream(LAS unsigned char* lds, const int pitch, const Sched& S, const Epi& E) {
    const int tid = threadIdx.x, wid = __builtin_amdgcn_readfirstlane(tid >> 6), lane = tid & 63, wr = wid >> 2, wc = wid & 3, fr = lane & 15, fq = lane >> 4;
    unsigned voffA[2], voffB[2];
#pragma unroll
    for (int i = 0; i < 2; ++i) { int R, C; stage_rc(tid * 16 + i * 8192, R, C); const int Rb = Epi::PERM ? ((R & ~31) + perm32(R & 31)) : R;
        voffA[i] = (unsigned)(R * pitch + C) * 2u; voffB[i] = (unsigned)(Rb * pitch + C) * 2u; }
    const size_t kstep = (size_t)(BK * 2);
    const size_t hstep = (size_t)HALF * pitch * 2;
    const unsigned ldsw = (unsigned)wid * 1024u;
    const int aoff = lds_byte(wr * 64 + fr, fq * 8), boff = lds_byte(wc * 32 + fr, fq * 8);
#define PG8_SA(b, h) (((b) * 2 + (h)) * HTB)
#define PG8_SB(b, h) ((4 + (b) * 2 + (h)) * HTB)
#define PG8_STAGE(bufoff, gbase, voff) do { const char* _gb = (const char*)(gbase); asm volatile("" : "+s"(_gb));   \
        _Pragma("unroll") for (int _i = 0; _i < 2; ++_i) \
        __builtin_amdgcn_global_load_lds((const unsigned*)(_gb + (voff)[_i]), (LAS unsigned*)(lds + (bufoff) + ldsw + _i * 8192), 16, 0, 0); } while (0)
#define PG8_LDA(dst, b, h) do { _Pragma("unroll") for (int m = 0; m < 4; ++m) _Pragma("unroll") for (int k = 0; k < 2; ++k) dst[m][k] = *(const LAS bf16x8*)(lds + PG8_SA(b, h) + aoff + m * 2048 + k * 1024); } while (0)
#define PG8_LDB(dst, b, h) do { _Pragma("unroll") for (int n = 0; n < 2; ++n) _Pragma("unroll") for (int k = 0; k < 2; ++k) dst[n][k] = *(const LAS bf16x8*)(lds + PG8_SB(b, h) + boff + n * 2048 + k * 1024); } while (0)
#define PG8_MMA(ai, bj, At, Bt) do { __builtin_amdgcn_s_setprio(1); _Pragma("unroll") for (int m = 0; m < 4; ++m) _Pragma("unroll") for (int n = 0; n < 2; ++n) _Pragma("unroll") for (int k = 0; k < 2; ++k) \
        acc[ai][bj][m][n] = __builtin_amdgcn_mfma_f32_16x16x32_bf16(Bt[n][k], At[m][k], acc[ai][bj][m][n], 0, 0, 0); __builtin_amdgcn_s_setprio(0); } while (0)
#define PG8_WAIT_V(n) asm volatile("s_waitcnt vmcnt(" #n ")" ::: "memory")
#define PG8_WAIT_VR() PG8_WAIT_V(8)
#define PG8_WAIT_L(n) asm volatile("s_waitcnt lgkmcnt(" #n ")" ::: "memory")
#define PG8_BAR __builtin_amdgcn_s_barrier()
#define PG8_SCHED __builtin_amdgcn_sched_barrier(0)
    Seg cur, nxt; int si = 0;
    if (!S.seg(0, cur)) return;
    f32x4 acc[2][2][4][2];
#pragma unroll
    for (int a = 0; a < 2; ++a)
#pragma unroll
        for (int b = 0; b < 2; ++b)
#pragma unroll
            for (int m = 0; m < 4; ++m)
#pragma unroll
                for (int n = 0; n < 2; ++n) acc[a][b][m][n] = (f32x4){0.f, 0.f, 0.f, 0.f};
    bf16x8 At[4][2], B0[2][2], B1[2][2];
    {
        const char* cA = cur.A; const char* cB = cur.B;
        PG8_STAGE(PG8_SB(0, 0), cB, voffB); PG8_STAGE(PG8_SB(0, 1), cB + hstep, voffB); PG8_STAGE(PG8_SA(0, 0), cA, voffA); PG8_STAGE(PG8_SA(0, 1), cA + hstep, voffA);
        if (wr == 1) PG8_BAR;
        PG8_WAIT_V(2); PG8_BAR;
        PG8_STAGE(PG8_SB(1, 0), cB + kstep, voffB); PG8_STAGE(PG8_SA(1, 0), cA + kstep, voffA); PG8_STAGE(PG8_SB(1, 1), cB + hstep + kstep, voffB);
        PG8_WAIT_V(6); PG8_BAR;
    }
    bool fresh = true, relax = false;
    for (;;) {
        const bool has_next = S.seg(si + 1, nxt);
        const char* cA = cur.A; const char* cB = cur.B; const int nt = cur.nt;
        const char* nA = has_next ? nxt.A : cA; const char* nB = has_next ? nxt.B : cB;
#pragma nounroll
        for (int t = 0; t < nt; t += 2) {
            const bool first = (t == 0) && !fresh;
            const bool last = (t == nt - 2);
            const char* a1 = cA + (size_t)(t + 1) * kstep;
            const char* a2 = last ? nA : cA + (size_t)(t + 2) * kstep; const char* b2 = last ? nB : cB + (size_t)(t + 2) * kstep;
            const char* a3 = a2 + kstep; const char* b3 = b2 + kstep;
            PG8_LDB(B0, 0, 0); PG8_LDB(B1, 0, 1); PG8_SCHED; PG8_LDA(At, 0, 0); if (!first) PG8_STAGE(PG8_SA(1, 1), a1 + hstep, voffA);
            PG8_WAIT_VR(); PG8_WAIT_L(0); PG8_BAR; PG8_MMA(0, 0, At, B0); PG8_MMA(0, 1, At, B1); PG8_BAR; PG8_SCHED;
            PG8_LDA(At, 0, 1); PG8_STAGE(PG8_SB(0, 0), b2, voffB); PG8_STAGE(PG8_SB(0, 1), b2 + hstep, voffB); PG8_STAGE(PG8_SA(0, 0), a2, voffA);
            PG8_WAIT_VR(); PG8_WAIT_L(0); PG8_BAR; PG8_MMA(1, 0, At, B0); PG8_MMA(1, 1, At, B1); PG8_BAR; PG8_SCHED;
            PG8_LDB(B0, 1, 0); PG8_LDB(B1, 1, 1); PG8_SCHED; PG8_LDA(At, 1, 0); PG8_STAGE(PG8_SA(0, 1), a2 + hstep, voffA);
            PG8_WAIT_VR(); PG8_WAIT_L(0); PG8_BAR; PG8_MMA(0, 0, At, B0); PG8_MMA(0, 1, At, B1); PG8_BAR; PG8_SCHED;
            PG8_LDA(At, 1, 1); PG8_STAGE(PG8_SB(1, 0), b3, voffB); PG8_STAGE(PG8_SB(1, 1), b3 + hstep, voffB); PG8_STAGE(PG8_SA(1, 0), a3, voffA);
            PG8_WAIT_V(8); PG8_WAIT_L(0); PG8_BAR; PG8_MMA(1, 0, At, B0); PG8_MMA(1, 1, At, B1); PG8_BAR; PG8_SCHED;
        }
        if (wr == 0) PG8_BAR;
        PG8_STAGE(PG8_SA(1, 1), nA + kstep + hstep, voffA);
        PG8_SCHED;
        if constexpr (DUAL) E.scale(acc, cur.u, wr, wc, fr, fq, cur.mid != 0);
        if (DUAL && cur.mid) { relax = false; }
        else {
            E(acc, cur.u, wr, wc, fr, fq); relax = true;
#pragma unroll
            for (int a = 0; a < 2; ++a)
#pragma unroll
                for (int b = 0; b < 2; ++b)
#pragma unroll
                    for (int m = 0; m < 4; ++m)
#pragma unroll
                        for (int n = 0; n < 2; ++n) acc[a][b][m][n] = (f32x4){0.f, 0.f, 0.f, 0.f};
        }
        PG8_SCHED;
        if (!has_next) break;
        cur = nxt; ++si; fresh = false;
        if (wr == 1) PG8_BAR;
    }
    PG8_WAIT_V(0);
    PG8_BAR;
#undef PG8_SA
#undef PG8_SB
#undef PG8_STAGE
#undef PG8_LDA
#undef PG8_LDB
#undef PG8_MMA
#undef PG8_WAIT_V
#undef PG8_WAIT_VR
#undef PG8_WAIT_L
#undef PG8_BAR
#undef PG8_SCHED
}
struct SegOrder1 {
    StaticOrder so; const char* A; const char* B; size_t tstep; int nt;
    __device__ __forceinline__ bool seg(int s, Seg& o) const { Unit u; if (!so.next(s, u)) return false; o.A = A + (size_t)u.pm * tstep; o.B = B + (size_t)u.pn * tstep; o.nt = nt; o.mid = 0; o.u = u; rfl_seg(o); return true; }
};

__device__ __forceinline__ u32x4 pack8(const f32x4 v0, const f32x4 v1) { u32x4 w; w.x = cvt_pk_bf16(v0[0], v0[1]); w.y = cvt_pk_bf16(v0[2], v0[3]); w.z = cvt_pk_bf16(v1[0], v1[1]); w.w = cvt_pk_bf16(v1[2], v1[3]); return w; }
__device__ __forceinline__ void unpack8(const u32x4 w, f32x4& v0, f32x4& v1) { v0 = (f32x4){bf_lo(w.x), bf_hi(w.x), bf_lo(w.y), bf_hi(w.y)}; v1 = (f32x4){bf_lo(w.z), bf_hi(w.z), bf_lo(w.w), bf_hi(w.w)}; }

#ifdef NT_STORES
#define ST16(p, v) __builtin_nontemporal_store((v), (u32x4*)(p))
#define ST8(p, v) __builtin_nontemporal_store((v), (u32x2*)(p))
#else
#define ST16(p, v) (*(u32x4*)(p) = (v))
#define ST8(p, v) (*(u32x2*)(p) = (v))
#endif
struct EpiProj {
    static constexpr bool PERM = true;
    __device__ __forceinline__ void mid(f32x4 (&)[2][2][4][2], const Unit&, int, int, int, int) const {}
    bf16_t *Q, *Kb, *V, *SZ, *P, *QC, *SGA, *SGC; const float* cs;
    __device__ __forceinline__ void operator()(const f32x4 (&acc)[2][2][4][2], const Unit& u, int wr, int wc, int fr, int fq) const {
        const int pn = u.pn; const int row0 = u.pm * BM + wr * 64 + fr; const int lc = wc * 32 + 8 * fq;
        if (pn < 24) {
            const bool isq = pn < 12; bf16_t* base = isq ? Q : Kb; const int colt = (isq ? pn : pn - 12) * BM; const float sc = isq ? QSCALE : 1.0f;
            const bool rot = (fq == 0);
#pragma unroll
            for (int ai = 0; ai < 2; ++ai) {
                f32x4 cv[4], sv[4];
#pragma unroll
                for (int m = 0; m < 4; ++m) { const float* cr = cs + (size_t)(row0 + ai * HALF + m * 16) * 32 + 4 * wc; cv[m] = *(const f32x4*)cr; sv[m] = *(const f32x4*)(cr + 16); }
#pragma unroll
                for (int m = 0; m < 4; ++m) {
                    const f32x4 c = rot ? cv[m] * sc : (f32x4){sc, sc, sc, sc}, sn = rot ? sv[m] * sc : (f32x4){0.f, 0.f, 0.f, 0.f};
                    bf16_t* rowp = base + (size_t)(row0 + ai * HALF + m * 16) * NQKV + colt + lc;
#pragma unroll
                    for (int bj = 0; bj < 2; ++bj) { const f32x4 v0 = acc[ai][bj][m][0], v1 = acc[ai][bj][m][1];
                        ST16((rowp + bj * HALF), (pack8(v0 * c - v1 * sn, v0 * sn + v1 * c))); }
                }
                asm volatile("" ::: "memory");
            }
        } else if (pn < 36) {
            const int colt = (pn - 24) * BM;
#pragma unroll
            for (int ai = 0; ai < 2; ++ai)
#pragma unroll
                for (int m = 0; m < 4; ++m) { bf16_t* rowp = V + (size_t)(row0 + ai * HALF + m * 16) * NQKV + colt + lc;
#pragma unroll
                    for (int bj = 0; bj < 2; ++bj) ST16((rowp + bj * HALF), (pack8(acc[ai][bj][m][0], acc[ai][bj][m][1]))); }
        } else if (pn < 40) {
            const int colt = (pn - 36) * BM;
#pragma unroll
            for (int ai = 0; ai < 2; ++ai)
#pragma unroll
                for (int m = 0; m < 4; ++m) { bf16_t* rowp = SZ + (size_t)(row0 + ai * HALF + m * 16) * NZA + colt + lc;
#pragma unroll
                    for (int bj = 0; bj < 2; ++bj) { f32x4 a = acc[ai][bj][m][0], b = acc[ai][bj][m][1];
#pragma unroll
                        for (int j = 0; j < 4; ++j) { a[j] = silu_f(a[j]); b[j] = silu_f(b[j]); }
                        ST16((rowp + bj * HALF), (pack8(a, b))); } }
        } else if (pn < 72) {
            const int chb = 64 * (pn - 40) + 16 * wc + 4 * fq;
#pragma unroll
            for (int ai = 0; ai < 2; ++ai)
#pragma unroll
                for (int m = 0; m < 4; ++m) { const size_t ro = (size_t)(row0 + ai * HALF + m * 16) * NCV + chb;
                    const f32x4 cb = acc[ai][0][m][0], cc = acc[ai][0][m][1], cx = acc[ai][1][m][0], z = acc[ai][1][m][1];
                    f32x4 pv = cc * cx, qv;
#pragma unroll
                    for (int j = 0; j < 4; ++j) qv[j] = cb[j] * silu_f(z[j]);
                    u32x2 pw, qw; pw.x = cvt_pk_bf16(pv[0], pv[1]); pw.y = cvt_pk_bf16(pv[2], pv[3]); qw.x = cvt_pk_bf16(qv[0], qv[1]); qw.y = cvt_pk_bf16(qv[2], qv[3]);
                    ST8((P + ro), (pw)); ST8((QC + ro), (qw)); }
        } else {
            const int colt = (pn - 72) * HALF;
#pragma unroll
            for (int ai = 0; ai < 2; ++ai)
#pragma unroll
                for (int m = 0; m < 4; ++m) { const size_t ro = (size_t)(row0 + ai * HALF + m * 16) * D + colt + lc;
                    f32x4 r[2], c[2];
#pragma unroll
                    for (int n = 0; n < 2; ++n)
#pragma unroll
                        for (int j = 0; j < 4; ++j) { const float ec = __builtin_amdgcn_exp2f(-acc[ai][1][m][n][j] * LOG2E); c[n][j] = __builtin_amdgcn_rcpf(1.0f + ec); r[n][j] = sigm_f(acc[ai][0][m][n][j]) * (1.0f + ec); }
                    ST16((SGA + ro), (pack8(r[0], r[1]))); ST16((SGC + ro), (pack8(c[0], c[1]))); }
        }
    }
};
struct EpiMerge {
    static constexpr bool PERM = true;
    bf16_t* O; const bf16_t* RHO; const bf16_t* SC; int ldc;
    __device__ __forceinline__ size_t lane_off(const Unit& u, int wr, int wc, int fr, int fq, int ai) const {
        size_t o = (size_t)(u.pm * BM + wr * 64 + fr + ai * HALF) * ldc + u.pn * BM + wc * 32 + 8 * fq; asm volatile("" : "+v"(o)); return o; }
    __device__ __forceinline__ void scale(f32x4 (&acc)[2][2][4][2], const Unit& u, int wr, int wc, int fr, int fq, bool is_mid) const {
        const bf16_t* G = is_mid ? RHO : SC;
#pragma unroll
        for (int ai = 0; ai < 2; ++ai) {
            const bf16_t* p = G + lane_off(u, wr, wc, fr, fq, ai);
            u32x4 gw[4][2];
#pragma unroll
            for (int m = 0; m < 4; ++m)
#pragma unroll
                for (int bj = 0; bj < 2; ++bj) gw[m][bj] = *(const u32x4*)(p + (size_t)m * 16 * ldc + bj * HALF);
#pragma unroll
            for (int m = 0; m < 4; ++m)
#pragma unroll
                for (int bj = 0; bj < 2; ++bj) { f32x4 g0, g1; unpack8(gw[m][bj], g0, g1); acc[ai][bj][m][0] *= g0; acc[ai][bj][m][1] *= g1; }
        }
    }
    __device__ __forceinline__ void mid(f32x4 (&)[2][2][4][2], const Unit&, int, int, int, int) const {}
    __device__ __forceinline__ void operator()(const f32x4 (&acc)[2][2][4][2], const Unit& u, int wr, int wc, int fr, int fq) const {
#pragma unroll
        for (int ai = 0; ai < 2; ++ai) {
            bf16_t* q = O + lane_off(u, wr, wc, fr, fq, ai);
#pragma unroll
            for (int m = 0; m < 4; ++m)
#pragma unroll
                for (int bj = 0; bj < 2; ++bj) *(u32x4*)(q + (size_t)m * 16 * ldc + bj * HALF) = pack8(acc[ai][bj][m][0], acc[ai][bj][m][1]);
        }
    }
};
struct EpiBf16 {
    static constexpr bool PERM = true;
    __device__ __forceinline__ void mid(f32x4 (&)[2][2][4][2], const Unit&, int, int, int, int) const {}
    bf16_t* O; int ldc;
    __device__ __forceinline__ void operator()(const f32x4 (&acc)[2][2][4][2], const Unit& u, int wr, int wc, int fr, int fq) const {
        const int row0 = u.pm * BM + wr * 64 + fr, col0 = u.pn * BM + wc * 32 + 8 * fq;
#pragma unroll
        for (int ai = 0; ai < 2; ++ai)
#pragma unroll
            for (int m = 0; m < 4; ++m) { bf16_t* rowp = O + (size_t)(row0 + ai * HALF + m * 16) * ldc + col0;
#pragma unroll
                for (int bj = 0; bj < 2; ++bj) *(u32x4*)(rowp + bj * HALF) = pack8(acc[ai][bj][m][0], acc[ai][bj][m][1]); }
    }
};
struct SegOrder2 {
    StaticOrder so; const char *A0, *B0, *A1, *B1; size_t tstep; int nt0, nt1;
    __device__ __forceinline__ bool seg(int s_, Seg& o) const { Unit u; if (!so.next(s_ >> 1, u)) return false; const int h = s_ & 1;
        o.A = (h ? A1 : A0) + (size_t)u.pm * tstep; o.B = (h ? B1 : B0) + (size_t)u.pn * tstep; o.nt = h ? nt1 : nt0; o.mid = !h; o.u = u; rfl_seg(o); return true; }
};
}

#ifndef PG8_SP2
#define PG8_SP2 true
#endif
#ifndef PG8_ALIGN
#define PG8_ALIGN true
#endif

constexpr int NWAVES = 8;
#ifndef MK_N_LAUNCHES
#define MK_N_LAUNCHES 1
#endif
constexpr int NPHASES = 8;
constexpr int N_LAUNCHES = MK_N_LAUNCHES;

constexpr size_t MiB = 1u << 20;
constexpr size_t WS_CTL = 0, CTL_ZERO_BYTES = 1 * MiB;
constexpr size_t WS_MOD = 1 * MiB;
constexpr size_t WS_CS = 2 * MiB;
constexpr size_t WS_WIN = 4 * MiB;
constexpr size_t WS_WA = 92 * MiB, WS_WC = 100 * MiB, WS_WO = 108 * MiB;
constexpr size_t WS_H = 116 * MiB;
constexpr size_t WS_Q = 180 * MiB, WS_K = 276 * MiB, WS_V = 372 * MiB;
constexpr size_t WS_SZ = 468 * MiB;
constexpr size_t WS_P = 500 * MiB, WS_QC = 564 * MiB;
constexpr size_t WS_O2 = 628 * MiB;
constexpr size_t WS_LSE = 660 * MiB;
constexpr size_t WS_END = 662 * MiB;
constexpr size_t WS_O0 = 116 * MiB, WS_O1 = 148 * MiB;
constexpr size_t WS_AATT = 180 * MiB, WS_R = 244 * MiB, WS_MG = 308 * MiB, WS_Y = 372 * MiB;
constexpr int CW_BAR = 4096;
#define XCD_BAR_WORDS 3456

constexpr int RING_BYTES = 131072;
constexpr int LDSCTL_OFF = RING_BYTES, MISC_OFF = LDSCTL_OFF + 320;
constexpr int LDS_BYTES = 147456;

typedef GAS unsigned gu32;
#define RLX_AGENT __ATOMIC_RELAXED, __HIP_MEMORY_SCOPE_AGENT

#define XB_TMO      128
#define XB_XCNT(j)  (256  + 64 * (j))
#define XB_XSUB(j)  (1280 + 64 * (j))
#define XB_XGEN(j)  (2304 + 64 * (j))
#define XB_TOP      3328
#define XB_TOPGEN   3392
#define XB_SPIN_CAP (1u << 18)

__device__ __forceinline__ unsigned xb_ld(unsigned* p)              { return __hip_atomic_load(p, __ATOMIC_RELAXED, __HIP_MEMORY_SCOPE_AGENT); }
__device__ __forceinline__ unsigned xb_add(unsigned* p, unsigned v) { return __hip_atomic_fetch_add(p, v, __ATOMIC_RELAXED, __HIP_MEMORY_SCOPE_AGENT); }
__device__ __forceinline__ unsigned xb_xcc_id() { return (unsigned)__builtin_amdgcn_s_getreg((3 << 11) | 20) & 0xFu; }
#define XB_SPIN(cond, bar) do { unsigned _sp = 0; while (cond) { __builtin_amdgcn_s_sleep(1); \
    if ((++_sp & 255u) == 0u) { if (xb_ld(&(bar)[XB_TMO])) break; if (_sp > XB_SPIN_CAP) { atomicAdd(&(bar)[XB_TMO], 1u); break; } } } } while (0)

struct XcdBarrier { unsigned* bar; unsigned x; volatile LAS unsigned* st; };

__device__ __forceinline__ XcdBarrier xcd_barrier_post(unsigned* bar, volatile LAS unsigned* st) {
    XcdBarrier b; b.bar = bar; b.x = xb_xcc_id(); b.st = st;
    if (threadIdx.x == 0) (void)xb_add(&bar[XB_XCNT(b.x)], 1u);
    return b;
}
__device__ __forceinline__ void xcd_barrier_complete(unsigned* bar, unsigned x, unsigned& nloc, unsigned& nx) {
    const unsigned G = gridDim.x * gridDim.y * gridDim.z;
    unsigned sum, cnt, mine, sp = 0u;
    for (;;) {
        sum = 0u; cnt = 0u; mine = 0u;
#pragma unroll
        for (unsigned j = 0; j < 16; ++j) { const unsigned c = xb_ld(&bar[XB_XCNT(j)]); sum += c; cnt += (c > 0u) ? 1u : 0u; mine = (j == x) ? c : mine; }
        if (sum == G) break;
        __builtin_amdgcn_s_sleep(1);
        if ((++sp & 255u) == 0u) { if (xb_ld(&bar[XB_TMO])) break; if (sp > XB_SPIN_CAP) { atomicAdd(&bar[XB_TMO], 1u); break; } }
    }
    nloc = mine > 0u ? mine : 1u; nx = cnt > 0u ? cnt : 1u;
}
__device__ __forceinline__ void xcd_barrier(const XcdBarrier& b) {
    asm volatile("s_waitcnt vmcnt(0)" ::: "memory");
    __syncthreads();
    if (threadIdx.x == 0) {
        unsigned* bar = b.bar;
        __builtin_amdgcn_s_waitcnt(0);
        unsigned nloc = b.st[0], nx = b.st[1];
        if (nloc == 0u) { xcd_barrier_complete(bar, b.x, nloc, nx); b.st[0] = nloc; b.st[1] = nx; }
        const unsigned old = xb_add(&bar[XB_XSUB(b.x)], 1u);
        const unsigned gen = old / nloc;
        if (old + 1u == (gen + 1u) * nloc) {
            __builtin_amdgcn_fence(__ATOMIC_RELEASE, "agent");
            asm volatile("s_waitcnt vmcnt(0)" ::: "memory");
            const unsigned og = xb_add(&bar[XB_TOP], 1u);
            const unsigned tg = og / nx;
            if (og + 1u == (tg + 1u) * nx) xb_add(&bar[XB_TOPGEN], 1u);
            else XB_SPIN(xb_ld(&bar[XB_TOPGEN]) == tg, bar);
            __builtin_amdgcn_fence(__ATOMIC_ACQUIRE, "agent");
            xb_add(&bar[XB_XGEN(b.x)], 1u);
            asm volatile("s_waitcnt vmcnt(0)" ::: "memory");
        } else {
            XB_SPIN(xb_ld(&bar[XB_XGEN(b.x)]) == gen, bar);
            __builtin_amdgcn_fence(__ATOMIC_ACQUIRE, "agent");
            asm volatile("s_waitcnt vmcnt(0)" ::: "memory");
        }
    }
    __syncthreads();
}

#define LDS_WAIT() asm volatile("s_waitcnt lgkmcnt(0)" ::: "memory")
__device__ __forceinline__ float wave_sum(float v) {
#pragma unroll
    for (int o = 1; o < 64; o <<= 1) v += __shfl_xor(v, o);
    return v;
}
__device__ __forceinline__ unsigned f2bf(float f) { unsigned u = __builtin_bit_cast(unsigned, f); return (u + 0x7fffu + ((u >> 16) & 1u)) >> 16; }
__device__ __forceinline__ unsigned pk2(float lo, float hi) { return f2bf(lo) | (f2bf(hi) << 16); }

__device__ __forceinline__ int proj_orig_col(int n) {
    const int tile = n >> 8, c = n & 255;
    if (tile < 24) { const int c7 = n & 127, wc = c7 >> 5, fq = (c7 >> 3) & 3, nn = (c7 >> 2) & 1, j = c7 & 3;
        const int dim = (fq == 0) ? (4 * wc + j + 16 * nn) : (32 + wc * 24 + (fq - 1) * 8 + 4 * nn + j); return (n & ~127) + dim; }
    if (tile < 40) return n;
    if (tile < 72) { const int kind = 2 * (c >> 7) + ((c >> 2) & 1), chl = 16 * ((c >> 5) & 3) + 4 * ((c >> 3) & 3) + (c & 3); return 10240 + kind * 2048 + 64 * (tile - 40) + chl; }
    return 18432 + (c >> 7) * 2048 + 128 * (tile - 72) + (c & 127);
}
template <bool REMAP>
__device__ __forceinline__ void p0_transpose_item(const float* W, int K, int N, bf16_t* WT, int pitch, LAS float* scr, int item, int lane) {
    const int nblk = N / 32, kb = item / nblk, nb = item % nblk, k0 = 64 * kb, n0 = 32 * nb;
    const int ncol = REMAP ? proj_orig_col(n0 + (lane & 31)) : n0 + (lane & 31);
#pragma unroll 8
    for (int i = 0; i < 32; ++i) { const int kk = 2 * i + (lane >> 5); scr[kk * 33 + (lane & 31)] = W[(size_t)(k0 + kk) * N + ncol]; }
    LDS_WAIT(); asm volatile("" ::: "memory");
    const int c = lane & 7;
#pragma unroll
    for (int j = 0; j < 4; ++j) { const int n = (lane >> 3) + 8 * j; const LAS float* s = scr + (8 * c) * 33 + n;
        u32x4 o; o.x = pk2(s[0 * 33], s[1 * 33]); o.y = pk2(s[2 * 33], s[3 * 33]); o.z = pk2(s[4 * 33], s[5 * 33]); o.w = pk2(s[6 * 33], s[7 * 33]);
        *(u32x4*)(WT + (size_t)(n0 + n) * pitch + k0 + 8 * c) = o; }
    LDS_WAIT(); asm volatile("" ::: "memory");
}

__device__ __forceinline__ void sincos_f64(float ang, float& s, float& c) {
    const double x = (double)ang;
    const double n = __builtin_rint(x * 0.15915494309189535);
    double r = __builtin_fma(-n, 6.283185307179586, x); r = __builtin_fma(-n, 2.4492935982947064e-16, r);
    const double r2 = r * r;
    double ps = 1.0 / 51090942171709440000.0;
    ps = __builtin_fma(ps, r2, -1.0 / 121645100408832000.0);
    ps = __builtin_fma(ps, r2, 1.0 / 355687428096000.0);
    ps = __builtin_fma(ps, r2, -1.0 / 1307674368000.0);
    ps = __builtin_fma(ps, r2, 1.0 / 6227020800.0);
    ps = __builtin_fma(ps, r2, -1.0 / 39916800.0);
    ps = __builtin_fma(ps, r2, 1.0 / 362880.0);
    ps = __builtin_fma(ps, r2, -1.0 / 5040.0);
    ps = __builtin_fma(ps, r2, 1.0 / 120.0);
    ps = __builtin_fma(ps, r2, -1.0 / 6.0);
    ps = __builtin_fma(ps, r2, 1.0);
    double pc = -1.0 / 1124000727777607680000.0;
    pc = __builtin_fma(pc, r2, 1.0 / 2432902008176640000.0);
    pc = __builtin_fma(pc, r2, -1.0 / 6402373705728000.0);
    pc = __builtin_fma(pc, r2, 1.0 / 20922789888000.0);
    pc = __builtin_fma(pc, r2, -1.0 / 87178291200.0);
    pc = __builtin_fma(pc, r2, 1.0 / 479001600.0);
    pc = __builtin_fma(pc, r2, -1.0 / 3628800.0);
    pc = __builtin_fma(pc, r2, 1.0 / 40320.0);
    pc = __builtin_fma(pc, r2, -1.0 / 720.0);
    pc = __builtin_fma(pc, r2, 1.0 / 24.0);
    pc = __builtin_fma(pc, r2, -0.5);
    pc = __builtin_fma(pc, r2, 1.0);
    s = (float)(r * ps); c = (float)pc;
}

__device__ __forceinline__ unsigned attn_offk(unsigned row, unsigned ch) { return 256u * row + 16u * (ch ^ (row & 15u)); }
__device__ __forceinline__ unsigned attn_offv(unsigned row, unsigned ch) { return 256u * row + 16u * (ch ^ (((row & 3u) << 2) | ((row >> 2) & 3u))); }
__device__ __forceinline__ unsigned attn_lrow(unsigned k) { return (k & ~31u) | (((k >> 2) & 3u) << 3) | (((k >> 4) & 1u) << 2) | (k & 3u); }

__device__ __forceinline__ void attn_phase(LAS unsigned char* lds, const bf16_t* Qb, const bf16_t* Kb, const bf16_t* Vb, bf16_t* O0, bf16_t* O1, bf16_t* O2, float* LSE, int G, int vcu) {
    const int tid = threadIdx.x, lane = tid & 63, wid = __builtin_amdgcn_readfirstlane(tid >> 6), fr = lane & 15, fq = lane >> 4;
    LAS unsigned char* ldsK = lds; LAS unsigned char* ldsV = lds + 65536;
    const int NU = 3072, per = (NU + G - 1) / G;
    const int u_lo = vcu * per, u_hi = (u_lo + per) < NU ? (u_lo + per) : NU;
    for (int uid = u_lo; uid < u_hi; ++uid) {
        const int g = uid >> 10, rem = uid & 1023, hh = rem >> 7, rem2 = rem & 127;
        const int dsh = 2 * g, d = 1 << dsh;
        const int nbs = 7 - dsh;
        const int r = rem2 >> nbs, n = rem2 & ((1 << nbs) - 1);
        const size_t colb = (size_t)(g * 1024 + hh * 128) * 2;
        {
            const int ch = tid & 15, rb = tid >> 4;
            u32x4 kreg[8], vreg[8];
#pragma unroll
            for (int i = 0; i < 8; ++i) { const int kr = rb + 32 * i; int lp = 128 * (n - 1) + kr; lp = lp < 0 ? 0 : lp; const size_t p = ((size_t)lp << dsh) + r;
                const size_t off = p * (size_t)(NQKV * 2) + colb + ch * 16;
                kreg[i] = *(const u32x4*)((const char*)Kb + off); vreg[i] = *(const u32x4*)((const char*)Vb + off); }
#pragma unroll
            for (int i = 0; i < 8; ++i) { const unsigned kr = rb + 32 * i;
                *(LAS u32x4*)(ldsK + attn_offk(kr, ch)) = kreg[i]; *(LAS u32x4*)(ldsV + attn_offv(attn_lrow(kr), ch)) = vreg[i]; }
        }
        const int lq = 128 * n + 16 * wid + fr; const size_t pq = ((size_t)lq << dsh) + r;
        bf16x8 qf[4];
        { const bf16x8* qp = (const bf16x8*)((const char*)Qb + pq * (size_t)(NQKV * 2) + colb + fq * 16);
#pragma unroll
          for (int s = 0; s < 4; ++s) qf[s] = qp[4 * s]; }
        __syncthreads();
        f32x4 S[9];
#pragma unroll
        for (int t = 0; t < 9; ++t) {
            S[t] = (f32x4){0.f, 0.f, 0.f, 0.f};
            const unsigned row = 16 * wid + 16 * t + fr;
#pragma unroll
            for (int s = 0; s < 4; ++s) { const bf16x8 kf = *(const LAS bf16x8*)(ldsK + attn_offk(row, 4 * s + fq)); S[t] = __builtin_amdgcn_mfma_f32_16x16x32_bf16(kf, qf[s], S[t], 0, 0, 0); }
        }
        const float NEG = -1e30f;
#pragma unroll
        for (int j = 0; j < 4; ++j) { const int ko0 = 4 * fq + j; if (ko0 < fr) S[0][j] = NEG; if (ko0 > fr) S[8][j] = NEG; }
        if (n == 0) {
#pragma unroll
            for (int t = 0; t < 9; ++t)
#pragma unroll
                for (int j = 0; j < 4; ++j) { if (16 * wid + 16 * t + 4 * fq + j < 128) S[t][j] = NEG; }
        }
        float mx = NEG;
#pragma unroll
        for (int t = 0; t < 9; ++t) mx = fmaxf(mx, fmaxf(fmaxf(S[t][0], S[t][1]), fmaxf(S[t][2], S[t][3])));
        mx = fmaxf(mx, __shfl_xor(mx, 16)); mx = fmaxf(mx, __shfl_xor(mx, 32));
        float sum = 0.f;
#pragma unroll
        for (int t = 0; t < 9; ++t)
#pragma unroll
            for (int j = 0; j < 4; ++j) { const float p = __builtin_amdgcn_exp2f(S[t][j] - mx); S[t][j] = p; sum += p; }
        sum += __shfl_xor(sum, 16); sum += __shfl_xor(sum, 32);
        f32x4 O[8];
#pragma unroll
        for (int c = 0; c < 8; ++c) O[c] = (f32x4){0.f, 0.f, 0.f, 0.f};
        const unsigned q4 = (unsigned)(lane & 15) >> 2, p4 = (unsigned)lane & 3u;
#pragma unroll
        for (int u = 0; u < 5; ++u) {
            u32x4 pw; pw.x = cvt_pk_bf16(S[2 * u][0], S[2 * u][1]); pw.y = cvt_pk_bf16(S[2 * u][2], S[2 * u][3]);
            if (u < 4) { pw.z = cvt_pk_bf16(S[2 * u + 1][0], S[2 * u + 1][1]); pw.w = cvt_pk_bf16(S[2 * u + 1][2], S[2 * u + 1][3]); } else { pw.z = 0u; pw.w = 0u; }
            const bf16x8 pf = __builtin_bit_cast(bf16x8, pw);
            const unsigned kba = 16 * wid + 32 * u, kbb = (u < 4) ? kba + 16 : kba;
            const unsigned lra = (kba & ~31u) | ((unsigned)fq << 3) | (((kba >> 4) & 1u) << 2) | q4;
            const unsigned lrb = (kbb & ~31u) | ((unsigned)fq << 3) | (((kbb >> 4) & 1u) << 2) | q4;
#pragma unroll
            for (int c = 0; c < 8; ++c) {
                const s16x4 va = __builtin_amdgcn_ds_read_tr16_b64_v4i16((LAS s16x4*)(ldsV + attn_offv(lra, 2 * c + (p4 >> 1)) + 8 * (p4 & 1)));
                const s16x4 vb = __builtin_amdgcn_ds_read_tr16_b64_v4i16((LAS s16x4*)(ldsV + attn_offv(lrb, 2 * c + (p4 >> 1)) + 8 * (p4 & 1)));
                const bf16x8 vf = __builtin_shufflevector(va, vb, 0, 1, 2, 3, 4, 5, 6, 7);
                O[c] = __builtin_amdgcn_mfma_f32_16x16x32_bf16(vf, pf, O[c], 0, 0, 0);
            }
        }
        const float inv = 1.0f / sum;
        bf16_t* Og = (g == 0) ? O0 : ((g == 1) ? O1 : O2);
        bf16_t* op = Og + pq * NZA + hh * 128 + 4 * fq;
#pragma unroll
        for (int c = 0; c < 8; ++c) { u32x2 w; w.x = cvt_pk_bf16(O[c][0] * inv, O[c][1] * inv); w.y = cvt_pk_bf16(O[c][2] * inv, O[c][3] * inv); *(u32x2*)(op + 16 * c) = w; }
        if (fq == 0) LSE[((size_t)g * M + pq) * 8 + hh] = mx + __builtin_amdgcn_logf(sum);
        __syncthreads();
    }
}

struct Args { const float* x; const float* c; const int* pos; const float* g_pre; const float* w_ada; const float* b_ada; const float* w_in; const float* conv_w;
              const float* w_attn_o; const float* w_conv_o; const float* w_o; const float* g_post; float* out; unsigned char* ws; int ph_lo, ph_hi, li, pad; };

__global__ void __launch_bounds__(NWAVES * 64, 2) mk_fwd(Args args) {
    extern __shared__ __attribute__((aligned(16))) unsigned char lds_raw[];
    LAS unsigned char* lds = (LAS unsigned char*)lds_raw;
    volatile LAS unsigned* MISC = (volatile LAS unsigned*)(lds + MISC_OFF);
    const int tid = threadIdx.x, lane = tid & 63, wave = __builtin_amdgcn_readfirstlane(tid >> 6);
    const int G = gridDim.x; const int bx = blockIdx.x; const int vcu = (G % 8 == 0) ? (bx % 8) * (G / 8) + bx / 8 : bx;
    unsigned char* ws = args.ws;
    gu32* ctl = (gu32*)(ws + WS_CTL);
    float* mod = (float*)(ws + WS_MOD); float* cs = (float*)(ws + WS_CS);
    bf16_t* WinT = (bf16_t*)(ws + WS_WIN); bf16_t* WaT = (bf16_t*)(ws + WS_WA); bf16_t* WcT = (bf16_t*)(ws + WS_WC); bf16_t* WoT = (bf16_t*)(ws + WS_WO);
    bf16_t* Hb = (bf16_t*)(ws + WS_H); bf16_t* Qb = (bf16_t*)(ws + WS_Q); bf16_t* Kb = (bf16_t*)(ws + WS_K); bf16_t* Vb = (bf16_t*)(ws + WS_V);
    bf16_t* SZ = (bf16_t*)(ws + WS_SZ); bf16_t* Pb = (bf16_t*)(ws + WS_P); bf16_t* QCb = (bf16_t*)(ws + WS_QC);
    bf16_t* SGA = (bf16_t*)args.out; bf16_t* SGC = SGA + (size_t)M * D;
    bf16_t* O0 = (bf16_t*)(ws + WS_O0); bf16_t* O1 = (bf16_t*)(ws + WS_O1); bf16_t* O2 = (bf16_t*)(ws + WS_O2); float* LSE = (float*)(ws + WS_LSE);
    bf16_t* AATT = (bf16_t*)(ws + WS_AATT); bf16_t* Rb = (bf16_t*)(ws + WS_R); bf16_t* MG = (bf16_t*)(ws + WS_MG);
    bf16_t* Yb = (bf16_t*)(ws + WS_Y);

    for (int u = tid; u < (LDS_BYTES - LDSCTL_OFF) / 4; u += NWAVES * 64) ((LAS unsigned*)(lds + LDSCTL_OFF))[u] = 0u;
    __syncthreads();
    const int bli = (N_LAUNCHES == 1) ? 0 : args.li;
    XcdBarrier bar; bar.bar = (unsigned*)(ctl + CW_BAR) + bli * XCD_BAR_WORDS; bar.x = 0; bar.st = nullptr;
    if (N_LAUNCHES == 1) bar = xcd_barrier_post((unsigned*)(ctl + CW_BAR), MISC + 8);
    const int lo = args.ph_lo, hi = args.ph_hi;
#define IN(k) (lo <= (k) && (k) < hi)
#define BOTH(k) (IN(k) && IN((k) + 1))
#define GRID_BAR() xcd_barrier(bar)
#ifndef PROBE_REPEAT_MASK
#define PROBE_REPEAT_MASK 0
#endif
#define NREP(k) ((((PROBE_REPEAT_MASK) >> (k)) & 1) + 1)
#if defined(PROBE_PH) || defined(PROBE_ARRIVE)
#define PHSTAMP(k) do { if (bx == 0 && tid == 0) ((unsigned long long*)(ws + WS_MOD + 65536))[16 + (k)] = __builtin_amdgcn_s_memrealtime(); } while (0)
#else
#define PHSTAMP(k) do {} while (0)
#endif
    PHSTAMP(0);
    const int gw = vcu * NWAVES + wave, NGW = G * NWAVES;
    const int gtid = vcu * (NWAVES * 64) + tid, NT = G * NWAVES * 64;

    if (IN(0)) for (int rep = 0; rep < NREP(0); ++rep) {
        {
            LAS float* red = (LAS float*)lds;
            for (int cbk = bx; cbk < 256; cbk += G) {
                const int c4 = tid % 6, rg = tid / 6;
                f32x4 a = (f32x4){0.f, 0.f, 0.f, 0.f};
                if (rg < 85) { for (int k = rg; k < D; k += 85) { const float cv = args.c[k]; const f32x4 w = *(const f32x4*)(args.w_ada + (size_t)k * NMOD + cbk * 24 + c4 * 4); a += w * cv; }
                    *(LAS f32x4*)(red + (rg * 6 + c4) * 4) = a; }
                __syncthreads();
                if (tid < 24) { float s = 0.f; for (int i = 0; i < 85; ++i) s += red[(i * 6 + (tid >> 2)) * 4 + (tid & 3)]; mod[cbk * 24 + tid] = s + args.b_ada[cbk * 24 + tid]; }
                __syncthreads();
            }
        }
        for (int idx = gtid; idx < M * 16; idx += NT) { const int m = idx >> 4, i = idx & 15; const float ang = (float)args.pos[m] * INVF[i]; float s, c; sincos_f64(ang, s, c); cs[m * 32 + i] = c; cs[m * 32 + 16 + i] = s; }
        {
            LAS float* scr = (LAS float*)(lds + wave * 16384);
            constexpr int I_IN = (D / 64) * (PROJ / 32), I_A = (NZA / 64) * (D / 32), I_C = (NCV / 64) * (D / 32), I_O = (D / 64) * (D / 32);
            constexpr int NITEMS = I_IN + I_A + I_C + I_O;
            for (int it = gw; it < NITEMS; it += NGW) {
                int r = it;
                if (r < I_IN) { p0_transpose_item<true>(args.w_in, D, PROJ, WinT, D, scr, r, lane); continue; } r -= I_IN;
                if (r < I_A) { p0_transpose_item<false>(args.w_attn_o, NZA, D, WaT, D, scr, r, lane); continue; } r -= I_A;
                if (r < I_C) { p0_transpose_item<false>(args.w_conv_o, NCV, D, WcT, D, scr, r, lane); continue; } r -= I_C;
                p0_transpose_item<false>(args.w_o, D, D, WoT, D, scr, r, lane);
            }
        }
        if (BOTH(0) || rep + 1 < NREP(0)) GRID_BAR();
    }
    PHSTAMP(1);
    if (IN(1)) for (int rep = 0; rep < NREP(1); ++rep) {
        f32x4 av[4][2], bv[4][2];
#pragma unroll
        for (int j = 0; j < 4; ++j)
#pragma unroll
            for (int h = 0; h < 2; ++h) { const int k = 512 * j + 8 * lane + 4 * h; const f32x4 gp = *(const f32x4*)(args.g_pre + k), sc = *(const f32x4*)(mod + D + k); av[j][h] = gp * (sc + 1.0f); bv[j][h] = *(const f32x4*)(mod + k); }
        for (int m = gw; m < M; m += NGW) {
            const float* xr = args.x + (size_t)m * D + 8 * lane;
            f32x4 v[4][2]; float ss = 0.f;
#pragma unroll
            for (int j = 0; j < 4; ++j)
#pragma unroll
                for (int h = 0; h < 2; ++h) { v[j][h] = *(const f32x4*)(xr + 512 * j + 4 * h); const f32x4 q = v[j][h] * v[j][h]; ss += (q[0] + q[1]) + (q[2] + q[3]); }
            const float rstd = 1.0f / sqrtf(wave_sum(ss) * (1.0f / D) + EPS);
            bf16_t* hr = Hb + (size_t)m * D + 8 * lane;
#pragma unroll
            for (int j = 0; j < 4; ++j) { const f32x4 h0 = v[j][0] * rstd * av[j][0] + bv[j][0], h1 = v[j][1] * rstd * av[j][1] + bv[j][1]; *(u32x4*)(hr + 512 * j) = pg8::pack8(h0, h1); }
        }
        if (BOTH(1) || rep + 1 < NREP(1)) GRID_BAR();
    }
    PHSTAMP(2);
    if (IN(2)) {
        pg8::SegOrder1 S; S.so.init(M, PROJ, G, bx, NREP(2)); S.A = (const char*)Hb; S.B = (const char*)WinT; S.tstep = (size_t)256 * D * 2; S.nt = D / 64;
        pg8::EpiProj E{Qb, Kb, Vb, SZ, Pb, QCb, SGA, SGC, cs};
        pg8::gemm_stream<pg8::EpiProj, pg8::SegOrder1>(lds, D, S, E);
        if (BOTH(2)) GRID_BAR();
    }
    PHSTAMP(3);
    if (IN(3)) for (int rep = 0; rep < NREP(3); ++rep) {
        attn_phase(lds, Qb, Kb, Vb, O0, O1, O2, LSE, G, vcu);
        if (BOTH(3) || rep + 1 < NREP(3)) GRID_BAR();
    }
    PHSTAMP(4);
    if (IN(4)) for (int rep = 0; rep < NREP(4); ++rep) {
        for (int it = gtid; it < M * 128; it += NT) {
            const int p = it >> 7, c8 = it & 127, hh = c8 >> 4;
            const float l0 = LSE[((size_t)0 * M + p) * 8 + hh], l1 = LSE[((size_t)1 * M + p) * 8 + hh], l2 = LSE[((size_t)2 * M + p) * 8 + hh];
            const float mx = fmaxf(l0, fmaxf(l1, l2));
            float w0 = __builtin_amdgcn_exp2f(l0 - mx), w1 = __builtin_amdgcn_exp2f(l1 - mx), w2 = __builtin_amdgcn_exp2f(l2 - mx);
            const float inv = 1.0f / (w0 + w1 + w2); w0 *= inv; w1 *= inv; w2 *= inv;
            const size_t off = (size_t)p * NZA + c8 * 8, offa = (size_t)p * D + c8 * 8;
            f32x4 a0, a1, b0, b1, c0, c1, z0, z1;
            pg8::unpack8(*(const u32x4*)(O0 + off), a0, a1); pg8::unpack8(*(const u32x4*)(O1 + off), b0, b1); pg8::unpack8(*(const u32x4*)(O2 + off), c0, c1); pg8::unpack8(*(const u32x4*)(SZ + off), z0, z1);
            const f32x4 r0 = (a0 * w0 + b0 * w1 + c0 * w2) * z0, r1 = (a1 * w0 + b1 * w1 + c1 * w2) * z1;
            *(u32x4*)(AATT + offa) = pg8::pack8(r0, r1);
        }
        for (int bk = vcu; bk < 256; bk += G) {
            const int chunk = tid & 255, half = tid >> 8, c0 = 8 * chunk, t0 = 64 * bk + 32 * half;
            f32x4 wa[3][2];
#pragma unroll
            for (int k = 0; k < 3; ++k) { wa[k][0] = *(const f32x4*)(args.conv_w + k * NCV + c0); wa[k][1] = *(const f32x4*)(args.conv_w + k * NCV + c0 + 4); }
            f32x4 pm2[2], pm1[2];
            if (t0 >= 2) { pg8::unpack8(*(const u32x4*)(Pb + (size_t)(t0 - 2) * NCV + c0), pm2[0], pm2[1]); pg8::unpack8(*(const u32x4*)(Pb + (size_t)(t0 - 1) * NCV + c0), pm1[0], pm1[1]); }
            else { pm2[0] = pm2[1] = pm1[0] = pm1[1] = (f32x4){0.f, 0.f, 0.f, 0.f}; }
#pragma unroll 4
            for (int t = t0; t < t0 + 32; ++t) {
                f32x4 pc[2], qc[2]; pg8::unpack8(*(const u32x4*)(Pb + (size_t)t * NCV + c0), pc[0], pc[1]); pg8::unpack8(*(const u32x4*)(QCb + (size_t)t * NCV + c0), qc[0], qc[1]);
                const f32x4 r0 = qc[0] * (wa[0][0] * pm2[0] + wa[1][0] * pm1[0] + wa[2][0] * pc[0]), r1 = qc[1] * (wa[0][1] * pm2[1] + wa[1][1] * pm1[1] + wa[2][1] * pc[1]);
                *(u32x4*)(Rb + (size_t)t * NCV + c0) = pg8::pack8(r0, r1);
                pm2[0] = pm1[0]; pm2[1] = pm1[1]; pm1[0] = pc[0]; pm1[1] = pc[1];
            }
        }
        if (BOTH(4) || rep + 1 < NREP(4)) GRID_BAR();
    }
    PHSTAMP(5);
    if (IN(5)) {
        pg8::SegOrder2 S; S.so.init(M, D, G, bx, NREP(5)); S.A0 = (const char*)AATT; S.B0 = (const char*)WaT; S.A1 = (const char*)Rb; S.B1 = (const char*)WcT; S.tstep = (size_t)256 * D * 2; S.nt0 = NZA / 64; S.nt1 = NCV / 64;
        pg8::EpiMerge E{MG, SGA, SGC, D};
        pg8::gemm_stream<pg8::EpiMerge, pg8::SegOrder2, true>(lds, D, S, E);
        if (BOTH(5)) GRID_BAR();
    }
    PHSTAMP(6);
    if (IN(6)) {
        pg8::SegOrder1 S; S.so.init(M, D, G, bx, NREP(6)); S.A = (const char*)MG; S.B = (const char*)WoT; S.tstep = (size_t)256 * D * 2; S.nt = D / 64;
        pg8::EpiBf16 E{Yb, D};
        pg8::gemm_stream<pg8::EpiBf16, pg8::SegOrder1>(lds, D, S, E);
#ifdef PROBE_ARRIVE
        if (tid == 0) { ((unsigned long long*)(ws + WS_MOD + 131072))[bx] = __builtin_amdgcn_s_memrealtime(); }
#endif
        if (BOTH(6)) GRID_BAR();
    }
    PHSTAMP(7);
    if (IN(7)) {
        f32x4 gv[4][2];
#pragma unroll
        for (int j = 0; j < 4; ++j)
#pragma unroll
            for (int h = 0; h < 2; ++h) { const int k = 512 * j + 8 * lane + 4 * h; gv[j][h] = *(const f32x4*)(mod + 2 * D + k) * *(const f32x4*)(args.g_post + k); }
        for (int m = gw; m < M; m += NGW) {
            const bf16_t* yr = Yb + (size_t)m * D + 8 * lane; const float* xr = args.x + (size_t)m * D + 8 * lane; float* orow = args.out + (size_t)m * D + 8 * lane;
            f32x4 v[4][2]; float ss = 0.f;
#pragma unroll
            for (int j = 0; j < 4; ++j) { pg8::unpack8(*(const u32x4*)(yr + 512 * j), v[j][0], v[j][1]);
#pragma unroll
                for (int h = 0; h < 2; ++h) { const f32x4 q = v[j][h] * v[j][h]; ss += (q[0] + q[1]) + (q[2] + q[3]); } }
            const float rstd = 1.0f / sqrtf(wave_sum(ss) * (1.0f / D) + EPS);
#pragma unroll
            for (int j = 0; j < 4; ++j)
#pragma unroll
                for (int h = 0; h < 2; ++h) { const f32x4 xv = *(const f32x4*)(xr + 512 * j + 4 * h); *(f32x4*)(orow + 512 * j + 4 * h) = xv + gv[j][h] * (v[j][h] * rstd); }
        }
    }
    PHSTAMP(8);
#ifdef PROBE_PH
    if (bx == 0 && tid == 0) {
        asm volatile("s_waitcnt vmcnt(0)" ::: "memory");
        unsigned long long* st = (unsigned long long*)(ws + WS_MOD + 65536) + 16;
        const int ia = (PROBE_PH) & 15, ib = ((PROBE_PH) >> 4) & 15;
        const unsigned long long ta = __hip_atomic_load(st + ia + 1, __ATOMIC_RELAXED, __HIP_MEMORY_SCOPE_AGENT) - __hip_atomic_load(st + ia, __ATOMIC_RELAXED, __HIP_MEMORY_SCOPE_AGENT);
        const unsigned long long tb = __hip_atomic_load(st + ib + 1, __ATOMIC_RELAXED, __HIP_MEMORY_SCOPE_AGENT) - __hip_atomic_load(st + ib, __ATOMIC_RELAXED, __HIP_MEMORY_SCOPE_AGENT);
        const unsigned long long ticks = 4ull * (ta > 99900ull ? 99900ull : ta) + 400000ull * (tb / 400ull);
        const unsigned long long t0 = __builtin_amdgcn_s_memrealtime();
        while (__builtin_amdgcn_s_memrealtime() - t0 < ticks) __builtin_amdgcn_s_sleep(32);
    }
#endif
#ifdef PROBE_ARRIVE
    if (bx == 0 && tid == 0) {
        unsigned long long* aw = (unsigned long long*)(ws + WS_MOD + 131072);
        unsigned long long tmax = 0, tmin = ~0ull; int imax = 0;
        for (int i = 0; i < G; ++i) { const unsigned long long t = __hip_atomic_load(aw + i, __ATOMIC_RELAXED, __HIP_MEMORY_SCOPE_AGENT); if (t > tmax) { tmax = t; imax = i; } if (t < tmin) tmin = t; }
        const unsigned long long t0a = __hip_atomic_load(aw, __ATOMIC_RELAXED, __HIP_MEMORY_SCOPE_AGENT);
        const unsigned long long tafter = __hip_atomic_load((unsigned long long*)(ws + WS_MOD + 65536) + 16 + 8, __ATOMIC_RELAXED, __HIP_MEMORY_SCOPE_AGENT);
        long long val[4];
        val[0] = (long long)(tmax - tmin) / 200;
        val[1] = (long long)(tafter - tmax) / 100;
        val[2] = (long long)(tmax - t0a) / 200;
        val[3] = imax / 4;
        long long a = val[PROBE_ARRIVE & 3], b = val[(PROBE_ARRIVE >> 2) & 3];
        a = a < 0 ? 0 : (a > 89 ? 89 : a); b = b < 0 ? 0 : (b > 99 ? 99 : b);
        const unsigned long long ticks = (unsigned long long)(10 * a + 1000 * b) * 100ull;
        const unsigned long long t0 = __builtin_amdgcn_s_memrealtime();
        while (__builtin_amdgcn_s_memrealtime() - t0 < ticks) __builtin_amdgcn_s_sleep(32);
    }
#endif
#undef IN
#undef BOTH
#undef GRID_BAR
}

extern "C" void kernel_launch(void* const* d_in, const int* in_sizes, int n_in, void* d_out, int out_size, void* d_ws, size_t ws_size, hipStream_t stream) {
    static int grid = 0;
    if (grid == 0) {
        if (n_in != 12 || in_sizes[0] != M * D || out_size != M * D || ws_size < WS_END) { fprintf(stderr, "kernel_launch: unexpected shapes (n_in %d, in0 %d, out %d, ws %zu); nothing launched\n", n_in, n_in > 0 ? in_sizes[0] : -1, out_size, ws_size); grid = -1; return; }
        int dev = 0, cus = 0;
        if (hipGetDevice(&dev) != hipSuccess || hipDeviceGetAttribute(&cus, hipDeviceAttributeMultiprocessorCount, dev) != hipSuccess) { grid = -1; return; }
        if (hipFuncSetAttribute((const void*)mk_fwd, hipFuncAttributeMaxDynamicSharedMemorySize, LDS_BYTES) != hipSuccess) { fprintf(stderr, "kernel_launch: hipFuncSetAttribute failed\n"); grid = -1; return; }
        (void)hipGetLastError();
        grid = cus;
    }
    if (grid < 0) return;
    if (hipMemsetAsync((char*)d_ws + WS_CTL, 0, CTL_ZERO_BYTES, stream) != hipSuccess) return;
    Args a{};
    a.x = (const float*)d_in[0]; a.c = (const float*)d_in[1]; a.pos = (const int*)d_in[2]; a.g_pre = (const float*)d_in[3]; a.w_ada = (const float*)d_in[4]; a.b_ada = (const float*)d_in[5];
    a.w_in = (const float*)d_in[6]; a.conv_w = (const float*)d_in[7]; a.w_attn_o = (const float*)d_in[8]; a.w_conv_o = (const float*)d_in[9]; a.w_o = (const float*)d_in[10]; a.g_post = (const float*)d_in[11];
    a.out = (float*)d_out; a.ws = (unsigned char*)d_ws;
    for (int li = 0; li < N_LAUNCHES; ++li) {
        a.ph_lo = (N_LAUNCHES == 1) ? 0 : li; a.ph_hi = (N_LAUNCHES == 1) ? NPHASES : li + 1; a.li = li;
        hipLaunchKernelGGL(mk_fwd, dim3(grid), dim3(NWAVES * 64), LDS_BYTES, stream, a);
        if (hipPeekAtLastError() != hipSuccess) break;
    }
}
```

```cpp
#include <hip/hip_runtime.h>
#include <cstdio>
#include <cstdint>

#define GAS __attribute__((address_space(1)))
#define LAS __attribute__((address_space(3)))
typedef unsigned short bf16_t;
typedef short bf16x8 __attribute__((ext_vector_type(8)));
typedef short s16x4 __attribute__((ext_vector_type(4)));
typedef float f32x4 __attribute__((ext_vector_type(4)));
typedef float f32x2 __attribute__((ext_vector_type(2)));
typedef unsigned u32x4 __attribute__((ext_vector_type(4)));
typedef unsigned u32x2 __attribute__((ext_vector_type(2)));

constexpr int M = 16384, D = 2048, NQKV = 3072, NZA = 1024, NCV = 2048, PROJ = 22528, NMOD = 6144;
constexpr float EPS = 1e-6f;
constexpr float LOG2E = 1.4426950408889634f;
constexpr float QSCALE = 0.08838834764831845f * 1.4426950408889634f;

__constant__ float INVF[16] = {1.0f, 0.44036659598350525f, 0.1939227432012558f, 0.08539710193872452f, 0.03760603070259094f, 0.016560440883040428f,
    0.007292664609849453f, 0.0032114461064338684f, 0.0014142135623842478f, 0.0006227724370546639f, 0.00027424818836152554f, 0.00012076973507646471f,
    5.3182957344688475e-05f, 2.34199997066753e-05f, 1.0313385246263351e-05f, 4.541670477919979e-06f};

typedef __bf16 bf16x2_t __attribute__((ext_vector_type(2)));
__device__ __forceinline__ unsigned cvt_pk_bf16(float lo, float hi) { const f32x2 v = {lo, hi}; return __builtin_bit_cast(unsigned, __builtin_convertvector(v, bf16x2_t)); }
__device__ __forceinline__ float bf_lo(unsigned w) { return __builtin_bit_cast(float, w << 16); }
__device__ __forceinline__ float bf_hi(unsigned w) { return __builtin_bit_cast(float, w & 0xffff0000u); }
__device__ __forceinline__ float silu_f(float v) { return v * __builtin_amdgcn_rcpf(1.0f + __builtin_amdgcn_exp2f(-v * LOG2E)); }
__device__ __forceinline__ float sigm_f(float v) { return __builtin_amdgcn_rcpf(1.0f + __builtin_amdgcn_exp2f(-v * LOG2E)); }

namespace pg8 {
constexpr int BM = 256, BK = 64, HALF = 128, HTB = HALF * BK * 2, STAGE_BYTES = 8 * HTB, NXCD = 8, WGM = 8;
__host__ __device__ __forceinline__ int lds_byte(int r, int c) { const int st = (r >> 4) * 2 + (c >> 5), rr = r & 15, cc = c & 31, ob = rr * 64 + cc * 2; return st * 1024 + (ob ^ (((ob >> 9) & 1) << 5)); }
__host__ __device__ __forceinline__ void stage_rc(int b, int& R, int& C) { const int st = b / 1024, sb = b % 1024, swz = sb ^ (((sb >> 9) & 1) << 5); R = (st >> 1) * 16 + swz / 64; C = (st & 1) * 32 + (swz % 64) / 2; }
__host__ __device__ __forceinline__ int perm32(int rho) { const int n = rho >> 4, i = rho & 15; return 8 * (i >> 2) + 4 * n + (i & 3); }

struct Unit { int pm, pn; };
struct Gemm { const bf16_t* A; const bf16_t* Bt; int M, N, K; };

struct StaticOrder {
    int nM, nN, nwg, G, c, rounds, rep;
    __host__ __device__ void init(int M_, int N_, int G_, int c_, int rep_ = 1) { nM = M_ / BM; nN = N_ / BM; nwg = nM * nN; G = G_; c = c_; rounds = (nwg + G - 1) / G; rep = rep_; }
    __host__ __device__ bool next(int i, Unit& u) const {
        if (i >= rounds * rep) return false;
        i = i % rounds;
        const long L = (long)i * G + c; if (L >= nwg) return false;
        int wgid = (int)L; { const int q = nwg / NXCD, r = nwg % NXCD, xcd = wgid % NXCD, off = wgid / NXCD; wgid = (xcd < r ? xcd * (q + 1) : r * (q + 1) + (xcd - r) * q) + off; }
        const int nig = WGM * nN, gid = wgid / nig, fm = gid * WGM, gsz = (nM - fm) < WGM ? (nM - fm) : WGM;
        u.pm = fm + ((wgid % nig) % gsz); u.pn = (wgid % nig) / gsz; return true;
    }
    __device__ __forceinline__ void a_ready(const Unit&) const {}
    __device__ __forceinline__ void done(const Unit&) const {}
};


struct Seg { const char* A; const char* B; int nt; int mid; Unit u; };
__device__ __forceinline__ const char* rfl_ptr(const char* p) { const unsigned long long v = (unsigned long long)p; const unsigned lo = __builtin_amdgcn_readfirstlane((unsigned)v), hi = __builtin_amdgcn_readfirstlane((unsigned)(v >> 32)); return (const char*)(((unsigned long long)hi << 32) | lo); }
__device__ __forceinline__ void rfl_seg(Seg& o) { o.A = rfl_ptr(o.A); o.B = rfl_ptr(o.B); o.nt = __builtin_amdgcn_readfirstlane(o.nt); o.mid = __builtin_amdgcn_readfirstlane(o.mid); o.u.pm = __builtin_amdgcn_readfirstlane(o.u.pm); o.u.pn = __builtin_amdgcn_readfirstlane(o.u.pn); }
constexpr int NSTORE = 16;
template <class Epi, class Sched, bool DUAL = false>
__device__ __forceinline__ void gemm_stream(LAS unsigned char* lds, const int pitch, const Sched& S, const Epi& E) {
    const int tid = threadIdx.x, wid = __builtin_amdgcn_readfirstlane(tid >> 6), lane = tid & 63, wr = wid >> 2, wc = wid & 3, fr = lane & 15, fq = lane >> 4;
    unsigned voffA[2], voffB[2];
#pragma unroll
    for (int i = 0; i < 2; ++i) { int R, C; stage_rc(tid * 16 + i * 8192, R, C); const int Rb = Epi::PERM ? ((R & ~31) + perm32(R & 31)) : R;
        voffA[i] = (unsigned)(R * pitch + C) * 2u; voffB[i] = (unsigned)(Rb * pitch + C) * 2u; }
    const size_t kstep = (size_t)(BK * 2);
    const size_t hstep = (size_t)HALF * pitch * 2;
    const unsigned ldsw = (unsigned)wid * 1024u;
    const int aoff = lds_byte(wr * 64 + fr, fq * 8), boff = lds_byte(wc * 32 + fr, fq * 8);
#define PG8_SA(b, h) (((b) * 2 + (h)) * HTB)
#define PG8_SB(b, h) ((4 + (b) * 2 + (h)) * HTB)
#define PG8_STAGE(bufoff, gbase, voff) do { const char* _gb = (const char*)(gbase); asm volatile("" : "+s"(_gb));   \
        _Pragma("unroll") for (int _i = 0; _i < 2; ++_i) \
        __builtin_amdgcn_global_load_lds((const unsigned*)(_gb + (voff)[_i]), (LAS unsigned*)(lds + (bufoff) + ldsw + _i * 8192), 16, 0, 0); } while (0)
#define PG8_LDA(dst, b, h) do { _Pragma("unroll") for (int m = 0; m < 4; ++m) _Pragma("unroll") for (int k = 0; k < 2; ++k) dst[m][k] = *(const LAS bf16x8*)(lds + PG8_SA(b, h) + aoff + m * 2048 + k * 1024); } while (0)
#define PG8_LDB(dst, b, h) do { _Pragma("unroll") for (int n = 0; n < 2; ++n) _Pragma("unroll") for (int k = 0; k < 2; ++k) dst[n][k] = *(const LAS bf16x8*)(lds + PG8_SB(b, h) + boff + n * 2048 + k * 1024); } while (0)
#define PG8_MMA(ai, bj, At, Bt) do { __builtin_amdgcn_s_setprio(1); _Pragma("unroll") for (int m = 0; m < 4; ++m) _Pragma("unroll") for (int n = 0; n < 2; ++n) _Pragma("unroll") for (int k = 0; k < 2; ++k) \
        acc[ai][bj][m][n] = __builtin_amdgcn_mfma_f32_16x16x32_bf16(Bt[n][k], At[m][k], acc[ai][bj][m][n], 0, 0, 0); __builtin_amdgcn_s_setprio(0); } while (0)
#define PG8_WAIT_V(n) asm volatile("s_waitcnt vmcnt(" #n ")" ::: "memory")
#define PG8_WAIT_VR() PG8_WAIT_V(8)
#define PG8_WAIT_L(n) asm volatile("s_waitcnt lgkmcnt(" #n ")" ::: "memory")
#define PG8_BAR __builtin_amdgcn_s_barrier()
#define PG8_SCHED __builtin_amdgcn_sched_barrier(0)
    Seg cur, nxt; int si = 0;
    if (!S.seg(0, cur)) return;
    f32x4 acc[2][2][4][2];
#pragma unroll
    for (int a = 0; a < 2; ++a)
#pragma unroll
        for (int b = 0; b < 2; ++b)
#pragma unroll
            for (int m = 0; m < 4; ++m)
#pragma unroll
                for (int n = 0; n < 2; ++n) acc[a][b][m][n] = (f32x4){0.f, 0.f, 0.f, 0.f};
    bf16x8 At[4][2], B0[2][2], B1[2][2];
    {
        const char* cA = cur.A; const char* cB = cur.B;
        PG8_STAGE(PG8_SB(0, 0), cB, voffB); PG8_STAGE(PG8_SB(0, 1), cB + hstep, voffB); PG8_STAGE(PG8_SA(0, 0), cA, voffA); PG8_STAGE(PG8_SA(0, 1), cA + hstep, voffA);
        if (wr == 1) PG8_BAR;
        PG8_WAIT_V(2); PG8_BAR;
        PG8_STAGE(PG8_SB(1, 0), cB + kstep, voffB); PG8_STAGE(PG8_SA(1, 0), cA + kstep, voffA); PG8_STAGE(PG8_SB(1, 1), cB + hstep + kstep, voffB);
        PG8_WAIT_V(6); PG8_BAR;
    }
    bool fresh = true, relax = false;
    for (;;) {
        const bool has_next = S.seg(si + 1, nxt);
        const char* cA = cur.A; const char* cB = cur.B; const int nt = cur.nt;
        const char* nA = has_next ? nxt.A : cA; const char* nB = has_next ? nxt.B : cB;
#pragma nounroll
        for (int t = 0; t < nt; t += 2) {
            const bool first = (t == 0) && !fresh;
            const bool last = (t == nt - 2);
            const char* a1 = cA + (size_t)(t + 1) * kstep;
            const char* a2 = last ? nA : cA + (size_t)(t + 2) * kstep; const char* b2 = last ? nB : cB + (size_t)(t + 2) * kstep;
            const char* a3 = a2 + kstep; const char* b3 = b2 + kstep;
            PG8_LDB(B0, 0, 0); PG8_LDB(B1, 0, 1); PG8_SCHED; PG8_LDA(At, 0, 0); if (!first) PG8_STAGE(PG8_SA(1, 1), a1 + hstep, voffA);
            PG8_WAIT_VR(); PG8_WAIT_L(0); PG8_BAR; PG8_MMA(0, 0, At, B0); PG8_MMA(0, 1, At, B1); PG8_BAR; PG8_SCHED;
            PG8_LDA(At, 0, 1); PG8_STAGE(PG8_SB(0, 0), b2, voffB); PG8_STAGE(PG8_SB(0, 1), b2 + hstep, voffB); PG8_STAGE(PG8_SA(0, 0), a2, voffA);
            PG8_WAIT_VR(); PG8_WAIT_L(0); PG8_BAR; PG8_MMA(1, 0, At, B0); PG8_MMA(1, 1, At, B1); PG8_BAR; PG8_SCHED;
            PG8_LDB(B0, 1, 0); PG8_LDB(B1, 1, 1); PG8_SCHED; PG8_LDA(At, 1, 0); PG8_STAGE(PG8_SA(0, 1), a2 + hstep, voffA);
            PG8_WAIT_VR(); PG8_WAIT_L(0); PG8_BAR; PG8_MMA(0, 0, At, B0); PG8_MMA(0, 1, At, B1); PG8_BAR; PG8_SCHED;
            PG8_LDA(At, 1, 1); PG8_STAGE(PG8_SB(1, 0), b3, voffB); PG8_STAGE(PG8_SB(1, 1), b3 + hstep, voffB); PG8_STAGE(PG8_SA(1, 0), a3, voffA);
            PG8_WAIT_V(8); PG8_WAIT_L(0); PG8_BAR; PG8_MMA(1, 0, At, B0); PG8_MMA(1, 1, At, B1); PG8_BAR; PG8_SCHED;
        }
        if (wr == 0) PG8_BAR;
        PG8_STAGE(PG8_SA(1, 1), nA + kstep + hstep, voffA);
        PG8_SCHED;
        if constexpr (DUAL) E.scale(acc, cur.u, wr, wc, fr, fq, cur.mid != 0);
        if (DUAL && cur.mid) { relax = false; }
        else {
            E(acc, cur.u, wr, wc, fr, fq); relax = true;
#pragma unroll
            for (int a = 0; a < 2; ++a)
#pragma unroll
                for (int b = 0; b < 2; ++b)
#pragma unroll
                    for (int m = 0; m < 4; ++m)
#pragma unroll
                        for (int n = 0; n < 2; ++n) acc[a][b][m][n] = (f32x4){0.f, 0.f, 0.f, 0.f};
        }
        PG8_SCHED;
        if (!has_next) break;
        cur = nxt; ++si; fresh = false;
        if (wr == 1) PG8_BAR;
    }
    PG8_WAIT_V(0);
    PG8_BAR;
#undef PG8_SA
#undef PG8_SB
#undef PG8_STAGE
#undef PG8_LDA
#undef PG8_LDB
#undef PG8_MMA
#undef PG8_WAIT_V
#undef PG8_WAIT_VR
#undef PG8_WAIT_L
#undef PG8_BAR
#undef PG8_SCHED
}
struct SegOrder1 {
    StaticOrder so; const char* A; const char* B; size_t tstep; int nt;
    __device__ __forceinline__ bool seg(int s, Seg& o) const { Unit u; if (!so.next(s, u)) return false; o.A = A + (size_t)u.pm * tstep; o.B = B + (size_t)u.pn * tstep; o.nt = nt; o.mid = 0; o.u = u; rfl_seg(o); return true; }
};

__device__ __forceinline__ u32x4 pack8(const f32x4 v0, const f32x4 v1) { u32x4 w; w.x = cvt_pk_bf16(v0[0], v0[1]); w.y = cvt_pk_bf16(v0[2], v0[3]); w.z = cvt_pk_bf16(v1[0], v1[1]); w.w = cvt_pk_bf16(v1[2], v1[3]); return w; }
__device__ __forceinline__ void unpack8(const u32x4 w, f32x4& v0, f32x4& v1) { v0 = (f32x4){bf_lo(w.x), bf_hi(w.x), bf_lo(w.y), bf_hi(w.y)}; v1 = (f32x4){bf_lo(w.z), bf_hi(w.z), bf_lo(w.w), bf_hi(w.w)}; }

#ifdef NT_STORES
#define ST16(p, v) __builtin_nontemporal_store((v), (u32x4*)(p))
#define ST8(p, v) __builtin_nontemporal_store((v), (u32x2*)(p))
#else
#define ST16(p, v) (*(u32x4*)(p) = (v))
#define ST8(p, v) (*(u32x2*)(p) = (v))
#endif
struct EpiProj {
    static constexpr bool PERM = true;
    __device__ __forceinline__ void mid(f32x4 (&)[2][2][4][2], const Unit&, int, int, int, int) const {}
    bf16_t *Q, *Kb, *V, *SZ, *P, *QC, *SGA, *SGC; const float* cs;
    __device__ __forceinline__ void operator()(const f32x4 (&acc)[2][2][4][2], const Unit& u, int wr, int wc, int fr, int fq) const {
        const int pn = u.pn; const int row0 = u.pm * BM + wr * 64 + fr; const int lc = wc * 32 + 8 * fq;
        if (pn < 24) {
            const bool isq = pn < 12; bf16_t* base = isq ? Q : Kb; const int colt = (isq ? pn : pn - 12) * BM; const float sc = isq ? QSCALE : 1.0f;
            const bool rot = (fq == 0);
            f32x4 cv[2][4], sv[2][4];
#pragma unroll
            for (int ai = 0; ai < 2; ++ai)
#pragma unroll
                for (int m = 0; m < 4; ++m) { const float* cr = cs + (size_t)(row0 + ai * HALF + m * 16) * 32 + 4 * wc; cv[ai][m] = *(const f32x4*)cr; sv[ai][m] = *(const f32x4*)(cr + 16); }
#pragma unroll
            for (int ai = 0; ai < 2; ++ai)
#pragma unroll
                for (int m = 0; m < 4; ++m) {
                    const f32x4 c = rot ? cv[ai][m] * sc : (f32x4){sc, sc, sc, sc}, sn = rot ? sv[ai][m] * sc : (f32x4){0.f, 0.f, 0.f, 0.f};
                    bf16_t* rowp = base + (size_t)(row0 + ai * HALF + m * 16) * NQKV + colt + lc;
#pragma unroll
                    for (int bj = 0; bj < 2; ++bj) { const f32x4 v0 = acc[ai][bj][m][0], v1 = acc[ai][bj][m][1];
                        ST16((rowp + bj * HALF), (pack8(v0 * c - v1 * sn, v0 * sn + v1 * c))); }
                }
        } else if (pn < 36) {
            const int colt = (pn - 24) * BM;
#pragma unroll
            for (int ai = 0; ai < 2; ++ai)
#pragma unroll
                for (int m = 0; m < 4; ++m) { bf16_t* rowp = V + (size_t)(row0 + ai * HALF + m * 16) * NQKV + colt + lc;
#pragma unroll
                    for (int bj = 0; bj < 2; ++bj) ST16((rowp + bj * HALF), (pack8(acc[ai][bj][m][0], acc[ai][bj][m][1]))); }
        } else if (pn < 40) {
            const int colt = (pn - 36) * BM;
#pragma unroll
            for (int ai = 0; ai < 2; ++ai)
#pragma unroll
                for (int m = 0; m < 4; ++m) { bf16_t* rowp = SZ + (size_t)(row0 + ai * HALF + m * 16) * NZA + colt + lc;
#pragma unroll
                    for (int bj = 0; bj < 2; ++bj) { f32x4 a = acc[ai][bj][m][0], b = acc[ai][bj][m][1];
#pragma unroll
                        for (int j = 0; j < 4; ++j) { a[j] = silu_f(a[j]); b[j] = silu_f(b[j]); }
                        ST16((rowp + bj * HALF), (pack8(a, b))); } }
        } else if (pn < 72) {
            const int chb = 64 * (pn - 40) + 16 * wc + 4 * fq;
#pragma unroll
            for (int ai = 0; ai < 2; ++ai)
#pragma unroll
                for (int m = 0; m < 4; ++m) { const size_t ro = (size_t)(row0 + ai * HALF + m * 16) * NCV + chb;
                    const f32x4 cb = acc[ai][0][m][0], cc = acc[ai][0][m][1], cx = acc[ai][1][m][0], z = acc[ai][1][m][1];
                    f32x4 pv = cc * cx, qv;
#pragma unroll
                    for (int j = 0; j < 4; ++j) qv[j] = cb[j] * silu_f(z[j]);
                    u32x2 pw, qw; pw.x = cvt_pk_bf16(pv[0], pv[1]); pw.y = cvt_pk_bf16(pv[2], pv[3]); qw.x = cvt_pk_bf16(qv[0], qv[1]); qw.y = cvt_pk_bf16(qv[2], qv[3]);
                    ST8((P + ro), (pw)); ST8((QC + ro), (qw)); }
        } else {
            const int colt = (pn - 72) * HALF;
#pragma unroll
            for (int ai = 0; ai < 2; ++ai)
#pragma unroll
                for (int m = 0; m < 4; ++m) { const size_t ro = (size_t)(row0 + ai * HALF + m * 16) * D + colt + lc;
                    f32x4 r[2], c[2];
#pragma unroll
                    for (int n = 0; n < 2; ++n)
#pragma unroll
                        for (int j = 0; j < 4; ++j) { const float ec = __builtin_amdgcn_exp2f(-acc[ai][1][m][n][j] * LOG2E); c[n][j] = __builtin_amdgcn_rcpf(1.0f + ec); r[n][j] = sigm_f(acc[ai][0][m][n][j]) * (1.0f + ec); }
                    ST16((SGA + ro), (pack8(r[0], r[1]))); ST16((SGC + ro), (pack8(c[0], c[1]))); }
        }
    }
};
struct EpiMerge {
    static constexpr bool PERM = true;
    bf16_t* O; const bf16_t* RHO; const bf16_t* SC; int ldc;
    __device__ __forceinline__ size_t lane_off(const Unit& u, int wr, int wc, int fr, int fq, int ai) const {
        size_t o = (size_t)(u.pm * BM + wr * 64 + fr + ai * HALF) * ldc + u.pn * BM + wc * 32 + 8 * fq; asm volatile("" : "+v"(o)); return o; }
    __device__ __forceinline__ void scale(f32x4 (&acc)[2][2][4][2], const Unit& u, int wr, int wc, int fr, int fq, bool is_mid) const {
        const bf16_t* G = is_mid ? RHO : SC;
#pragma unroll
        for (int ai = 0; ai < 2; ++ai) {
            const bf16_t* p = G + lane_off(u, wr, wc, fr, fq, ai);
            u32x4 gw[4][2];
#pragma unroll
            for (int m = 0; m < 4; ++m)
#pragma unroll
                for (int bj = 0; bj < 2; ++bj) gw[m][bj] = *(const u32x4*)(p + (size_t)m * 16 * ldc + bj * HALF);
#pragma unroll
            for (int m = 0; m < 4; ++m)
#pragma unroll
                for (int bj = 0; bj < 2; ++bj) { f32x4 g0, g1; unpack8(gw[m][bj], g0, g1); acc[ai][bj][m][0] *= g0; acc[ai][bj][m][1] *= g1; }
        }
    }
    __device__ __forceinline__ void mid(f32x4 (&)[2][2][4][2], const Unit&, int, int, int, int) const {}
    __device__ __forceinline__ void operator()(const f32x4 (&acc)[2][2][4][2], const Unit& u, int wr, int wc, int fr, int fq) const {
#pragma unroll
        for (int ai = 0; ai < 2; ++ai) {
            bf16_t* q = O + lane_off(u, wr, wc, fr, fq, ai);
#pragma unroll
            for (int m = 0; m < 4; ++m)
#pragma unroll
                for (int bj = 0; bj < 2; ++bj) *(u32x4*)(q + (size_t)m * 16 * ldc + bj * HALF) = pack8(acc[ai][bj][m][0], acc[ai][bj][m][1]);
        }
    }
};
struct EpiBf16 {
    static constexpr bool PERM = true;
    __device__ __forceinline__ void mid(f32x4 (&)[2][2][4][2], const Unit&, int, int, int, int) const {}
    bf16_t* O; int ldc;
    __device__ __forceinline__ void operator()(const f32x4 (&acc)[2][2][4][2], const Unit& u, int wr, int wc, int fr, int fq) const {
        const int row0 = u.pm * BM + wr * 64 + fr, col0 = u.pn * BM + wc * 32 + 8 * fq;
#pragma unroll
        for (int ai = 0; ai < 2; ++ai)
#pragma unroll
            for (int m = 0; m < 4; ++m) { bf16_t* rowp = O + (size_t)(row0 + ai * HALF + m * 16) * ldc + col0;
#pragma unroll
                for (int bj = 0; bj < 2; ++bj) *(u32x4*)(rowp + bj * HALF) = pack8(acc[ai][bj][m][0], acc[ai][bj][m][1]); }
    }
};
struct SegOrder2 {
    StaticOrder so; const char *A0, *B0, *A1, *B1; size_t tstep; int nt0, nt1;
    __device__ __forceinline__ bool seg(int s_, Seg& o) const { Unit u; if (!so.next(s_ >> 1, u)) return false; const int h = s_ & 1;
        o.A = (h ? A1 : A0) + (size_t)u.pm * tstep; o.B = (h ? B1 : B0) + (size_t)u.pn * tstep; o.nt = h ? nt1 : nt0; o.mid = !h; o.u = u; rfl_seg(o); return true; }
};
}

#ifndef PG8_SP2
#define PG8_SP2 true
#endif
#ifndef PG8_ALIGN
#define PG8_ALIGN true
#endif

constexpr int NWAVES = 8;
#ifndef MK_N_LAUNCHES
#define MK_N_LAUNCHES 1
#endif
constexpr int NPHASES = 8;
constexpr int N_LAUNCHES = MK_N_LAUNCHES;

constexpr size_t MiB = 1u << 20;
constexpr size_t WS_CTL = 0, CTL_ZERO_BYTES = 1 * MiB;
constexpr size_t WS_MOD = 1 * MiB;
constexpr size_t WS_CS = 2 * MiB;
constexpr size_t WS_WIN = 4 * MiB;
constexpr size_t WS_WA = 92 * MiB, WS_WC = 100 * MiB, WS_WO = 108 * MiB;
constexpr size_t WS_H = 116 * MiB;
constexpr size_t WS_Q = 180 * MiB, WS_K = 276 * MiB, WS_V = 372 * MiB;
constexpr size_t WS_SZ = 468 * MiB;
constexpr size_t WS_P = 500 * MiB, WS_QC = 564 * MiB;
constexpr size_t WS_O2 = 628 * MiB;
constexpr size_t WS_LSE = 660 * MiB;
constexpr size_t WS_END = 662 * MiB;
constexpr size_t WS_O0 = 116 * MiB, WS_O1 = 148 * MiB;
constexpr size_t WS_AATT = 180 * MiB, WS_R = 244 * MiB, WS_MG = 308 * MiB, WS_Y = 372 * MiB;
constexpr int CW_BAR = 4096;
#define XCD_BAR_WORDS 3456

constexpr int RING_BYTES = 131072;
constexpr int LDSCTL_OFF = RING_BYTES, MISC_OFF = LDSCTL_OFF + 320;
constexpr int LDS_BYTES = 147456;

typedef GAS unsigned gu32;
#define RLX_AGENT __ATOMIC_RELAXED, __HIP_MEMORY_SCOPE_AGENT

#define XB_TMO      128
#define XB_XCNT(j)  (256  + 64 * (j))
#define XB_XSUB(j)  (1280 + 64 * (j))
#define XB_XGEN(j)  (2304 + 64 * (j))
#define XB_TOP      3328
#define XB_TOPGEN   3392
#define XB_SPIN_CAP (1u << 18)

__device__ __forceinline__ unsigned xb_ld(unsigned* p)              { return __hip_atomic_load(p, __ATOMIC_RELAXED, __HIP_MEMORY_SCOPE_AGENT); }
__device__ __forceinline__ unsigned xb_add(unsigned* p, unsigned v) { return __hip_atomic_fetch_add(p, v, __ATOMIC_RELAXED, __HIP_MEMORY_SCOPE_AGENT); }
__device__ __forceinline__ unsigned xb_xcc_id() { return (unsigned)__builtin_amdgcn_s_getreg((3 << 11) | 20) & 0xFu; }
#define XB_SPIN(cond, bar) do { unsigned _sp = 0; while (cond) { __builtin_amdgcn_s_sleep(1); \
    if ((++_sp & 255u) == 0u) { if (xb_ld(&(bar)[XB_TMO])) break; if (_sp > XB_SPIN_CAP) { atomicAdd(&(bar)[XB_TMO], 1u); break; } } } } while (0)

struct XcdBarrier { unsigned* bar; unsigned x; volatile LAS unsigned* st; };

__device__ __forceinline__ XcdBarrier xcd_barrier_post(unsigned* bar, volatile LAS unsigned* st) {
    XcdBarrier b; b.bar = bar; b.x = xb_xcc_id(); b.st = st;
    if (threadIdx.x == 0) (void)xb_add(&bar[XB_XCNT(b.x)], 1u);
    return b;
}
__device__ __forceinline__ void xcd_barrier_complete(unsigned* bar, unsigned x, unsigned& nloc, unsigned& nx) {
    const unsigned G = gridDim.x * gridDim.y * gridDim.z;
    unsigned sum, cnt, mine, sp = 0u;
    for (;;) {
        sum = 0u; cnt = 0u; mine = 0u;
#pragma unroll
        for (unsigned j = 0; j < 16; ++j) { const unsigned c = xb_ld(&bar[XB_XCNT(j)]); sum += c; cnt += (c > 0u) ? 1u : 0u; mine = (j == x) ? c : mine; }
        if (sum == G) break;
        __builtin_amdgcn_s_sleep(1);
        if ((++sp & 255u) == 0u) { if (xb_ld(&bar[XB_TMO])) break; if (sp > XB_SPIN_CAP) { atomicAdd(&bar[XB_TMO], 1u); break; } }
    }
    nloc = mine > 0u ? mine : 1u; nx = cnt > 0u ? cnt : 1u;
}
__device__ __forceinline__ void xcd_barrier(const XcdBarrier& b) {
    asm volatile("s_waitcnt vmcnt(0)" ::: "memory");
    __syncthreads();
    if (threadIdx.x == 0) {
        unsigned* bar = b.bar;
        __builtin_amdgcn_s_waitcnt(0);
        unsigned nloc = b.st[0], nx = b.st[1];
        if (nloc == 0u) { xcd_barrier_complete(bar, b.x, nloc, nx); b.st[0] = nloc; b.st[1] = nx; }
        const unsigned old = xb_add(&bar[XB_XSUB(b.x)], 1u);
        const unsigned gen = old / nloc;
        if (old + 1u == (gen + 1u) * nloc) {
            __builtin_amdgcn_fence(__ATOMIC_RELEASE, "agent");
            asm volatile("s_waitcnt vmcnt(0)" ::: "memory");
            const unsigned og = xb_add(&bar[XB_TOP], 1u);
            const unsigned tg = og / nx;
            if (og + 1u == (tg + 1u) * nx) xb_add(&bar[XB_TOPGEN], 1u);
            else XB_SPIN(xb_ld(&bar[XB_TOPGEN]) == tg, bar);
            __builtin_amdgcn_fence(__ATOMIC_ACQUIRE, "agent");
            xb_add(&bar[XB_XGEN(b.x)], 1u);
            asm volatile("s_waitcnt vmcnt(0)" ::: "memory");
        } else {
            XB_SPIN(xb_ld(&bar[XB_XGEN(b.x)]) == gen, bar);
            __builtin_amdgcn_fence(__ATOMIC_ACQUIRE, "agent");
            asm volatile("s_waitcnt vmcnt(0)" ::: "memory");
        }
    }
    __syncthreads();
}

#define LDS_WAIT() asm volatile("s_waitcnt lgkmcnt(0)" ::: "memory")
__device__ __forceinline__ float wave_sum(float v) {
#pragma unroll
    for (int o = 1; o < 64; o <<= 1) v += __shfl_xor(v, o);
    return v;
}
__device__ __forceinline__ unsigned f2bf(float f) { unsigned u = __builtin_bit_cast(unsigned, f); return (u + 0x7fffu + ((u >> 16) & 1u)) >> 16; }
__device__ __forceinline__ unsigned pk2(float lo, float hi) { return f2bf(lo) | (f2bf(hi) << 16); }

__device__ __forceinline__ int proj_orig_col(int n) {
    const int tile = n >> 8, c = n & 255;
    if (tile < 24) { const int c7 = n & 127, wc = c7 >> 5, fq = (c7 >> 3) & 3, nn = (c7 >> 2) & 1, j = c7 & 3;
        const int dim = (fq == 0) ? (4 * wc + j + 16 * nn) : (32 + wc * 24 + (fq - 1) * 8 + 4 * nn + j); return (n & ~127) + dim; }
    if (tile < 40) return n;
    if (tile < 72) { const int kind = 2 * (c >> 7) + ((c >> 2) & 1), chl = 16 * ((c >> 5) & 3) + 4 * ((c >> 3) & 3) + (c & 3); return 10240 + kind * 2048 + 64 * (tile - 40) + chl; }
    return 18432 + (c >> 7) * 2048 + 128 * (tile - 72) + (c & 127);
}
template <bool REMAP>
__device__ __forceinline__ void p0_transpose_item(const float* W, int K, int N, bf16_t* WT, int pitch, LAS float* scr, int item, int lane) {
    const int nblk = N / 32, kb = item / nblk, nb = item % nblk, k0 = 64 * kb, n0 = 32 * nb;
    const int ncol = REMAP ? proj_orig_col(n0 + (lane & 31)) : n0 + (lane & 31);
#pragma unroll 8
    for (int i = 0; i < 32; ++i) { const int kk = 2 * i + (lane >> 5); scr[kk * 33 + (lane & 31)] = W[(size_t)(k0 + kk) * N + ncol]; }
    LDS_WAIT(); asm volatile("" ::: "memory");
    const int c = lane & 7;
#pragma unroll
    for (int j = 0; j < 4; ++j) { const int n = (lane >> 3) + 8 * j; const LAS float* s = scr + (8 * c) * 33 + n;
        u32x4 o; o.x = pk2(s[0 * 33], s[1 * 33]); o.y = pk2(s[2 * 33], s[3 * 33]); o.z = pk2(s[4 * 33], s[5 * 33]); o.w = pk2(s[6 * 33], s[7 * 33]);
        *(u32x4*)(WT + (size_t)(n0 + n) * pitch + k0 + 8 * c) = o; }
    LDS_WAIT(); asm volatile("" ::: "memory");
}

__device__ __forceinline__ void sincos_f64(float ang, float& s, float& c) {
    const double x = (double)ang;
    const double n = __builtin_rint(x * 0.15915494309189535);
    double r = __builtin_fma(-n, 6.283185307179586, x); r = __builtin_fma(-n, 2.4492935982947064e-16, r);
    const double r2 = r * r;
    double ps = 1.0 / 51090942171709440000.0;
    ps = __builtin_fma(ps, r2, -1.0 / 121645100408832000.0);
    ps = __builtin_fma(ps, r2, 1.0 / 355687428096000.0);
    ps = __builtin_fma(ps, r2, -1.0 / 1307674368000.0);
    ps = __builtin_fma(ps, r2, 1.0 / 6227020800.0);
    ps = __builtin_fma(ps, r2, -1.0 / 39916800.0);
    ps = __builtin_fma(ps, r2, 1.0 / 362880.0);
    ps = __builtin_fma(ps, r2, -1.0 / 5040.0);
    ps = __builtin_fma(ps, r2, 1.0 / 120.0);
    ps = __builtin_fma(ps, r2, -1.0 / 6.0);
    ps = __builtin_fma(ps, r2, 1.0);
    double pc = -1.0 / 1124000727777607680000.0;
    pc = __builtin_fma(pc, r2, 1.0 / 2432902008176640000.0);
    pc = __builtin_fma(pc, r2, -1.0 / 6402373705728000.0);
    pc = __builtin_fma(pc, r2, 1.0 / 20922789888000.0);
    pc = __builtin_fma(pc, r2, -1.0 / 87178291200.0);
    pc = __builtin_fma(pc, r2, 1.0 / 479001600.0);
    pc = __builtin_fma(pc, r2, -1.0 / 3628800.0);
    pc = __builtin_fma(pc, r2, 1.0 / 40320.0);
    pc = __builtin_fma(pc, r2, -1.0 / 720.0);
    pc = __builtin_fma(pc, r2, 1.0 / 24.0);
    pc = __builtin_fma(pc, r2, -0.5);
    pc = __builtin_fma(pc, r2, 1.0);
    s = (float)(r * ps); c = (float)pc;
}

__device__ __forceinline__ unsigned attn_offk(unsigned row, unsigned ch) { return 256u * row + 16u * (ch ^ (row & 15u)); }
__device__ __forceinline__ unsigned attn_offv(unsigned row, unsigned ch) { return 256u * row + 16u * (ch ^ (((row & 3u) << 2) | ((row >> 2) & 3u))); }
__device__ __forceinline__ unsigned attn_lrow(unsigned k) { return (k & ~31u) | (((k >> 2) & 3u) << 3) | (((k >> 4) & 1u) << 2) | (k & 3u); }

__device__ __forceinline__ void attn_phase(LAS unsigned char* lds, const bf16_t* Qb, const bf16_t* Kb, const bf16_t* Vb, bf16_t* O0, bf16_t* O1, bf16_t* O2, float* LSE, int G, int vcu) {
    const int tid = threadIdx.x, lane = tid & 63, wid = __builtin_amdgcn_readfirstlane(tid >> 6), fr = lane & 15, fq = lane >> 4;
    LAS unsigned char* ldsK = lds; LAS unsigned char* ldsV = lds + 65536;
    const int NU = 3072, per = (NU + G - 1) / G;
    const int u_lo = vcu * per, u_hi = (u_lo + per) < NU ? (u_lo + per) : NU;
    for (int uid = u_lo; uid < u_hi; ++uid) {
        const int g = uid >> 10, rem = uid & 1023, hh = rem >> 7, rem2 = rem & 127;
        const int dsh = 2 * g, d = 1 << dsh;
        const int nbs = 7 - dsh;
        const int r = rem2 >> nbs, n = rem2 & ((1 << nbs) - 1);
        const size_t colb = (size_t)(g * 1024 + hh * 128) * 2;
        {
            const int ch = tid & 15, rb = tid >> 4;
            u32x4 kreg[8], vreg[8];
#pragma unroll
            for (int i = 0; i < 8; ++i) { const int kr = rb + 32 * i; int lp = 128 * (n - 1) + kr; lp = lp < 0 ? 0 : lp; const size_t p = ((size_t)lp << dsh) + r;
                const size_t off = p * (size_t)(NQKV * 2) + colb + ch * 16;
                kreg[i] = *(const u32x4*)((const char*)Kb + off); vreg[i] = *(const u32x4*)((const char*)Vb + off); }
#pragma unroll
            for (int i = 0; i < 8; ++i) { const unsigned kr = rb + 32 * i;
                *(LAS u32x4*)(ldsK + attn_offk(kr, ch)) = kreg[i]; *(LAS u32x4*)(ldsV + attn_offv(attn_lrow(kr), ch)) = vreg[i]; }
        }
        const int lq = 128 * n + 16 * wid + fr; const size_t pq = ((size_t)lq << dsh) + r;
        bf16x8 qf[4];
        { const bf16x8* qp = (const bf16x8*)((const char*)Qb + pq * (size_t)(NQKV * 2) + colb + fq * 16);
#pragma unroll
          for (int s = 0; s < 4; ++s) qf[s] = qp[4 * s]; }
        __syncthreads();
        f32x4 S[9];
#pragma unroll
        for (int t = 0; t < 9; ++t) {
            S[t] = (f32x4){0.f, 0.f, 0.f, 0.f};
            const unsigned row = 16 * wid + 16 * t + fr;
#pragma unroll
            for (int s = 0; s < 4; ++s) { const bf16x8 kf = *(const LAS bf16x8*)(ldsK + attn_offk(row, 4 * s + fq)); S[t] = __builtin_amdgcn_mfma_f32_16x16x32_bf16(kf, qf[s], S[t], 0, 0, 0); }
        }
        const float NEG = -1e30f;
#pragma unroll
        for (int j = 0; j < 4; ++j) { const int ko0 = 4 * fq + j; if (ko0 < fr) S[0][j] = NEG; if (ko0 > fr) S[8][j] = NEG; }
        if (n == 0) {
#pragma unroll
            for (int t = 0; t < 9; ++t)
#pragma unroll
                for (int j = 0; j < 4; ++j) { if (16 * wid + 16 * t + 4 * fq + j < 128) S[t][j] = NEG; }
        }
        float mx = NEG;
#pragma unroll
        for (int t = 0; t < 9; ++t) mx = fmaxf(mx, fmaxf(fmaxf(S[t][0], S[t][1]), fmaxf(S[t][2], S[t][3])));
        mx = fmaxf(mx, __shfl_xor(mx, 16)); mx = fmaxf(mx, __shfl_xor(mx, 32));
        float sum = 0.f;
#pragma unroll
        for (int t = 0; t < 9; ++t)
#pragma unroll
            for (int j = 0; j < 4; ++j) { const float p = __builtin_amdgcn_exp2f(S[t][j] - mx); S[t][j] = p; sum += p; }
        sum += __shfl_xor(sum, 16); sum += __shfl_xor(sum, 32);
        f32x4 O[8];
#pragma unroll
        for (int c = 0; c < 8; ++c) O[c] = (f32x4){0.f, 0.f, 0.f, 0.f};
        const unsigned q4 = (unsigned)(lane & 15) >> 2, p4 = (unsigned)lane & 3u;
#pragma unroll
        for (int u = 0; u < 5; ++u) {
            u32x4 pw; pw.x = cvt_pk_bf16(S[2 * u][0], S[2 * u][1]); pw.y = cvt_pk_bf16(S[2 * u][2], S[2 * u][3]);
            if (u < 4) { pw.z = cvt_pk_bf16(S[2 * u + 1][0], S[2 * u + 1][1]); pw.w = cvt_pk_bf16(S[2 * u + 1][2], S[2 * u + 1][3]); } else { pw.z = 0u; pw.w = 0u; }
            const bf16x8 pf = __builtin_bit_cast(bf16x8, pw);
            const unsigned kba = 16 * wid + 32 * u, kbb = (u < 4) ? kba + 16 : kba;
            const unsigned lra = (kba & ~31u) | ((unsigned)fq << 3) | (((kba >> 4) & 1u) << 2) | q4;
            const unsigned lrb = (kbb & ~31u) | ((unsigned)fq << 3) | (((kbb >> 4) & 1u) << 2) | q4;
#pragma unroll
            for (int c = 0; c < 8; ++c) {
                const s16x4 va = __builtin_amdgcn_ds_read_tr16_b64_v4i16((LAS s16x4*)(ldsV + attn_offv(lra, 2 * c + (p4 >> 1)) + 8 * (p4 & 1)));
                const s16x4 vb = __builtin_amdgcn_ds_read_tr16_b64_v4i16((LAS s16x4*)(ldsV + attn_offv(lrb, 2 * c + (p4 >> 1)) + 8 * (p4 & 1)));
                const bf16x8 vf = __builtin_shufflevector(va, vb, 0, 1, 2, 3, 4, 5, 6, 7);
                O[c] = __builtin_amdgcn_mfma_f32_16x16x32_bf16(vf, pf, O[c], 0, 0, 0);
            }
        }
        const float inv = 1.0f / sum;
        bf16_t* Og = (g == 0) ? O0 : ((g == 1) ? O1 : O2);
        bf16_t* op = Og + pq * NZA + hh * 128 + 4 * fq;
#pragma unroll
        for (int c = 0; c < 8; ++c) { u32x2 w; w.x = cvt_pk_bf16(O[c][0] * inv, O[c][1] * inv); w.y = cvt_pk_bf16(O[c][2] * inv, O[c][3] * inv); *(u32x2*)(op + 16 * c) = w; }
        if (fq == 0) LSE[((size_t)g * M + pq) * 8 + hh] = mx + __builtin_amdgcn_logf(sum);
        __syncthreads();
    }
}

struct Args { const float* x; const float* c; const int* pos; const float* g_pre; const float* w_ada; const float* b_ada; const float* w_in; const float* conv_w;
              const float* w_attn_o; const float* w_conv_o; const float* w_o; const float* g_post; float* out; unsigned char* ws; int ph_lo, ph_hi, li, pad; };

__global__ void __launch_bounds__(NWAVES * 64, 2) mk_fwd(Args args) {
    extern __shared__ __attribute__((aligned(16))) unsigned char lds_raw[];
    LAS unsigned char* lds = (LAS unsigned char*)lds_raw;
    volatile LAS unsigned* MISC = (volatile LAS unsigned*)(lds + MISC_OFF);
    const int tid = threadIdx.x, lane = tid & 63, wave = __builtin_amdgcn_readfirstlane(tid >> 6);
    const int G = gridDim.x; const int bx = blockIdx.x; const int vcu = (G % 8 == 0) ? (bx % 8) * (G / 8) + bx / 8 : bx;
    unsigned char* ws = args.ws;
    gu32* ctl = (gu32*)(ws + WS_CTL);
    float* mod = (float*)(ws + WS_MOD); float* cs = (float*)(ws + WS_CS);
    bf16_t* WinT = (bf16_t*)(ws + WS_WIN); bf16_t* WaT = (bf16_t*)(ws + WS_WA); bf16_t* WcT = (bf16_t*)(ws + WS_WC); bf16_t* WoT = (bf16_t*)(ws + WS_WO);
    bf16_t* Hb = (bf16_t*)(ws + WS_H); bf16_t* Qb = (bf16_t*)(ws + WS_Q); bf16_t* Kb = (bf16_t*)(ws + WS_K); bf16_t* Vb = (bf16_t*)(ws + WS_V);
    bf16_t* SZ = (bf16_t*)(ws + WS_SZ); bf16_t* Pb = (bf16_t*)(ws + WS_P); bf16_t* QCb = (bf16_t*)(ws + WS_QC);
    bf16_t* SGA = (bf16_t*)args.out; bf16_t* SGC = SGA + (size_t)M * D;
    bf16_t* O0 = (bf16_t*)(ws + WS_O0); bf16_t* O1 = (bf16_t*)(ws + WS_O1); bf16_t* O2 = (bf16_t*)(ws + WS_O2); float* LSE = (float*)(ws + WS_LSE);
    bf16_t* AATT = (bf16_t*)(ws + WS_AATT); bf16_t* Rb = (bf16_t*)(ws + WS_R); bf16_t* MG = (bf16_t*)(ws + WS_MG);
    bf16_t* Yb = (bf16_t*)(ws + WS_Y);

    for (int u = tid; u < (LDS_BYTES - LDSCTL_OFF) / 4; u += NWAVES * 64) ((LAS unsigned*)(lds + LDSCTL_OFF))[u] = 0u;
    __syncthreads();
    const int bli = (N_LAUNCHES == 1) ? 0 : args.li;
    XcdBarrier bar; bar.bar = (unsigned*)(ctl + CW_BAR) + bli * XCD_BAR_WORDS; bar.x = 0; bar.st = nullptr;
    if (N_LAUNCHES == 1) bar = xcd_barrier_post((unsigned*)(ctl + CW_BAR), MISC + 8);
    const int lo = args.ph_lo, hi = args.ph_hi;
#define IN(k) (lo <= (k) && (k) < hi)
#define BOTH(k) (IN(k) && IN((k) + 1))
#define GRID_BAR() xcd_barrier(bar)
#ifndef PROBE_REPEAT_MASK
#define PROBE_REPEAT_MASK 0
#endif
#define NREP(k) ((((PROBE_REPEAT_MASK) >> (k)) & 1) + 1)
#if defined(PROBE_PH) || defined(PROBE_ARRIVE)
#define PHSTAMP(k) do { if (bx == 0 && tid == 0) ((unsigned long long*)(ws + WS_MOD + 65536))[16 + (k)] = __builtin_amdgcn_s_memrealtime(); } while (0)
#else
#define PHSTAMP(k) do {} while (0)
#endif
    PHSTAMP(0);
    const int gw = vcu * NWAVES + wave, NGW = G * NWAVES;
    const int gtid = vcu * (NWAVES * 64) + tid, NT = G * NWAVES * 64;

    if (IN(0)) for (int rep = 0; rep < NREP(0); ++rep) {
        {
            LAS float* red = (LAS float*)lds;
            for (int cbk = bx; cbk < 256; cbk += G) {
                const int c4 = tid % 6, rg = tid / 6;
                f32x4 a = (f32x4){0.f, 0.f, 0.f, 0.f};
                if (rg < 85) { for (int k = rg; k < D; k += 85) { const float cv = args.c[k]; const f32x4 w = *(const f32x4*)(args.w_ada + (size_t)k * NMOD + cbk * 24 + c4 * 4); a += w * cv; }
                    *(LAS f32x4*)(red + (rg * 6 + c4) * 4) = a; }
                __syncthreads();
                if (tid < 24) { float s = 0.f; for (int i = 0; i < 85; ++i) s += red[(i * 6 + (tid >> 2)) * 4 + (tid & 3)]; mod[cbk * 24 + tid] = s + args.b_ada[cbk * 24 + tid]; }
                __syncthreads();
            }
        }
        for (int idx = gtid; idx < M * 16; idx += NT) { const int m = idx >> 4, i = idx & 15; const float ang = (float)args.pos[m] * INVF[i]; float s, c; sincos_f64(ang, s, c); cs[m * 32 + i] = c; cs[m * 32 + 16 + i] = s; }
        {
            LAS float* scr = (LAS float*)(lds + wave * 16384);
            constexpr int I_IN = (D / 64) * (PROJ / 32), I_A = (NZA / 64) * (D / 32), I_C = (NCV / 64) * (D / 32), I_O = (D / 64) * (D / 32);
            constexpr int NITEMS = I_IN + I_A + I_C + I_O;
            for (int it = gw; it < NITEMS; it += NGW) {
                int r = it;
                if (r < I_IN) { p0_transpose_item<true>(args.w_in, D, PROJ, WinT, D, scr, r, lane); continue; } r -= I_IN;
                if (r < I_A) { p0_transpose_item<false>(args.w_attn_o, NZA, D, WaT, D, scr, r, lane); continue; } r -= I_A;
                if (r < I_C) { p0_transpose_item<false>(args.w_conv_o, NCV, D, WcT, D, scr, r, lane); continue; } r -= I_C;
                p0_transpose_item<false>(args.w_o, D, D, WoT, D, scr, r, lane);
            }
        }
        if (BOTH(0) || rep + 1 < NREP(0)) GRID_BAR();
    }
    PHSTAMP(1);
    if (IN(1)) for (int rep = 0; rep < NREP(1); ++rep) {
        f32x4 av[4][2], bv[4][2];
#pragma unroll
        for (int j = 0; j < 4; ++j)
#pragma unroll
            for (int h = 0; h < 2; ++h) { const int k = 512 * j + 8 * lane + 4 * h; const f32x4 gp = *(const f32x4*)(args.g_pre + k), sc = *(const f32x4*)(mod + D + k); av[j][h] = gp * (sc + 1.0f); bv[j][h] = *(const f32x4*)(mod + k); }
        for (int m = gw; m < M; m += NGW) {
            const float* xr = args.x + (size_t)m * D + 8 * lane;
            f32x4 v[4][2]; float ss = 0.f;
#pragma unroll
            for (int j = 0; j < 4; ++j)
#pragma unroll
                for (int h = 0; h < 2; ++h) { v[j][h] = *(const f32x4*)(xr + 512 * j + 4 * h); const f32x4 q = v[j][h] * v[j][h]; ss += (q[0] + q[1]) + (q[2] + q[3]); }
            const float rstd = 1.0f / sqrtf(wave_sum(ss) * (1.0f / D) + EPS);
            bf16_t* hr = Hb + (size_t)m * D + 8 * lane;
#pragma unroll
            for (int j = 0; j < 4; ++j) { const f32x4 h0 = v[j][0] * rstd * av[j][0] + bv[j][0], h1 = v[j][1] * rstd * av[j][1] + bv[j][1]; *(u32x4*)(hr + 512 * j) = pg8::pack8(h0, h1); }
        }
        if (BOTH(1) || rep + 1 < NREP(1)) GRID_BAR();
    }
    PHSTAMP(2);
    if (IN(2)) {
        pg8::SegOrder1 S; S.so.init(M, PROJ, G, bx, NREP(2)); S.A = (const char*)Hb; S.B = (const char*)WinT; S.tstep = (size_t)256 * D * 2; S.nt = D / 64;
        pg8::EpiProj E{Qb, Kb, Vb, SZ, Pb, QCb, SGA, SGC, cs};
        pg8::gemm_stream<pg8::EpiProj, pg8::SegOrder1>(lds, D, S, E);
        if (BOTH(2)) GRID_BAR();
    }
    PHSTAMP(3);
    if (IN(3)) for (int rep = 0; rep < NREP(3); ++rep) {
        attn_phase(lds, Qb, Kb, Vb, O0, O1, O2, LSE, G, vcu);
        if (BOTH(3) || rep + 1 < NREP(3)) GRID_BAR();
    }
    PHSTAMP(4);
    if (IN(4)) for (int rep = 0; rep < NREP(4); ++rep) {
        for (int it = gtid; it < M * 128; it += NT) {
            const int p = it >> 7, c8 = it & 127, hh = c8 >> 4;
            const float l0 = LSE[((size_t)0 * M + p) * 8 + hh], l1 = LSE[((size_t)1 * M + p) * 8 + hh], l2 = LSE[((size_t)2 * M + p) * 8 + hh];
            const float mx = fmaxf(l0, fmaxf(l1, l2));
            float w0 = __builtin_amdgcn_exp2f(l0 - mx), w1 = __builtin_amdgcn_exp2f(l1 - mx), w2 = __builtin_amdgcn_exp2f(l2 - mx);
            const float inv = 1.0f / (w0 + w1 + w2); w0 *= inv; w1 *= inv; w2 *= inv;
            const size_t off = (size_t)p * NZA + c8 * 8, offa = (size_t)p * D + c8 * 8;
            f32x4 a0, a1, b0, b1, c0, c1, z0, z1;
            pg8::unpack8(*(const u32x4*)(O0 + off), a0, a1); pg8::unpack8(*(const u32x4*)(O1 + off), b0, b1); pg8::unpack8(*(const u32x4*)(O2 + off), c0, c1); pg8::unpack8(*(const u32x4*)(SZ + off), z0, z1);
            const f32x4 r0 = (a0 * w0 + b0 * w1 + c0 * w2) * z0, r1 = (a1 * w0 + b1 * w1 + c1 * w2) * z1;
            *(u32x4*)(AATT + offa) = pg8::pack8(r0, r1);
        }
        for (int bk = vcu; bk < 256; bk += G) {
            const int chunk = tid & 255, half = tid >> 8, c0 = 8 * chunk, t0 = 64 * bk + 32 * half;
            f32x4 wa[3][2];
#pragma unroll
            for (int k = 0; k < 3; ++k) { wa[k][0] = *(const f32x4*)(args.conv_w + k * NCV + c0); wa[k][1] = *(const f32x4*)(args.conv_w + k * NCV + c0 + 4); }
            f32x4 pm2[2], pm1[2];
            if (t0 >= 2) { pg8::unpack8(*(const u32x4*)(Pb + (size_t)(t0 - 2) * NCV + c0), pm2[0], pm2[1]); pg8::unpack8(*(const u32x4*)(Pb + (size_t)(t0 - 1) * NCV + c0), pm1[0], pm1[1]); }
            else { pm2[0] = pm2[1] = pm1[0] = pm1[1] = (f32x4){0.f, 0.f, 0.f, 0.f}; }
#pragma unroll 4
            for (int t = t0; t < t0 + 32; ++t) {
                f32x4 pc[2], qc[2]; pg8::unpack8(*(const u32x4*)(Pb + (size_t)t * NCV + c0), pc[0], pc[1]); pg8::unpack8(*(const u32x4*)(QCb + (size_t)t * NCV + c0), qc[0], qc[1]);
                const f32x4 r0 = qc[0] * (wa[0][0] * pm2[0] + wa[1][0] * pm1[0] + wa[2][0] * pc[0]), r1 = qc[1] * (wa[0][1] * pm2[1] + wa[1][1] * pm1[1] + wa[2][1] * pc[1]);
                *(u32x4*)(Rb + (size_t)t * NCV + c0) = pg8::pack8(r0, r1);
                pm2[0] = pm1[0]; pm2[1] = pm1[1]; pm1[0] = pc[0]; pm1[1] = pc[1];
            }
        }
        if (BOTH(4) || rep + 1 < NREP(4)) GRID_BAR();
    }
    PHSTAMP(5);
    if (IN(5)) {
        pg8::SegOrder2 S; S.so.init(M, D, G, bx, NREP(5)); S.A0 = (const char*)AATT; S.B0 = (const char*)WaT; S.A1 = (const char*)Rb; S.B1 = (const char*)WcT; S.tstep = (size_t)256 * D * 2; S.nt0 = NZA / 64; S.nt1 = NCV / 64;
        pg8::EpiMerge E{MG, SGA, SGC, D};
        pg8::gemm_stream<pg8::EpiMerge, pg8::SegOrder2, true>(lds, D, S, E);
        if (BOTH(5)) GRID_BAR();
    }
    PHSTAMP(6);
    if (IN(6)) {
        pg8::SegOrder1 S; S.so.init(M, D, G, bx, NREP(6)); S.A = (const char*)MG; S.B = (const char*)WoT; S.tstep = (size_t)256 * D * 2; S.nt = D / 64;
        pg8::EpiBf16 E{Yb, D};
        pg8::gemm_stream<pg8::EpiBf16, pg8::SegOrder1>(lds, D, S, E);
#ifdef PROBE_ARRIVE
        if (tid == 0) { ((unsigned long long*)(ws + WS_MOD + 131072))[bx] = __builtin_amdgcn_s_memrealtime(); }
#endif
        if (BOTH(6)) GRID_BAR();
    }
    PHSTAMP(7);
    if (IN(7)) {
        f32x4 gv[4][2];
#pragma unroll
        for (int j = 0; j < 4; ++j)
#pragma unroll
            for (int h = 0; h < 2; ++h) { const int k = 512 * j + 8 * lane + 4 * h; gv[j][h] = *(const f32x4*)(mod + 2 * D + k) * *(const f32x4*)(args.g_post + k); }
        for (int m = gw; m < M; m += NGW) {
            const bf16_t* yr = Yb + (size_t)m * D + 8 * lane; const float* xr = args.x + (size_t)m * D + 8 * lane; float* orow = args.out + (size_t)m * D + 8 * lane;
            f32x4 v[4][2]; float ss = 0.f;
#pragma unroll
            for (int j = 0; j < 4; ++j) { pg8::unpack8(*(const u32x4*)(yr + 512 * j), v[j][0], v[j][1]);
#pragma unroll
                for (int h = 0; h < 2; ++h) { const f32x4 q = v[j][h] * v[j][h]; ss += (q[0] + q[1]) + (q[2] + q[3]); } }
            const float rstd = 1.0f / sqrtf(wave_sum(ss) * (1.0f / D) + EPS);
#pragma unroll
            for (int j = 0; j < 4; ++j)
#pragma unroll
                for (int h = 0; h < 2; ++h) { const f32x4 xv = *(const f32x4*)(xr + 512 * j + 4 * h); *(f32x4*)(orow + 512 * j + 4 * h) = xv + gv[j][h] * (v[j][h] * rstd); }
        }
    }
    PHSTAMP(8);
#ifdef PROBE_PH
    if (bx == 0 && tid == 0) {
        asm volatile("s_waitcnt vmcnt(0)" ::: "memory");
        unsigned long long* st = (unsigned long long*)(ws + WS_MOD + 65536) + 16;
        const int ia = (PROBE_PH) & 15, ib = ((PROBE_PH) >> 4) & 15;
        const unsigned long long ta = __hip_atomic_load(st + ia + 1, __ATOMIC_RELAXED, __HIP_MEMORY_SCOPE_AGENT) - __hip_atomic_load(st + ia, __ATOMIC_RELAXED, __HIP_MEMORY_SCOPE_AGENT);
        const unsigned long long tb = __hip_atomic_load(st + ib + 1, __ATOMIC_RELAXED, __HIP_MEMORY_SCOPE_AGENT) - __hip_atomic_load(st + ib, __ATOMIC_RELAXED, __HIP_MEMORY_SCOPE_AGENT);
        const unsigned long long ticks = 4ull * (ta > 99900ull ? 99900ull : ta) + 400000ull * (tb / 400ull);
        const unsigned long long t0 = __builtin_amdgcn_s_memrealtime();
        while (__builtin_amdgcn_s_memrealtime() - t0 < ticks) __builtin_amdgcn_s_sleep(32);
    }
#endif
#ifdef PROBE_ARRIVE
    if (bx == 0 && tid == 0) {
        unsigned long long* aw = (unsigned long long*)(ws + WS_MOD + 131072);
        unsigned long long tmax = 0, tmin = ~0ull; int imax = 0;
        for (int i = 0; i < G; ++i) { const unsigned long long t = __hip_atomic_load(aw + i, __ATOMIC_RELAXED, __HIP_MEMORY_SCOPE_AGENT); if (t > tmax) { tmax = t; imax = i; } if (t < tmin) tmin = t; }
        const unsigned long long t0a = __hip_atomic_load(aw, __ATOMIC_RELAXED, __HIP_MEMORY_SCOPE_AGENT);
        const unsigned long long tafter = __hip_atomic_load((unsigned long long*)(ws + WS_MOD + 65536) + 16 + 8, __ATOMIC_RELAXED, __HIP_MEMORY_SCOPE_AGENT);
        long long val[4];
        val[0] = (long long)(tmax - tmin) / 200;
        val[1] = (long long)(tafter - tmax) / 100;
        val[2] = (long long)(tmax - t0a) / 200;
        val[3] = imax / 4;
        long long a = val[PROBE_ARRIVE & 3], b = val[(PROBE_ARRIVE >> 2) & 3];
        a = a < 0 ? 0 : (a > 89 ? 89 : a); b = b < 0 ? 0 : (b > 99 ? 99 : b);
        const unsigned long long ticks = (unsigned long long)(10 * a + 1000 * b) * 100ull;
        const unsigned long long t0 = __builtin_amdgcn_s_memrealtime();
        while (__builtin_amdgcn_s_memrealtime() - t0 < ticks) __builtin_amdgcn_s_sleep(32);
    }
#endif
#undef IN
#undef BOTH
#undef GRID_BAR
}

extern "C" void kernel_launch(void* const* d_in, const int* in_sizes, int n_in, void* d_out, int out_size, void* d_ws, size_t ws_size, hipStream_t stream) {
    static int grid = 0;
    if (grid == 0) {
        if (n_in != 12 || in_sizes[0] != M * D || out_size != M * D || ws_size < WS_END) { fprintf(stderr, "kernel_launch: unexpected shapes (n_in %d, in0 %d, out %d, ws %zu); nothing launched\n", n_in, n_in > 0 ? in_sizes[0] : -1, out_size, ws_size); grid = -1; return; }
        int dev = 0, cus = 0;
        if (hipGetDevice(&dev) != hipSuccess || hipDeviceGetAttribute(&cus, hipDeviceAttributeMultiprocessorCount, dev) != hipSuccess) { grid = -1; return; }
        if (hipFuncSetAttribute((const void*)mk_fwd, hipFuncAttributeMaxDynamicSharedMemorySize, LDS_BYTES) != hipSuccess) { fprintf(stderr, "kernel_launch: hipFuncSetAttribute failed\n"); grid = -1; return; }
        (void)hipGetLastError();
        grid = cus;
    }
    if (grid < 0) return;
    if (hipMemsetAsync((char*)d_ws + WS_CTL, 0, CTL_ZERO_BYTES, stream) != hipSuccess) return;
    Args a{};
    a.x = (const float*)d_in[0]; a.c = (const float*)d_in[1]; a.pos = (const int*)d_in[2]; a.g_pre = (const float*)d_in[3]; a.w_ada = (const float*)d_in[4]; a.b_ada = (const float*)d_in[5];
    a.w_in = (const float*)d_in[6]; a.conv_w = (const float*)d_in[7]; a.w_attn_o = (const float*)d_in[8]; a.w_conv_o = (const float*)d_in[9]; a.w_o = (const float*)d_in[10]; a.g_post = (const float*)d_in[11];
    a.out = (float*)d_out; a.ws = (unsigned char*)d_ws;
    for (int li = 0; li < N_LAUNCHES; ++li) {
        a.ph_lo = (N_LAUNCHES == 1) ? 0 : li; a.ph_hi = (N_LAUNCHES == 1) ? NPHASES : li + 1; a.li = li;
        hipLaunchKernelGGL(mk_fwd, dim3(grid), dim3(NWAVES * 64), LDS_BYTES, stream, a);
        if (hipPeekAtLastError() != hipSuccess) break;
    }
}
```

```cpp
#include <hip/hip_runtime.h>
#include <cstdio>
#include <cstdint>

#define GAS __attribute__((address_space(1)))
#define LAS __attribute__((address_space(3)))
typedef unsigned short bf16_t;
typedef short bf16x8 __attribute__((ext_vector_type(8)));
typedef short s16x4 __attribute__((ext_vector_type(4)));
typedef float f32x4 __attribute__((ext_vector_type(4)));
typedef float f32x2 __attribute__((ext_vector_type(2)));
typedef unsigned u32x4 __attribute__((ext_vector_type(4)));
typedef unsigned u32x2 __attribute__((ext_vector_type(2)));

constexpr int M = 16384, D = 2048, NQKV = 3072, NZA = 1024, NCV = 2048, PROJ = 22528, NMOD = 6144;
constexpr float EPS = 1e-6f;
constexpr float LOG2E = 1.4426950408889634f;
constexpr float QSCALE = 0.08838834764831845f * 1.4426950408889634f;

__constant__ float INVF[16] = {1.0f, 0.44036659598350525f, 0.1939227432012558f, 0.08539710193872452f, 0.03760603070259094f, 0.016560440883040428f,
    0.007292664609849453f, 0.0032114461064338684f, 0.0014142135623842478f, 0.0006227724370546639f, 0.00027424818836152554f, 0.00012076973507646471f,
    5.3182957344688475e-05f, 2.34199997066753e-05f, 1.0313385246263351e-05f, 4.541670477919979e-06f};

typedef __bf16 bf16x2_t __attribute__((ext_vector_type(2)));
__device__ __forceinline__ unsigned cvt_pk_bf16(float lo, float hi) { const f32x2 v = {lo, hi}; return __builtin_bit_cast(unsigned, __builtin_convertvector(v, bf16x2_t)); }
__device__ __forceinline__ float bf_lo(unsigned w) { return __builtin_bit_cast(float, w << 16); }
__device__ __forceinline__ float bf_hi(unsigned w) { return __builtin_bit_cast(float, w & 0xffff0000u); }
__device__ __forceinline__ float silu_f(float v) { return v * __builtin_amdgcn_rcpf(1.0f + __builtin_amdgcn_exp2f(-v * LOG2E)); }
__device__ __forceinline__ float sigm_f(float v) { return __builtin_amdgcn_rcpf(1.0f + __builtin_amdgcn_exp2f(-v * LOG2E)); }

namespace pg8 {
constexpr int BM = 256, BK = 64, HALF = 128, HTB = HALF * BK * 2, STAGE_BYTES = 8 * HTB, NXCD = 8, WGM = 8;
__host__ __device__ __forceinline__ int lds_byte(int r, int c) { const int st = (r >> 4) * 2 + (c >> 5), rr = r & 15, cc = c & 31, ob = rr * 64 + cc * 2; return st * 1024 + (ob ^ (((ob >> 9) & 1) << 5)); }
__host__ __device__ __forceinline__ void stage_rc(int b, int& R, int& C) { const int st = b / 1024, sb = b % 1024, swz = sb ^ (((sb >> 9) & 1) << 5); R = (st >> 1) * 16 + swz / 64; C = (st & 1) * 32 + (swz % 64) / 2; }
__host__ __device__ __forceinline__ int perm32(int rho) { const int n = rho >> 4, i = rho & 15; return 8 * (i >> 2) + 4 * n + (i & 3); }

struct Unit { int pm, pn; };
struct Gemm { const bf16_t* A; const bf16_t* Bt; int M, N, K; };

struct StaticOrder {
    int nM, nN, nwg, G, c, rounds, rep;
    __host__ __device__ void init(int M_, int N_, int G_, int c_, int rep_ = 1) { nM = M_ / BM; nN = N_ / BM; nwg = nM * nN; G = G_; c = c_; rounds = (nwg + G - 1) / G; rep = rep_; }
    __host__ __device__ bool next(int i, Unit& u) const {
        if (i >= rounds * rep) return false;
        i = i % rounds;
        const long L = (long)i * G + c; if (L >= nwg) return false;
        int wgid = (int)L; { const int q = nwg / NXCD, r = nwg % NXCD, xcd = wgid % NXCD, off = wgid / NXCD; wgid = (xcd < r ? xcd * (q + 1) : r * (q + 1) + (xcd - r) * q) + off; }
        const int nig = WGM * nN, gid = wgid / nig, fm = gid * WGM, gsz = (nM - fm) < WGM ? (nM - fm) : WGM;
        u.pm = fm + ((wgid % nig) % gsz); u.pn = (wgid % nig) / gsz; return true;
    }
    __device__ __forceinline__ void a_ready(const Unit&) const {}
    __device__ __forceinline__ void done(const Unit&) const {}
};


struct Seg { const char* A; const char* B; int nt; int mid; Unit u; };
__device__ __forceinline__ const char* rfl_ptr(const char* p) { const unsigned long long v = (unsigned long long)p; const unsigned lo = __builtin_amdgcn_readfirstlane((unsigned)v), hi = __builtin_amdgcn_readfirstlane((unsigned)(v >> 32)); return (const char*)(((unsigned long long)hi << 32) | lo); }
__device__ __forceinline__ void rfl_seg(Seg& o) { o.A = rfl_ptr(o.A); o.B = rfl_ptr(o.B); o.nt = __builtin_amdgcn_readfirstlane(o.nt); o.mid = __builtin_amdgcn_readfirstlane(o.mid); o.u.pm = __builtin_amdgcn_readfirstlane(o.u.pm); o.u.pn = __builtin_amdgcn_readfirstlane(o.u.pn); }
constexpr int NSTORE = 16;
template <class Epi, class Sched, bool DUAL = false>
__device__ __forceinline__ void gemm_stream(LAS unsigned char* lds, const int pitch, const Sched& S, const Epi& E) {
    const int tid = threadIdx.x, wid = __builtin_amdgcn_readfirstlane(tid >> 6), lane = tid & 63, wr = wid >> 2, wc = wid & 3, fr = lane & 15, fq = lane >> 4;
    unsigned voffA[2], voffB[2];
#pragma unroll
    for (int i = 0; i < 2; ++i) { int R, C; stage_rc(tid * 16 + i * 8192, R, C); const int Rb = Epi::PERM ? ((R & ~31) + perm32(R & 31)) : R;
        voffA[i] = (unsigned)(R * pitch + C) * 2u; voffB[i] = (unsigned)(Rb * pitch + C) * 2u; }
    const size_t kstep = (size_t)(BK * 2);
    const size_t hstep = (size_t)HALF * pitch * 2;
    const unsigned ldsw = (unsigned)wid * 1024u;
    const int aoff = lds_byte(wr * 64 + fr, fq * 8), boff = lds_byte(wc * 32 + fr, fq * 8);
#define PG8_SA(b, h) (((b) * 2 + (h)) * HTB)
#define PG8_SB(b, h) ((4 + (b) * 2 + (h)) * HTB)
#define PG8_STAGE(bufoff, gbase, voff) do { const char* _gb = (const char*)(gbase); asm volatile("" : "+s"(_gb));   \
        _Pragma("unroll") for (int _i = 0; _i < 2; ++_i) \
        __builtin_amdgcn_global_load_lds((const unsigned*)(_gb + (voff)[_i]), (LAS unsigned*)(lds + (bufoff) + ldsw + _i * 8192), 16, 0, 0); } while (0)
#define PG8_LDA(dst, b, h) do { _Pragma("unroll") for (int m = 0; m < 4; ++m) _Pragma("unroll") for (int k = 0; k < 2; ++k) dst[m][k] = *(const LAS bf16x8*)(lds + PG8_SA(b, h) + aoff + m * 2048 + k * 1024); } while (0)
#define PG8_LDB(dst, b, h) do { _Pragma("unroll") for (int n = 0; n < 2; ++n) _Pragma("unroll") for (int k = 0; k < 2; ++k) dst[n][k] = *(const LAS bf16x8*)(lds + PG8_SB(b, h) + boff + n * 2048 + k * 1024); } while (0)
#define PG8_MMA(ai, bj, At, Bt) do { __builtin_amdgcn_s_setprio(1); _Pragma("unroll") for (int m = 0; m < 4; ++m) _Pragma("unroll") for (int n = 0; n < 2; ++n) _Pragma("unroll") for (int k = 0; k < 2; ++k) \
        acc[ai][bj][m][n] = __builtin_amdgcn_mfma_f32_16x16x32_bf16(Bt[n][k], At[m][k], acc[ai][bj][m][n], 0, 0, 0); __builtin_amdgcn_s_setprio(0); } while (0)
#define PG8_WAIT_V(n) asm volatile("s_waitcnt vmcnt(" #n ")" ::: "memory")
#define PG8_WAIT_VR() PG8_WAIT_V(8)
#define PG8_WAIT_L(n) asm volatile("s_waitcnt lgkmcnt(" #n ")" ::: "memory")
#define PG8_BAR __builtin_amdgcn_s_barrier()
#define PG8_SCHED __builtin_amdgcn_sched_barrier(0)
    Seg cur, nxt; int si = 0;
    if (!S.seg(0, cur)) return;
    f32x4 acc[2][2][4][2];
#pragma unroll
    for (int a = 0; a < 2; ++a)
#pragma unroll
        for (int b = 0; b < 2; ++b)
#pragma unroll
            for (int m = 0; m < 4; ++m)
#pragma unroll
                for (int n = 0; n < 2; ++n) acc[a][b][m][n] = (f32x4){0.f, 0.f, 0.f, 0.f};
    bf16x8 At[4][2], B0[2][2], B1[2][2];
    {
        const char* cA = cur.A; const char* cB = cur.B;
        PG8_STAGE(PG8_SB(0, 0), cB, voffB); PG8_STAGE(PG8_SB(0, 1), cB + hstep, voffB); PG8_STAGE(PG8_SA(0, 0), cA, voffA); PG8_STAGE(PG8_SA(0, 1), cA + hstep, voffA);
        if (wr == 1) PG8_BAR;
        PG8_WAIT_V(2); PG8_BAR;
        PG8_STAGE(PG8_SB(1, 0), cB + kstep, voffB); PG8_STAGE(PG8_SA(1, 0), cA + kstep, voffA); PG8_STAGE(PG8_SB(1, 1), cB + hstep + kstep, voffB);
        PG8_WAIT_V(6); PG8_BAR;
    }
    bool fresh = true, relax = false;
    for (;;) {
        const bool has_next = S.seg(si + 1, nxt);
        const char* cA = cur.A; const char* cB = cur.B; const int nt = cur.nt;
        const char* nA = has_next ? nxt.A : cA; const char* nB = has_next ? nxt.B : cB;
#pragma nounroll
        for (int t = 0; t < nt; t += 2) {
            const bool first = (t == 0) && !fresh;
            const bool last = (t == nt - 2);
            const char* a1 = cA + (size_t)(t + 1) * kstep;
            const char* a2 = last ? nA : cA + (size_t)(t + 2) * kstep; const char* b2 = last ? nB : cB + (size_t)(t + 2) * kstep;
            const char* a3 = a2 + kstep; const char* b3 = b2 + kstep;
            PG8_LDB(B0, 0, 0); PG8_LDB(B1, 0, 1); PG8_SCHED; PG8_LDA(At, 0, 0); if (!first) PG8_STAGE(PG8_SA(1, 1), a1 + hstep, voffA);
            PG8_WAIT_VR(); PG8_WAIT_L(0); PG8_BAR; PG8_MMA(0, 0, At, B0); PG8_MMA(0, 1, At, B1); PG8_BAR; PG8_SCHED;
            PG8_LDA(At, 0, 1); PG8_STAGE(PG8_SB(0, 0), b2, voffB); PG8_STAGE(PG8_SB(0, 1), b2 + hstep, voffB); PG8_STAGE(PG8_SA(0, 0), a2, voffA);
            PG8_WAIT_VR(); PG8_WAIT_L(0); PG8_BAR; PG8_MMA(1, 0, At, B0); PG8_MMA(1, 1, At, B1); PG8_BAR; PG8_SCHED;
            PG8_LDB(B0, 1, 0); PG8_LDB(B1, 1, 1); PG8_SCHED; PG8_LDA(At, 1, 0); PG8_STAGE(PG8_SA(0, 1), a2 + hstep, voffA);
            PG8_WAIT_VR(); PG8_WAIT_L(0); PG8_BAR; PG8_MMA(0, 0, At, B0); PG8_MMA(0, 1, At, B1); PG8_BAR; PG8_SCHED;
            PG8_LDA(At, 1, 1); PG8_STAGE(PG8_SB(1, 0), b3, voffB); PG8_STAGE(PG8_SB(1, 1), b3 + hstep, voffB); PG8_STAGE(PG8_SA(1, 0), a3, voffA);
            PG8_WAIT_V(8); PG8_WAIT_L(0); PG8_BAR; PG8_MMA(1, 0, At, B0); PG8_MMA(1, 1, At, B1); PG8_BAR; PG8_SCHED;
        }
        if (wr == 0) PG8_BAR;
        PG8_STAGE(PG8_SA(1, 1), nA + kstep + hstep, voffA);
        PG8_SCHED;
        if constexpr (DUAL) E.scale(acc, cur.u, wr, wc, fr, fq, cur.mid != 0);
        if (DUAL && cur.mid) { relax = false; }
        else {
            E(acc, cur.u, wr, wc, fr, fq); relax = true;
#pragma unroll
            for (int a = 0; a < 2; ++a)
#pragma unroll
                for (int b = 0; b < 2; ++b)
#pragma unroll
                    for (int m = 0; m < 4; ++m)
#pragma unroll
                        for (int n = 0; n < 2; ++n) acc[a][b][m][n] = (f32x4){0.f, 0.f, 0.f, 0.f};
        }
        PG8_SCHED;
        if (!has_next) break;
        cur = nxt; ++si; fresh = false;
        if (wr == 1) PG8_BAR;
    }
    PG8_WAIT_V(0);
    PG8_BAR;
#undef PG8_SA
#undef PG8_SB
#undef PG8_STAGE
#undef PG8_LDA
#undef PG8_LDB
#undef PG8_MMA
#undef PG8_WAIT_V
#undef PG8_WAIT_VR
#undef PG8_WAIT_L
#undef PG8_BAR
#undef PG8_SCHED
}
struct SegOrder1 {
    StaticOrder so; const char* A; const char* B; size_t tstep; int nt;
    __device__ __forceinline__ bool seg(int s, Seg& o) const { Unit u; if (!so.next(s, u)) return false; o.A = A + (size_t)u.pm * tstep; o.B = B + (size_t)u.pn * tstep; o.nt = nt; o.mid = 0; o.u = u; rfl_seg(o); return true; }
};

__device__ __forceinline__ u32x4 pack8(const f32x4 v0, const f32x4 v1) { u32x4 w; w.x = cvt_pk_bf16(v0[0], v0[1]); w.y = cvt_pk_bf16(v0[2], v0[3]); w.z = cvt_pk_bf16(v1[0], v1[1]); w.w = cvt_pk_bf16(v1[2], v1[3]); return w; }
__device__ __forceinline__ void unpack8(const u32x4 w, f32x4& v0, f32x4& v1) { v0 = (f32x4){bf_lo(w.x), bf_hi(w.x), bf_lo(w.y), bf_hi(w.y)}; v1 = (f32x4){bf_lo(w.z), bf_hi(w.z), bf_lo(w.w), bf_hi(w.w)}; }

#ifdef NT_STORES
#define ST16(p, v) __builtin_nontemporal_store((v), (u32x4*)(p))
#define ST8(p, v) __builtin_nontemporal_store((v), (u32x2*)(p))
#else
#define ST16(p, v) (*(u32x4*)(p) = (v))
#define ST8(p, v) (*(u32x2*)(p) = (v))
#endif
struct EpiProj {
    static constexpr bool PERM = true;
    __device__ __forceinline__ void mid(f32x4 (&)[2][2][4][2], const Unit&, int, int, int, int) const {}
    bf16_t *Q, *Kb, *V, *SZ, *P, *QC, *SGA, *SGC; const float* cs;
    __device__ __forceinline__ void operator()(const f32x4 (&acc)[2][2][4][2], const Unit& u, int wr, int wc, int fr, int fq) const {
        const int pn = u.pn; const int row0 = u.pm * BM + wr * 64 + fr; const int lc = wc * 32 + 8 * fq;
        if (pn < 24) {
            const bool isq = pn < 12; const int tq = isq ? pn : pn - 12; bf16_t* base = (isq ? Q : Kb) + (size_t)(tq >> 2) * M * 1024; const int colt = (tq & 3) * BM; const float sc = isq ? QSCALE : 1.0f;
            const bool rot = (fq == 0);
            f32x4 cv[2][4], sv[2][4];
#pragma unroll
            for (int ai = 0; ai < 2; ++ai)
#pragma unroll
                for (int m = 0; m < 4; ++m) { const float* cr = cs + (size_t)(row0 + ai * HALF + m * 16) * 32 + 4 * wc; cv[ai][m] = *(const f32x4*)cr; sv[ai][m] = *(const f32x4*)(cr + 16); }
#pragma unroll
            for (int ai = 0; ai < 2; ++ai)
#pragma unroll
                for (int m = 0; m < 4; ++m) {
                    const f32x4 c = rot ? cv[ai][m] * sc : (f32x4){sc, sc, sc, sc}, sn = rot ? sv[ai][m] * sc : (f32x4){0.f, 0.f, 0.f, 0.f};
                    bf16_t* rowp = base + (size_t)(row0 + ai * HALF + m * 16) * 1024 + colt + lc;
#pragma unroll
                    for (int bj = 0; bj < 2; ++bj) { const f32x4 v0 = acc[ai][bj][m][0], v1 = acc[ai][bj][m][1];
                        ST16((rowp + bj * HALF), (pack8(v0 * c - v1 * sn, v0 * sn + v1 * c))); }
                }
        } else if (pn < 36) {
            const int tv = pn - 24, colt = (tv & 3) * BM; bf16_t* vbase = V + (size_t)(tv >> 2) * M * 1024;
#pragma unroll
            for (int ai = 0; ai < 2; ++ai)
#pragma unroll
                for (int m = 0; m < 4; ++m) { bf16_t* rowp = vbase + (size_t)(row0 + ai * HALF + m * 16) * 1024 + colt + lc;
#pragma unroll
                    for (int bj = 0; bj < 2; ++bj) ST16((rowp + bj * HALF), (pack8(acc[ai][bj][m][0], acc[ai][bj][m][1]))); }
        } else if (pn < 40) {
            const int colt = (pn - 36) * BM;
#pragma unroll
            for (int ai = 0; ai < 2; ++ai)
#pragma unroll
                for (int m = 0; m < 4; ++m) { bf16_t* rowp = SZ + (size_t)(row0 + ai * HALF + m * 16) * NZA + colt + lc;
#pragma unroll
                    for (int bj = 0; bj < 2; ++bj) { f32x4 a = acc[ai][bj][m][0], b = acc[ai][bj][m][1];
#pragma unroll
                        for (int j = 0; j < 4; ++j) { a[j] = silu_f(a[j]); b[j] = silu_f(b[j]); }
                        ST16((rowp + bj * HALF), (pack8(a, b))); } }
        } else if (pn < 72) {
            const int chb = 64 * (pn - 40) + 16 * wc + 4 * fq;
#pragma unroll
            for (int ai = 0; ai < 2; ++ai)
#pragma unroll
                for (int m = 0; m < 4; ++m) { const size_t ro = (size_t)(row0 + ai * HALF + m * 16) * NCV + chb;
                    const f32x4 cb = acc[ai][0][m][0], cc = acc[ai][0][m][1], cx = acc[ai][1][m][0], z = acc[ai][1][m][1];
                    f32x4 pv = cc * cx, qv;
#pragma unroll
                    for (int j = 0; j < 4; ++j) qv[j] = cb[j] * silu_f(z[j]);
                    u32x2 pw, qw; pw.x = cvt_pk_bf16(pv[0], pv[1]); pw.y = cvt_pk_bf16(pv[2], pv[3]); qw.x = cvt_pk_bf16(qv[0], qv[1]); qw.y = cvt_pk_bf16(qv[2], qv[3]);
                    ST8((P + ro), (pw)); ST8((QC + ro), (qw)); }
        } else {
            const int colt = (pn - 72) * HALF;
#pragma unroll
            for (int ai = 0; ai < 2; ++ai)
#pragma unroll
                for (int m = 0; m < 4; ++m) { const size_t ro = (size_t)(row0 + ai * HALF + m * 16) * D + colt + lc;
                    f32x4 r[2], c[2];
#pragma unroll
                    for (int n = 0; n < 2; ++n)
#pragma unroll
                        for (int j = 0; j < 4; ++j) { const float ec = __builtin_amdgcn_exp2f(-acc[ai][1][m][n][j] * LOG2E); c[n][j] = __builtin_amdgcn_rcpf(1.0f + ec); r[n][j] = sigm_f(acc[ai][0][m][n][j]) * (1.0f + ec); }
                    ST16((SGA + ro), (pack8(r[0], r[1]))); ST16((SGC + ro), (pack8(c[0], c[1]))); }
        }
    }
};
struct EpiMerge {
    static constexpr bool PERM = true;
    bf16_t* O; const bf16_t* RHO; const bf16_t* SC; int ldc;
    __device__ __forceinline__ size_t lane_off(const Unit& u, int wr, int wc, int fr, int fq, int ai) const {
        size_t o = (size_t)(u.pm * BM + wr * 64 + fr + ai * HALF) * ldc + u.pn * BM + wc * 32 + 8 * fq; asm volatile("" : "+v"(o)); return o; }
    __device__ __forceinline__ void scale(f32x4 (&acc)[2][2][4][2], const Unit& u, int wr, int wc, int fr, int fq, bool is_mid) const {
        const bf16_t* G = is_mid ? RHO : SC;
#pragma unroll
        for (int ai = 0; ai < 2; ++ai) {
            const bf16_t* p = G + lane_off(u, wr, wc, fr, fq, ai);
            u32x4 gw[4][2];
#pragma unroll
            for (int m = 0; m < 4; ++m)
#pragma unroll
                for (int bj = 0; bj < 2; ++bj) gw[m][bj] = *(const u32x4*)(p + (size_t)m * 16 * ldc + bj * HALF);
#pragma unroll
            for (int m = 0; m < 4; ++m)
#pragma unroll
                for (int bj = 0; bj < 2; ++bj) { f32x4 g0, g1; unpack8(gw[m][bj], g0, g1); acc[ai][bj][m][0] *= g0; acc[ai][bj][m][1] *= g1; }
        }
    }
    __device__ __forceinline__ void mid(f32x4 (&)[2][2][4][2], const Unit&, int, int, int, int) const {}
    __device__ __forceinline__ void operator()(const f32x4 (&acc)[2][2][4][2], const Unit& u, int wr, int wc, int fr, int fq) const {
#pragma unroll
        for (int ai = 0; ai < 2; ++ai) {
            bf16_t* q = O + lane_off(u, wr, wc, fr, fq, ai);
#pragma unroll
            for (int m = 0; m < 4; ++m)
#pragma unroll
                for (int bj = 0; bj < 2; ++bj) *(u32x4*)(q + (size_t)m * 16 * ldc + bj * HALF) = pack8(acc[ai][bj][m][0], acc[ai][bj][m][1]);
        }
    }
};
struct EpiBf16 {
    static constexpr bool PERM = true;
    __device__ __forceinline__ void mid(f32x4 (&)[2][2][4][2], const Unit&, int, int, int, int) const {}
    bf16_t* O; int ldc;
    __device__ __forceinline__ void operator()(const f32x4 (&acc)[2][2][4][2], const Unit& u, int wr, int wc, int fr, int fq) const {
        const int row0 = u.pm * BM + wr * 64 + fr, col0 = u.pn * BM + wc * 32 + 8 * fq;
#pragma unroll
        for (int ai = 0; ai < 2; ++ai)
#pragma unroll
            for (int m = 0; m < 4; ++m) { bf16_t* rowp = O + (size_t)(row0 + ai * HALF + m * 16) * ldc + col0;
#pragma unroll
                for (int bj = 0; bj < 2; ++bj) *(u32x4*)(rowp + bj * HALF) = pack8(acc[ai][bj][m][0], acc[ai][bj][m][1]); }
    }
};
struct SegOrder2 {
    StaticOrder so; const char *A0, *B0, *A1, *B1; size_t tstep; int nt0, nt1;
    __device__ __forceinline__ bool seg(int s_, Seg& o) const { Unit u; if (!so.next(s_ >> 1, u)) return false; const int h = s_ & 1;
        o.A = (h ? A1 : A0) + (size_t)u.pm * tstep; o.B = (h ? B1 : B0) + (size_t)u.pn * tstep; o.nt = h ? nt1 : nt0; o.mid = !h; o.u = u; rfl_seg(o); return true; }
};
}

#ifndef PG8_SP2
#define PG8_SP2 true
#endif
#ifndef PG8_ALIGN
#define PG8_ALIGN true
#endif

constexpr int NWAVES = 8;
#ifndef MK_N_LAUNCHES
#define MK_N_LAUNCHES 1
#endif
constexpr int NPHASES = 8;
constexpr int N_LAUNCHES = MK_N_LAUNCHES;

constexpr size_t MiB = 1u << 20;
constexpr size_t WS_CTL = 0, CTL_ZERO_BYTES = 1 * MiB;
constexpr size_t WS_MOD = 1 * MiB;
constexpr size_t WS_CS = 2 * MiB;
constexpr size_t WS_WIN = 4 * MiB;
constexpr size_t WS_WA = 92 * MiB, WS_WC = 100 * MiB, WS_WO = 108 * MiB;
constexpr size_t WS_H = 116 * MiB;
constexpr size_t WS_Q = 180 * MiB, WS_K = 276 * MiB, WS_V = 372 * MiB;
constexpr size_t WS_SZ = 468 * MiB;
constexpr size_t WS_P = 500 * MiB, WS_QC = 564 * MiB;
constexpr size_t WS_O2 = 628 * MiB;
constexpr size_t WS_LSE = 660 * MiB;
constexpr size_t WS_END = 662 * MiB;
constexpr size_t WS_O1 = 148 * MiB;
constexpr size_t WS_R = WS_Q + 32 * MiB, WS_AATT = WS_K + 32 * MiB, WS_MG = WS_V + 32 * MiB, WS_Y = WS_R;
constexpr int CW_BAR = 4096;
#define XCD_BAR_WORDS 3456

constexpr int RING_BYTES = 131072;
constexpr int LDSCTL_OFF = RING_BYTES, MISC_OFF = LDSCTL_OFF + 320;
constexpr int LDS_BYTES = 147456;

typedef GAS unsigned gu32;
#define RLX_AGENT __ATOMIC_RELAXED, __HIP_MEMORY_SCOPE_AGENT

#define XB_TMO      128
#define XB_XCNT(j)  (256  + 64 * (j))
#define XB_XSUB(j)  (1280 + 64 * (j))
#define XB_XGEN(j)  (2304 + 64 * (j))
#define XB_TOP      3328
#define XB_TOPGEN   3392
#define XB_SPIN_CAP (1u << 18)

__device__ __forceinline__ unsigned xb_ld(unsigned* p)              { return __hip_atomic_load(p, __ATOMIC_RELAXED, __HIP_MEMORY_SCOPE_AGENT); }
__device__ __forceinline__ unsigned xb_add(unsigned* p, unsigned v) { return __hip_atomic_fetch_add(p, v, __ATOMIC_RELAXED, __HIP_MEMORY_SCOPE_AGENT); }
__device__ __forceinline__ unsigned xb_xcc_id() { return (unsigned)__builtin_amdgcn_s_getreg((3 << 11) | 20) & 0xFu; }
#define XB_SPIN(cond, bar) do { unsigned _sp = 0; while (cond) { __builtin_amdgcn_s_sleep(1); \
    if ((++_sp & 255u) == 0u) { if (xb_ld(&(bar)[XB_TMO])) break; if (_sp > XB_SPIN_CAP) { atomicAdd(&(bar)[XB_TMO], 1u); break; } } } } while (0)

struct XcdBarrier { unsigned* bar; unsigned x; volatile LAS unsigned* st; };

__device__ __forceinline__ XcdBarrier xcd_barrier_post(unsigned* bar, volatile LAS unsigned* st) {
    XcdBarrier b; b.bar = bar; b.x = xb_xcc_id(); b.st = st;
    if (threadIdx.x == 0) (void)xb_add(&bar[XB_XCNT(b.x)], 1u);
    return b;
}
__device__ __forceinline__ void xcd_barrier_complete(unsigned* bar, unsigned x, unsigned& nloc, unsigned& nx) {
    const unsigned G = gridDim.x * gridDim.y * gridDim.z;
    unsigned sum, cnt, mine, sp = 0u;
    for (;;) {
        sum = 0u; cnt = 0u; mine = 0u;
#pragma unroll
        for (unsigned j = 0; j < 16; ++j) { const unsigned c = xb_ld(&bar[XB_XCNT(j)]); sum += c; cnt += (c > 0u) ? 1u : 0u; mine = (j == x) ? c : mine; }
        if (sum == G) break;
        __builtin_amdgcn_s_sleep(1);
        if ((++sp & 255u) == 0u) { if (xb_ld(&bar[XB_TMO])) break; if (sp > XB_SPIN_CAP) { atomicAdd(&bar[XB_TMO], 1u); break; } }
    }
    nloc = mine > 0u ? mine : 1u; nx = cnt > 0u ? cnt : 1u;
}
__device__ __forceinline__ void xcd_barrier(const XcdBarrier& b) {
    asm volatile("s_waitcnt vmcnt(0)" ::: "memory");
    __syncthreads();
    if (threadIdx.x == 0) {
        unsigned* bar = b.bar;
        __builtin_amdgcn_s_waitcnt(0);
        unsigned nloc = b.st[0], nx = b.st[1];
        if (nloc == 0u) { xcd_barrier_complete(bar, b.x, nloc, nx); b.st[0] = nloc; b.st[1] = nx; }
        const unsigned old = xb_add(&bar[XB_XSUB(b.x)], 1u);
        const unsigned gen = old / nloc;
        if (old + 1u == (gen + 1u) * nloc) {
            __builtin_amdgcn_fence(__ATOMIC_RELEASE, "agent");
            asm volatile("s_waitcnt vmcnt(0)" ::: "memory");
            const unsigned og = xb_add(&bar[XB_TOP], 1u);
            const unsigned tg = og / nx;
            if (og + 1u == (tg + 1u) * nx) xb_add(&bar[XB_TOPGEN], 1u);
            else XB_SPIN(xb_ld(&bar[XB_TOPGEN]) == tg, bar);
            __builtin_amdgcn_fence(__ATOMIC_ACQUIRE, "agent");
            xb_add(&bar[XB_XGEN(b.x)], 1u);
            asm volatile("s_waitcnt vmcnt(0)" ::: "memory");
        } else {
            XB_SPIN(xb_ld(&bar[XB_XGEN(b.x)]) == gen, bar);
            __builtin_amdgcn_fence(__ATOMIC_ACQUIRE, "agent");
            asm volatile("s_waitcnt vmcnt(0)" ::: "memory");
        }
    }
    __syncthreads();
}

#define LDS_WAIT() asm volatile("s_waitcnt lgkmcnt(0)" ::: "memory")
__device__ __forceinline__ float wave_sum(float v) {
#pragma unroll
    for (int o = 1; o < 64; o <<= 1) v += __shfl_xor(v, o);
    return v;
}
__device__ __forceinline__ unsigned f2bf(float f) { unsigned u = __builtin_bit_cast(unsigned, f); return (u + 0x7fffu + ((u >> 16) & 1u)) >> 16; }
__device__ __forceinline__ unsigned pk2(float lo, float hi) { return f2bf(lo) | (f2bf(hi) << 16); }

__device__ __forceinline__ int proj_orig_col(int n) {
    const int tile = n >> 8, c = n & 255;
    if (tile < 24) { const int c7 = n & 127, wc = c7 >> 5, fq = (c7 >> 3) & 3, nn = (c7 >> 2) & 1, j = c7 & 3;
        const int dim = (fq == 0) ? (4 * wc + j + 16 * nn) : (32 + wc * 24 + (fq - 1) * 8 + 4 * nn + j); return (n & ~127) + dim; }
    if (tile < 40) return n;
    if (tile < 72) { const int kind = 2 * (c >> 7) + ((c >> 2) & 1), chl = 16 * ((c >> 5) & 3) + 4 * ((c >> 3) & 3) + (c & 3); return 10240 + kind * 2048 + 64 * (tile - 40) + chl; }
    return 18432 + (c >> 7) * 2048 + 128 * (tile - 72) + (c & 127);
}
template <bool REMAP>
__device__ __forceinline__ void p0_transpose_item(const float* W, int K, int N, bf16_t* WT, int pitch, LAS float* scr, int item, int lane) {
    const int nblk = N / 32, kb = item / nblk, nb = item % nblk, k0 = 64 * kb, n0 = 32 * nb;
    const int ncol = REMAP ? proj_orig_col(n0 + (lane & 31)) : n0 + (lane & 31);
#pragma unroll 8
    for (int i = 0; i < 32; ++i) { const int kk = 2 * i + (lane >> 5); scr[kk * 33 + (lane & 31)] = W[(size_t)(k0 + kk) * N + ncol]; }
    LDS_WAIT(); asm volatile("" ::: "memory");
    const int c = lane & 7;
#pragma unroll
    for (int j = 0; j < 4; ++j) { const int n = (lane >> 3) + 8 * j; const LAS float* s = scr + (8 * c) * 33 + n;
        u32x4 o; o.x = pk2(s[0 * 33], s[1 * 33]); o.y = pk2(s[2 * 33], s[3 * 33]); o.z = pk2(s[4 * 33], s[5 * 33]); o.w = pk2(s[6 * 33], s[7 * 33]);
        *(u32x4*)(WT + (size_t)(n0 + n) * pitch + k0 + 8 * c) = o; }
    LDS_WAIT(); asm volatile("" ::: "memory");
}

__device__ __forceinline__ void sincos_f64(float ang, float& s, float& c) {
    const double x = (double)ang;
    const double n = __builtin_rint(x * 0.15915494309189535);
    double r = __builtin_fma(-n, 6.283185307179586, x); r = __builtin_fma(-n, 2.4492935982947064e-16, r);
    const double r2 = r * r;
    double ps = 1.0 / 51090942171709440000.0;
    ps = __builtin_fma(ps, r2, -1.0 / 121645100408832000.0);
    ps = __builtin_fma(ps, r2, 1.0 / 355687428096000.0);
    ps = __builtin_fma(ps, r2, -1.0 / 1307674368000.0);
    ps = __builtin_fma(ps, r2, 1.0 / 6227020800.0);
    ps = __builtin_fma(ps, r2, -1.0 / 39916800.0);
    ps = __builtin_fma(ps, r2, 1.0 / 362880.0);
    ps = __builtin_fma(ps, r2, -1.0 / 5040.0);
    ps = __builtin_fma(ps, r2, 1.0 / 120.0);
    ps = __builtin_fma(ps, r2, -1.0 / 6.0);
    ps = __builtin_fma(ps, r2, 1.0);
    double pc = -1.0 / 1124000727777607680000.0;
    pc = __builtin_fma(pc, r2, 1.0 / 2432902008176640000.0);
    pc = __builtin_fma(pc, r2, -1.0 / 6402373705728000.0);
    pc = __builtin_fma(pc, r2, 1.0 / 20922789888000.0);
    pc = __builtin_fma(pc, r2, -1.0 / 87178291200.0);
    pc = __builtin_fma(pc, r2, 1.0 / 479001600.0);
    pc = __builtin_fma(pc, r2, -1.0 / 3628800.0);
    pc = __builtin_fma(pc, r2, 1.0 / 40320.0);
    pc = __builtin_fma(pc, r2, -1.0 / 720.0);
    pc = __builtin_fma(pc, r2, 1.0 / 24.0);
    pc = __builtin_fma(pc, r2, -0.5);
    pc = __builtin_fma(pc, r2, 1.0);
    s = (float)(r * ps); c = (float)pc;
}

__device__ __forceinline__ unsigned attn_offk(unsigned slot, unsigned row, unsigned ch) { return slot * 32768u + 256u * row + 16u * (ch ^ (row & 15u)); }
__device__ __forceinline__ unsigned attn_offv(unsigned slot, unsigned lrow, unsigned ch) { return 65536u + slot * 32768u + 256u * lrow + 16u * (ch ^ (((lrow & 3u) << 2) | ((lrow >> 2) & 3u))); }
__device__ __forceinline__ unsigned attn_lrow(unsigned k) { return (k & ~31u) | (((k >> 2) & 3u) << 3) | (((k >> 4) & 1u) << 2) | (k & 3u); }

template <bool COMBINE>
__device__ __forceinline__ void attn_chunk(LAS unsigned char* lds, const bf16_t* Qg, const bf16_t* Kg, const bf16_t* Vg, const int dsh, const int hh, const int r, const int n0, const int nblk,
                                           bf16_t* Og, float* LSEg, const bf16_t* O1, const bf16_t* O2, const float* LSE1, const float* LSE2, const bf16_t* SZ, bf16_t* AATT) {
    const int tid = threadIdx.x, lane = tid & 63, wid = __builtin_amdgcn_readfirstlane(tid >> 6), fr = lane & 15, fq = lane >> 4;
    const int sch = tid & 15, srb = tid >> 4;
    const size_t scol = (size_t)hh * 256 + sch * 16;
    u32x4 kreg[4], vreg[4];
#define ATT_LOAD(blk) do { _Pragma("unroll") for (int i = 0; i < 4; ++i) { const size_t p = ((size_t)(128 * (blk) + srb + 32 * i) << dsh) + r; const size_t off = p * 2048 + scol; \
        kreg[i] = *(const u32x4*)((const char*)Kg + off); vreg[i] = *(const u32x4*)((const char*)Vg + off); } } while (0)
#define ATT_WRITE(slot) do { _Pragma("unroll") for (int i = 0; i < 4; ++i) { const unsigned row = srb + 32 * i; \
        *(LAS u32x4*)(lds + attn_offk((slot), row, sch)) = kreg[i]; *(LAS u32x4*)(lds + attn_offv((slot), attn_lrow(row), sch)) = vreg[i]; } } while (0)
    const unsigned q4 = (unsigned)(lane & 15) >> 2, p4 = (unsigned)lane & 3u, parA = (unsigned)wid & 1u, parB = parA ^ 1u;
    unsigned kbase[4], vbA[8], vbB[8];
#pragma unroll
    for (int s_ = 0; s_ < 4; ++s_) kbase[s_] = 256u * fr + 16u * ((unsigned)(4 * s_ + fq) ^ (unsigned)fr);
#pragma unroll
    for (int c = 0; c < 8; ++c) {
        vbA[c] = 65536u + 256u * (((unsigned)fq << 3) | (parA << 2) | q4) + 16u * ((unsigned)(2 * c + (p4 >> 1)) ^ ((q4 << 2) | (((unsigned)fq & 1u) << 1) | parA)) + 8u * (p4 & 1u);
        vbB[c] = 65536u + 256u * (((unsigned)fq << 3) | (parB << 2) | q4) + 16u * ((unsigned)(2 * c + (p4 >> 1)) ^ ((q4 << 2) | (((unsigned)fq & 1u) << 1) | parB)) + 8u * (p4 & 1u);
    }
    if (n0 > 0) { ATT_LOAD(n0 - 1); }
    else {
#pragma unroll
        for (int i = 0; i < 4; ++i) { kreg[i] = (u32x4){0u, 0u, 0u, 0u}; vreg[i] = (u32x4){0u, 0u, 0u, 0u}; } }
    ATT_WRITE((unsigned)((n0 + 1) & 1));
    ATT_LOAD(n0); ATT_WRITE((unsigned)(n0 & 1));
    __syncthreads();
    for (int n = n0; n < n0 + nblk; ++n) {
        const bool more = (n + 1 < n0 + nblk);
        if (more) ATT_LOAD(n + 1);
        const unsigned cs_ = (unsigned)(n & 1), ps_ = cs_ ^ 1u;
        const int lq = 128 * n + 16 * wid + fr; const size_t pq = ((size_t)lq << dsh) + r;
        bf16x8 qf[4];
        { const bf16x8* qp = (const bf16x8*)((const char*)Qg + pq * 2048 + (size_t)hh * 256 + fq * 16);
#pragma unroll
          for (int s = 0; s < 4; ++s) qf[s] = qp[4 * s]; }
        f32x4 S[9];
#pragma unroll
        for (int t = 0; t < 9; ++t) {
            S[t] = (f32x4){0.f, 0.f, 0.f, 0.f};
            const unsigned kr0 = 16 * wid + 16 * t, uo = ((kr0 < 128u) ? ps_ : cs_) * 32768u + 256u * (kr0 & 127u);
#pragma unroll
            for (int s = 0; s < 4; ++s) { const bf16x8 kf = *(const LAS bf16x8*)(lds + (kbase[s] + uo)); S[t] = __builtin_amdgcn_mfma_f32_16x16x32_bf16(kf, qf[s], S[t], 0, 0, 0); }
        }
        const float NEG = -1e30f;
#pragma unroll
        for (int j = 0; j < 4; ++j) { const int ko0 = 4 * fq + j; if (ko0 < fr) S[0][j] = NEG; if (ko0 > fr) S[8][j] = NEG; }
        if (n == 0) {
#pragma unroll
            for (int t = 0; t < 9; ++t)
#pragma unroll
                for (int j = 0; j < 4; ++j) { if (16 * wid + 16 * t + 4 * fq + j < 128) S[t][j] = NEG; }
        }
        float mx = NEG;
#pragma unroll
        for (int t = 0; t < 9; ++t) mx = fmaxf(mx, fmaxf(fmaxf(S[t][0], S[t][1]), fmaxf(S[t][2], S[t][3])));
        mx = fmaxf(mx, __shfl_xor(mx, 16)); mx = fmaxf(mx, __shfl_xor(mx, 32));
        float sum = 0.f;
#pragma unroll
        for (int t = 0; t < 9; ++t)
#pragma unroll
            for (int j = 0; j < 4; ++j) { const float p = __builtin_amdgcn_exp2f(S[t][j] - mx); S[t][j] = p; sum += p; }
        sum += __shfl_xor(sum, 16); sum += __shfl_xor(sum, 32);
        u32x2 o1w[8], o2w[8], szw[8]; float l1 = 0.f, l2 = 0.f;
        if (COMBINE) {
            asm volatile("" ::: "memory");
            const size_t eo = pq * 1024 + hh * 128 + 4 * fq;
#pragma unroll
            for (int c = 0; c < 8; ++c) { o1w[c] = *(const u32x2*)(O1 + eo + 16 * c); o2w[c] = *(const u32x2*)(O2 + eo + 16 * c); szw[c] = *(const u32x2*)(SZ + eo + 16 * c); }
            l1 = LSE1[pq * 8 + hh]; l2 = LSE2[pq * 8 + hh];
        }
        f32x4 O[8];
#pragma unroll
        for (int c = 0; c < 8; ++c) O[c] = (f32x4){0.f, 0.f, 0.f, 0.f};
#pragma unroll
        for (int u = 0; u < 5; ++u) {
            u32x4 pw; pw.x = cvt_pk_bf16(S[2 * u][0], S[2 * u][1]); pw.y = cvt_pk_bf16(S[2 * u][2], S[2 * u][3]);
            if (u < 4) { pw.z = cvt_pk_bf16(S[2 * u + 1][0], S[2 * u + 1][1]); pw.w = cvt_pk_bf16(S[2 * u + 1][2], S[2 * u + 1][3]); } else { pw.z = 0u; pw.w = 0u; }
            const bf16x8 pf = __builtin_bit_cast(bf16x8, pw);
            const unsigned kba = 16 * wid + 32 * u, kbb = kba + 16;
            const unsigned uoa = ((kba < 128u) ? ps_ : cs_) * 32768u + 256u * (kba & 96u), uob = ((kbb < 128u) ? ps_ : cs_) * 32768u + 256u * (kbb & 96u);
#pragma unroll
            for (int c = 0; c < 8; ++c) {
                const s16x4 va = __builtin_amdgcn_ds_read_tr16_b64_v4i16((LAS s16x4*)(lds + (vbA[c] + uoa)));
                const s16x4 vb = __builtin_amdgcn_ds_read_tr16_b64_v4i16((LAS s16x4*)(lds + ((u < 4) ? (vbB[c] + uob) : (vbA[c] + uoa))));
                const bf16x8 vf = __builtin_shufflevector(va, vb, 0, 1, 2, 3, 4, 5, 6, 7);
                O[c] = __builtin_amdgcn_mfma_f32_16x16x32_bf16(vf, pf, O[c], 0, 0, 0);
            }
        }
        const float inv = 1.0f / sum;
        if (!COMBINE) {
            bf16_t* op = Og + pq * 1024 + hh * 128 + 4 * fq;
#pragma unroll
            for (int c = 0; c < 8; ++c) { u32x2 w; w.x = cvt_pk_bf16(O[c][0] * inv, O[c][1] * inv); w.y = cvt_pk_bf16(O[c][2] * inv, O[c][3] * inv); *(u32x2*)(op + 16 * c) = w; }
            if (fq == 0) LSEg[pq * 8 + hh] = mx + __builtin_amdgcn_logf(sum);
        } else {
            const float l0 = mx + __builtin_amdgcn_logf(sum), m3 = fmaxf(l0, fmaxf(l1, l2));
            float w0 = __builtin_amdgcn_exp2f(l0 - m3), w1 = __builtin_amdgcn_exp2f(l1 - m3), w2 = __builtin_amdgcn_exp2f(l2 - m3);
            const float iw = 1.0f / (w0 + w1 + w2); w0 *= iw * inv; w1 *= iw; w2 *= iw;
            bf16_t* ap = AATT + pq * 2048 + hh * 128 + 4 * fq;
#pragma unroll
            for (int c = 0; c < 8; ++c) {
                const f32x4 a1 = (f32x4){bf_lo(o1w[c].x), bf_hi(o1w[c].x), bf_lo(o1w[c].y), bf_hi(o1w[c].y)}, a2 = (f32x4){bf_lo(o2w[c].x), bf_hi(o2w[c].x), bf_lo(o2w[c].y), bf_hi(o2w[c].y)};
                const f32x4 zz = (f32x4){bf_lo(szw[c].x), bf_hi(szw[c].x), bf_lo(szw[c].y), bf_hi(szw[c].y)};
                const f32x4 res = (O[c] * w0 + a1 * w1 + a2 * w2) * zz;
                u32x2 w; w.x = cvt_pk_bf16(res[0], res[1]); w.y = cvt_pk_bf16(res[2], res[3]); *(u32x2*)(ap + 16 * c) = w;
            }
        }
        __syncthreads();
        if (more) ATT_WRITE(ps_);
        __syncthreads();
    }
#undef ATT_LOAD
#undef ATT_WRITE
}

struct Args { const float* x; const float* c; const int* pos; const float* g_pre; const float* w_ada; const float* b_ada; const float* w_in; const float* conv_w;
              const float* w_attn_o; const float* w_conv_o; const float* w_o; const float* g_post; float* out; unsigned char* ws; int ph_lo, ph_hi, li, pad; };

__global__ void __launch_bounds__(NWAVES * 64, 2) mk_fwd(Args args) {
    extern __shared__ __attribute__((aligned(16))) unsigned char lds_raw[];
    LAS unsigned char* lds = (LAS unsigned char*)lds_raw;
    volatile LAS unsigned* MISC = (volatile LAS unsigned*)(lds + MISC_OFF);
    const int tid = threadIdx.x, lane = tid & 63, wave = __builtin_amdgcn_readfirstlane(tid >> 6);
    const int G = gridDim.x; const int bx = blockIdx.x; const int vcu = (G % 8 == 0) ? (bx % 8) * (G / 8) + bx / 8 : bx;
    unsigned char* ws = args.ws;
    gu32* ctl = (gu32*)(ws + WS_CTL);
    float* mod = (float*)(ws + WS_MOD); float* cs = (float*)(ws + WS_CS);
    bf16_t* WinT = (bf16_t*)(ws + WS_WIN); bf16_t* WaT = (bf16_t*)(ws + WS_WA); bf16_t* WcT = (bf16_t*)(ws + WS_WC); bf16_t* WoT = (bf16_t*)(ws + WS_WO);
    bf16_t* Hb = (bf16_t*)(ws + WS_H); bf16_t* Qb = (bf16_t*)(ws + WS_Q); bf16_t* Kb = (bf16_t*)(ws + WS_K); bf16_t* Vb = (bf16_t*)(ws + WS_V);
    bf16_t* SZ = (bf16_t*)(ws + WS_SZ); bf16_t* Pb = (bf16_t*)(ws + WS_P); bf16_t* QCb = (bf16_t*)(ws + WS_QC);
    bf16_t* SGA = (bf16_t*)args.out; bf16_t* SGC = SGA + (size_t)M * D;
    bf16_t* O1 = (bf16_t*)(ws + WS_O1); bf16_t* O2 = (bf16_t*)(ws + WS_O2); float* LSE = (float*)(ws + WS_LSE);
    bf16_t* AATT = (bf16_t*)(ws + WS_AATT); bf16_t* Rb = (bf16_t*)(ws + WS_R); bf16_t* MG = (bf16_t*)(ws + WS_MG);
    bf16_t* Yb = (bf16_t*)(ws + WS_Y);

    for (int u = tid; u < (LDS_BYTES - LDSCTL_OFF) / 4; u += NWAVES * 64) ((LAS unsigned*)(lds + LDSCTL_OFF))[u] = 0u;
    __syncthreads();
    const int bli = (N_LAUNCHES == 1) ? 0 : args.li;
    XcdBarrier bar; bar.bar = (unsigned*)(ctl + CW_BAR) + bli * XCD_BAR_WORDS; bar.x = 0; bar.st = nullptr;
    if (N_LAUNCHES == 1) bar = xcd_barrier_post((unsigned*)(ctl + CW_BAR), MISC + 8);
    const int lo = args.ph_lo, hi = args.ph_hi;
#define IN(k) (lo <= (k) && (k) < hi)
#define BOTH(k) (IN(k) && IN((k) + 1))
#define GRID_BAR() xcd_barrier(bar)
#ifndef PROBE_REPEAT_MASK
#define PROBE_REPEAT_MASK 0
#endif
#define NREP(k) ((((PROBE_REPEAT_MASK) >> (k)) & 1) + 1)
#if defined(PROBE_PH) || defined(PROBE_ARRIVE)
#define PHSTAMP(k) do { if (bx == 0 && tid == 0) ((unsigned long long*)(ws + WS_MOD + 65536))[16 + (k)] = __builtin_amdgcn_s_memrealtime(); } while (0)
#else
#define PHSTAMP(k) do {} while (0)
#endif
    PHSTAMP(0);
    const int gw = vcu * NWAVES + wave, NGW = G * NWAVES;
    const int gtid = vcu * (NWAVES * 64) + tid, NT = G * NWAVES * 64;

    if (IN(0)) for (int rep = 0; rep < NREP(0); ++rep) {
        {
            LAS float* red = (LAS float*)lds;
            for (int cbk = bx; cbk < 256; cbk += G) {
                const int c4 = tid % 6, rg = tid / 6;
                f32x4 a = (f32x4){0.f, 0.f, 0.f, 0.f};
                if (rg < 85) { for (int k = rg; k < D; k += 85) { const float cv = args.c[k]; const f32x4 w = *(const f32x4*)(args.w_ada + (size_t)k * NMOD + cbk * 24 + c4 * 4); a += w * cv; }
                    *(LAS f32x4*)(red + (rg * 6 + c4) * 4) = a; }
                __syncthreads();
                if (tid < 24) { float s = 0.f; for (int i = 0; i < 85; ++i) s += red[(i * 6 + (tid >> 2)) * 4 + (tid & 3)]; mod[cbk * 24 + tid] = s + args.b_ada[cbk * 24 + tid]; }
                __syncthreads();
            }
        }
        for (int idx = gtid; idx < M * 16; idx += NT) { const int m = idx >> 4, i = idx & 15; const float ang = (float)args.pos[m] * INVF[i]; float s, c; sincos_f64(ang, s, c); cs[m * 32 + i] = c; cs[m * 32 + 16 + i] = s; }
        {
            LAS float* scr = (LAS float*)(lds + wave * 16384);
            constexpr int I_IN = (D / 64) * (PROJ / 32), I_A = (NZA / 64) * (D / 32), I_C = (NCV / 64) * (D / 32), I_O = (D / 64) * (D / 32);
            constexpr int NITEMS = I_IN + I_A + I_C + I_O;
            for (int it = gw; it < NITEMS; it += NGW) {
                int r = it;
                if (r < I_IN) { p0_transpose_item<true>(args.w_in, D, PROJ, WinT, D, scr, r, lane); continue; } r -= I_IN;
                if (r < I_A) { p0_transpose_item<false>(args.w_attn_o, NZA, D, WaT, D, scr, r, lane); continue; } r -= I_A;
                if (r < I_C) { p0_transpose_item<false>(args.w_conv_o, NCV, D, WcT, D, scr, r, lane); continue; } r -= I_C;
                p0_transpose_item<false>(args.w_o, D, D, WoT, D, scr, r, lane);
            }
        }
        if (BOTH(0) || rep + 1 < NREP(0)) GRID_BAR();
    }
    PHSTAMP(1);
    if (IN(1)) for (int rep = 0; rep < NREP(1); ++rep) {
        f32x4 av[4][2], bv[4][2];
#pragma unroll
        for (int j = 0; j < 4; ++j)
#pragma unroll
            for (int h = 0; h < 2; ++h) { const int k = 512 * j + 8 * lane + 4 * h; const f32x4 gp = *(const f32x4*)(args.g_pre + k), sc = *(const f32x4*)(mod + D + k); av[j][h] = gp * (sc + 1.0f); bv[j][h] = *(const f32x4*)(mod + k); }
        for (int m = gw; m < M; m += NGW) {
            const float* xr = args.x + (size_t)m * D + 8 * lane;
            f32x4 v[4][2]; float ss = 0.f;
#pragma unroll
            for (int j = 0; j < 4; ++j)
#pragma unroll
                for (int h = 0; h < 2; ++h) { v[j][h] = *(const f32x4*)(xr + 512 * j + 4 * h); const f32x4 q = v[j][h] * v[j][h]; ss += (q[0] + q[1]) + (q[2] + q[3]); }
            const float rstd = 1.0f / sqrtf(wave_sum(ss) * (1.0f / D) + EPS);
            bf16_t* hr = Hb + (size_t)m * D + 8 * lane;
#pragma unroll
            for (int j = 0; j < 4; ++j) { const f32x4 h0 = v[j][0] * rstd * av[j][0] + bv[j][0], h1 = v[j][1] * rstd * av[j][1] + bv[j][1]; *(u32x4*)(hr + 512 * j) = pg8::pack8(h0, h1); }
        }
        if (BOTH(1) || rep + 1 < NREP(1)) GRID_BAR();
    }
    PHSTAMP(2);
    if (IN(2)) {
        pg8::SegOrder1 S; S.so.init(M, PROJ, G, bx, NREP(2)); S.A = (const char*)Hb; S.B = (const char*)WinT; S.tstep = (size_t)256 * D * 2; S.nt = D / 64;
        pg8::EpiProj E{Qb, Kb, Vb, SZ, Pb, QCb, SGA, SGC, cs};
        pg8::gemm_stream<pg8::EpiProj, pg8::SegOrder1>(lds, D, S, E);
        if (BOTH(2)) GRID_BAR();
    }
    PHSTAMP(3);
    if (IN(3)) for (int rep = 0; rep < NREP(3); ++rep) {
        for (int chunk = vcu; chunk < 256; chunk += G) {
            int g, hh, r, n0;
            if (chunk < 128) { g = 2; hh = chunk >> 4; r = chunk & 15; n0 = 0; } else { const int idx = chunk - 128; g = 1; hh = idx >> 4; r = (idx & 15) >> 2; n0 = (idx & 3) * 8; }
            const size_t go = (size_t)g * M * 1024;
            attn_chunk<false>(lds, Qb + go, Kb + go, Vb + go, 2 * g, hh, r, n0, 8, (g == 1) ? O1 : O2, LSE + (size_t)g * M * 8, nullptr, nullptr, nullptr, nullptr, nullptr, nullptr);
        }
        if (BOTH(3) || rep + 1 < NREP(3)) GRID_BAR();
    }
    PHSTAMP(4);
    if (IN(4)) for (int rep = 0; rep < NREP(4); ++rep) {
        for (int bk = vcu; bk < 256; bk += G) {
            const int chunk = tid & 255, half = tid >> 8, c0 = 8 * chunk, t0 = 64 * bk + 32 * half;
            f32x4 wa[3][2];
#pragma unroll
            for (int k = 0; k < 3; ++k) { wa[k][0] = *(const f32x4*)(args.conv_w + k * NCV + c0); wa[k][1] = *(const f32x4*)(args.conv_w + k * NCV + c0 + 4); }
            f32x4 pm2[2], pm1[2];
            if (t0 >= 2) { pg8::unpack8(*(const u32x4*)(Pb + (size_t)(t0 - 2) * NCV + c0), pm2[0], pm2[1]); pg8::unpack8(*(const u32x4*)(Pb + (size_t)(t0 - 1) * NCV + c0), pm1[0], pm1[1]); }
            else { pm2[0] = pm2[1] = pm1[0] = pm1[1] = (f32x4){0.f, 0.f, 0.f, 0.f}; }
#pragma unroll 4
            for (int t = t0; t < t0 + 32; ++t) {
                f32x4 pc[2], qc[2]; pg8::unpack8(*(const u32x4*)(Pb + (size_t)t * NCV + c0), pc[0], pc[1]); pg8::unpack8(*(const u32x4*)(QCb + (size_t)t * NCV + c0), qc[0], qc[1]);
                const f32x4 r0 = qc[0] * (wa[0][0] * pm2[0] + wa[1][0] * pm1[0] + wa[2][0] * pc[0]), r1 = qc[1] * (wa[0][1] * pm2[1] + wa[1][1] * pm1[1] + wa[2][1] * pc[1]);
                *(u32x4*)(Rb + (size_t)t * NCV + c0) = pg8::pack8(r0, r1);
                pm2[0] = pm1[0]; pm2[1] = pm1[1]; pm1[0] = pc[0]; pm1[1] = pc[1];
            }
        }
        for (int chunk = vcu; chunk < 256; chunk += G)
            attn_chunk<true>(lds, Qb, Kb, Vb, 0, chunk >> 5, 0, (chunk & 31) * 4, 4, nullptr, nullptr, O1, O2, LSE + (size_t)1 * M * 8, LSE + (size_t)2 * M * 8, SZ, AATT);
        if (BOTH(4) || rep + 1 < NREP(4)) GRID_BAR();
    }
    PHSTAMP(5);
    if (IN(5)) {
        pg8::SegOrder2 S; S.so.init(M, D, G, bx, NREP(5)); S.A0 = (const char*)AATT; S.B0 = (const char*)WaT; S.A1 = (const char*)Rb; S.B1 = (const char*)WcT; S.tstep = (size_t)256 * D * 2; S.nt0 = NZA / 64; S.nt1 = NCV / 64;
        pg8::EpiMerge E{MG, SGA, SGC, D};
        pg8::gemm_stream<pg8::EpiMerge, pg8::SegOrder2, true>(lds, D, S, E);
        if (BOTH(5)) GRID_BAR();
    }
    PHSTAMP(6);
    if (IN(6)) {
        pg8::SegOrder1 S; S.so.init(M, D, G, bx, NREP(6)); S.A = (const char*)MG; S.B = (const char*)WoT; S.tstep = (size_t)256 * D * 2; S.nt = D / 64;
        pg8::EpiBf16 E{Yb, D};
        pg8::gemm_stream<pg8::EpiBf16, pg8::SegOrder1>(lds, D, S, E);
#ifdef PROBE_ARRIVE
        if (tid == 0) { ((unsigned long long*)(ws + WS_MOD + 131072))[bx] = __builtin_amdgcn_s_memrealtime(); }
#endif
        if (BOTH(6)) GRID_BAR();
    }
    PHSTAMP(7);
    if (IN(7)) {
        f32x4 gv[4][2];
#pragma unroll
        for (int j = 0; j < 4; ++j)
#pragma unroll
            for (int h = 0; h < 2; ++h) { const int k = 512 * j + 8 * lane + 4 * h; gv[j][h] = *(const f32x4*)(mod + 2 * D + k) * *(const f32x4*)(args.g_post + k); }
        for (int m = gw; m < M; m += NGW) {
            const bf16_t* yr = Yb + (size_t)m * D + 8 * lane; const float* xr = args.x + (size_t)m * D + 8 * lane; float* orow = args.out + (size_t)m * D + 8 * lane;
            f32x4 v[4][2]; float ss = 0.f;
#pragma unroll
            for (int j = 0; j < 4; ++j) { pg8::unpack8(*(const u32x4*)(yr + 512 * j), v[j][0], v[j][1]);
#pragma unroll
                for (int h = 0; h < 2; ++h) { const f32x4 q = v[j][h] * v[j][h]; ss += (q[0] + q[1]) + (q[2] + q[3]); } }
            const float rstd = 1.0f / sqrtf(wave_sum(ss) * (1.0f / D) + EPS);
#pragma unroll
            for (int j = 0; j < 4; ++j)
#pragma unroll
                for (int h = 0; h < 2; ++h) { const f32x4 xv = *(const f32x4*)(xr + 512 * j + 4 * h); *(f32x4*)(orow + 512 * j + 4 * h) = xv + gv[j][h] * (v[j][h] * rstd); }
        }
    }
    PHSTAMP(8);
#ifdef PROBE_PH
    if (bx == 0 && tid == 0) {
        asm volatile("s_waitcnt vmcnt(0)" ::: "memory");
        unsigned long long* st = (unsigned long long*)(ws + WS_MOD + 65536) + 16;
        const int ia = (PROBE_PH) & 15, ib = ((PROBE_PH) >> 4) & 15;
        const unsigned long long ta = __hip_atomic_load(st + ia + 1, __ATOMIC_RELAXED, __HIP_MEMORY_SCOPE_AGENT) - __hip_atomic_load(st + ia, __ATOMIC_RELAXED, __HIP_MEMORY_SCOPE_AGENT);
        const unsigned long long tb = __hip_atomic_load(st + ib + 1, __ATOMIC_RELAXED, __HIP_MEMORY_SCOPE_AGENT) - __hip_atomic_load(st + ib, __ATOMIC_RELAXED, __HIP_MEMORY_SCOPE_AGENT);
        const unsigned long long ticks = 4ull * (ta > 99900ull ? 99900ull : ta) + 400000ull * (tb / 400ull);
        const unsigned long long t0 = __builtin_amdgcn_s_memrealtime();
        while (__builtin_amdgcn_s_memrealtime() - t0 < ticks) __builtin_amdgcn_s_sleep(32);
    }
#endif
#ifdef PROBE_ARRIVE
    if (bx == 0 && tid == 0) {
        unsigned long long* aw = (unsigned long long*)(ws + WS_MOD + 131072);
        unsigned long long tmax = 0, tmin = ~0ull; int imax = 0;
        for (int i = 0; i < G; ++i) { const unsigned long long t = __hip_atomic_load(aw + i, __ATOMIC_RELAXED, __HIP_MEMORY_SCOPE_AGENT); if (t > tmax) { tmax = t; imax = i; } if (t < tmin) tmin = t; }
        const unsigned long long t0a = __hip_atomic_load(aw, __ATOMIC_RELAXED, __HIP_MEMORY_SCOPE_AGENT);
        const unsigned long long tafter = __hip_atomic_load((unsigned long long*)(ws + WS_MOD + 65536) + 16 + 8, __ATOMIC_RELAXED, __HIP_MEMORY_SCOPE_AGENT);
        long long val[4];
        val[0] = (long long)(tmax - tmin) / 200;
        val[1] = (long long)(tafter - tmax) / 100;
        val[2] = (long long)(tmax - t0a) / 200;
        val[3] = imax / 4;
        long long a = val[PROBE_ARRIVE & 3], b = val[(PROBE_ARRIVE >> 2) & 3];
        a = a < 0 ? 0 : (a > 89 ? 89 : a); b = b < 0 ? 0 : (b > 99 ? 99 : b);
        const unsigned long long ticks = (unsigned long long)(10 * a + 1000 * b) * 100ull;
        const unsigned long long t0 = __builtin_amdgcn_s_memrealtime();
        while (__builtin_amdgcn_s_memrealtime() - t0 < ticks) __builtin_amdgcn_s_sleep(32);
    }
#endif
#undef IN
#undef BOTH
#undef GRID_BAR
}

extern "C" void kernel_launch(void* const* d_in, const int* in_sizes, int n_in, void* d_out, int out_size, void* d_ws, size_t ws_size, hipStream_t stream) {
    static int grid = 0;
    if (grid == 0) {
        if (n_in != 12 || in_sizes[0] != M * D || out_size != M * D || ws_size < WS_END) { fprintf(stderr, "kernel_launch: unexpected shapes (n_in %d, in0 %d, out %d, ws %zu); nothing launched\n", n_in, n_in > 0 ? in_sizes[0] : -1, out_size, ws_size); grid = -1; return; }
        int dev = 0, cus = 0;
        if (hipGetDevice(&dev) != hipSuccess || hipDeviceGetAttribute(&cus, hipDeviceAttributeMultiprocessorCount, dev) != hipSuccess) { grid = -1; return; }
        if (hipFuncSetAttribute((const void*)mk_fwd, hipFuncAttributeMaxDynamicSharedMemorySize, LDS_BYTES) != hipSuccess) { fprintf(stderr, "kernel_launch: hipFuncSetAttribute failed\n"); grid = -1; return; }
        (void)hipGetLastError();
        grid = cus;
    }
    if (grid < 0) return;
    if (hipMemsetAsync((char*)d_ws + WS_CTL, 0, CTL_ZERO_BYTES, stream) != hipSuccess) return;
    Args a{};
    a.x = (const float*)d_in[0]; a.c = (const float*)d_in[1]; a.pos = (const int*)d_in[2]; a.g_pre = (const float*)d_in[3]; a.w_ada = (const float*)d_in[4]; a.b_ada = (const float*)d_in[5];
    a.w_in = (const float*)d_in[6]; a.conv_w = (const float*)d_in[7]; a.w_attn_o = (const float*)d_in[8]; a.w_conv_o = (const float*)d_in[9]; a.w_o = (const float*)d_in[10]; a.g_post = (const float*)d_in[11];
    a.out = (float*)d_out; a.ws = (unsigned char*)d_ws;
    for (int li = 0; li < N_LAUNCHES; ++li) {
        a.ph_lo = (N_LAUNCHES == 1) ? 0 : li; a.ph_hi = (N_LAUNCHES == 1) ? NPHASES : li + 1; a.li = li;
        hipLaunchKernelGGL(mk_fwd, dim3(grid), dim3(NWAVES * 64), LDS_BYTES, stream, a);
        if (hipPeekAtLastError() != hipSuccess) break;
    }
}
```

```cpp
#include <hip/hip_runtime.h>
#include <cstdio>
#include <cstdint>

#define GAS __attribute__((address_space(1)))
#define LAS __attribute__((address_space(3)))
typedef unsigned short bf16_t;
typedef short bf16x8 __attribute__((ext_vector_type(8)));
typedef short s16x4 __attribute__((ext_vector_type(4)));
typedef float f32x4 __attribute__((ext_vector_type(4)));
typedef float f32x2 __attribute__((ext_vector_type(2)));
typedef unsigned u32x4 __attribute__((ext_vector_type(4)));
typedef unsigned u32x2 __attribute__((ext_vector_type(2)));

constexpr int M = 16384, D = 2048, NQKV = 3072, NZA = 1024, NCV = 2048, PROJ = 22528, NMOD = 6144;
constexpr float EPS = 1e-6f;
constexpr float LOG2E = 1.4426950408889634f;
constexpr float QSCALE = 0.08838834764831845f * 1.4426950408889634f;

__constant__ float INVF[16] = {1.0f, 0.44036659598350525f, 0.1939227432012558f, 0.08539710193872452f, 0.03760603070259094f, 0.016560440883040428f,
    0.007292664609849453f, 0.0032114461064338684f, 0.0014142135623842478f, 0.0006227724370546639f, 0.00027424818836152554f, 0.00012076973507646471f,
    5.3182957344688475e-05f, 2.34199997066753e-05f, 1.0313385246263351e-05f, 4.541670477919979e-06f};

typedef __bf16 bf16x2_t __attribute__((ext_vector_type(2)));
__device__ __forceinline__ unsigned cvt_pk_bf16(float lo, float hi) { const f32x2 v = {lo, hi}; return __builtin_bit_cast(unsigned, __builtin_convertvector(v, bf16x2_t)); }
__device__ __forceinline__ float bf_lo(unsigned w) { return __builtin_bit_cast(float, w << 16); }
__device__ __forceinline__ float bf_hi(unsigned w) { return __builtin_bit_cast(float, w & 0xffff0000u); }
template <int CTRL> __device__ __forceinline__ float dpp_row_shr(float old, float src) { return __int_as_float(__builtin_amdgcn_update_dpp(__float_as_int(old), __float_as_int(src), CTRL, 0xf, 0xf, false)); }
__device__ __forceinline__ float silu_f(float v) { return v * __builtin_amdgcn_rcpf(1.0f + __builtin_amdgcn_exp2f(-v * LOG2E)); }
__device__ __forceinline__ float sigm_f(float v) { return __builtin_amdgcn_rcpf(1.0f + __builtin_amdgcn_exp2f(-v * LOG2E)); }

constexpr size_t MiB = 1u << 20;
constexpr size_t WS_CTL = 0, CTL_ZERO_BYTES = 1 * MiB;
constexpr size_t WS_MOD = 1 * MiB;
constexpr size_t WS_CS = 2 * MiB;
constexpr size_t WS_WIN = 4 * MiB;
constexpr size_t WS_WA = 92 * MiB, WS_WC = 100 * MiB, WS_WO = 108 * MiB;
constexpr size_t WS_H = 116 * MiB;
constexpr size_t WS_Q = 180 * MiB, WS_K = 276 * MiB, WS_V = 372 * MiB;
constexpr size_t WS_SZ = 468 * MiB;
constexpr size_t WS_R = 500 * MiB;
constexpr size_t WS_FX = 564 * MiB;
constexpr size_t WS_O2 = 628 * MiB;
constexpr size_t WS_LSE = 660 * MiB;
constexpr size_t WS_END = 662 * MiB;
constexpr size_t WS_O1 = 148 * MiB;
constexpr size_t WS_AATT = WS_K + 32 * MiB, WS_MG = WS_V + 32 * MiB, WS_Y = WS_R;

namespace pg8 {
constexpr int BM = 256, BK = 64, HALF = 128, HTB = HALF * BK * 2, STAGE_BYTES = 8 * HTB, NXCD = 8, WGM = 8;
__host__ __device__ __forceinline__ int lds_byte(int r, int c) { const int st = (r >> 4) * 2 + (c >> 5), rr = r & 15, cc = c & 31, ob = rr * 64 + cc * 2; return st * 1024 + (ob ^ (((ob >> 9) & 1) << 5)); }
__host__ __device__ __forceinline__ void stage_rc(int b, int& R, int& C) { const int st = b / 1024, sb = b % 1024, swz = sb ^ (((sb >> 9) & 1) << 5); R = (st >> 1) * 16 + swz / 64; C = (st & 1) * 32 + (swz % 64) / 2; }
__host__ __device__ __forceinline__ int perm32(int rho) { const int n = rho >> 4, i = rho & 15; return 8 * (i >> 2) + 4 * n + (i & 3); }

struct Unit { int pm, pn; };
struct Gemm { const bf16_t* A; const bf16_t* Bt; int M, N, K; };

struct StaticOrder {
    int nM, nN, nwg, G, c, rounds, rep;
    __host__ __device__ void init(int M_, int N_, int G_, int c_, int rep_ = 1) { nM = M_ / BM; nN = N_ / BM; nwg = nM * nN; G = G_; c = c_; rounds = (nwg + G - 1) / G; rep = rep_; }
    __host__ __device__ bool next(int i, Unit& u) const {
        if (i >= rounds * rep) return false;
        i = i % rounds;
        const long L = (long)i * G + c; if (L >= nwg) return false;
        int wgid = (int)L; { const int q = nwg / NXCD, r = nwg % NXCD, xcd = wgid % NXCD, off = wgid / NXCD; wgid = (xcd < r ? xcd * (q + 1) : r * (q + 1) + (xcd - r) * q) + off; }
        const int nig = WGM * nN, gid = wgid / nig, fm = gid * WGM, gsz = (nM - fm) < WGM ? (nM - fm) : WGM;
        u.pm = fm + ((wgid % nig) % gsz); u.pn = (wgid % nig) / gsz; return true;
    }
    __device__ __forceinline__ void a_ready(const Unit&) const {}
    __device__ __forceinline__ void done(const Unit&) const {}
};


struct Seg { const char* A; const char* B; int nt; int mid; Unit u; };
__device__ __forceinline__ const char* rfl_ptr(const char* p) { const unsigned long long v = (unsigned long long)p; const unsigned lo = __builtin_amdgcn_readfirstlane((unsigned)v), hi = __builtin_amdgcn_readfirstlane((unsigned)(v >> 32)); return (const char*)(((unsigned long long)hi << 32) | lo); }
__device__ __forceinline__ void rfl_seg(Seg& o) { o.A = rfl_ptr(o.A); o.B = rfl_ptr(o.B); o.nt = __builtin_amdgcn_readfirstlane(o.nt); o.mid = __builtin_amdgcn_readfirstlane(o.mid); o.u.pm = __builtin_amdgcn_readfirstlane(o.u.pm); o.u.pn = __builtin_amdgcn_readfirstlane(o.u.pn); }
constexpr int NSTORE = 16;
template <class Epi, class Sched, bool DUAL = false>
__device__ __forceinline__ void gemm_stream(LAS unsigned char* lds, const int pitch, const Sched& S, const Epi& E) {
    const int tid = threadIdx.x, wid = __builtin_amdgcn_readfirstlane(tid >> 6), lane = tid & 63, wr = wid >> 2, wc = wid & 3, fr = lane & 15, fq = lane >> 4;
    unsigned voffA[2], voffB[2];
#pragma unroll
    for (int i = 0; i < 2; ++i) { int R, C; stage_rc(tid * 16 + i * 8192, R, C); const int Rb = Epi::PERM ? ((R & ~31) + perm32(R & 31)) : R;
        voffA[i] = (unsigned)(R * pitch + C) * 2u; voffB[i] = (unsigned)(Rb * pitch + C) * 2u; }
    const size_t kstep = (size_t)(BK * 2);
    const size_t hstep = (size_t)HALF * pitch * 2;
    const unsigned ldsw = (unsigned)wid * 1024u;
    const int aoff = lds_byte(wr * 64 + fr, fq * 8), boff = lds_byte(wc * 32 + fr, fq * 8);
#define PG8_SA(b, h) (((b) * 2 + (h)) * HTB)
#define PG8_SB(b, h) ((4 + (b) * 2 + (h)) * HTB)
#define PG8_STAGE(bufoff, gbase, voff) do { const char* _gb = (const char*)(gbase); asm volatile("" : "+s"(_gb));   \
        _Pragma("unroll") for (int _i = 0; _i < 2; ++_i) \
        __builtin_amdgcn_global_load_lds((const unsigned*)(_gb + (voff)[_i]), (LAS unsigned*)(lds + (bufoff) + ldsw + _i * 8192), 16, 0, 0); } while (0)
#define PG8_LDA(dst, b, h) do { _Pragma("unroll") for (int m = 0; m < 4; ++m) _Pragma("unroll") for (int k = 0; k < 2; ++k) dst[m][k] = *(const LAS bf16x8*)(lds + PG8_SA(b, h) + aoff + m * 2048 + k * 1024); } while (0)
#define PG8_LDB(dst, b, h) do { _Pragma("unroll") for (int n = 0; n < 2; ++n) _Pragma("unroll") for (int k = 0; k < 2; ++k) dst[n][k] = *(const LAS bf16x8*)(lds + PG8_SB(b, h) + boff + n * 2048 + k * 1024); } while (0)
#define PG8_MMA(ai, bj, At, Bt) do { __builtin_amdgcn_s_setprio(1); _Pragma("unroll") for (int m = 0; m < 4; ++m) _Pragma("unroll") for (int n = 0; n < 2; ++n) _Pragma("unroll") for (int k = 0; k < 2; ++k) \
        acc[ai][bj][m][n] = __builtin_amdgcn_mfma_f32_16x16x32_bf16(Bt[n][k], At[m][k], acc[ai][bj][m][n], 0, 0, 0); __builtin_amdgcn_s_setprio(0); } while (0)
#define PG8_WAIT_V(n) asm volatile("s_waitcnt vmcnt(" #n ")" ::: "memory")
#define PG8_WAIT_VR() PG8_WAIT_V(8)
#define PG8_WAIT_L(n) asm volatile("s_waitcnt lgkmcnt(" #n ")" ::: "memory")
#define PG8_BAR __builtin_amdgcn_s_barrier()
#define PG8_SCHED __builtin_amdgcn_sched_barrier(0)
    Seg cur, nxt; int si = 0;
    if (!S.seg(0, cur)) return;
    f32x4 acc[2][2][4][2];
#pragma unroll
    for (int a = 0; a < 2; ++a)
#pragma unroll
        for (int b = 0; b < 2; ++b)
#pragma unroll
            for (int m = 0; m < 4; ++m)
#pragma unroll
                for (int n = 0; n < 2; ++n) acc[a][b][m][n] = (f32x4){0.f, 0.f, 0.f, 0.f};
    bf16x8 At[4][2], B0[2][2], B1[2][2];
    {
        const char* cA = cur.A; const char* cB = cur.B;
        PG8_STAGE(PG8_SB(0, 0), cB, voffB); PG8_STAGE(PG8_SB(0, 1), cB + hstep, voffB); PG8_STAGE(PG8_SA(0, 0), cA, voffA); PG8_STAGE(PG8_SA(0, 1), cA + hstep, voffA);
        if (wr == 1) PG8_BAR;
        PG8_WAIT_V(2); PG8_BAR;
        PG8_STAGE(PG8_SB(1, 0), cB + kstep, voffB); PG8_STAGE(PG8_SA(1, 0), cA + kstep, voffA); PG8_STAGE(PG8_SB(1, 1), cB + hstep + kstep, voffB);
        PG8_WAIT_V(6); PG8_BAR;
    }
    bool fresh = true, relax = false;
    for (;;) {
        const bool has_next = S.seg(si + 1, nxt);
        const char* cA = cur.A; const char* cB = cur.B; const int nt = cur.nt;
        const char* nA = has_next ? nxt.A : cA; const char* nB = has_next ? nxt.B : cB;
#pragma nounroll
        for (int t = 0; t < nt; t += 2) {
            const bool first = (t == 0) && !fresh;
            const bool last = (t == nt - 2);
            const char* a1 = cA + (size_t)(t + 1) * kstep;
            const char* a2 = last ? nA : cA + (size_t)(t + 2) * kstep; const char* b2 = last ? nB : cB + (size_t)(t + 2) * kstep;
            const char* a3 = a2 + kstep; const char* b3 = b2 + kstep;
            PG8_LDB(B0, 0, 0); PG8_LDB(B1, 0, 1); PG8_SCHED; PG8_LDA(At, 0, 0); if (!first) PG8_STAGE(PG8_SA(1, 1), a1 + hstep, voffA);
            PG8_WAIT_VR(); PG8_WAIT_L(0); PG8_BAR; PG8_MMA(0, 0, At, B0); PG8_MMA(0, 1, At, B1); PG8_BAR; PG8_SCHED;
            PG8_LDA(At, 0, 1); PG8_STAGE(PG8_SB(0, 0), b2, voffB); PG8_STAGE(PG8_SB(0, 1), b2 + hstep, voffB); PG8_STAGE(PG8_SA(0, 0), a2, voffA);
            PG8_WAIT_VR(); PG8_WAIT_L(0); PG8_BAR; PG8_MMA(1, 0, At, B0); PG8_MMA(1, 1, At, B1); PG8_BAR; PG8_SCHED;
            PG8_LDB(B0, 1, 0); PG8_LDB(B1, 1, 1); PG8_SCHED; PG8_LDA(At, 1, 0); PG8_STAGE(PG8_SA(0, 1), a2 + hstep, voffA);
            PG8_WAIT_VR(); PG8_WAIT_L(0); PG8_BAR; PG8_MMA(0, 0, At, B0); PG8_MMA(0, 1, At, B1); PG8_BAR; PG8_SCHED;
            PG8_LDA(At, 1, 1); PG8_STAGE(PG8_SB(1, 0), b3, voffB); PG8_STAGE(PG8_SB(1, 1), b3 + hstep, voffB); PG8_STAGE(PG8_SA(1, 0), a3, voffA);
            PG8_WAIT_V(8); PG8_WAIT_L(0); PG8_BAR; PG8_MMA(1, 0, At, B0); PG8_MMA(1, 1, At, B1); PG8_BAR; PG8_SCHED;
        }
        if (wr == 0) PG8_BAR;
        PG8_STAGE(PG8_SA(1, 1), nA + kstep + hstep, voffA);
        PG8_SCHED;
        if constexpr (DUAL) E.scale(acc, cur.u, wr, wc, fr, fq, cur.mid != 0);
        if (DUAL && cur.mid) { relax = false; }
        else {
            E(acc, cur.u, wr, wc, fr, fq); relax = true;
#pragma unroll
            for (int a = 0; a < 2; ++a)
#pragma unroll
                for (int b = 0; b < 2; ++b)
#pragma unroll
                    for (int m = 0; m < 4; ++m)
#pragma unroll
                        for (int n = 0; n < 2; ++n) acc[a][b][m][n] = (f32x4){0.f, 0.f, 0.f, 0.f};
        }
        PG8_SCHED;
        if (!has_next) break;
        cur = nxt; ++si; fresh = false;
        if (wr == 1) PG8_BAR;
    }
    PG8_WAIT_V(0);
    PG8_BAR;
#undef PG8_SA
#undef PG8_SB
#undef PG8_STAGE
#undef PG8_LDA
#undef PG8_LDB
#undef PG8_MMA
#undef PG8_WAIT_V
#undef PG8_WAIT_VR
#undef PG8_WAIT_L
#undef PG8_BAR
#undef PG8_SCHED
}
struct SegOrder1 {
    StaticOrder so; const char* A; const char* B; size_t tstep; int nt;
    __device__ __forceinline__ bool seg(int s, Seg& o) const { Unit u; if (!so.next(s, u)) return false; o.A = A + (size_t)u.pm * tstep; o.B = B + (size_t)u.pn * tstep; o.nt = nt; o.mid = 0; o.u = u; rfl_seg(o); return true; }
};

__device__ __forceinline__ u32x4 pack8(const f32x4 v0, const f32x4 v1) { u32x4 w; w.x = cvt_pk_bf16(v0[0], v0[1]); w.y = cvt_pk_bf16(v0[2], v0[3]); w.z = cvt_pk_bf16(v1[0], v1[1]); w.w = cvt_pk_bf16(v1[2], v1[3]); return w; }
__device__ __forceinline__ void unpack8(const u32x4 w, f32x4& v0, f32x4& v1) { v0 = (f32x4){bf_lo(w.x), bf_hi(w.x), bf_lo(w.y), bf_hi(w.y)}; v1 = (f32x4){bf_lo(w.z), bf_hi(w.z), bf_lo(w.w), bf_hi(w.w)}; }

#ifdef NT_STORES
#define ST16(p, v) __builtin_nontemporal_store((v), (u32x4*)(p))
#define ST8(p, v) __builtin_nontemporal_store((v), (u32x2*)(p))
#else
#define ST16(p, v) (*(u32x4*)(p) = (v))
#define ST8(p, v) (*(u32x2*)(p) = (v))
#endif
struct EpiProj {
    static constexpr bool PERM = true;
    __device__ __forceinline__ void mid(f32x4 (&)[2][2][4][2], const Unit&, int, int, int, int) const {}
    unsigned char* ws; bf16_t* SGA; const float* cw; LAS unsigned char* halo;
    __device__ __forceinline__ void operator()(const f32x4 (&acc)[2][2][4][2], const Unit& u, int wr, int wc, int fr, int fq) const {
        const int pn = u.pn; const int row0 = u.pm * BM + wr * 64 + fr; const int lc = wc * 32 + 8 * fq;
        bf16_t* const Q = (bf16_t*)(ws + WS_Q); bf16_t* const Kb = (bf16_t*)(ws + WS_K); bf16_t* const V = (bf16_t*)(ws + WS_V); bf16_t* const SZ = (bf16_t*)(ws + WS_SZ); bf16_t* const R = (bf16_t*)(ws + WS_R);
        bf16_t* const SGC = SGA + (size_t)M * D; const float* const cs = (const float*)(ws + WS_CS);
        float* const HP = (float*)(ws + WS_FX); float* const FXQ = HP + (size_t)64 * 2 * NCV; float* const FXU = FXQ + (size_t)64 * 2 * NCV;
        if (pn < 24) {
            const bool isq = pn < 12; const int tq = isq ? pn : pn - 12; bf16_t* base = (isq ? Q : Kb) + (size_t)(tq >> 2) * M * 1024; const int colt = (tq & 3) * BM; const float sc = isq ? QSCALE : 1.0f;
            const bool rot = (fq == 0);
            f32x4 cv[2][4], sv[2][4];
#pragma unroll
            for (int ai = 0; ai < 2; ++ai)
#pragma unroll
                for (int m = 0; m < 4; ++m) { const float* cr = cs + (size_t)(row0 + ai * HALF + m * 16) * 32 + 4 * wc; cv[ai][m] = *(const f32x4*)cr; sv[ai][m] = *(const f32x4*)(cr + 16); }
#pragma unroll
            for (int ai = 0; ai < 2; ++ai)
#pragma unroll
                for (int m = 0; m < 4; ++m) {
                    const f32x4 c = rot ? cv[ai][m] * sc : (f32x4){sc, sc, sc, sc}, sn = rot ? sv[ai][m] * sc : (f32x4){0.f, 0.f, 0.f, 0.f};
                    bf16_t* rowp = base + (size_t)(row0 + ai * HALF + m * 16) * 1024 + colt + lc;
#pragma unroll
                    for (int bj = 0; bj < 2; ++bj) { const f32x4 v0 = acc[ai][bj][m][0], v1 = acc[ai][bj][m][1];
                        ST16((rowp + bj * HALF), (pack8(v0 * c - v1 * sn, v0 * sn + v1 * c))); }
                }
        } else if (pn < 36) {
            const int tv = pn - 24, colt = (tv & 3) * BM; bf16_t* vbase = V + (size_t)(tv >> 2) * M * 1024;
#pragma unroll
            for (int ai = 0; ai < 2; ++ai)
#pragma unroll
                for (int m = 0; m < 4; ++m) { bf16_t* rowp = vbase + (size_t)(row0 + ai * HALF + m * 16) * 1024 + colt + lc;
#pragma unroll
                    for (int bj = 0; bj < 2; ++bj) ST16((rowp + bj * HALF), (pack8(acc[ai][bj][m][0], acc[ai][bj][m][1]))); }
        } else if (pn < 40) {
            const int colt = (pn - 36) * BM;
#pragma unroll
            for (int ai = 0; ai < 2; ++ai)
#pragma unroll
                for (int m = 0; m < 4; ++m) { bf16_t* rowp = SZ + (size_t)(row0 + ai * HALF + m * 16) * NZA + colt + lc;
#pragma unroll
                    for (int bj = 0; bj < 2; ++bj) { f32x4 a = acc[ai][bj][m][0], b = acc[ai][bj][m][1];
#pragma unroll
                        for (int j = 0; j < 4; ++j) { a[j] = silu_f(a[j]); b[j] = silu_f(b[j]); }
                        ST16((rowp + bj * HALF), (pack8(a, b))); } }
        } else if (pn < 72) {
            int chl = 16 * wc + 4 * fq; asm volatile("" : "+v"(chl));
            const int ct = pn - 40, chb = 64 * ct + chl, pm = u.pm;
            const f32x4 w0 = *(const f32x4*)(cw + chb), w1 = *(const f32x4*)(cw + NCV + chb), w2 = *(const f32x4*)(cw + 2 * NCV + chb);
#pragma unroll
            for (int ai = 0; ai < 2; ++ai)
#pragma unroll
                for (int m = 0; m < 4; ++m) { const f32x4 pv = acc[ai][0][m][1] * acc[ai][1][m][0];
                    const int gi = 8 * ai + 4 * wr + m;
                    if (fr >= 14) { *(LAS f32x4*)(halo + (size_t)(((gi * 2 + (fr - 14)) * 64 + chl) * 4)) = pv;
                        if (gi == 15) *(f32x4*)(HP + ((size_t)(pm * 2 + (fr - 14)) * NCV + chb)) = pv; } }
            asm volatile("s_waitcnt lgkmcnt(0)" ::: "memory"); __builtin_amdgcn_s_barrier(); asm volatile("" ::: "memory");
#pragma unroll
            for (int ai = 0; ai < 2; ++ai)
#pragma unroll
                for (int m = 0; m < 4; ++m) {
                    const int gi = 8 * ai + 4 * wr + m; const int gp = gi > 0 ? gi - 1 : 0;
                    f32x4 H0 = *(const LAS f32x4*)(halo + (size_t)(((gp * 2 + 0) * 64 + chl) * 4)), H1 = *(const LAS f32x4*)(halo + (size_t)(((gp * 2 + 1) * 64 + chl) * 4));
                    if (gi == 0) { H0 = (f32x4){0.f, 0.f, 0.f, 0.f}; H1 = H0; }
                    const f32x4 Hs = (fr == 1) ? H1 : H0, pvv = acc[ai][0][m][1] * acc[ai][1][m][0];
                    f32x4 Pm1, Pm2, qv;
#pragma unroll
                    for (int j = 0; j < 4; ++j) {
                        const float pj = pvv[j], h1j = H1[j], hsj = Hs[j];
                        Pm1[j] = dpp_row_shr<0x111>(h1j, pj); Pm2[j] = dpp_row_shr<0x112>(hsj, pj);
                        qv[j] = acc[ai][0][m][0][j] * silu_f(acc[ai][1][m][1][j]); }
                    const f32x4 uu = w2 * pvv + w1 * Pm1 + w0 * Pm2, rv = qv * uu;
                    const size_t ro = (size_t)(row0 + ai * HALF + m * 16) * NCV + chb;
                    u32x2 rw; rw.x = cvt_pk_bf16(rv[0], rv[1]); rw.y = cvt_pk_bf16(rv[2], rv[3]);
                    ST8((R + ro), (rw));
                    if (gi == 0 && fr < 2 && pm > 0) { *(f32x4*)(FXQ + ((size_t)(pm * 2 + fr) * NCV + chb)) = qv; *(f32x4*)(FXU + ((size_t)(pm * 2 + fr) * NCV + chb)) = uu; }
                }
        } else {
            const int colt = (pn - 72) * HALF;
#pragma unroll
            for (int ai = 0; ai < 2; ++ai)
#pragma unroll
                for (int m = 0; m < 4; ++m) { const size_t ro = (size_t)(row0 + ai * HALF + m * 16) * D + colt + lc;
                    f32x4 r[2], c[2];
#pragma unroll
                    for (int n = 0; n < 2; ++n)
#pragma unroll
                        for (int j = 0; j < 4; ++j) { const float ec = __builtin_amdgcn_exp2f(-acc[ai][1][m][n][j] * LOG2E); c[n][j] = __builtin_amdgcn_rcpf(1.0f + ec); r[n][j] = sigm_f(acc[ai][0][m][n][j]) * (1.0f + ec); }
                    ST16((SGA + ro), (pack8(r[0], r[1]))); ST16((SGC + ro), (pack8(c[0], c[1]))); }
        }
    }
};
struct EpiMerge {
    static constexpr bool PERM = true;
    bf16_t* O; const bf16_t* RHO; const bf16_t* SC; int ldc;
    __device__ __forceinline__ size_t lane_off(const Unit& u, int wr, int wc, int fr, int fq, int ai) const {
        size_t o = (size_t)(u.pm * BM + wr * 64 + fr + ai * HALF) * ldc + u.pn * BM + wc * 32 + 8 * fq; asm volatile("" : "+v"(o)); return o; }
    __device__ __forceinline__ void scale(f32x4 (&acc)[2][2][4][2], const Unit& u, int wr, int wc, int fr, int fq, bool is_mid) const {
        const bf16_t* G = is_mid ? RHO : SC;
#pragma unroll
        for (int ai = 0; ai < 2; ++ai) {
            const bf16_t* p = G + lane_off(u, wr, wc, fr, fq, ai);
            u32x4 gw[4][2];
#pragma unroll
            for (int m = 0; m < 4; ++m)
#pragma unroll
                for (int bj = 0; bj < 2; ++bj) gw[m][bj] = *(const u32x4*)(p + (size_t)m * 16 * ldc + bj * HALF);
#pragma unroll
            for (int m = 0; m < 4; ++m)
#pragma unroll
                for (int bj = 0; bj < 2; ++bj) { f32x4 g0, g1; unpack8(gw[m][bj], g0, g1); acc[ai][bj][m][0] *= g0; acc[ai][bj][m][1] *= g1; }
        }
    }
    __device__ __forceinline__ void mid(f32x4 (&)[2][2][4][2], const Unit&, int, int, int, int) const {}
    __device__ __forceinline__ void operator()(const f32x4 (&acc)[2][2][4][2], const Unit& u, int wr, int wc, int fr, int fq) const {
#pragma unroll
        for (int ai = 0; ai < 2; ++ai) {
            bf16_t* q = O + lane_off(u, wr, wc, fr, fq, ai);
#pragma unroll
            for (int m = 0; m < 4; ++m)
#pragma unroll
                for (int bj = 0; bj < 2; ++bj) *(u32x4*)(q + (size_t)m * 16 * ldc + bj * HALF) = pack8(acc[ai][bj][m][0], acc[ai][bj][m][1]);
        }
    }
};
struct EpiBf16 {
    static constexpr bool PERM = true;
    __device__ __forceinline__ void mid(f32x4 (&)[2][2][4][2], const Unit&, int, int, int, int) const {}
    bf16_t* O; int ldc;
    __device__ __forceinline__ void operator()(const f32x4 (&acc)[2][2][4][2], const Unit& u, int wr, int wc, int fr, int fq) const {
        const int row0 = u.pm * BM + wr * 64 + fr, col0 = u.pn * BM + wc * 32 + 8 * fq;
#pragma unroll
        for (int ai = 0; ai < 2; ++ai)
#pragma unroll
            for (int m = 0; m < 4; ++m) { bf16_t* rowp = O + (size_t)(row0 + ai * HALF + m * 16) * ldc + col0;
#pragma unroll
                for (int bj = 0; bj < 2; ++bj) *(u32x4*)(rowp + bj * HALF) = pack8(acc[ai][bj][m][0], acc[ai][bj][m][1]); }
    }
};
struct SegOrder2 {
    StaticOrder so; const char *A0, *B0, *A1, *B1; size_t tstep; int nt0, nt1;
    __device__ __forceinline__ bool seg(int s_, Seg& o) const { Unit u; if (!so.next(s_ >> 1, u)) return false; const int h = s_ & 1;
        o.A = (h ? A1 : A0) + (size_t)u.pm * tstep; o.B = (h ? B1 : B0) + (size_t)u.pn * tstep; o.nt = h ? nt1 : nt0; o.mid = !h; o.u = u; rfl_seg(o); return true; }
};
}

#ifndef PG8_SP2
#define PG8_SP2 true
#endif
#ifndef PG8_ALIGN
#define PG8_ALIGN true
#endif

constexpr int NWAVES = 8;
#ifndef MK_N_LAUNCHES
#define MK_N_LAUNCHES 1
#endif
constexpr int NPHASES = 8;
constexpr int N_LAUNCHES = MK_N_LAUNCHES;

constexpr int CW_BAR = 4096;
#define XCD_BAR_WORDS 3456

constexpr int RING_BYTES = 131072;
constexpr int LDSCTL_OFF = RING_BYTES, MISC_OFF = LDSCTL_OFF + 320, HALO_OFF = RING_BYTES + 1024;
constexpr int LDS_BYTES = 147456;

typedef GAS unsigned gu32;
#define RLX_AGENT __ATOMIC_RELAXED, __HIP_MEMORY_SCOPE_AGENT

#define XB_TMO      128
#define XB_XCNT(j)  (256  + 64 * (j))
#define XB_XSUB(j)  (1280 + 64 * (j))
#define XB_XGEN(j)  (2304 + 64 * (j))
#define XB_TOP      3328
#define XB_TOPGEN   3392
#define XB_SPIN_CAP (1u << 18)

__device__ __forceinline__ unsigned xb_ld(unsigned* p)              { return __hip_atomic_load(p, __ATOMIC_RELAXED, __HIP_MEMORY_SCOPE_AGENT); }
__device__ __forceinline__ unsigned xb_add(unsigned* p, unsigned v) { return __hip_atomic_fetch_add(p, v, __ATOMIC_RELAXED, __HIP_MEMORY_SCOPE_AGENT); }
__device__ __forceinline__ unsigned xb_xcc_id() { return (unsigned)__builtin_amdgcn_s_getreg((3 << 11) | 20) & 0xFu; }
#define XB_SPIN(cond, bar) do { unsigned _sp = 0; while (cond) { __builtin_amdgcn_s_sleep(1); \
    if ((++_sp & 255u) == 0u) { if (xb_ld(&(bar)[XB_TMO])) break; if (_sp > XB_SPIN_CAP) { atomicAdd(&(bar)[XB_TMO], 1u); break; } } } } while (0)

struct XcdBarrier { unsigned* bar; unsigned x; volatile LAS unsigned* st; };

__device__ __forceinline__ XcdBarrier xcd_barrier_post(unsigned* bar, volatile LAS unsigned* st) {
    XcdBarrier b; b.bar = bar; b.x = xb_xcc_id(); b.st = st;
    if (threadIdx.x == 0) (void)xb_add(&bar[XB_XCNT(b.x)], 1u);
    return b;
}
__device__ __forceinline__ void xcd_barrier_complete(unsigned* bar, unsigned x, unsigned& nloc, unsigned& nx) {
    const unsigned G = gridDim.x * gridDim.y * gridDim.z;
    unsigned sum, cnt, mine, sp = 0u;
    for (;;) {
        sum = 0u; cnt = 0u; mine = 0u;
#pragma unroll
        for (unsigned j = 0; j < 16; ++j) { const unsigned c = xb_ld(&bar[XB_XCNT(j)]); sum += c; cnt += (c > 0u) ? 1u : 0u; mine = (j == x) ? c : mine; }
        if (sum == G) break;
        __builtin_amdgcn_s_sleep(1);
        if ((++sp & 255u) == 0u) { if (xb_ld(&bar[XB_TMO])) break; if (sp > XB_SPIN_CAP) { atomicAdd(&bar[XB_TMO], 1u); break; } }
    }
    nloc = mine > 0u ? mine : 1u; nx = cnt > 0u ? cnt : 1u;
}
__device__ __forceinline__ void xcd_barrier(const XcdBarrier& b) {
    asm volatile("s_waitcnt vmcnt(0)" ::: "memory");
    __syncthreads();
    if (threadIdx.x == 0) {
        unsigned* bar = b.bar;
        __builtin_amdgcn_s_waitcnt(0);
        unsigned nloc = b.st[0], nx = b.st[1];
        if (nloc == 0u) { xcd_barrier_complete(bar, b.x, nloc, nx); b.st[0] = nloc; b.st[1] = nx; }
        const unsigned old = xb_add(&bar[XB_XSUB(b.x)], 1u);
        const unsigned gen = old / nloc;
        if (old + 1u == (gen + 1u) * nloc) {
            __builtin_amdgcn_fence(__ATOMIC_RELEASE, "agent");
            asm volatile("s_waitcnt vmcnt(0)" ::: "memory");
            const unsigned og = xb_add(&bar[XB_TOP], 1u);
            const unsigned tg = og / nx;
            if (og + 1u == (tg + 1u) * nx) xb_add(&bar[XB_TOPGEN], 1u);
            else XB_SPIN(xb_ld(&bar[XB_TOPGEN]) == tg, bar);
            __builtin_amdgcn_fence(__ATOMIC_ACQUIRE, "agent");
            xb_add(&bar[XB_XGEN(b.x)], 1u);
            asm volatile("s_waitcnt vmcnt(0)" ::: "memory");
        } else {
            XB_SPIN(xb_ld(&bar[XB_XGEN(b.x)]) == gen, bar);
            __builtin_amdgcn_fence(__ATOMIC_ACQUIRE, "agent");
            asm volatile("s_waitcnt vmcnt(0)" ::: "memory");
        }
    }
    __syncthreads();
}

#define LDS_WAIT() asm volatile("s_waitcnt lgkmcnt(0)" ::: "memory")
__device__ __forceinline__ float wave_sum(float v) {
#pragma unroll
    for (int o = 1; o < 64; o <<= 1) v += __shfl_xor(v, o);
    return v;
}
__device__ __forceinline__ unsigned f2bf(float f) { unsigned u = __builtin_bit_cast(unsigned, f); return (u + 0x7fffu + ((u >> 16) & 1u)) >> 16; }
__device__ __forceinline__ unsigned pk2(float lo, float hi) { return f2bf(lo) | (f2bf(hi) << 16); }

__device__ __forceinline__ int proj_orig_col(int n) {
    const int tile = n >> 8, c = n & 255;
    if (tile < 24) { const int c7 = n & 127, wc = c7 >> 5, fq = (c7 >> 3) & 3, nn = (c7 >> 2) & 1, j = c7 & 3;
        const int dim = (fq == 0) ? (4 * wc + j + 16 * nn) : (32 + wc * 24 + (fq - 1) * 8 + 4 * nn + j); return (n & ~127) + dim; }
    if (tile < 40) return n;
    if (tile < 72) { const int kind = 2 * (c >> 7) + ((c >> 2) & 1), chl = 16 * ((c >> 5) & 3) + 4 * ((c >> 3) & 3) + (c & 3); return 10240 + kind * 2048 + 64 * (tile - 40) + chl; }
    return 18432 + (c >> 7) * 2048 + 128 * (tile - 72) + (c & 127);
}
template <bool REMAP>
__device__ __forceinline__ void p0_transpose_item(const float* W, int K, int N, bf16_t* WT, int pitch, LAS float* scr, int item, int lane) {
    const int nblk = N / 32, kb = item / nblk, nb = item % nblk, k0 = 64 * kb, n0 = 32 * nb;
    const int ncol = REMAP ? proj_orig_col(n0 + (lane & 31)) : n0 + (lane & 31);
#pragma unroll 8
    for (int i = 0; i < 32; ++i) { const int kk = 2 * i + (lane >> 5); scr[kk * 33 + (lane & 31)] = W[(size_t)(k0 + kk) * N + ncol]; }
    LDS_WAIT(); asm volatile("" ::: "memory");
    const int c = lane & 7;
#pragma unroll
    for (int j = 0; j < 4; ++j) { const int n = (lane >> 3) + 8 * j; const LAS float* s = scr + (8 * c) * 33 + n;
        u32x4 o; o.x = pk2(s[0 * 33], s[1 * 33]); o.y = pk2(s[2 * 33], s[3 * 33]); o.z = pk2(s[4 * 33], s[5 * 33]); o.w = pk2(s[6 * 33], s[7 * 33]);
        *(u32x4*)(WT + (size_t)(n0 + n) * pitch + k0 + 8 * c) = o; }
    LDS_WAIT(); asm volatile("" ::: "memory");
}

__device__ __forceinline__ void sincos_f64(float ang, float& s, float& c) {
    const double x = (double)ang;
    const double n = __builtin_rint(x * 0.15915494309189535);
    double r = __builtin_fma(-n, 6.283185307179586, x); r = __builtin_fma(-n, 2.4492935982947064e-16, r);
    const double r2 = r * r;
    double ps = 1.0 / 51090942171709440000.0;
    ps = __builtin_fma(ps, r2, -1.0 / 121645100408832000.0);
    ps = __builtin_fma(ps, r2, 1.0 / 355687428096000.0);
    ps = __builtin_fma(ps, r2, -1.0 / 1307674368000.0);
    ps = __builtin_fma(ps, r2, 1.0 / 6227020800.0);
    ps = __builtin_fma(ps, r2, -1.0 / 39916800.0);
    ps = __builtin_fma(ps, r2, 1.0 / 362880.0);
    ps = __builtin_fma(ps, r2, -1.0 / 5040.0);
    ps = __builtin_fma(ps, r2, 1.0 / 120.0);
    ps = __builtin_fma(ps, r2, -1.0 / 6.0);
    ps = __builtin_fma(ps, r2, 1.0);
    double pc = -1.0 / 1124000727777607680000.0;
    pc = __builtin_fma(pc, r2, 1.0 / 2432902008176640000.0);
    pc = __builtin_fma(pc, r2, -1.0 / 6402373705728000.0);
    pc = __builtin_fma(pc, r2, 1.0 / 20922789888000.0);
    pc = __builtin_fma(pc, r2, -1.0 / 87178291200.0);
    pc = __builtin_fma(pc, r2, 1.0 / 479001600.0);
    pc = __builtin_fma(pc, r2, -1.0 / 3628800.0);
    pc = __builtin_fma(pc, r2, 1.0 / 40320.0);
    pc = __builtin_fma(pc, r2, -1.0 / 720.0);
    pc = __builtin_fma(pc, r2, 1.0 / 24.0);
    pc = __builtin_fma(pc, r2, -0.5);
    pc = __builtin_fma(pc, r2, 1.0);
    s = (float)(r * ps); c = (float)pc;
}

__device__ __forceinline__ unsigned attn_offk(unsigned slot, unsigned row, unsigned ch) { return slot * 32768u + 256u * row + 16u * (ch ^ (row & 15u)); }
__device__ __forceinline__ unsigned attn_offv(unsigned slot, unsigned lrow, unsigned ch) { return 65536u + slot * 32768u + 256u * lrow + 16u * (ch ^ (((lrow & 3u) << 2) | ((lrow >> 2) & 3u))); }
__device__ __forceinline__ unsigned attn_lrow(unsigned k) { return (k & ~31u) | (((k >> 2) & 3u) << 3) | (((k >> 4) & 1u) << 2) | (k & 3u); }

template <bool COMBINE>
__device__ __forceinline__ void attn_chunk(LAS unsigned char* lds, const bf16_t* Qg, const bf16_t* Kg, const bf16_t* Vg, const int dsh, const int hh, const int r, const int n0, const int nblk,
                                           bf16_t* Og, float* LSEg, const bf16_t* O1, const bf16_t* O2, const float* LSE1, const float* LSE2, const bf16_t* SZ, bf16_t* AATT) {
    const int tid = threadIdx.x, lane = tid & 63, wid = __builtin_amdgcn_readfirstlane(tid >> 6), fr = lane & 15, fq = lane >> 4;
    const int sch = tid & 15, srb = tid >> 4;
    const size_t scol = (size_t)hh * 256 + sch * 16;
    u32x4 kreg[4], vreg[4];
#define ATT_LOAD(blk) do { _Pragma("unroll") for (int i = 0; i < 4; ++i) { const size_t p = ((size_t)(128 * (blk) + srb + 32 * i) << dsh) + r; const size_t off = p * 2048 + scol; \
        kreg[i] = *(const u32x4*)((const char*)Kg + off); vreg[i] = *(const u32x4*)((const char*)Vg + off); } } while (0)
#define ATT_WRITE(slot) do { _Pragma("unroll") for (int i = 0; i < 4; ++i) { const unsigned row = srb + 32 * i; \
        *(LAS u32x4*)(lds + attn_offk((slot), row, sch)) = kreg[i]; *(LAS u32x4*)(lds + attn_offv((slot), attn_lrow(row), sch)) = vreg[i]; } } while (0)
    const unsigned q4 = (unsigned)(lane & 15) >> 2, p4 = (unsigned)lane & 3u, parA = (unsigned)wid & 1u, parB = parA ^ 1u;
    unsigned kbase[4], vbA[8], vbB[8];
#pragma unroll
    for (int s_ = 0; s_ < 4; ++s_) kbase[s_] = 256u * fr + 16u * ((unsigned)(4 * s_ + fq) ^ (unsigned)fr);
#pragma unroll
    for (int c = 0; c < 8; ++c) {
        vbA[c] = 65536u + 256u * (((unsigned)fq << 3) | (parA << 2) | q4) + 16u * ((unsigned)(2 * c + (p4 >> 1)) ^ ((q4 << 2) | (((unsigned)fq & 1u) << 1) | parA)) + 8u * (p4 & 1u);
        vbB[c] = 65536u + 256u * (((unsigned)fq << 3) | (parB << 2) | q4) + 16u * ((unsigned)(2 * c + (p4 >> 1)) ^ ((q4 << 2) | (((unsigned)fq & 1u) << 1) | parB)) + 8u * (p4 & 1u);
    }
    if (n0 > 0) { ATT_LOAD(n0 - 1); }
    else {
#pragma unroll
        for (int i = 0; i < 4; ++i) { kreg[i] = (u32x4){0u, 0u, 0u, 0u}; vreg[i] = (u32x4){0u, 0u, 0u, 0u}; } }
    ATT_WRITE((unsigned)((n0 + 1) & 1));
    ATT_LOAD(n0); ATT_WRITE((unsigned)(n0 & 1));
    __syncthreads();
    for (int n = n0; n < n0 + nblk; ++n) {
        const bool more = (n + 1 < n0 + nblk);
        if (more) ATT_LOAD(n + 1);
        const unsigned cs_ = (unsigned)(n & 1), ps_ = cs_ ^ 1u;
        const int lq = 128 * n + 16 * wid + fr; const size_t pq = ((size_t)lq << dsh) + r;
        bf16x8 qf[4];
        { const bf16x8* qp = (const bf16x8*)((const char*)Qg + pq * 2048 + (size_t)hh * 256 + fq * 16);
#pragma unroll
          for (int s = 0; s < 4; ++s) qf[s] = qp[4 * s]; }
        f32x4 S[9];
#pragma unroll
        for (int t = 0; t < 9; ++t) {
            S[t] = (f32x4){0.f, 0.f, 0.f, 0.f};
            const unsigned kr0 = 16 * wid + 16 * t, uo = ((kr0 < 128u) ? ps_ : cs_) * 32768u + 256u * (kr0 & 127u);
#pragma unroll
            for (int s = 0; s < 4; ++s) { const bf16x8 kf = *(const LAS bf16x8*)(lds + (kbase[s] + uo)); S[t] = __builtin_amdgcn_mfma_f32_16x16x32_bf16(kf, qf[s], S[t], 0, 0, 0); }
        }
        const float NEG = -1e30f;
#pragma unroll
        for (int j = 0; j < 4; ++j) { const int ko0 = 4 * fq + j; if (ko0 < fr) S[0][j] = NEG; if (ko0 > fr) S[8][j] = NEG; }
        if (n == 0) {
#pragma unroll
            for (int t = 0; t < 9; ++t)
#pragma unroll
                for (int j = 0; j < 4; ++j) { if (16 * wid + 16 * t + 4 * fq + j < 128) S[t][j] = NEG; }
        }
        float mx = NEG;
#pragma unroll
        for (int t = 0; t < 9; ++t) mx = fmaxf(mx, fmaxf(fmaxf(S[t][0], S[t][1]), fmaxf(S[t][2], S[t][3])));
        mx = fmaxf(mx, __shfl_xor(mx, 16)); mx = fmaxf(mx, __shfl_xor(mx, 32));
        float sum = 0.f;
#pragma unroll
        for (int t = 0; t < 9; ++t)
#pragma unroll
            for (int j = 0; j < 4; ++j) { const float p = __builtin_amdgcn_exp2f(S[t][j] - mx); S[t][j] = p; sum += p; }
        sum += __shfl_xor(sum, 16); sum += __shfl_xor(sum, 32);
        u32x2 o1w[8], o2w[8], szw[8]; float l1 = 0.f, l2 = 0.f;
        if (COMBINE) {
            asm volatile("" ::: "memory");
            const size_t eo = pq * 1024 + hh * 128 + 4 * fq;
#pragma unroll
            for (int c = 0; c < 8; ++c) { o1w[c] = *(const u32x2*)(O1 + eo + 16 * c); o2w[c] = *(const u32x2*)(O2 + eo + 16 * c); szw[c] = *(const u32x2*)(SZ + eo + 16 * c); }
            l1 = LSE1[pq * 8 + hh]; l2 = LSE2[pq * 8 + hh];
        }
        f32x4 O[8];
#pragma unroll
        for (int c = 0; c < 8; ++c) O[c] = (f32x4){0.f, 0.f, 0.f, 0.f};
#pragma unroll
        for (int u = 0; u < 5; ++u) {
            u32x4 pw; pw.x = cvt_pk_bf16(S[2 * u][0], S[2 * u][1]); pw.y = cvt_pk_bf16(S[2 * u][2], S[2 * u][3]);
            if (u < 4) { pw.z = cvt_pk_bf16(S[2 * u + 1][0], S[2 * u + 1][1]); pw.w = cvt_pk_bf16(S[2 * u + 1][2], S[2 * u + 1][3]); } else { pw.z = 0u; pw.w = 0u; }
            const bf16x8 pf = __builtin_bit_cast(bf16x8, pw);
            const unsigned kba = 16 * wid + 32 * u, kbb = kba + 16;
            const unsigned uoa = ((kba < 128u) ? ps_ : cs_) * 32768u + 256u * (kba & 96u), uob = ((kbb < 128u) ? ps_ : cs_) * 32768u + 256u * (kbb & 96u);
#pragma unroll
            for (int c = 0; c < 8; ++c) {
                const s16x4 va = __builtin_amdgcn_ds_read_tr16_b64_v4i16((LAS s16x4*)(lds + (vbA[c] + uoa)));
                const s16x4 vb = __builtin_amdgcn_ds_read_tr16_b64_v4i16((LAS s16x4*)(lds + ((u < 4) ? (vbB[c] + uob) : (vbA[c] + uoa))));
                const bf16x8 vf = __builtin_shufflevector(va, vb, 0, 1, 2, 3, 4, 5, 6, 7);
                O[c] = __builtin_amdgcn_mfma_f32_16x16x32_bf16(vf, pf, O[c], 0, 0, 0);
            }
        }
        const float inv = 1.0f / sum;
        if (!COMBINE) {
            bf16_t* op = Og + pq * 1024 + hh * 128 + 4 * fq;
#pragma unroll
            for (int c = 0; c < 8; ++c) { u32x2 w; w.x = cvt_pk_bf16(O[c][0] * inv, O[c][1] * inv); w.y = cvt_pk_bf16(O[c][2] * inv, O[c][3] * inv); *(u32x2*)(op + 16 * c) = w; }
            if (fq == 0) LSEg[pq * 8 + hh] = mx + __builtin_amdgcn_logf(sum);
        } else {
            const float l0 = mx + __builtin_amdgcn_logf(sum), m3 = fmaxf(l0, fmaxf(l1, l2));
            float w0 = __builtin_amdgcn_exp2f(l0 - m3), w1 = __builtin_amdgcn_exp2f(l1 - m3), w2 = __builtin_amdgcn_exp2f(l2 - m3);
            const float iw = 1.0f / (w0 + w1 + w2); w0 *= iw * inv; w1 *= iw; w2 *= iw;
            bf16_t* ap = AATT + pq * 2048 + hh * 128 + 4 * fq;
#pragma unroll
            for (int c = 0; c < 8; ++c) {
                const f32x4 a1 = (f32x4){bf_lo(o1w[c].x), bf_hi(o1w[c].x), bf_lo(o1w[c].y), bf_hi(o1w[c].y)}, a2 = (f32x4){bf_lo(o2w[c].x), bf_hi(o2w[c].x), bf_lo(o2w[c].y), bf_hi(o2w[c].y)};
                const f32x4 zz = (f32x4){bf_lo(szw[c].x), bf_hi(szw[c].x), bf_lo(szw[c].y), bf_hi(szw[c].y)};
                const f32x4 res = (O[c] * w0 + a1 * w1 + a2 * w2) * zz;
                u32x2 w; w.x = cvt_pk_bf16(res[0], res[1]); w.y = cvt_pk_bf16(res[2], res[3]); *(u32x2*)(ap + 16 * c) = w;
            }
        }
        __syncthreads();
        if (more) ATT_WRITE(ps_);
        __syncthreads();
    }
#undef ATT_LOAD
#undef ATT_WRITE
}

struct Args { const float* x; const float* c; const int* pos; const float* g_pre; const float* w_ada; const float* b_ada; const float* w_in; const float* conv_w;
              const float* w_attn_o; const float* w_conv_o; const float* w_o; const float* g_post; float* out; unsigned char* ws; int ph_lo, ph_hi, li, pad; };

__global__ void __launch_bounds__(NWAVES * 64, 2) mk_fwd(Args args) {
    extern __shared__ __attribute__((aligned(16))) unsigned char lds_raw[];
    LAS unsigned char* lds = (LAS unsigned char*)lds_raw;
    volatile LAS unsigned* MISC = (volatile LAS unsigned*)(lds + MISC_OFF);
    const int tid = threadIdx.x, lane = tid & 63, wave = __builtin_amdgcn_readfirstlane(tid >> 6);
    const int G = gridDim.x; const int bx = blockIdx.x; const int vcu = (G % 8 == 0) ? (bx % 8) * (G / 8) + bx / 8 : bx;
    unsigned char* ws = args.ws;
    gu32* ctl = (gu32*)(ws + WS_CTL);
    float* mod = (float*)(ws + WS_MOD); float* cs = (float*)(ws + WS_CS);
    bf16_t* WinT = (bf16_t*)(ws + WS_WIN); bf16_t* WaT = (bf16_t*)(ws + WS_WA); bf16_t* WcT = (bf16_t*)(ws + WS_WC); bf16_t* WoT = (bf16_t*)(ws + WS_WO);
    bf16_t* Hb = (bf16_t*)(ws + WS_H); bf16_t* Qb = (bf16_t*)(ws + WS_Q); bf16_t* Kb = (bf16_t*)(ws + WS_K); bf16_t* Vb = (bf16_t*)(ws + WS_V);
    bf16_t* SZ = (bf16_t*)(ws + WS_SZ); float* HPb = (float*)(ws + WS_FX); float* FXQb = HPb + (size_t)64 * 2 * NCV; float* FXUb = FXQb + (size_t)64 * 2 * NCV;
    bf16_t* SGA = (bf16_t*)args.out; bf16_t* SGC = SGA + (size_t)M * D;
    bf16_t* O1 = (bf16_t*)(ws + WS_O1); bf16_t* O2 = (bf16_t*)(ws + WS_O2); float* LSE = (float*)(ws + WS_LSE);
    bf16_t* AATT = (bf16_t*)(ws + WS_AATT); bf16_t* Rb = (bf16_t*)(ws + WS_R); bf16_t* MG = (bf16_t*)(ws + WS_MG);
    bf16_t* Yb = (bf16_t*)(ws + WS_Y);

    for (int u = tid; u < (LDS_BYTES - LDSCTL_OFF) / 4; u += NWAVES * 64) ((LAS unsigned*)(lds + LDSCTL_OFF))[u] = 0u;
    __syncthreads();
    const int bli = (N_LAUNCHES == 1) ? 0 : args.li;
    XcdBarrier bar; bar.bar = (unsigned*)(ctl + CW_BAR) + bli * XCD_BAR_WORDS; bar.x = 0; bar.st = nullptr;
    if (N_LAUNCHES == 1) bar = xcd_barrier_post((unsigned*)(ctl + CW_BAR), MISC + 8);
    const int lo = args.ph_lo, hi = args.ph_hi;
#define IN(k) (lo <= (k) && (k) < hi)
#define BOTH(k) (IN(k) && IN((k) + 1))
#define GRID_BAR() xcd_barrier(bar)
#ifndef PROBE_REPEAT_MASK
#define PROBE_REPEAT_MASK 0
#endif
#define NREP(k) ((((PROBE_REPEAT_MASK) >> (k)) & 1) + 1)
#if defined(PROBE_PH) || defined(PROBE_ARRIVE)
#define PHSTAMP(k) do { if (bx == 0 && tid == 0) ((unsigned long long*)(ws + WS_MOD + 65536))[16 + (k)] = __builtin_amdgcn_s_memrealtime(); } while (0)
#else
#define PHSTAMP(k) do {} while (0)
#endif
    PHSTAMP(0);
    const int gw = vcu * NWAVES + wave, NGW = G * NWAVES;
    const int gtid = vcu * (NWAVES * 64) + tid, NT = G * NWAVES * 64;

    if (IN(0)) for (int rep = 0; rep < NREP(0); ++rep) {
        {
            LAS float* red = (LAS float*)lds;
            for (int cbk = bx; cbk < 256; cbk += G) {
                const int c4 = tid % 6, rg = tid / 6;
                f32x4 a = (f32x4){0.f, 0.f, 0.f, 0.f};
                if (rg < 85) { for (int k = rg; k < D; k += 85) { const float cv = args.c[k]; const f32x4 w = *(const f32x4*)(args.w_ada + (size_t)k * NMOD + cbk * 24 + c4 * 4); a += w * cv; }
                    *(LAS f32x4*)(red + (rg * 6 + c4) * 4) = a; }
                __syncthreads();
                if (tid < 24) { float s = 0.f; for (int i = 0; i < 85; ++i) s += red[(i * 6 + (tid >> 2)) * 4 + (tid & 3)]; mod[cbk * 24 + tid] = s + args.b_ada[cbk * 24 + tid]; }
                __syncthreads();
            }
        }
        for (int idx = gtid; idx < M * 16; idx += NT) { const int m = idx >> 4, i = idx & 15; const float ang = (float)args.pos[m] * INVF[i]; float s, c; sincos_f64(ang, s, c); cs[m * 32 + i] = c; cs[m * 32 + 16 + i] = s; }
        {
            LAS float* scr = (LAS float*)(lds + wave * 16384);
            constexpr int I_IN = (D / 64) * (PROJ / 32), I_A = (NZA / 64) * (D / 32), I_C = (NCV / 64) * (D / 32), I_O = (D / 64) * (D / 32);
            constexpr int NITEMS = I_IN + I_A + I_C + I_O;
            for (int it = gw; it < NITEMS; it += NGW) {
                int r = it;
                if (r < I_IN) { p0_transpose_item<true>(args.w_in, D, PROJ, WinT, D, scr, r, lane); continue; } r -= I_IN;
                if (r < I_A) { p0_transpose_item<false>(args.w_attn_o, NZA, D, WaT, D, scr, r, lane); continue; } r -= I_A;
                if (r < I_C) { p0_transpose_item<false>(args.w_conv_o, NCV, D, WcT, D, scr, r, lane); continue; } r -= I_C;
                p0_transpose_item<false>(args.w_o, D, D, WoT, D, scr, r, lane);
            }
        }
        if (BOTH(0) || rep + 1 < NREP(0)) GRID_BAR();
    }
    PHSTAMP(1);
    if (IN(1)) for (int rep = 0; rep < NREP(1); ++rep) {
        f32x4 av[4][2], bv[4][2];
#pragma unroll
        for (int j = 0; j < 4; ++j)
#pragma unroll
            for (int h = 0; h < 2; ++h) { const int k = 512 * j + 8 * lane + 4 * h; const f32x4 gp = *(const f32x4*)(args.g_pre + k), sc = *(const f32x4*)(mod + D + k); av[j][h] = gp * (sc + 1.0f); bv[j][h] = *(const f32x4*)(mod + k); }
        for (int m = gw; m < M; m += NGW) {
            const float* xr = args.x + (size_t)m * D + 8 * lane;
            f32x4 v[4][2]; float ss = 0.f;
#pragma unroll
            for (int j = 0; j < 4; ++j)
#pragma unroll
                for (int h = 0; h < 2; ++h) { v[j][h] = *(const f32x4*)(xr + 512 * j + 4 * h); const f32x4 q = v[j][h] * v[j][h]; ss += (q[0] + q[1]) + (q[2] + q[3]); }
            const float rstd = 1.0f / sqrtf(wave_sum(ss) * (1.0f / D) + EPS);
            bf16_t* hr = Hb + (size_t)m * D + 8 * lane;
#pragma unroll
            for (int j = 0; j < 4; ++j) { const f32x4 h0 = v[j][0] * rstd * av[j][0] + bv[j][0], h1 = v[j][1] * rstd * av[j][1] + bv[j][1]; *(u32x4*)(hr + 512 * j) = pg8::pack8(h0, h1); }
        }
        if (BOTH(1) || rep + 1 < NREP(1)) GRID_BAR();
    }
    PHSTAMP(2);
    if (IN(2)) {
        pg8::SegOrder1 S; S.so.init(M, PROJ, G, bx, NREP(2)); S.A = (const char*)Hb; S.B = (const char*)WinT; S.tstep = (size_t)256 * D * 2; S.nt = D / 64;
        pg8::EpiProj E{ws, SGA, args.conv_w, lds + HALO_OFF};
        pg8::gemm_stream<pg8::EpiProj, pg8::SegOrder1>(lds, D, S, E);
        if (BOTH(2)) GRID_BAR();
    }
    PHSTAMP(3);
    if (IN(3)) for (int rep = 0; rep < NREP(3); ++rep) {
        for (int idx = gtid; idx < 63 * 2 * (NCV / 4); idx += NT) {
            const int c4 = idx % (NCV / 4), pj = idx / (NCV / 4), j = pj & 1, pm = 1 + (pj >> 1), ch = 4 * c4;
            const f32x4 h0 = *(const f32x4*)(HPb + ((size_t)((pm - 1) * 2 + 0) * NCV + ch)), h1 = *(const f32x4*)(HPb + ((size_t)((pm - 1) * 2 + 1) * NCV + ch));
            const f32x4 w0 = *(const f32x4*)(args.conv_w + ch), w1 = *(const f32x4*)(args.conv_w + NCV + ch);
            const f32x4 qv = *(const f32x4*)(FXQb + ((size_t)(pm * 2 + j) * NCV + ch)), uu = *(const f32x4*)(FXUb + ((size_t)(pm * 2 + j) * NCV + ch));
            const f32x4 miss = (j == 0) ? (w1 * h1 + w0 * h0) : (w0 * h1);
            const f32x4 rv = qv * (uu + miss);
            u32x2 rw; rw.x = cvt_pk_bf16(rv[0], rv[1]); rw.y = cvt_pk_bf16(rv[2], rv[3]);
            *(u32x2*)(Rb + ((size_t)(256 * pm + j) * NCV + ch)) = rw;
        }
        for (int chunk = vcu; chunk < 256; chunk += G) {
            int g, hh, r, n0;
            if (chunk < 128) { g = 2; hh = chunk >> 4; r = chunk & 15; n0 = 0; } else { const int idx = chunk - 128; g = 1; hh = idx >> 4; r = (idx & 15) >> 2; n0 = (idx & 3) * 8; }
            const size_t go = (size_t)g * M * 1024;
            attn_chunk<false>(lds, Qb + go, Kb + go, Vb + go, 2 * g, hh, r, n0, 8, (g == 1) ? O1 : O2, LSE + (size_t)g * M * 8, nullptr, nullptr, nullptr, nullptr, nullptr, nullptr);
        }
        if (BOTH(3) || rep + 1 < NREP(3)) GRID_BAR();
    }
    PHSTAMP(4);
    if (IN(4)) for (int rep = 0; rep < NREP(4); ++rep) {
        for (int chunk = vcu; chunk < 256; chunk += G)
            attn_chunk<true>(lds, Qb, Kb, Vb, 0, chunk >> 5, 0, (chunk & 31) * 4, 4, nullptr, nullptr, O1, O2, LSE + (size_t)1 * M * 8, LSE + (size_t)2 * M * 8, SZ, AATT);
        if (BOTH(4) || rep + 1 < NREP(4)) GRID_BAR();
    }
    PHSTAMP(5);
    if (IN(5)) {
        pg8::SegOrder2 S; S.so.init(M, D, G, bx, NREP(5)); S.A0 = (const char*)AATT; S.B0 = (const char*)WaT; S.A1 = (const char*)Rb; S.B1 = (const char*)WcT; S.tstep = (size_t)256 * D * 2; S.nt0 = NZA / 64; S.nt1 = NCV / 64;
        pg8::EpiMerge E{MG, SGA, SGC, D};
        pg8::gemm_stream<pg8::EpiMerge, pg8::SegOrder2, true>(lds, D, S, E);
        if (BOTH(5)) GRID_BAR();
    }
    PHSTAMP(6);
    if (IN(6)) {
        pg8::SegOrder1 S; S.so.init(M, D, G, bx, NREP(6)); S.A = (const char*)MG; S.B = (const char*)WoT; S.tstep = (size_t)256 * D * 2; S.nt = D / 64;
        pg8::EpiBf16 E{Yb, D};
        pg8::gemm_stream<pg8::EpiBf16, pg8::SegOrder1>(lds, D, S, E);
#ifdef PROBE_ARRIVE
        if (tid == 0) { ((unsigned long long*)(ws + WS_MOD + 131072))[bx] = __builtin_amdgcn_s_memrealtime(); }
#endif
        if (BOTH(6)) GRID_BAR();
    }
    PHSTAMP(7);
    if (IN(7)) {
        f32x4 gv[4][2];
#pragma unroll
        for (int j = 0; j < 4; ++j)
#pragma unroll
            for (int h = 0; h < 2; ++h) { const int k = 512 * j + 8 * lane + 4 * h; gv[j][h] = *(const f32x4*)(mod + 2 * D + k) * *(const f32x4*)(args.g_post + k); }
        for (int m = gw; m < M; m += NGW) {
            const bf16_t* yr = Yb + (size_t)m * D + 8 * lane; const float* xr = args.x + (size_t)m * D + 8 * lane; float* orow = args.out + (size_t)m * D + 8 * lane;
            f32x4 v[4][2]; float ss = 0.f;
#pragma unroll
            for (int j = 0; j < 4; ++j) { pg8::unpack8(*(const u32x4*)(yr + 512 * j), v[j][0], v[j][1]);
#pragma unroll
                for (int h = 0; h < 2; ++h) { const f32x4 q = v[j][h] * v[j][h]; ss += (q[0] + q[1]) + (q[2] + q[3]); } }
            const float rstd = 1.0f / sqrtf(wave_sum(ss) * (1.0f / D) + EPS);
#pragma unroll
            for (int j = 0; j < 4; ++j)
#pragma unroll
                for (int h = 0; h < 2; ++h) { const f32x4 xv = *(const f32x4*)(xr + 512 * j + 4 * h); *(f32x4*)(orow + 512 * j + 4 * h) = xv + gv[j][h] * (v[j][h] * rstd); }
        }
    }
    PHSTAMP(8);
#ifdef PROBE_PH
    if (bx == 0 && tid == 0) {
        asm volatile("s_waitcnt vmcnt(0)" ::: "memory");
        unsigned long long* st = (unsigned long long*)(ws + WS_MOD + 65536) + 16;
        const int ia = (PROBE_PH) & 15, ib = ((PROBE_PH) >> 4) & 15;
        const unsigned long long ta = __hip_atomic_load(st + ia + 1, __ATOMIC_RELAXED, __HIP_MEMORY_SCOPE_AGENT) - __hip_atomic_load(st + ia, __ATOMIC_RELAXED, __HIP_MEMORY_SCOPE_AGENT);
        const unsigned long long tb = __hip_atomic_load(st + ib + 1, __ATOMIC_RELAXED, __HIP_MEMORY_SCOPE_AGENT) - __hip_atomic_load(st + ib, __ATOMIC_RELAXED, __HIP_MEMORY_SCOPE_AGENT);
        const unsigned long long ticks = 4ull * (ta > 99900ull ? 99900ull : ta) + 400000ull * (tb / 400ull);
        const unsigned long long t0 = __builtin_amdgcn_s_memrealtime();
        while (__builtin_amdgcn_s_memrealtime() - t0 < ticks) __builtin_amdgcn_s_sleep(32);
    }
#endif
#ifdef PROBE_ARRIVE
    if (bx == 0 && tid == 0) {
        unsigned long long* aw = (unsigned long long*)(ws + WS_MOD + 131072);
        unsigned long long tmax = 0, tmin = ~0ull; int imax = 0;
        for (int i = 0; i < G; ++i) { const unsigned long long t = __hip_atomic_load(aw + i, __ATOMIC_RELAXED, __HIP_MEMORY_SCOPE_AGENT); if (t > tmax) { tmax = t; imax = i; } if (t < tmin) tmin = t; }
        const unsigned long long t0a = __hip_atomic_load(aw, __ATOMIC_RELAXED, __HIP_MEMORY_SCOPE_AGENT);
        const unsigned long long tafter = __hip_atomic_load((unsigned long long*)(ws + WS_MOD + 65536) + 16 + 8, __ATOMIC_RELAXED, __HIP_MEMORY_SCOPE_AGENT);
        long long val[4];
        val[0] = (long long)(tmax - tmin) / 200;
        val[1] = (long long)(tafter - tmax) / 100;
        val[2] = (long long)(tmax - t0a) / 200;
        val[3] = imax / 4;
        long long a = val[PROBE_ARRIVE & 3], b = val[(PROBE_ARRIVE >> 2) & 3];
        a = a < 0 ? 0 : (a > 89 ? 89 : a); b = b < 0 ? 0 : (b > 99 ? 99 : b);
        const unsigned long long ticks = (unsigned long long)(10 * a + 1000 * b) * 100ull;
        const unsigned long long t0 = __builtin_amdgcn_s_memrealtime();
        while (__builtin_amdgcn_s_memrealtime() - t0 < ticks) __builtin_amdgcn_s_sleep(32);
    }
#endif
#undef IN
#undef BOTH
#undef GRID_BAR
}

extern "C" void kernel_launch(void* const* d_in, const int* in_sizes, int n_in, void* d_out, int out_size, void* d_ws, size_t ws_size, hipStream_t stream) {
    static int grid = 0;
    if (grid == 0) {
        if (n_in != 12 || in_sizes[0] != M * D || out_size != M * D || ws_size < WS_END) { fprintf(stderr, "kernel_launch: unexpected shapes (n_in %d, in0 %d, out %d, ws %zu); nothing launched\n", n_in, n_in > 0 ? in_sizes[0] : -1, out_size, ws_size); grid = -1; return; }
        int dev = 0, cus = 0;
        if (hipGetDevice(&dev) != hipSuccess || hipDeviceGetAttribute(&cus, hipDeviceAttributeMultiprocessorCount, dev) != hipSuccess) { grid = -1; return; }
        if (hipFuncSetAttribute((const void*)mk_fwd, hipFuncAttributeMaxDynamicSharedMemorySize, LDS_BYTES) != hipSuccess) { fprintf(stderr, "kernel_launch: hipFuncSetAttribute failed\n"); grid = -1; return; }
        (void)hipGetLastError();
        grid = cus;
    }
    if (grid < 0) return;
    if (hipMemsetAsync((char*)d_ws + WS_CTL, 0, CTL_ZERO_BYTES, stream) != hipSuccess) return;
    Args a{};
    a.x = (const float*)d_in[0]; a.c = (const float*)d_in[1]; a.pos = (const int*)d_in[2]; a.g_pre = (const float*)d_in[3]; a.w_ada = (const float*)d_in[4]; a.b_ada = (const float*)d_in[5];
    a.w_in = (const float*)d_in[6]; a.conv_w = (const float*)d_in[7]; a.w_attn_o = (const float*)d_in[8]; a.w_conv_o = (const float*)d_in[9]; a.w_o = (const float*)d_in[10]; a.g_post = (const float*)d_in[11];
    a.out = (float*)d_out; a.ws = (unsigned char*)d_ws;
    for (int li = 0; li < N_LAUNCHES; ++li) {
        a.ph_lo = (N_LAUNCHES == 1) ? 0 : li; a.ph_hi = (N_LAUNCHES == 1) ? NPHASES : li + 1; a.li = li;
        hipLaunchKernelGGL(mk_fwd, dim3(grid), dim3(NWAVES * 64), LDS_BYTES, stream, a);
        if (hipPeekAtLastError() != hipSuccess) break;
    }
}
```

```cpp
#include <hip/hip_runtime.h>
#include <cstdio>
#include <cstdint>

#define GAS __attribute__((address_space(1)))
#define LAS __attribute__((address_space(3)))
typedef unsigned short bf16_t;
typedef short bf16x8 __attribute__((ext_vector_type(8)));
typedef short s16x4 __attribute__((ext_vector_type(4)));
typedef float f32x4 __attribute__((ext_vector_type(4)));
typedef float f32x2 __attribute__((ext_vector_type(2)));
typedef unsigned u32x4 __attribute__((ext_vector_type(4)));
typedef unsigned u32x2 __attribute__((ext_vector_type(2)));

constexpr int M = 16384, D = 2048, NQKV = 3072, NZA = 1024, NCV = 2048, PROJ = 22528, NMOD = 6144;
constexpr float EPS = 1e-6f;
constexpr float LOG2E = 1.4426950408889634f;
constexpr float QSCALE = 0.08838834764831845f * 1.4426950408889634f;

__constant__ float INVF[16] = {1.0f, 0.44036659598350525f, 0.1939227432012558f, 0.08539710193872452f, 0.03760603070259094f, 0.016560440883040428f,
    0.007292664609849453f, 0.0032114461064338684f, 0.0014142135623842478f, 0.0006227724370546639f, 0.00027424818836152554f, 0.00012076973507646471f,
    5.3182957344688475e-05f, 2.34199997066753e-05f, 1.0313385246263351e-05f, 4.541670477919979e-06f};

typedef __bf16 bf16x2_t __attribute__((ext_vector_type(2)));
__device__ __forceinline__ unsigned cvt_pk_bf16(float lo, float hi) { const f32x2 v = {lo, hi}; return __builtin_bit_cast(unsigned, __builtin_convertvector(v, bf16x2_t)); }
__device__ __forceinline__ float bf_lo(unsigned w) { return __builtin_bit_cast(float, w << 16); }
__device__ __forceinline__ float bf_hi(unsigned w) { return __builtin_bit_cast(float, w & 0xffff0000u); }
template <int CTRL> __device__ __forceinline__ float dpp_row_shr(float old, float src) { return __int_as_float(__builtin_amdgcn_update_dpp(__float_as_int(old), __float_as_int(src), CTRL, 0xf, 0xf, false)); }
__device__ __forceinline__ float silu_f(float v) { return v * __builtin_amdgcn_rcpf(1.0f + __builtin_amdgcn_exp2f(-v * LOG2E)); }
__device__ __forceinline__ float sigm_f(float v) { return __builtin_amdgcn_rcpf(1.0f + __builtin_amdgcn_exp2f(-v * LOG2E)); }

constexpr size_t MiB = 1u << 20;
constexpr size_t WS_CTL = 0, CTL_ZERO_BYTES = 1 * MiB;
constexpr size_t WS_MOD = 1 * MiB;
constexpr size_t WS_CS = 2 * MiB;
constexpr size_t WS_WIN = 4 * MiB;
constexpr size_t WS_WA = 92 * MiB, WS_WC = 100 * MiB, WS_WO = 108 * MiB;
constexpr size_t WS_H = 116 * MiB;
constexpr size_t WS_Q = 180 * MiB, WS_K = 276 * MiB, WS_V = 372 * MiB;
constexpr size_t WS_SZ = 468 * MiB;
constexpr size_t WS_R = 500 * MiB;
constexpr size_t WS_FX = 564 * MiB;
constexpr size_t WS_O2 = 628 * MiB;
constexpr size_t WS_LSE = 660 * MiB;
constexpr size_t WS_END = 662 * MiB;
constexpr size_t WS_O1 = 148 * MiB;
constexpr size_t WS_AATT = WS_K + 32 * MiB, WS_MG = WS_V + 32 * MiB, WS_Y = WS_R;

namespace pg8 {
constexpr int BM = 256, BK = 64, HALF = 128, HTB = HALF * BK * 2, STAGE_BYTES = 8 * HTB, NXCD = 8, WGM = 8;
__host__ __device__ __forceinline__ int lds_byte(int r, int c) { const int st = (r >> 4) * 2 + (c >> 5), rr = r & 15, cc = c & 31, ob = rr * 64 + cc * 2; return st * 1024 + (ob ^ (((ob >> 9) & 1) << 5)); }
__host__ __device__ __forceinline__ void stage_rc(int b, int& R, int& C) { const int st = b / 1024, sb = b % 1024, swz = sb ^ (((sb >> 9) & 1) << 5); R = (st >> 1) * 16 + swz / 64; C = (st & 1) * 32 + (swz % 64) / 2; }
__host__ __device__ __forceinline__ int perm32(int rho) { const int n = rho >> 4, i = rho & 15; return 8 * (i >> 2) + 4 * n + (i & 3); }

struct Unit { int pm, pn; };
struct Gemm { const bf16_t* A; const bf16_t* Bt; int M, N, K; };

struct StaticOrder {
    int nM, nN, nwg, G, c, rounds, rep;
    __host__ __device__ void init(int M_, int N_, int G_, int c_, int rep_ = 1) { nM = M_ / BM; nN = N_ / BM; nwg = nM * nN; G = G_; c = c_; rounds = (nwg + G - 1) / G; rep = rep_; }
    __host__ __device__ bool next(int i, Unit& u) const {
        if (i >= rounds * rep) return false;
        i = i % rounds;
        const long L = (long)i * G + c; if (L >= nwg) return false;
        int wgid = (int)L; { const int q = nwg / NXCD, r = nwg % NXCD, xcd = wgid % NXCD, off = wgid / NXCD; wgid = (xcd < r ? xcd * (q + 1) : r * (q + 1) + (xcd - r) * q) + off; }
        const int nig = WGM * nN, gid = wgid / nig, fm = gid * WGM, gsz = (nM - fm) < WGM ? (nM - fm) : WGM;
        u.pm = fm + ((wgid % nig) % gsz); u.pn = (wgid % nig) / gsz; return true;
    }
    __device__ __forceinline__ void a_ready(const Unit&) const {}
    __device__ __forceinline__ void done(const Unit&) const {}
};


struct Seg { const char* A; const char* B; int nt; int mid; Unit u; };
__device__ __forceinline__ const char* rfl_ptr(const char* p) { const unsigned long long v = (unsigned long long)p; const unsigned lo = __builtin_amdgcn_readfirstlane((unsigned)v), hi = __builtin_amdgcn_readfirstlane((unsigned)(v >> 32)); return (const char*)(((unsigned long long)hi << 32) | lo); }
__device__ __forceinline__ void rfl_seg(Seg& o) { o.A = rfl_ptr(o.A); o.B = rfl_ptr(o.B); o.nt = __builtin_amdgcn_readfirstlane(o.nt); o.mid = __builtin_amdgcn_readfirstlane(o.mid); o.u.pm = __builtin_amdgcn_readfirstlane(o.u.pm); o.u.pn = __builtin_amdgcn_readfirstlane(o.u.pn); }
constexpr int NSTORE = 16;
template <class Epi, class Sched, bool DUAL = false>
__device__ __forceinline__ void gemm_stream(LAS unsigned char* lds, const int pitch, const Sched& S, const Epi& E) {
    const int tid = threadIdx.x, wid = __builtin_amdgcn_readfirstlane(tid >> 6), lane = tid & 63, wr = wid >> 2, wc = wid & 3, fr = lane & 15, fq = lane >> 4;
    unsigned voffA[2], voffB[2];
#pragma unroll
    for (int i = 0; i < 2; ++i) { int R, C; stage_rc(tid * 16 + i * 8192, R, C); const int Rb = Epi::PERM ? ((R & ~31) + perm32(R & 31)) : R;
        voffA[i] = (unsigned)(R * pitch + C) * 2u; voffB[i] = (unsigned)(Rb * pitch + C) * 2u; }
    const size_t kstep = (size_t)(BK * 2);
    const size_t hstep = (size_t)HALF * pitch * 2;
    const unsigned ldsw = (unsigned)wid * 1024u;
    const int aoff = lds_byte(wr * 64 + fr, fq * 8), boff = lds_byte(wc * 32 + fr, fq * 8);
#define PG8_SA(b, h) (((b) * 2 + (h)) * HTB)
#define PG8_SB(b, h) ((4 + (b) * 2 + (h)) * HTB)
#define PG8_STAGE(bufoff, gbase, voff) do { const char* _gb = (const char*)(gbase); asm volatile("" : "+s"(_gb));   \
        _Pragma("unroll") for (int _i = 0; _i < 2; ++_i) \
        __builtin_amdgcn_global_load_lds((const unsigned*)(_gb + (voff)[_i]), (LAS unsigned*)(lds + (bufoff) + ldsw + _i * 8192), 16, 0, 0); } while (0)
#define PG8_LDA(dst, b, h) do { _Pragma("unroll") for (int m = 0; m < 4; ++m) _Pragma("unroll") for (int k = 0; k < 2; ++k) dst[m][k] = *(const LAS bf16x8*)(lds + PG8_SA(b, h) + aoff + m * 2048 + k * 1024); } while (0)
#define PG8_LDB(dst, b, h) do { _Pragma("unroll") for (int n = 0; n < 2; ++n) _Pragma("unroll") for (int k = 0; k < 2; ++k) dst[n][k] = *(const LAS bf16x8*)(lds + PG8_SB(b, h) + boff + n * 2048 + k * 1024); } while (0)
#define PG8_MMA(ai, bj, At, Bt) do { __builtin_amdgcn_s_setprio(1); _Pragma("unroll") for (int m = 0; m < 4; ++m) _Pragma("unroll") for (int n = 0; n < 2; ++n) _Pragma("unroll") for (int k = 0; k < 2; ++k) \
        acc[ai][bj][m][n] = __builtin_amdgcn_mfma_f32_16x16x32_bf16(Bt[n][k], At[m][k], acc[ai][bj][m][n], 0, 0, 0); __builtin_amdgcn_s_setprio(0); } while (0)
#define PG8_WAIT_V(n) asm volatile("s_waitcnt vmcnt(" #n ")" ::: "memory")
#define PG8_WAIT_VR() PG8_WAIT_V(8)
#define PG8_WAIT_L(n) asm volatile("s_waitcnt lgkmcnt(" #n ")" ::: "memory")
#define PG8_BAR __builtin_amdgcn_s_barrier()
#define PG8_SCHED __builtin_amdgcn_sched_barrier(0)
    Seg cur, nxt; int si = 0;
    if (!S.seg(0, cur)) return;
    f32x4 acc[2][2][4][2];
#pragma unroll
    for (int a = 0; a < 2; ++a)
#pragma unroll
        for (int b = 0; b < 2; ++b)
#pragma unroll
            for (int m = 0; m < 4; ++m)
#pragma unroll
                for (int n = 0; n < 2; ++n) acc[a][b][m][n] = (f32x4){0.f, 0.f, 0.f, 0.f};
    bf16x8 At[4][2], B0[2][2], B1[2][2];
    {
        const char* cA = cur.A; const char* cB = cur.B;
        PG8_STAGE(PG8_SB(0, 0), cB, voffB); PG8_STAGE(PG8_SB(0, 1), cB + hstep, voffB); PG8_STAGE(PG8_SA(0, 0), cA, voffA); PG8_STAGE(PG8_SA(0, 1), cA + hstep, voffA);
        if (wr == 1) PG8_BAR;
        PG8_WAIT_V(2); PG8_BAR;
        PG8_STAGE(PG8_SB(1, 0), cB + kstep, voffB); PG8_STAGE(PG8_SA(1, 0), cA + kstep, voffA); PG8_STAGE(PG8_SB(1, 1), cB + hstep + kstep, voffB);
        PG8_WAIT_V(6); PG8_BAR;
    }
    bool fresh = true, relax = false;
    for (;;) {
        const bool has_next = S.seg(si + 1, nxt);
        const char* cA = cur.A; const char* cB = cur.B; const int nt = cur.nt;
        const char* nA = has_next ? nxt.A : cA; const char* nB = has_next ? nxt.B : cB;
#pragma nounroll
        for (int t = 0; t < nt; t += 2) {
            const bool first = (t == 0) && !fresh;
            const bool last = (t == nt - 2);
            const char* a1 = cA + (size_t)(t + 1) * kstep;
            const char* a2 = last ? nA : cA + (size_t)(t + 2) * kstep; const char* b2 = last ? nB : cB + (size_t)(t + 2) * kstep;
            const char* a3 = a2 + kstep; const char* b3 = b2 + kstep;
            PG8_LDB(B0, 0, 0); PG8_LDB(B1, 0, 1); PG8_SCHED; PG8_LDA(At, 0, 0); if (!first) PG8_STAGE(PG8_SA(1, 1), a1 + hstep, voffA);
            PG8_WAIT_VR(); PG8_WAIT_L(0); PG8_BAR; PG8_MMA(0, 0, At, B0); PG8_MMA(0, 1, At, B1); PG8_BAR; PG8_SCHED;
            PG8_LDA(At, 0, 1); PG8_STAGE(PG8_SB(0, 0), b2, voffB); PG8_STAGE(PG8_SB(0, 1), b2 + hstep, voffB); PG8_STAGE(PG8_SA(0, 0), a2, voffA);
            PG8_WAIT_VR(); PG8_WAIT_L(0); PG8_BAR; PG8_MMA(1, 0, At, B0); PG8_MMA(1, 1, At, B1); PG8_BAR; PG8_SCHED;
            PG8_LDB(B0, 1, 0); PG8_LDB(B1, 1, 1); PG8_SCHED; PG8_LDA(At, 1, 0); PG8_STAGE(PG8_SA(0, 1), a2 + hstep, voffA);
            PG8_WAIT_VR(); PG8_WAIT_L(0); PG8_BAR; PG8_MMA(0, 0, At, B0); PG8_MMA(0, 1, At, B1); PG8_BAR; PG8_SCHED;
            PG8_LDA(At, 1, 1); PG8_STAGE(PG8_SB(1, 0), b3, voffB); PG8_STAGE(PG8_SB(1, 1), b3 + hstep, voffB); PG8_STAGE(PG8_SA(1, 0), a3, voffA);
            PG8_WAIT_V(8); PG8_WAIT_L(0); PG8_BAR; PG8_MMA(1, 0, At, B0); PG8_MMA(1, 1, At, B1); PG8_BAR; PG8_SCHED;
        }
        if (wr == 0) PG8_BAR;
        PG8_STAGE(PG8_SA(1, 1), nA + kstep + hstep, voffA);
        PG8_SCHED;
        if constexpr (DUAL) E.scale(acc, cur.u, wr, wc, fr, fq, cur.mid != 0);
        if (DUAL && cur.mid) { relax = false; }
        else {
            E(acc, cur.u, wr, wc, fr, fq); relax = true;
#pragma unroll
            for (int a = 0; a < 2; ++a)
#pragma unroll
                for (int b = 0; b < 2; ++b)
#pragma unroll
                    for (int m = 0; m < 4; ++m)
#pragma unroll
                        for (int n = 0; n < 2; ++n) acc[a][b][m][n] = (f32x4){0.f, 0.f, 0.f, 0.f};
        }
        PG8_SCHED;
        if (!has_next) break;
        cur = nxt; ++si; fresh = false;
        if (wr == 1) PG8_BAR;
    }
    PG8_WAIT_V(0);
    PG8_BAR;
#undef PG8_SA
#undef PG8_SB
#undef PG8_STAGE
#undef PG8_LDA
#undef PG8_LDB
#undef PG8_MMA
#undef PG8_WAIT_V
#undef PG8_WAIT_VR
#undef PG8_WAIT_L
#undef PG8_BAR
#undef PG8_SCHED
}
struct SegOrder1 {
    StaticOrder so; const char* A; const char* B; size_t tstep; int nt;
    __device__ __forceinline__ bool seg(int s, Seg& o) const { Unit u; if (!so.next(s, u)) return false; o.A = A + (size_t)u.pm * tstep; o.B = B + (size_t)u.pn * tstep; o.nt = nt; o.mid = 0; o.u = u; rfl_seg(o); return true; }
};

__device__ __forceinline__ u32x4 pack8(const f32x4 v0, const f32x4 v1) { u32x4 w; w.x = cvt_pk_bf16(v0[0], v0[1]); w.y = cvt_pk_bf16(v0[2], v0[3]); w.z = cvt_pk_bf16(v1[0], v1[1]); w.w = cvt_pk_bf16(v1[2], v1[3]); return w; }
__device__ __forceinline__ void unpack8(const u32x4 w, f32x4& v0, f32x4& v1) { v0 = (f32x4){bf_lo(w.x), bf_hi(w.x), bf_lo(w.y), bf_hi(w.y)}; v1 = (f32x4){bf_lo(w.z), bf_hi(w.z), bf_lo(w.w), bf_hi(w.w)}; }

#ifdef NT_STORES
#define ST16(p, v) __builtin_nontemporal_store((v), (u32x4*)(p))
#define ST8(p, v) __builtin_nontemporal_store((v), (u32x2*)(p))
#else
#define ST16(p, v) (*(u32x4*)(p) = (v))
#define ST8(p, v) (*(u32x2*)(p) = (v))
#endif
struct EpiProj {
    static constexpr bool PERM = true;
    __device__ __forceinline__ void mid(f32x4 (&)[2][2][4][2], const Unit&, int, int, int, int) const {}
    unsigned char* ws; bf16_t* SGA; const float* cw; LAS unsigned char* halo;
    __device__ __forceinline__ void operator()(const f32x4 (&acc)[2][2][4][2], const Unit& u, int wr, int wc, int fr, int fq) const {
        const int pn = u.pn; const int row0 = u.pm * BM + wr * 64 + fr; const int lc = wc * 32 + 8 * fq;
        bf16_t* const Q = (bf16_t*)(ws + WS_Q); bf16_t* const Kb = (bf16_t*)(ws + WS_K); bf16_t* const V = (bf16_t*)(ws + WS_V); bf16_t* const SZ = (bf16_t*)(ws + WS_SZ); bf16_t* const R = (bf16_t*)(ws + WS_R);
        bf16_t* const SGC = SGA + (size_t)M * D; const float* const cs = (const float*)(ws + WS_CS);
        float* const HP = (float*)(ws + WS_FX); float* const FXQ = HP + (size_t)64 * 2 * NCV; float* const FXU = FXQ + (size_t)64 * 2 * NCV;
        if (pn < 24) {
            const bool isq = pn < 12; const int tq = isq ? pn : pn - 12; bf16_t* base = (isq ? Q : Kb) + (size_t)(tq >> 2) * M * 1024; const int colt = (tq & 3) * BM; const float sc = isq ? QSCALE : 1.0f;
            const bool rot = (fq == 0);
            f32x4 cv[2][4], sv[2][4];
#pragma unroll
            for (int ai = 0; ai < 2; ++ai)
#pragma unroll
                for (int m = 0; m < 4; ++m) { const float* cr = cs + (size_t)(row0 + ai * HALF + m * 16) * 32 + 4 * wc; cv[ai][m] = *(const f32x4*)cr; sv[ai][m] = *(const f32x4*)(cr + 16); }
#pragma unroll
            for (int ai = 0; ai < 2; ++ai)
#pragma unroll
                for (int m = 0; m < 4; ++m) {
                    const f32x4 c = rot ? cv[ai][m] * sc : (f32x4){sc, sc, sc, sc}, sn = rot ? sv[ai][m] * sc : (f32x4){0.f, 0.f, 0.f, 0.f};
                    bf16_t* rowp = base + (size_t)(row0 + ai * HALF + m * 16) * 1024 + colt + lc;
#pragma unroll
                    for (int bj = 0; bj < 2; ++bj) { const f32x4 v0 = acc[ai][bj][m][0], v1 = acc[ai][bj][m][1];
                        ST16((rowp + bj * HALF), (pack8(v0 * c - v1 * sn, v0 * sn + v1 * c))); }
                }
        } else if (pn < 36) {
            const int tv = pn - 24, colt = (tv & 3) * BM; bf16_t* vbase = V + (size_t)(tv >> 2) * M * 1024;
#pragma unroll
            for (int ai = 0; ai < 2; ++ai)
#pragma unroll
                for (int m = 0; m < 4; ++m) { bf16_t* rowp = vbase + (size_t)(row0 + ai * HALF + m * 16) * 1024 + colt + lc;
#pragma unroll
                    for (int bj = 0; bj < 2; ++bj) ST16((rowp + bj * HALF), (pack8(acc[ai][bj][m][0], acc[ai][bj][m][1]))); }
        } else if (pn < 40) {
            const int colt = (pn - 36) * BM;
#pragma unroll
            for (int ai = 0; ai < 2; ++ai)
#pragma unroll
                for (int m = 0; m < 4; ++m) { bf16_t* rowp = SZ + (size_t)(row0 + ai * HALF + m * 16) * NZA + colt + lc;
#pragma unroll
                    for (int bj = 0; bj < 2; ++bj) { f32x4 a = acc[ai][bj][m][0], b = acc[ai][bj][m][1];
#pragma unroll
                        for (int j = 0; j < 4; ++j) { a[j] = silu_f(a[j]); b[j] = silu_f(b[j]); }
                        ST16((rowp + bj * HALF), (pack8(a, b))); } }
        } else if (pn < 72) {
            int chl = 16 * wc + 4 * fq; asm volatile("" : "+v"(chl));
            const int ct = pn - 40, chb = 64 * ct + chl, pm = u.pm;
            const f32x4 w0 = *(const f32x4*)(cw + chb), w1 = *(const f32x4*)(cw + NCV + chb), w2 = *(const f32x4*)(cw + 2 * NCV + chb);
#pragma unroll
            for (int ai = 0; ai < 2; ++ai)
#pragma unroll
                for (int m = 0; m < 4; ++m) { const f32x4 pv = acc[ai][0][m][1] * acc[ai][1][m][0];
                    const int gi = 8 * ai + 4 * wr + m;
                    if (fr >= 14) { *(LAS f32x4*)(halo + (size_t)(((gi * 2 + (fr - 14)) * 64 + chl) * 4)) = pv;
                        if (gi == 15) *(f32x4*)(HP + ((size_t)(pm * 2 + (fr - 14)) * NCV + chb)) = pv; } }
            asm volatile("s_waitcnt lgkmcnt(0)" ::: "memory"); __builtin_amdgcn_s_barrier(); asm volatile("" ::: "memory");
#pragma unroll
            for (int ai = 0; ai < 2; ++ai)
#pragma unroll
                for (int m = 0; m < 4; ++m) {
                    const int gi = 8 * ai + 4 * wr + m; const int gp = gi > 0 ? gi - 1 : 0;
                    f32x4 H0 = *(const LAS f32x4*)(halo + (size_t)(((gp * 2 + 0) * 64 + chl) * 4)), H1 = *(const LAS f32x4*)(halo + (size_t)(((gp * 2 + 1) * 64 + chl) * 4));
                    if (gi == 0) { H0 = (f32x4){0.f, 0.f, 0.f, 0.f}; H1 = H0; }
                    const f32x4 Hs = (fr == 1) ? H1 : H0, pvv = acc[ai][0][m][1] * acc[ai][1][m][0];
                    f32x4 Pm1, Pm2, qv;
#pragma unroll
                    for (int j = 0; j < 4; ++j) {
                        const float pj = pvv[j], h1j = H1[j], hsj = Hs[j];
                        Pm1[j] = dpp_row_shr<0x111>(h1j, pj); Pm2[j] = dpp_row_shr<0x112>(hsj, pj);
                        qv[j] = acc[ai][0][m][0][j] * silu_f(acc[ai][1][m][1][j]); }
                    const f32x4 uu = w2 * pvv + w1 * Pm1 + w0 * Pm2, rv = qv * uu;
                    const size_t ro = (size_t)(row0 + ai * HALF + m * 16) * NCV + chb;
                    u32x2 rw; rw.x = cvt_pk_bf16(rv[0], rv[1]); rw.y = cvt_pk_bf16(rv[2], rv[3]);
                    ST8((R + ro), (rw));
                    if (gi == 0 && fr < 2 && pm > 0) { *(f32x4*)(FXQ + ((size_t)(pm * 2 + fr) * NCV + chb)) = qv; *(f32x4*)(FXU + ((size_t)(pm * 2 + fr) * NCV + chb)) = uu; }
                }
        } else {
            const int colt = (pn - 72) * HALF;
#pragma unroll
            for (int ai = 0; ai < 2; ++ai)
#pragma unroll
                for (int m = 0; m < 4; ++m) { const size_t ro = (size_t)(row0 + ai * HALF + m * 16) * D + colt + lc;
                    f32x4 r[2], c[2];
#pragma unroll
                    for (int n = 0; n < 2; ++n)
#pragma unroll
                        for (int j = 0; j < 4; ++j) { const float ec = __builtin_amdgcn_exp2f(-acc[ai][1][m][n][j] * LOG2E); c[n][j] = __builtin_amdgcn_rcpf(1.0f + ec); r[n][j] = sigm_f(acc[ai][0][m][n][j]) * (1.0f + ec); }
                    ST16((SGA + ro), (pack8(r[0], r[1]))); ST16((SGC + ro), (pack8(c[0], c[1]))); }
        }
    }
};
struct EpiMerge {
    static constexpr bool PERM = true;
    bf16_t* O; const bf16_t* RHO; const bf16_t* SC; int ldc;
    __device__ __forceinline__ size_t lane_off(const Unit& u, int wr, int wc, int fr, int fq, int ai) const {
        size_t o = (size_t)(u.pm * BM + wr * 64 + fr + ai * HALF) * ldc + u.pn * BM + wc * 32 + 8 * fq; asm volatile("" : "+v"(o)); return o; }
    __device__ __forceinline__ void scale(f32x4 (&acc)[2][2][4][2], const Unit& u, int wr, int wc, int fr, int fq, bool is_mid) const {
        const bf16_t* G = is_mid ? RHO : SC;
#pragma unroll
        for (int ai = 0; ai < 2; ++ai) {
            const bf16_t* p = G + lane_off(u, wr, wc, fr, fq, ai);
            u32x4 gw[4][2];
#pragma unroll
            for (int m = 0; m < 4; ++m)
#pragma unroll
                for (int bj = 0; bj < 2; ++bj) gw[m][bj] = *(const u32x4*)(p + (size_t)m * 16 * ldc + bj * HALF);
#pragma unroll
            for (int m = 0; m < 4; ++m)
#pragma unroll
                for (int bj = 0; bj < 2; ++bj) { f32x4 g0, g1; unpack8(gw[m][bj], g0, g1); acc[ai][bj][m][0] *= g0; acc[ai][bj][m][1] *= g1; }
        }
    }
    __device__ __forceinline__ void mid(f32x4 (&)[2][2][4][2], const Unit&, int, int, int, int) const {}
    __device__ __forceinline__ void operator()(const f32x4 (&acc)[2][2][4][2], const Unit& u, int wr, int wc, int fr, int fq) const {
#pragma unroll
        for (int ai = 0; ai < 2; ++ai) {
            bf16_t* q = O + lane_off(u, wr, wc, fr, fq, ai);
#pragma unroll
            for (int m = 0; m < 4; ++m)
#pragma unroll
                for (int bj = 0; bj < 2; ++bj) *(u32x4*)(q + (size_t)m * 16 * ldc + bj * HALF) = pack8(acc[ai][bj][m][0], acc[ai][bj][m][1]);
        }
    }
};
struct EpiBf16 {
    static constexpr bool PERM = true;
    __device__ __forceinline__ void mid(f32x4 (&)[2][2][4][2], const Unit&, int, int, int, int) const {}
    bf16_t* O; int ldc;
    __device__ __forceinline__ void operator()(const f32x4 (&acc)[2][2][4][2], const Unit& u, int wr, int wc, int fr, int fq) const {
        const int row0 = u.pm * BM + wr * 64 + fr, col0 = u.pn * BM + wc * 32 + 8 * fq;
#pragma unroll
        for (int ai = 0; ai < 2; ++ai)
#pragma unroll
            for (int m = 0; m < 4; ++m) { bf16_t* rowp = O + (size_t)(row0 + ai * HALF + m * 16) * ldc + col0;
#pragma unroll
                for (int bj = 0; bj < 2; ++bj) *(u32x4*)(rowp + bj * HALF) = pack8(acc[ai][bj][m][0], acc[ai][bj][m][1]); }
    }
};
struct SegOrder2 {
    StaticOrder so; const char *A0, *B0, *A1, *B1; size_t tstep; int nt0, nt1;
    __device__ __forceinline__ bool seg(int s_, Seg& o) const { Unit u; if (!so.next(s_ >> 1, u)) return false; const int h = s_ & 1;
        o.A = (h ? A1 : A0) + (size_t)u.pm * tstep; o.B = (h ? B1 : B0) + (size_t)u.pn * tstep; o.nt = h ? nt1 : nt0; o.mid = !h; o.u = u; rfl_seg(o); return true; }
};
}

#ifndef PG8_SP2
#define PG8_SP2 true
#endif
#ifndef PG8_ALIGN
#define PG8_ALIGN true
#endif

constexpr int NWAVES = 8;
#ifndef MK_N_LAUNCHES
#define MK_N_LAUNCHES 1
#endif
constexpr int NPHASES = 8;
constexpr int N_LAUNCHES = MK_N_LAUNCHES;

constexpr int CW_BAR = 4096;
#define XCD_BAR_WORDS 3456

constexpr int RING_BYTES = 131072;
constexpr int LDSCTL_OFF = RING_BYTES, MISC_OFF = LDSCTL_OFF + 320, HALO_OFF = RING_BYTES + 1024;
constexpr int LDS_BYTES = 147456;

typedef GAS unsigned gu32;
#define RLX_AGENT __ATOMIC_RELAXED, __HIP_MEMORY_SCOPE_AGENT

#define XB_TMO      128
#define XB_XCNT(j)  (256  + 64 * (j))
#define XB_XSUB(j)  (1280 + 64 * (j))
#define XB_XGEN(j)  (2304 + 64 * (j))
#define XB_TOP      3328
#define XB_TOPGEN   3392
#define XB_SPIN_CAP (1u << 18)

__device__ __forceinline__ unsigned xb_ld(unsigned* p)              { return __hip_atomic_load(p, __ATOMIC_RELAXED, __HIP_MEMORY_SCOPE_AGENT); }
__device__ __forceinline__ unsigned xb_add(unsigned* p, unsigned v) { return __hip_atomic_fetch_add(p, v, __ATOMIC_RELAXED, __HIP_MEMORY_SCOPE_AGENT); }
__device__ __forceinline__ unsigned xb_xcc_id() { return (unsigned)__builtin_amdgcn_s_getreg((3 << 11) | 20) & 0xFu; }
#define XB_SPIN(cond, bar) do { unsigned _sp = 0; while (cond) { __builtin_amdgcn_s_sleep(1); \
    if ((++_sp & 255u) == 0u) { if (xb_ld(&(bar)[XB_TMO])) break; if (_sp > XB_SPIN_CAP) { atomicAdd(&(bar)[XB_TMO], 1u); break; } } } } while (0)

struct XcdBarrier { unsigned* bar; unsigned x; volatile LAS unsigned* st; };

__device__ __forceinline__ XcdBarrier xcd_barrier_post(unsigned* bar, volatile LAS unsigned* st) {
    XcdBarrier b; b.bar = bar; b.x = xb_xcc_id(); b.st = st;
    if (threadIdx.x == 0) (void)xb_add(&bar[XB_XCNT(b.x)], 1u);
    return b;
}
__device__ __forceinline__ void xcd_barrier_complete(unsigned* bar, unsigned x, unsigned& nloc, unsigned& nx) {
    const unsigned G = gridDim.x * gridDim.y * gridDim.z;
    unsigned sum, cnt, mine, sp = 0u;
    for (;;) {
        sum = 0u; cnt = 0u; mine = 0u;
#pragma unroll
        for (unsigned j = 0; j < 16; ++j) { const unsigned c = xb_ld(&bar[XB_XCNT(j)]); sum += c; cnt += (c > 0u) ? 1u : 0u; mine = (j == x) ? c : mine; }
        if (sum == G) break;
        __builtin_amdgcn_s_sleep(1);
        if ((++sp & 255u) == 0u) { if (xb_ld(&bar[XB_TMO])) break; if (sp > XB_SPIN_CAP) { atomicAdd(&bar[XB_TMO], 1u); break; } }
    }
    nloc = mine > 0u ? mine : 1u; nx = cnt > 0u ? cnt : 1u;
}
__device__ __forceinline__ void xcd_barrier(const XcdBarrier& b) {
    asm volatile("s_waitcnt vmcnt(0)" ::: "memory");
    __syncthreads();
    if (threadIdx.x == 0) {
        unsigned* bar = b.bar;
        __builtin_amdgcn_s_waitcnt(0);
        unsigned nloc = b.st[0], nx = b.st[1];
        if (nloc == 0u) { xcd_barrier_complete(bar, b.x, nloc, nx); b.st[0] = nloc; b.st[1] = nx; }
        const unsigned old = xb_add(&bar[XB_XSUB(b.x)], 1u);
        const unsigned gen = old / nloc;
        if (old + 1u == (gen + 1u) * nloc) {
            __builtin_amdgcn_fence(__ATOMIC_RELEASE, "agent");
            asm volatile("s_waitcnt vmcnt(0)" ::: "memory");
            const unsigned og = xb_add(&bar[XB_TOP], 1u);
            const unsigned tg = og / nx;
            if (og + 1u == (tg + 1u) * nx) xb_add(&bar[XB_TOPGEN], 1u);
            else XB_SPIN(xb_ld(&bar[XB_TOPGEN]) == tg, bar);
            __builtin_amdgcn_fence(__ATOMIC_ACQUIRE, "agent");
            xb_add(&bar[XB_XGEN(b.x)], 1u);
            asm volatile("s_waitcnt vmcnt(0)" ::: "memory");
        } else {
            XB_SPIN(xb_ld(&bar[XB_XGEN(b.x)]) == gen, bar);
            __builtin_amdgcn_fence(__ATOMIC_ACQUIRE, "agent");
            asm volatile("s_waitcnt vmcnt(0)" ::: "memory");
        }
    }
    __syncthreads();
}

#define LDS_WAIT() asm volatile("s_waitcnt lgkmcnt(0)" ::: "memory")
__device__ __forceinline__ float wave_sum(float v) {
#pragma unroll
    for (int o = 1; o < 64; o <<= 1) v += __shfl_xor(v, o);
    return v;
}
__device__ __forceinline__ unsigned f2bf(float f) { unsigned u = __builtin_bit_cast(unsigned, f); return (u + 0x7fffu + ((u >> 16) & 1u)) >> 16; }
__device__ __forceinline__ unsigned pk2(float lo, float hi) { return f2bf(lo) | (f2bf(hi) << 16); }

__device__ __forceinline__ int proj_orig_col(int n) {
    const int tile = n >> 8, c = n & 255;
    if (tile < 24) { const int c7 = n & 127, wc = c7 >> 5, fq = (c7 >> 3) & 3, nn = (c7 >> 2) & 1, j = c7 & 3;
        const int dim = (fq == 0) ? (4 * wc + j + 16 * nn) : (32 + wc * 24 + (fq - 1) * 8 + 4 * nn + j); return (n & ~127) + dim; }
    if (tile < 40) return n;
    if (tile < 72) { const int kind = 2 * (c >> 7) + ((c >> 2) & 1), chl = 16 * ((c >> 5) & 3) + 4 * ((c >> 3) & 3) + (c & 3); return 10240 + kind * 2048 + 64 * (tile - 40) + chl; }
    return 18432 + (c >> 7) * 2048 + 128 * (tile - 72) + (c & 127);
}
template <bool REMAP>
__device__ __forceinline__ void p0_transpose_item(const float* W, int K, int N, bf16_t* WT, int pitch, LAS float* scr, int item, int lane) {
    const int nblk = N / 32, kb = item / nblk, nb = item % nblk, k0 = 64 * kb, n0 = 32 * nb;
    const int ncol = REMAP ? proj_orig_col(n0 + (lane & 31)) : n0 + (lane & 31);
    float wv[32];
#pragma unroll
    for (int i = 0; i < 32; ++i) wv[i] = W[(size_t)(k0 + 2 * i + (lane >> 5)) * N + ncol];
#pragma unroll
    for (int i = 0; i < 32; ++i) scr[(2 * i + (lane >> 5)) * 33 + (lane & 31)] = wv[i];
    LDS_WAIT(); asm volatile("" ::: "memory");
    const int c = lane & 7;
#pragma unroll
    for (int j = 0; j < 4; ++j) { const int n = (lane >> 3) + 8 * j; const LAS float* s = scr + (8 * c) * 33 + n;
        u32x4 o; o.x = pk2(s[0 * 33], s[1 * 33]); o.y = pk2(s[2 * 33], s[3 * 33]); o.z = pk2(s[4 * 33], s[5 * 33]); o.w = pk2(s[6 * 33], s[7 * 33]);
        *(u32x4*)(WT + (size_t)(n0 + n) * pitch + k0 + 8 * c) = o; }
    LDS_WAIT(); asm volatile("" ::: "memory");
}

__device__ __forceinline__ void sincos_f64(float ang, float& s, float& c) {
    const double x = (double)ang;
    const double n = __builtin_rint(x * 0.15915494309189535);
    double r = __builtin_fma(-n, 6.283185307179586, x); r = __builtin_fma(-n, 2.4492935982947064e-16, r);
    const double r2 = r * r;
    double ps = 1.0 / 51090942171709440000.0;
    ps = __builtin_fma(ps, r2, -1.0 / 121645100408832000.0);
    ps = __builtin_fma(ps, r2, 1.0 / 355687428096000.0);
    ps = __builtin_fma(ps, r2, -1.0 / 1307674368000.0);
    ps = __builtin_fma(ps, r2, 1.0 / 6227020800.0);
    ps = __builtin_fma(ps, r2, -1.0 / 39916800.0);
    ps = __builtin_fma(ps, r2, 1.0 / 362880.0);
    ps = __builtin_fma(ps, r2, -1.0 / 5040.0);
    ps = __builtin_fma(ps, r2, 1.0 / 120.0);
    ps = __builtin_fma(ps, r2, -1.0 / 6.0);
    ps = __builtin_fma(ps, r2, 1.0);
    double pc = -1.0 / 1124000727777607680000.0;
    pc = __builtin_fma(pc, r2, 1.0 / 2432902008176640000.0);
    pc = __builtin_fma(pc, r2, -1.0 / 6402373705728000.0);
    pc = __builtin_fma(pc, r2, 1.0 / 20922789888000.0);
    pc = __builtin_fma(pc, r2, -1.0 / 87178291200.0);
    pc = __builtin_fma(pc, r2, 1.0 / 479001600.0);
    pc = __builtin_fma(pc, r2, -1.0 / 3628800.0);
    pc = __builtin_fma(pc, r2, 1.0 / 40320.0);
    pc = __builtin_fma(pc, r2, -1.0 / 720.0);
    pc = __builtin_fma(pc, r2, 1.0 / 24.0);
    pc = __builtin_fma(pc, r2, -0.5);
    pc = __builtin_fma(pc, r2, 1.0);
    s = (float)(r * ps); c = (float)pc;
}

__device__ __forceinline__ unsigned attn_offk(unsigned slot, unsigned row, unsigned ch) { return slot * 32768u + 256u * row + 16u * (ch ^ (row & 15u)); }
__device__ __forceinline__ unsigned attn_offv(unsigned slot, unsigned lrow, unsigned ch) { return 65536u + slot * 32768u + 256u * lrow + 16u * (ch ^ (((lrow & 3u) << 2) | ((lrow >> 2) & 3u))); }
__device__ __forceinline__ unsigned attn_lrow(unsigned k) { return (k & ~31u) | (((k >> 2) & 3u) << 3) | (((k >> 4) & 1u) << 2) | (k & 3u); }

template <bool COMBINE>
__device__ __forceinline__ void attn_chunk(LAS unsigned char* lds, const bf16_t* Qg, const bf16_t* Kg, const bf16_t* Vg, const int dsh, const int hh, const int r, const int n0, const int nblk,
                                           bf16_t* Og, float* LSEg, const bf16_t* O1, const bf16_t* O2, const float* LSE1, const float* LSE2, const bf16_t* SZ, bf16_t* AATT) {
    const int tid = threadIdx.x, lane = tid & 63, wid = __builtin_amdgcn_readfirstlane(tid >> 6), fr = lane & 15, fq = lane >> 4;
    const int sch = tid & 15, srb = tid >> 4;
    const size_t scol = (size_t)hh * 256 + sch * 16;
    u32x4 kreg[4], vreg[4];
#define ATT_LOAD(blk) do { _Pragma("unroll") for (int i = 0; i < 4; ++i) { const size_t p = ((size_t)(128 * (blk) + srb + 32 * i) << dsh) + r; const size_t off = p * 2048 + scol; \
        kreg[i] = *(const u32x4*)((const char*)Kg + off); vreg[i] = *(const u32x4*)((const char*)Vg + off); } } while (0)
#define ATT_WRITE(slot) do { _Pragma("unroll") for (int i = 0; i < 4; ++i) { const unsigned row = srb + 32 * i; \
        *(LAS u32x4*)(lds + attn_offk((slot), row, sch)) = kreg[i]; *(LAS u32x4*)(lds + attn_offv((slot), attn_lrow(row), sch)) = vreg[i]; } } while (0)
    const unsigned q4 = (unsigned)(lane & 15) >> 2, p4 = (unsigned)lane & 3u, parA = (unsigned)wid & 1u, parB = parA ^ 1u;
    unsigned kbase[4], vbA[8], vbB[8];
#pragma unroll
    for (int s_ = 0; s_ < 4; ++s_) kbase[s_] = 256u * fr + 16u * ((unsigned)(4 * s_ + fq) ^ (unsigned)fr);
#pragma unroll
    for (int c = 0; c < 8; ++c) {
        vbA[c] = 65536u + 256u * (((unsigned)fq << 3) | (parA << 2) | q4) + 16u * ((unsigned)(2 * c + (p4 >> 1)) ^ ((q4 << 2) | (((unsigned)fq & 1u) << 1) | parA)) + 8u * (p4 & 1u);
        vbB[c] = 65536u + 256u * (((unsigned)fq << 3) | (parB << 2) | q4) + 16u * ((unsigned)(2 * c + (p4 >> 1)) ^ ((q4 << 2) | (((unsigned)fq & 1u) << 1) | parB)) + 8u * (p4 & 1u);
    }
    if (n0 > 0) { ATT_LOAD(n0 - 1); }
    else {
#pragma unroll
        for (int i = 0; i < 4; ++i) { kreg[i] = (u32x4){0u, 0u, 0u, 0u}; vreg[i] = (u32x4){0u, 0u, 0u, 0u}; } }
    ATT_WRITE((unsigned)((n0 + 1) & 1));
    ATT_LOAD(n0); ATT_WRITE((unsigned)(n0 & 1));
    __syncthreads();
    for (int n = n0; n < n0 + nblk; ++n) {
        const bool more = (n + 1 < n0 + nblk);
        if (more) ATT_LOAD(n + 1);
        const unsigned cs_ = (unsigned)(n & 1), ps_ = cs_ ^ 1u;
        const int lq = 128 * n + 16 * wid + fr; const size_t pq = ((size_t)lq << dsh) + r;
        bf16x8 qf[4];
        { const bf16x8* qp = (const bf16x8*)((const char*)Qg + pq * 2048 + (size_t)hh * 256 + fq * 16);
#pragma unroll
          for (int s = 0; s < 4; ++s) qf[s] = qp[4 * s]; }
        f32x4 S[9];
#pragma unroll
        for (int t = 0; t < 9; ++t) {
            S[t] = (f32x4){0.f, 0.f, 0.f, 0.f};
            const unsigned kr0 = 16 * wid + 16 * t, uo = ((kr0 < 128u) ? ps_ : cs_) * 32768u + 256u * (kr0 & 127u);
#pragma unroll
            for (int s = 0; s < 4; ++s) { const bf16x8 kf = *(const LAS bf16x8*)(lds + (kbase[s] + uo)); S[t] = __builtin_amdgcn_mfma_f32_16x16x32_bf16(kf, qf[s], S[t], 0, 0, 0); }
        }
        const float NEG = -1e30f;
#pragma unroll
        for (int j = 0; j < 4; ++j) { const int ko0 = 4 * fq + j; if (ko0 < fr) S[0][j] = NEG; if (ko0 > fr) S[8][j] = NEG; }
        if (n == 0) {
#pragma unroll
            for (int t = 0; t < 9; ++t)
#pragma unroll
                for (int j = 0; j < 4; ++j) { if (16 * wid + 16 * t + 4 * fq + j < 128) S[t][j] = NEG; }
        }
        float mx = NEG;
#pragma unroll
        for (int t = 0; t < 9; ++t) mx = fmaxf(mx, fmaxf(fmaxf(S[t][0], S[t][1]), fmaxf(S[t][2], S[t][3])));
        mx = fmaxf(mx, __shfl_xor(mx, 16)); mx = fmaxf(mx, __shfl_xor(mx, 32));
        float sum = 0.f;
#pragma unroll
        for (int t = 0; t < 9; ++t)
#pragma unroll
            for (int j = 0; j < 4; ++j) { const float p = __builtin_amdgcn_exp2f(S[t][j] - mx); S[t][j] = p; sum += p; }
        sum += __shfl_xor(sum, 16); sum += __shfl_xor(sum, 32);
        u32x2 o1w[8], o2w[8], szw[8]; float l1 = 0.f, l2 = 0.f;
        if (COMBINE) {
            asm volatile("" ::: "memory");
            const size_t eo = pq * 1024 + hh * 128 + 4 * fq;
#pragma unroll
            for (int c = 0; c < 8; ++c) { o1w[c] = *(const u32x2*)(O1 + eo + 16 * c); o2w[c] = *(const u32x2*)(O2 + eo + 16 * c); szw[c] = *(const u32x2*)(SZ + eo + 16 * c); }
            l1 = LSE1[pq * 8 + hh]; l2 = LSE2[pq * 8 + hh];
        }
        f32x4 O[8];
#pragma unroll
        for (int c = 0; c < 8; ++c) O[c] = (f32x4){0.f, 0.f, 0.f, 0.f};
#pragma unroll
        for (int u = 0; u < 5; ++u) {
            u32x4 pw; pw.x = cvt_pk_bf16(S[2 * u][0], S[2 * u][1]); pw.y = cvt_pk_bf16(S[2 * u][2], S[2 * u][3]);
            if (u < 4) { pw.z = cvt_pk_bf16(S[2 * u + 1][0], S[2 * u + 1][1]); pw.w = cvt_pk_bf16(S[2 * u + 1][2], S[2 * u + 1][3]); } else { pw.z = 0u; pw.w = 0u; }
            const bf16x8 pf = __builtin_bit_cast(bf16x8, pw);
            const unsigned kba = 16 * wid + 32 * u, kbb = kba + 16;
            const unsigned uoa = ((kba < 128u) ? ps_ : cs_) * 32768u + 256u * (kba & 96u), uob = ((kbb < 128u) ? ps_ : cs_) * 32768u + 256u * (kbb & 96u);
#pragma unroll
            for (int c = 0; c < 8; ++c) {
                const s16x4 va = __builtin_amdgcn_ds_read_tr16_b64_v4i16((LAS s16x4*)(lds + (vbA[c] + uoa)));
                const s16x4 vb = __builtin_amdgcn_ds_read_tr16_b64_v4i16((LAS s16x4*)(lds + ((u < 4) ? (vbB[c] + uob) : (vbA[c] + uoa))));
                const bf16x8 vf = __builtin_shufflevector(va, vb, 0, 1, 2, 3, 4, 5, 6, 7);
                O[c] = __builtin_amdgcn_mfma_f32_16x16x32_bf16(vf, pf, O[c], 0, 0, 0);
            }
        }
        const float inv = 1.0f / sum;
        if (!COMBINE) {
            bf16_t* op = Og + pq * 1024 + hh * 128 + 4 * fq;
#pragma unroll
            for (int c = 0; c < 8; ++c) { u32x2 w; w.x = cvt_pk_bf16(O[c][0] * inv, O[c][1] * inv); w.y = cvt_pk_bf16(O[c][2] * inv, O[c][3] * inv); *(u32x2*)(op + 16 * c) = w; }
            if (fq == 0) LSEg[pq * 8 + hh] = mx + __builtin_amdgcn_logf(sum);
        } else {
            const float l0 = mx + __builtin_amdgcn_logf(sum), m3 = fmaxf(l0, fmaxf(l1, l2));
            float w0 = __builtin_amdgcn_exp2f(l0 - m3), w1 = __builtin_amdgcn_exp2f(l1 - m3), w2 = __builtin_amdgcn_exp2f(l2 - m3);
            const float iw = 1.0f / (w0 + w1 + w2); w0 *= iw * inv; w1 *= iw; w2 *= iw;
            bf16_t* ap = AATT + pq * 2048 + hh * 128 + 4 * fq;
#pragma unroll
            for (int c = 0; c < 8; ++c) {
                const f32x4 a1 = (f32x4){bf_lo(o1w[c].x), bf_hi(o1w[c].x), bf_lo(o1w[c].y), bf_hi(o1w[c].y)}, a2 = (f32x4){bf_lo(o2w[c].x), bf_hi(o2w[c].x), bf_lo(o2w[c].y), bf_hi(o2w[c].y)};
                const f32x4 zz = (f32x4){bf_lo(szw[c].x), bf_hi(szw[c].x), bf_lo(szw[c].y), bf_hi(szw[c].y)};
                const f32x4 res = (O[c] * w0 + a1 * w1 + a2 * w2) * zz;
                u32x2 w; w.x = cvt_pk_bf16(res[0], res[1]); w.y = cvt_pk_bf16(res[2], res[3]); *(u32x2*)(ap + 16 * c) = w;
            }
        }
        __syncthreads();
        if (more) ATT_WRITE(ps_);
        __syncthreads();
    }
#undef ATT_LOAD
#undef ATT_WRITE
}

struct Args { const float* x; const float* c; const int* pos; const float* g_pre; const float* w_ada; const float* b_ada; const float* w_in; const float* conv_w;
              const float* w_attn_o; const float* w_conv_o; const float* w_o; const float* g_post; float* out; unsigned char* ws; int ph_lo, ph_hi, li, pad; };

__global__ void __launch_bounds__(NWAVES * 64, 2) mk_fwd(Args args) {
    extern __shared__ __attribute__((aligned(16))) unsigned char lds_raw[];
    LAS unsigned char* lds = (LAS unsigned char*)lds_raw;
    volatile LAS unsigned* MISC = (volatile LAS unsigned*)(lds + MISC_OFF);
    const int tid = threadIdx.x, lane = tid & 63, wave = __builtin_amdgcn_readfirstlane(tid >> 6);
    const int G = gridDim.x; const int bx = blockIdx.x; const int vcu = (G % 8 == 0) ? (bx % 8) * (G / 8) + bx / 8 : bx;
    unsigned char* ws = args.ws;
    gu32* ctl = (gu32*)(ws + WS_CTL);
    float* mod = (float*)(ws + WS_MOD); float* cs = (float*)(ws + WS_CS);
    bf16_t* WinT = (bf16_t*)(ws + WS_WIN); bf16_t* WaT = (bf16_t*)(ws + WS_WA); bf16_t* WcT = (bf16_t*)(ws + WS_WC); bf16_t* WoT = (bf16_t*)(ws + WS_WO);
    bf16_t* Hb = (bf16_t*)(ws + WS_H); bf16_t* Qb = (bf16_t*)(ws + WS_Q); bf16_t* Kb = (bf16_t*)(ws + WS_K); bf16_t* Vb = (bf16_t*)(ws + WS_V);
    bf16_t* SZ = (bf16_t*)(ws + WS_SZ); float* HPb = (float*)(ws + WS_FX); float* FXQb = HPb + (size_t)64 * 2 * NCV; float* FXUb = FXQb + (size_t)64 * 2 * NCV;
    bf16_t* SGA = (bf16_t*)args.out; bf16_t* SGC = SGA + (size_t)M * D;
    bf16_t* O1 = (bf16_t*)(ws + WS_O1); bf16_t* O2 = (bf16_t*)(ws + WS_O2); float* LSE = (float*)(ws + WS_LSE);
    bf16_t* AATT = (bf16_t*)(ws + WS_AATT); bf16_t* Rb = (bf16_t*)(ws + WS_R); bf16_t* MG = (bf16_t*)(ws + WS_MG);
    bf16_t* Yb = (bf16_t*)(ws + WS_Y);

    for (int u = tid; u < (LDS_BYTES - LDSCTL_OFF) / 4; u += NWAVES * 64) ((LAS unsigned*)(lds + LDSCTL_OFF))[u] = 0u;
    __syncthreads();
    const int bli = (N_LAUNCHES == 1) ? 0 : args.li;
    XcdBarrier bar; bar.bar = (unsigned*)(ctl + CW_BAR) + bli * XCD_BAR_WORDS; bar.x = 0; bar.st = nullptr;
    if (N_LAUNCHES == 1) bar = xcd_barrier_post((unsigned*)(ctl + CW_BAR), MISC + 8);
    const int lo = args.ph_lo, hi = args.ph_hi;
#define IN(k) (lo <= (k) && (k) < hi)
#define BOTH(k) (IN(k) && IN((k) + 1))
#define GRID_BAR() xcd_barrier(bar)
#ifndef PROBE_REPEAT_MASK
#define PROBE_REPEAT_MASK 0
#endif
#define NREP(k) ((((PROBE_REPEAT_MASK) >> (k)) & 1) + 1)
#if defined(PROBE_PH) || defined(PROBE_ARRIVE)
#define PHSTAMP(k) do { if (bx == 0 && tid == 0) ((unsigned long long*)(ws + WS_MOD + 65536))[16 + (k)] = __builtin_amdgcn_s_memrealtime(); } while (0)
#else
#define PHSTAMP(k) do {} while (0)
#endif
    PHSTAMP(0);
    const int gw = vcu * NWAVES + wave, NGW = G * NWAVES;
    const int gtid = vcu * (NWAVES * 64) + tid, NT = G * NWAVES * 64;

    if (IN(0)) for (int rep = 0; rep < NREP(0); ++rep) {
        {
            LAS float* red = (LAS float*)lds;
            for (int cbk = bx; cbk < 256; cbk += G) {
                const int c4 = tid % 6, rg = tid / 6;
                f32x4 a = (f32x4){0.f, 0.f, 0.f, 0.f};
                if (rg < 85) {
#pragma unroll 6
                    for (int k = rg; k < D; k += 85) { const float cv = args.c[k]; const f32x4 w = *(const f32x4*)(args.w_ada + (size_t)k * NMOD + cbk * 24 + c4 * 4); a += w * cv; }
                    *(LAS f32x4*)(red + (rg * 6 + c4) * 4) = a; }
                __syncthreads();
                if (tid < 24) { float s = 0.f; for (int i = 0; i < 85; ++i) s += red[(i * 6 + (tid >> 2)) * 4 + (tid & 3)]; mod[cbk * 24 + tid] = s + args.b_ada[cbk * 24 + tid]; }
                __syncthreads();
            }
        }
        for (int idx = gtid; idx < M * 16; idx += NT) { const int m = idx >> 4, i = idx & 15; const float ang = (float)args.pos[m] * INVF[i]; float s, c; sincos_f64(ang, s, c); cs[m * 32 + i] = c; cs[m * 32 + 16 + i] = s; }
        {
            LAS float* scr = (LAS float*)(lds + wave * 16384);
            constexpr int I_IN = (D / 64) * (PROJ / 32), I_A = (NZA / 64) * (D / 32), I_C = (NCV / 64) * (D / 32), I_O = (D / 64) * (D / 32);
            constexpr int NITEMS = I_IN + I_A + I_C + I_O;
            for (int it = gw; it < NITEMS; it += NGW) {
                int r = it;
                if (r < I_IN) { p0_transpose_item<true>(args.w_in, D, PROJ, WinT, D, scr, r, lane); continue; } r -= I_IN;
                if (r < I_A) { p0_transpose_item<false>(args.w_attn_o, NZA, D, WaT, D, scr, r, lane); continue; } r -= I_A;
                if (r < I_C) { p0_transpose_item<false>(args.w_conv_o, NCV, D, WcT, D, scr, r, lane); continue; } r -= I_C;
                p0_transpose_item<false>(args.w_o, D, D, WoT, D, scr, r, lane);
            }
        }
        if (BOTH(0) || rep + 1 < NREP(0)) GRID_BAR();
    }
    PHSTAMP(1);
    if (IN(1)) for (int rep = 0; rep < NREP(1); ++rep) {
        f32x4 av[4][2], bv[4][2];
#pragma unroll
        for (int j = 0; j < 4; ++j)
#pragma unroll
            for (int h = 0; h < 2; ++h) { const int k = 512 * j + 8 * lane + 4 * h; const f32x4 gp = *(const f32x4*)(args.g_pre + k), sc = *(const f32x4*)(mod + D + k); av[j][h] = gp * (sc + 1.0f); bv[j][h] = *(const f32x4*)(mod + k); }
        for (int m = gw; m < M; m += NGW) {
            const float* xr = args.x + (size_t)m * D + 8 * lane;
            f32x4 v[4][2]; float ss = 0.f;
#pragma unroll
            for (int j = 0; j < 4; ++j)
#pragma unroll
                for (int h = 0; h < 2; ++h) { v[j][h] = *(const f32x4*)(xr + 512 * j + 4 * h); const f32x4 q = v[j][h] * v[j][h]; ss += (q[0] + q[1]) + (q[2] + q[3]); }
            const float rstd = 1.0f / sqrtf(wave_sum(ss) * (1.0f / D) + EPS);
            bf16_t* hr = Hb + (size_t)m * D + 8 * lane;
#pragma unroll
            for (int j = 0; j < 4; ++j) { const f32x4 h0 = v[j][0] * rstd * av[j][0] + bv[j][0], h1 = v[j][1] * rstd * av[j][1] + bv[j][1]; *(u32x4*)(hr + 512 * j) = pg8::pack8(h0, h1); }
        }
        if (BOTH(1) || rep + 1 < NREP(1)) GRID_BAR();
    }
    PHSTAMP(2);
    if (IN(2)) {
        pg8::SegOrder1 S; S.so.init(M, PROJ, G, bx, NREP(2)); S.A = (const char*)Hb; S.B = (const char*)WinT; S.tstep = (size_t)256 * D * 2; S.nt = D / 64;
        pg8::EpiProj E{ws, SGA, args.conv_w, lds + HALO_OFF};
        pg8::gemm_stream<pg8::EpiProj, pg8::SegOrder1>(lds, D, S, E);
        if (BOTH(2)) GRID_BAR();
    }
    PHSTAMP(3);
    if (IN(3)) for (int rep = 0; rep < NREP(3); ++rep) {
        for (int idx = gtid; idx < 63 * 2 * (NCV / 4); idx += NT) {
            const int c4 = idx % (NCV / 4), pj = idx / (NCV / 4), j = pj & 1, pm = 1 + (pj >> 1), ch = 4 * c4;
            const f32x4 h0 = *(const f32x4*)(HPb + ((size_t)((pm - 1) * 2 + 0) * NCV + ch)), h1 = *(const f32x4*)(HPb + ((size_t)((pm - 1) * 2 + 1) * NCV + ch));
            const f32x4 w0 = *(const f32x4*)(args.conv_w + ch), w1 = *(const f32x4*)(args.conv_w + NCV + ch);
            const f32x4 qv = *(const f32x4*)(FXQb + ((size_t)(pm * 2 + j) * NCV + ch)), uu = *(const f32x4*)(FXUb + ((size_t)(pm * 2 + j) * NCV + ch));
            const f32x4 miss = (j == 0) ? (w1 * h1 + w0 * h0) : (w0 * h1);
            const f32x4 rv = qv * (uu + miss);
            u32x2 rw; rw.x = cvt_pk_bf16(rv[0], rv[1]); rw.y = cvt_pk_bf16(rv[2], rv[3]);
            *(u32x2*)(Rb + ((size_t)(256 * pm + j) * NCV + ch)) = rw;
        }
        for (int chunk = vcu; chunk < 256; chunk += G) {
            int g, hh, r, n0;
            if (chunk < 128) { g = 2; hh = chunk >> 4; r = chunk & 15; n0 = 0; } else { const int idx = chunk - 128; g = 1; hh = idx >> 4; r = (idx & 15) >> 2; n0 = (idx & 3) * 8; }
            const size_t go = (size_t)g * M * 1024;
            attn_chunk<false>(lds, Qb + go, Kb + go, Vb + go, 2 * g, hh, r, n0, 8, (g == 1) ? O1 : O2, LSE + (size_t)g * M * 8, nullptr, nullptr, nullptr, nullptr, nullptr, nullptr);
        }
        if (BOTH(3) || rep + 1 < NREP(3)) GRID_BAR();
    }
    PHSTAMP(4);
    if (IN(4)) for (int rep = 0; rep < NREP(4); ++rep) {
        for (int chunk = vcu; chunk < 256; chunk += G)
            attn_chunk<true>(lds, Qb, Kb, Vb, 0, chunk >> 5, 0, (chunk & 31) * 4, 4, nullptr, nullptr, O1, O2, LSE + (size_t)1 * M * 8, LSE + (size_t)2 * M * 8, SZ, AATT);
        if (BOTH(4) || rep + 1 < NREP(4)) GRID_BAR();
    }
    PHSTAMP(5);
    if (IN(5)) {
        pg8::SegOrder2 S; S.so.init(M, D, G, bx, NREP(5)); S.A0 = (const char*)AATT; S.B0 = (const char*)WaT; S.A1 = (const char*)Rb; S.B1 = (const char*)WcT; S.tstep = (size_t)256 * D * 2; S.nt0 = NZA / 64; S.nt1 = NCV / 64;
        pg8::EpiMerge E{MG, SGA, SGC, D};
        pg8::gemm_stream<pg8::EpiMerge, pg8::SegOrder2, true>(lds, D, S, E);
        if (BOTH(5)) GRID_BAR();
    }
    PHSTAMP(6);
    if (IN(6)) {
        pg8::SegOrder1 S; S.so.init(M, D, G, bx, NREP(6)); S.A = (const char*)MG; S.B = (const char*)WoT; S.tstep = (size_t)256 * D * 2; S.nt = D / 64;
        pg8::EpiBf16 E{Yb, D};
        pg8::gemm_stream<pg8::EpiBf16, pg8::SegOrder1>(lds, D, S, E);
#ifdef PROBE_ARRIVE
        if (tid == 0) { ((unsigned long long*)(ws + WS_MOD + 131072))[bx] = __builtin_amdgcn_s_memrealtime(); }
#endif
        if (BOTH(6)) GRID_BAR();
    }
    PHSTAMP(7);
    if (IN(7)) {
        f32x4 gv[4][2];
#pragma unroll
        for (int j = 0; j < 4; ++j)
#pragma unroll
            for (int h = 0; h < 2; ++h) { const int k = 512 * j + 8 * lane + 4 * h; gv[j][h] = *(const f32x4*)(mod + 2 * D + k) * *(const f32x4*)(args.g_post + k); }
        for (int m = gw; m < M; m += NGW) {
            const bf16_t* yr = Yb + (size_t)m * D + 8 * lane; const float* xr = args.x + (size_t)m * D + 8 * lane; float* orow = args.out + (size_t)m * D + 8 * lane;
            f32x4 v[4][2], xv[4][2]; u32x4 yw[4]; float ss = 0.f;
#pragma unroll
            for (int j = 0; j < 4; ++j) { yw[j] = *(const u32x4*)(yr + 512 * j); xv[j][0] = *(const f32x4*)(xr + 512 * j); xv[j][1] = *(const f32x4*)(xr + 512 * j + 4); }
#pragma unroll
            for (int j = 0; j < 4; ++j) { pg8::unpack8(yw[j], v[j][0], v[j][1]);
#pragma unroll
                for (int h = 0; h < 2; ++h) { const f32x4 q = v[j][h] * v[j][h]; ss += (q[0] + q[1]) + (q[2] + q[3]); } }
            const float rstd = 1.0f / sqrtf(wave_sum(ss) * (1.0f / D) + EPS);
#pragma unroll
            for (int j = 0; j < 4; ++j)
#pragma unroll
                for (int h = 0; h < 2; ++h) *(f32x4*)(orow + 512 * j + 4 * h) = xv[j][h] + gv[j][h] * (v[j][h] * rstd);
        }
    }
    PHSTAMP(8);
#ifdef PROBE_PH
    if (bx == 0 && tid == 0) {
        asm volatile("s_waitcnt vmcnt(0)" ::: "memory");
        unsigned long long* st = (unsigned long long*)(ws + WS_MOD + 65536) + 16;
        const int ia = (PROBE_PH) & 15, ib = ((PROBE_PH) >> 4) & 15;
        const unsigned long long ta = __hip_atomic_load(st + ia + 1, __ATOMIC_RELAXED, __HIP_MEMORY_SCOPE_AGENT) - __hip_atomic_load(st + ia, __ATOMIC_RELAXED, __HIP_MEMORY_SCOPE_AGENT);
        const unsigned long long tb = __hip_atomic_load(st + ib + 1, __ATOMIC_RELAXED, __HIP_MEMORY_SCOPE_AGENT) - __hip_atomic_load(st + ib, __ATOMIC_RELAXED, __HIP_MEMORY_SCOPE_AGENT);
        const unsigned long long ticks = 4ull * (ta > 99900ull ? 99900ull : ta) + 400000ull * (tb / 400ull);
        const unsigned long long t0 = __builtin_amdgcn_s_memrealtime();
        while (__builtin_amdgcn_s_memrealtime() - t0 < ticks) __builtin_amdgcn_s_sleep(32);
    }
#endif
#ifdef PROBE_ARRIVE
    if (bx == 0 && tid == 0) {
        unsigned long long* aw = (unsigned long long*)(ws + WS_MOD + 131072);
        unsigned long long tmax = 0, tmin = ~0ull; int imax = 0;
        for (int i = 0; i < G; ++i) { const unsigned long long t = __hip_atomic_load(aw + i, __ATOMIC_RELAXED, __HIP_MEMORY_SCOPE_AGENT); if (t > tmax) { tmax = t; imax = i; } if (t < tmin) tmin = t; }
        const unsigned long long t0a = __hip_atomic_load(aw, __ATOMIC_RELAXED, __HIP_MEMORY_SCOPE_AGENT);
        const unsigned long long tafter = __hip_atomic_load((unsigned long long*)(ws + WS_MOD + 65536) + 16 + 8, __ATOMIC_RELAXED, __HIP_MEMORY_SCOPE_AGENT);
        long long val[4];
        val[0] = (long long)(tmax - tmin) / 200;
        val[1] = (long long)(tafter - tmax) / 100;
        val[2] = (long long)(tmax - t0a) / 200;
        val[3] = imax / 4;
        long long a = val[PROBE_ARRIVE & 3], b = val[(PROBE_ARRIVE >> 2) & 3];
        a = a < 0 ? 0 : (a > 89 ? 89 : a); b = b < 0 ? 0 : (b > 99 ? 99 : b);
        const unsigned long long ticks = (unsigned long long)(10 * a + 1000 * b) * 100ull;
        const unsigned long long t0 = __builtin_amdgcn_s_memrealtime();
        while (__builtin_amdgcn_s_memrealtime() - t0 < ticks) __builtin_amdgcn_s_sleep(32);
    }
#endif
#undef IN
#undef BOTH
#undef GRID_BAR
}

extern "C" void kernel_launch(void* const* d_in, const int* in_sizes, int n_in, void* d_out, int out_size, void* d_ws, size_t ws_size, hipStream_t stream) {
    static int grid = 0;
    if (grid == 0) {
        if (n_in != 12 || in_sizes[0] != M * D || out_size != M * D || ws_size < WS_END) { fprintf(stderr, "kernel_launch: unexpected shapes (n_in %d, in0 %d, out %d, ws %zu); nothing launched\n", n_in, n_in > 0 ? in_sizes[0] : -1, out_size, ws_size); grid = -1; return; }
        int dev = 0, cus = 0;
        if (hipGetDevice(&dev) != hipSuccess || hipDeviceGetAttribute(&cus, hipDeviceAttributeMultiprocessorCount, dev) != hipSuccess) { grid = -1; return; }
        if (hipFuncSetAttribute((const void*)mk_fwd, hipFuncAttributeMaxDynamicSharedMemorySize, LDS_BYTES) != hipSuccess) { fprintf(stderr, "kernel_launch: hipFuncSetAttribute failed\n"); grid = -1; return; }
        (void)hipGetLastError();
        grid = cus;
    }
    if (grid < 0) return;
    if (hipMemsetAsync((char*)d_ws + WS_CTL, 0, CTL_ZERO_BYTES, stream) != hipSuccess) return;
    Args a{};
    a.x = (const float*)d_in[0]; a.c = (const float*)d_in[1]; a.pos = (const int*)d_in[2]; a.g_pre = (const float*)d_in[3]; a.w_ada = (const float*)d_in[4]; a.b_ada = (const float*)d_in[5];
    a.w_in = (const float*)d_in[6]; a.conv_w = (const float*)d_in[7]; a.w_attn_o = (const float*)d_in[8]; a.w_conv_o = (const float*)d_in[9]; a.w_o = (const float*)d_in[10]; a.g_post = (const float*)d_in[11];
    a.out = (float*)d_out; a.ws = (unsigned char*)d_ws;
    for (int li = 0; li < N_LAUNCHES; ++li) {
        a.ph_lo = (N_LAUNCHES == 1) ? 0 : li; a.ph_hi = (N_LAUNCHES == 1) ? NPHASES : li + 1; a.li = li;
        hipLaunchKernelGGL(mk_fwd, dim3(grid), dim3(NWAVES * 64), LDS_BYTES, stream, a);
        if (hipPeekAtLastError() != hipSuccess) break;
    }
}
```

```cpp
#include <hip/hip_runtime.h>
#include <cstdio>
#include <cstdint>

#define GAS __attribute__((address_space(1)))
#define LAS __attribute__((address_space(3)))
typedef unsigned short bf16_t;
typedef short bf16x8 __attribute__((ext_vector_type(8)));
typedef short s16x4 __attribute__((ext_vector_type(4)));
typedef float f32x4 __attribute__((ext_vector_type(4)));
typedef float f32x2 __attribute__((ext_vector_type(2)));
typedef unsigned u32x4 __attribute__((ext_vector_type(4)));
typedef unsigned u32x2 __attribute__((ext_vector_type(2)));

constexpr int M = 16384, D = 2048, NQKV = 3072, NZA = 1024, NCV = 2048, PROJ = 22528, NMOD = 6144;
constexpr float EPS = 1e-6f;
constexpr float LOG2E = 1.4426950408889634f;
constexpr float QSCALE = 0.08838834764831845f * 1.4426950408889634f;

__constant__ float INVF[16] = {1.0f, 0.44036659598350525f, 0.1939227432012558f, 0.08539710193872452f, 0.03760603070259094f, 0.016560440883040428f,
    0.007292664609849453f, 0.0032114461064338684f, 0.0014142135623842478f, 0.0006227724370546639f, 0.00027424818836152554f, 0.00012076973507646471f,
    5.3182957344688475e-05f, 2.34199997066753e-05f, 1.0313385246263351e-05f, 4.541670477919979e-06f};

typedef __bf16 bf16x2_t __attribute__((ext_vector_type(2)));
__device__ __forceinline__ unsigned cvt_pk_bf16(float lo, float hi) { const f32x2 v = {lo, hi}; return __builtin_bit_cast(unsigned, __builtin_convertvector(v, bf16x2_t)); }
__device__ __forceinline__ float bf_lo(unsigned w) { return __builtin_bit_cast(float, w << 16); }
__device__ __forceinline__ float bf_hi(unsigned w) { return __builtin_bit_cast(float, w & 0xffff0000u); }
template <int CTRL> __device__ __forceinline__ float dpp_row_shr(float old, float src) { return __int_as_float(__builtin_amdgcn_update_dpp(__float_as_int(old), __float_as_int(src), CTRL, 0xf, 0xf, false)); }
__device__ __forceinline__ float silu_f(float v) { return v * __builtin_amdgcn_rcpf(1.0f + __builtin_amdgcn_exp2f(-v * LOG2E)); }
__device__ __forceinline__ float sigm_f(float v) { return __builtin_amdgcn_rcpf(1.0f + __builtin_amdgcn_exp2f(-v * LOG2E)); }

constexpr size_t MiB = 1u << 20;
constexpr size_t WS_CTL = 0, CTL_ZERO_BYTES = 32768;
constexpr size_t WS_MOD = 1 * MiB;
constexpr size_t WS_CS = 2 * MiB;
constexpr size_t WS_WIN = 4 * MiB;
constexpr size_t WS_WA = 92 * MiB, WS_WC = 100 * MiB, WS_WO = 108 * MiB;
constexpr size_t WS_H = 116 * MiB;
constexpr size_t WS_Q = 180 * MiB, WS_K = 276 * MiB, WS_V = 372 * MiB;
constexpr size_t WS_SZ = 468 * MiB;
constexpr size_t WS_R = 500 * MiB;
constexpr size_t WS_FX = 564 * MiB;
constexpr size_t WS_O2 = 628 * MiB;
constexpr size_t WS_LSE = 660 * MiB;
constexpr size_t WS_END = 662 * MiB;
constexpr size_t WS_O1 = 148 * MiB;
constexpr size_t WS_AATT = WS_K + 32 * MiB, WS_MG = WS_V + 32 * MiB, WS_Y = WS_R;

#ifndef PG8_A_AUX
#define PG8_A_AUX 0
#endif
#ifndef PG8_B_AUX
#define PG8_B_AUX 0
#endif
namespace pg8 {
constexpr int BM = 256, BK = 64, HALF = 128, HTB = HALF * BK * 2, STAGE_BYTES = 8 * HTB, NXCD = 8, WGM = 8;
__host__ __device__ __forceinline__ int lds_byte(int r, int c) { const int st = (r >> 4) * 2 + (c >> 5), rr = r & 15, cc = c & 31, ob = rr * 64 + cc * 2; return st * 1024 + (ob ^ (((ob >> 9) & 1) << 5)); }
__host__ __device__ __forceinline__ void stage_rc(int b, int& R, int& C) { const int st = b / 1024, sb = b % 1024, swz = sb ^ (((sb >> 9) & 1) << 5); R = (st >> 1) * 16 + swz / 64; C = (st & 1) * 32 + (swz % 64) / 2; }
__host__ __device__ __forceinline__ int perm32(int rho) { const int n = rho >> 4, i = rho & 15; return 8 * (i >> 2) + 4 * n + (i & 3); }

struct Unit { int pm, pn; };
struct Gemm { const bf16_t* A; const bf16_t* Bt; int M, N, K; };

struct StaticOrder {
    int nM, nN, nwg, G, c, rounds, rep;
    __host__ __device__ void init(int M_, int N_, int G_, int c_, int rep_ = 1) { nM = M_ / BM; nN = N_ / BM; nwg = nM * nN; G = G_; c = c_; rounds = (nwg + G - 1) / G; rep = rep_; }
    __host__ __device__ bool next(int i, Unit& u) const {
        if (i >= rounds * rep) return false;
        i = i % rounds;
        const long L = (long)i * G + c; if (L >= nwg) return false;
        int wgid = (int)L; { const int q = nwg / NXCD, r = nwg % NXCD, xcd = wgid % NXCD, off = wgid / NXCD; wgid = (xcd < r ? xcd * (q + 1) : r * (q + 1) + (xcd - r) * q) + off; }
        const int nig = WGM * nN, gid = wgid / nig, fm = gid * WGM, gsz = (nM - fm) < WGM ? (nM - fm) : WGM;
        u.pm = fm + ((wgid % nig) % gsz); u.pn = (wgid % nig) / gsz; return true;
    }
    __device__ __forceinline__ void a_ready(const Unit&) const {}
    __device__ __forceinline__ void done(const Unit&) const {}
};


struct Seg { const char* A; const char* B; int nt; int mid; Unit u; };
__device__ __forceinline__ const char* rfl_ptr(const char* p) { const unsigned long long v = (unsigned long long)p; const unsigned lo = __builtin_amdgcn_readfirstlane((unsigned)v), hi = __builtin_amdgcn_readfirstlane((unsigned)(v >> 32)); return (const char*)(((unsigned long long)hi << 32) | lo); }
__device__ __forceinline__ void rfl_seg(Seg& o) { o.A = rfl_ptr(o.A); o.B = rfl_ptr(o.B); o.nt = __builtin_amdgcn_readfirstlane(o.nt); o.mid = __builtin_amdgcn_readfirstlane(o.mid); o.u.pm = __builtin_amdgcn_readfirstlane(o.u.pm); o.u.pn = __builtin_amdgcn_readfirstlane(o.u.pn); }
constexpr int NSTORE = 16;
template <class Epi, class Sched, bool DUAL = false>
__device__ __forceinline__ void gemm_stream(LAS unsigned char* lds, const int pitch, const Sched& S, const Epi& E) {
    const int tid = threadIdx.x, wid = __builtin_amdgcn_readfirstlane(tid >> 6), lane = tid & 63, wr = wid >> 2, wc = wid & 3, fr = lane & 15, fq = lane >> 4;
    unsigned voffA[2], voffB[2];
#pragma unroll
    for (int i = 0; i < 2; ++i) { int R, C; stage_rc(tid * 16 + i * 8192, R, C); const int Rb = Epi::PERM ? ((R & ~31) + perm32(R & 31)) : R;
        voffA[i] = (unsigned)(R * pitch + C) * 2u; voffB[i] = (unsigned)(Rb * pitch + C) * 2u; }
    const size_t kstep = (size_t)(BK * 2);
    const size_t hstep = (size_t)HALF * pitch * 2;
    const unsigned ldsw = (unsigned)wid * 1024u;
    const int aoff = lds_byte(wr * 64 + fr, fq * 8), boff = lds_byte(wc * 32 + fr, fq * 8);
#define PG8_SA(b, h) (((b) * 2 + (h)) * HTB)
#define PG8_SB(b, h) ((4 + (b) * 2 + (h)) * HTB)
#define PG8_STAGE(bufoff, gbase, voff) do { const char* _gb = (const char*)(gbase); asm volatile("" : "+s"(_gb));   \
        _Pragma("unroll") for (int _i = 0; _i < 2; ++_i) \
        __builtin_amdgcn_global_load_lds((const unsigned*)(_gb + (voff)[_i]), (LAS unsigned*)(lds + (bufoff) + ldsw + _i * 8192), 16, 0, PG8_A_AUX); } while (0)
#define PG8_STAGEB(bufoff, gbase, voff) do { const char* _gb = (const char*)(gbase); asm volatile("" : "+s"(_gb)); \
        _Pragma("unroll") for (int _i = 0; _i < 2; ++_i) \
        __builtin_amdgcn_global_load_lds((const unsigned*)(_gb + (voff)[_i]), (LAS unsigned*)(lds + (bufoff) + ldsw + _i * 8192), 16, 0, PG8_B_AUX); } while (0)
#define PG8_LDA(dst, b, h) do { _Pragma("unroll") for (int m = 0; m < 4; ++m) _Pragma("unroll") for (int k = 0; k < 2; ++k) dst[m][k] = *(const LAS bf16x8*)(lds + PG8_SA(b, h) + aoff + m * 2048 + k * 1024); } while (0)
#define PG8_LDB(dst, b, h) do { _Pragma("unroll") for (int n = 0; n < 2; ++n) _Pragma("unroll") for (int k = 0; k < 2; ++k) dst[n][k] = *(const LAS bf16x8*)(lds + PG8_SB(b, h) + boff + n * 2048 + k * 1024); } while (0)
#define PG8_MMA(ai, bj, At, Bt) do { __builtin_amdgcn_s_setprio(1); _Pragma("unroll") for (int m = 0; m < 4; ++m) _Pragma("unroll") for (int n = 0; n < 2; ++n) _Pragma("unroll") for (int k = 0; k < 2; ++k) \
        acc[ai][bj][m][n] = __builtin_amdgcn_mfma_f32_16x16x32_bf16(Bt[n][k], At[m][k], acc[ai][bj][m][n], 0, 0, 0); __builtin_amdgcn_s_setprio(0); } while (0)
#define PG8_WAIT_V(n) asm volatile("s_waitcnt vmcnt(" #n ")" ::: "memory")
#define PG8_WAIT_VR() PG8_WAIT_V(8)
#define PG8_WAIT_L(n) asm volatile("s_waitcnt lgkmcnt(" #n ")" ::: "memory")
#define PG8_BAR __builtin_amdgcn_s_barrier()
#define PG8_SCHED __builtin_amdgcn_sched_barrier(0)
    Seg cur, nxt; int si = 0;
    if (!S.seg(0, cur)) return;
    f32x4 acc[2][2][4][2];
#pragma unroll
    for (int a = 0; a < 2; ++a)
#pragma unroll
        for (int b = 0; b < 2; ++b)
#pragma unroll
            for (int m = 0; m < 4; ++m)
#pragma unroll
                for (int n = 0; n < 2; ++n) acc[a][b][m][n] = (f32x4){0.f, 0.f, 0.f, 0.f};
    bf16x8 At[4][2], B0[2][2], B1[2][2];
    {
        const char* cA = cur.A; const char* cB = cur.B;
        PG8_STAGEB(PG8_SB(0, 0), cB, voffB); PG8_STAGEB(PG8_SB(0, 1), cB + hstep, voffB); PG8_STAGE(PG8_SA(0, 0), cA, voffA); PG8_STAGE(PG8_SA(0, 1), cA + hstep, voffA);
        if (wr == 1) PG8_BAR;
        PG8_WAIT_V(2); PG8_BAR;
        PG8_STAGEB(PG8_SB(1, 0), cB + kstep, voffB); PG8_STAGE(PG8_SA(1, 0), cA + kstep, voffA); PG8_STAGEB(PG8_SB(1, 1), cB + hstep + kstep, voffB);
        PG8_WAIT_V(6); PG8_BAR;
    }
#define PG8_ZERO(ai) do { _Pragma("unroll") for (int b = 0; b < 2; ++b) _Pragma("unroll") for (int m = 0; m < 4; ++m) _Pragma("unroll") for (int n = 0; n < 2; ++n) acc[ai][b][m][n] = (f32x4){0.f, 0.f, 0.f, 0.f}; } while (0)
#define PG8_SEAM(ai) do { E.template half<ai>(acc, pu, wr, wc, fr, fq); PG8_ZERO(ai); } while (0)
    bool fresh = true; Unit pu = cur.u;
    for (;;) {
        const bool has_next = S.seg(si + 1, nxt);
        const char* cA = cur.A; const char* cB = cur.B; const int nt = cur.nt;
        const char* nA = has_next ? nxt.A : cA; const char* nB = has_next ? nxt.B : cB;
#pragma nounroll
        for (int t = 0; t < nt; t += 2) {
            const bool first = (t == 0) && !fresh;
            const bool last = (t == nt - 2);
            const char* a1 = cA + (size_t)(t + 1) * kstep;
            const char* a2 = last ? nA : cA + (size_t)(t + 2) * kstep; const char* b2 = last ? nB : cB + (size_t)(t + 2) * kstep;
            const char* a3 = a2 + kstep; const char* b3 = b2 + kstep;
            if constexpr (!DUAL) { if (first) { PG8_SEAM(0); PG8_SCHED; } }
            PG8_LDB(B0, 0, 0); PG8_LDB(B1, 0, 1); PG8_SCHED; PG8_LDA(At, 0, 0); if (!first) PG8_STAGE(PG8_SA(1, 1), a1 + hstep, voffA);
            PG8_WAIT_VR(); PG8_WAIT_L(0); PG8_BAR; PG8_MMA(0, 0, At, B0); PG8_MMA(0, 1, At, B1); PG8_BAR; PG8_SCHED;
            if constexpr (!DUAL) { if (first) { PG8_SEAM(1); PG8_SCHED; } }
            PG8_LDA(At, 0, 1); PG8_STAGEB(PG8_SB(0, 0), b2, voffB); PG8_STAGEB(PG8_SB(0, 1), b2 + hstep, voffB); PG8_STAGE(PG8_SA(0, 0), a2, voffA);
            PG8_WAIT_VR(); PG8_WAIT_L(0); PG8_BAR; PG8_MMA(1, 0, At, B0); PG8_MMA(1, 1, At, B1); PG8_BAR; PG8_SCHED;
            PG8_LDB(B0, 1, 0); PG8_LDB(B1, 1, 1); PG8_SCHED; PG8_LDA(At, 1, 0); PG8_STAGE(PG8_SA(0, 1), a2 + hstep, voffA);
            PG8_WAIT_VR(); PG8_WAIT_L(0); PG8_BAR; PG8_MMA(0, 0, At, B0); PG8_MMA(0, 1, At, B1); PG8_BAR; PG8_SCHED;
            PG8_LDA(At, 1, 1); PG8_STAGEB(PG8_SB(1, 0), b3, voffB); PG8_STAGEB(PG8_SB(1, 1), b3 + hstep, voffB); PG8_STAGE(PG8_SA(1, 0), a3, voffA);
            PG8_WAIT_V(8); PG8_WAIT_L(0); PG8_BAR; PG8_MMA(1, 0, At, B0); PG8_MMA(1, 1, At, B1); PG8_BAR; PG8_SCHED;
        }
        PG8_STAGE(PG8_SA(1, 1), nA + kstep + hstep, voffA);
        PG8_SCHED;
        if constexpr (!DUAL) {
            if (has_next) { pu = cur.u; cur = nxt; ++si; fresh = false; continue; }
            if (wr == 0) PG8_BAR;
            E(acc, cur.u, wr, wc, fr, fq);
            break;
        } else {
            if (wr == 0) PG8_BAR;
            E.scale(acc, cur.u, wr, wc, fr, fq, cur.mid != 0);
            if (!cur.mid) { E(acc, cur.u, wr, wc, fr, fq); PG8_ZERO(0); PG8_ZERO(1); }
            if (!has_next) break;
            cur = nxt; ++si; fresh = false;
            if (wr == 1) PG8_BAR;
        }
    }
#undef PG8_ZERO
#undef PG8_SEAM
    PG8_WAIT_V(0);
    PG8_BAR;
#undef PG8_SA
#undef PG8_SB
#undef PG8_STAGE
#undef PG8_STAGEB
#undef PG8_LDA
#undef PG8_LDB
#undef PG8_MMA
#undef PG8_WAIT_V
#undef PG8_WAIT_VR
#undef PG8_WAIT_L
#undef PG8_BAR
#undef PG8_SCHED
}
struct SegOrder1 {
    StaticOrder so; const char* A; const char* B; size_t tstep; int nt;
    __device__ __forceinline__ bool seg(int s, Seg& o) const { Unit u; if (!so.next(s, u)) return false; o.A = A + (size_t)u.pm * tstep; o.B = B + (size_t)u.pn * tstep; o.nt = nt; o.mid = 0; o.u = u; rfl_seg(o); return true; }
};

__device__ __forceinline__ u32x4 pack8(const f32x4 v0, const f32x4 v1) { u32x4 w; w.x = cvt_pk_bf16(v0[0], v0[1]); w.y = cvt_pk_bf16(v0[2], v0[3]); w.z = cvt_pk_bf16(v1[0], v1[1]); w.w = cvt_pk_bf16(v1[2], v1[3]); return w; }
__device__ __forceinline__ void unpack8(const u32x4 w, f32x4& v0, f32x4& v1) { v0 = (f32x4){bf_lo(w.x), bf_hi(w.x), bf_lo(w.y), bf_hi(w.y)}; v1 = (f32x4){bf_lo(w.z), bf_hi(w.z), bf_lo(w.w), bf_hi(w.w)}; }

#ifdef NT_STORES
#define ST16(p, v) __builtin_nontemporal_store((v), (u32x4*)(p))
#define ST8(p, v) __builtin_nontemporal_store((v), (u32x2*)(p))
#else
#define ST16(p, v) (*(u32x4*)(p) = (v))
#define ST8(p, v) (*(u32x2*)(p) = (v))
#endif
struct EpiProj {
    static constexpr bool PERM = true;
    __device__ __forceinline__ void mid(f32x4 (&)[2][2][4][2], const Unit&, int, int, int, int) const {}
    unsigned char* ws; bf16_t* SGA; const float* cw; LAS unsigned char* halo;
    template <int AI>
    __device__ __forceinline__ void half(const f32x4 (&acc)[2][2][4][2], const Unit& u, int wr, int wc, int fr, int fq) const {
        asm volatile("" ::: "memory");
        int lro = wr * 64 + fr, lc = wc * 32 + 8 * fq; asm volatile("" : "+v"(lro), "+v"(lc));
        int pn = u.pn, upm = u.pm; asm volatile("" : "+s"(pn), "+s"(upm));
        const int row0 = upm * BM + lro + AI * HALF;
        bf16_t* const Q = (bf16_t*)(ws + WS_Q); bf16_t* const Kb = (bf16_t*)(ws + WS_K); bf16_t* const V = (bf16_t*)(ws + WS_V); bf16_t* const SZ = (bf16_t*)(ws + WS_SZ); bf16_t* const R = (bf16_t*)(ws + WS_R);
        bf16_t* const SGC = SGA + (size_t)M * D; const float* const cs = (const float*)(ws + WS_CS);
        float* const HP = (float*)(ws + WS_FX); float* const FXQ = HP + (size_t)64 * 2 * NCV; float* const FXU = FXQ + (size_t)64 * 2 * NCV;
        if (pn < 24) {
            const bool isq = pn < 12; const int tq = isq ? pn : pn - 12; bf16_t* base = (isq ? Q : Kb) + (size_t)(tq >> 2) * M * 1024; const int colt = (tq & 3) * BM; const float sc = isq ? QSCALE : 1.0f;
            const bool rot = (fq == 0);
            f32x4 cv[4], sv[4];
#pragma unroll
            for (int m = 0; m < 4; ++m) { const float* cr = cs + (size_t)(row0 + m * 16) * 32 + 4 * wc; cv[m] = *(const f32x4*)cr; sv[m] = *(const f32x4*)(cr + 16); }
#pragma unroll
            for (int m = 0; m < 4; ++m) {
                const f32x4 c = rot ? cv[m] * sc : (f32x4){sc, sc, sc, sc}, sn = rot ? sv[m] * sc : (f32x4){0.f, 0.f, 0.f, 0.f};
                bf16_t* rowp = base + (size_t)(row0 + m * 16) * 1024 + colt + lc;
#pragma unroll
                for (int bj = 0; bj < 2; ++bj) { const f32x4 v0 = acc[AI][bj][m][0], v1 = acc[AI][bj][m][1];
                    ST16((rowp + bj * HALF), (pack8(v0 * c - v1 * sn, v0 * sn + v1 * c))); }
            }
        } else if (pn < 40) {
            bf16_t* tb; int ld, colt;
            if (pn < 36) { const int tv = pn - 24; colt = (tv & 3) * BM; tb = V + (size_t)(tv >> 2) * M * 1024; ld = 1024; } else { colt = (pn - 36) * BM; tb = SZ; ld = NZA; }
#pragma unroll
            for (int m = 0; m < 4; ++m) { bf16_t* rowp = tb + (size_t)(row0 + m * 16) * ld + colt + lc;
#pragma unroll
                for (int bj = 0; bj < 2; ++bj) ST16((rowp + bj * HALF), (pack8(acc[AI][bj][m][0], acc[AI][bj][m][1]))); }
        } else if (pn < 72) {
            int chl = 16 * wc + 4 * fq; asm volatile("" : "+v"(chl));
            const int ct = pn - 40, chb = 64 * ct + chl, pm = upm;
            const f32x4 w0 = *(const f32x4*)(cw + chb), w1 = *(const f32x4*)(cw + NCV + chb), w2 = *(const f32x4*)(cw + 2 * NCV + chb);
#pragma unroll
            for (int m = 0; m < 4; ++m) { const f32x4 pv = acc[AI][0][m][1] * acc[AI][1][m][0];
                const int gi = 8 * AI + 4 * wr + m;
                if (fr >= 14) { *(LAS f32x4*)(halo + (size_t)(((gi * 2 + (fr - 14)) * 64 + chl) * 4)) = pv;
                    if (gi == 15) *(f32x4*)(HP + ((size_t)(pm * 2 + (fr - 14)) * NCV + chb)) = pv; } }
            asm volatile("s_waitcnt lgkmcnt(0)" ::: "memory");
#pragma unroll
            for (int m = 0; m < 4; ++m) {
                const int gi = 8 * AI + 4 * wr + m; const int gp = gi > 0 ? gi - 1 : 0;
                f32x4 H0 = *(const LAS f32x4*)(halo + (size_t)(((gp * 2 + 0) * 64 + chl) * 4)), H1 = *(const LAS f32x4*)(halo + (size_t)(((gp * 2 + 1) * 64 + chl) * 4));
                if (gi == 0) { H0 = (f32x4){0.f, 0.f, 0.f, 0.f}; H1 = H0; }
                const f32x4 Hs = (fr == 1) ? H1 : H0, pvv = acc[AI][0][m][1] * acc[AI][1][m][0];
                f32x4 Pm1, Pm2, qv;
#pragma unroll
                for (int j = 0; j < 4; ++j) {
                    const float pj = pvv[j], h1j = H1[j], hsj = Hs[j];
                    Pm1[j] = dpp_row_shr<0x111>(h1j, pj); Pm2[j] = dpp_row_shr<0x112>(hsj, pj);
                    qv[j] = acc[AI][0][m][0][j] * silu_f(acc[AI][1][m][1][j]); }
                const f32x4 uu = w2 * pvv + w1 * Pm1 + w0 * Pm2, rv = qv * uu;
                const size_t ro = (size_t)(row0 + m * 16) * NCV + chb;
                u32x2 rw; rw.x = cvt_pk_bf16(rv[0], rv[1]); rw.y = cvt_pk_bf16(rv[2], rv[3]);
                ST8((R + ro), (rw));
                if (gi == 0 && fr < 2 && pm > 0) { *(f32x4*)(FXQ + ((size_t)(pm * 2 + fr) * NCV + chb)) = qv; *(f32x4*)(FXU + ((size_t)(pm * 2 + fr) * NCV + chb)) = uu; }
            }
        } else {
            const int colt = (pn - 72) * HALF;
#pragma unroll
            for (int m = 0; m < 4; ++m) { const size_t ro = (size_t)(row0 + m * 16) * D + colt + lc;
                f32x4 r[2], c[2];
#pragma unroll
                for (int n = 0; n < 2; ++n)
#pragma unroll
                    for (int j = 0; j < 4; ++j) { const float pc = 1.0f + __builtin_amdgcn_exp2f(-acc[AI][1][m][n][j] * LOG2E), pa = 1.0f + __builtin_amdgcn_exp2f(-acc[AI][0][m][n][j] * LOG2E);
                        const float t = __builtin_amdgcn_rcpf(pa * pc); c[n][j] = pa * t; r[n][j] = pc * pc * t; }
                ST16((SGA + ro), (pack8(r[0], r[1]))); ST16((SGC + ro), (pack8(c[0], c[1]))); }
        }
    }
    __device__ __forceinline__ void operator()(const f32x4 (&acc)[2][2][4][2], const Unit& u, int wr, int wc, int fr, int fq) const {
        int pn = u.pn, upm = u.pm; asm volatile("" : "+s"(pn), "+s"(upm));
        const int row0 = upm * BM + wr * 64 + fr; const int lc = wc * 32 + 8 * fq;
        bf16_t* const Q = (bf16_t*)(ws + WS_Q); bf16_t* const Kb = (bf16_t*)(ws + WS_K); bf16_t* const V = (bf16_t*)(ws + WS_V); bf16_t* const SZ = (bf16_t*)(ws + WS_SZ); bf16_t* const R = (bf16_t*)(ws + WS_R);
        bf16_t* const SGC = SGA + (size_t)M * D; const float* const cs = (const float*)(ws + WS_CS);
        float* const HP = (float*)(ws + WS_FX); float* const FXQ = HP + (size_t)64 * 2 * NCV; float* const FXU = FXQ + (size_t)64 * 2 * NCV;
        if (pn < 24) {
            const bool isq = pn < 12; const int tq = isq ? pn : pn - 12; bf16_t* base = (isq ? Q : Kb) + (size_t)(tq >> 2) * M * 1024; const int colt = (tq & 3) * BM; const float sc = isq ? QSCALE : 1.0f;
            const bool rot = (fq == 0);
            f32x4 cv[2][4], sv[2][4];
#pragma unroll
            for (int ai = 0; ai < 2; ++ai)
#pragma unroll
                for (int m = 0; m < 4; ++m) { const float* cr = cs + (size_t)(row0 + ai * HALF + m * 16) * 32 + 4 * wc; cv[ai][m] = *(const f32x4*)cr; sv[ai][m] = *(const f32x4*)(cr + 16); }
#pragma unroll
            for (int ai = 0; ai < 2; ++ai)
#pragma unroll
                for (int m = 0; m < 4; ++m) {
                    const f32x4 c = rot ? cv[ai][m] * sc : (f32x4){sc, sc, sc, sc}, sn = rot ? sv[ai][m] * sc : (f32x4){0.f, 0.f, 0.f, 0.f};
                    bf16_t* rowp = base + (size_t)(row0 + ai * HALF + m * 16) * 1024 + colt + lc;
#pragma unroll
                    for (int bj = 0; bj < 2; ++bj) { const f32x4 v0 = acc[ai][bj][m][0], v1 = acc[ai][bj][m][1];
                        ST16((rowp + bj * HALF), (pack8(v0 * c - v1 * sn, v0 * sn + v1 * c))); }
                }
        } else if (pn < 36) {
            const int tv = pn - 24, colt = (tv & 3) * BM; bf16_t* vbase = V + (size_t)(tv >> 2) * M * 1024;
#pragma unroll
            for (int ai = 0; ai < 2; ++ai)
#pragma unroll
                for (int m = 0; m < 4; ++m) { bf16_t* rowp = vbase + (size_t)(row0 + ai * HALF + m * 16) * 1024 + colt + lc;
#pragma unroll
                    for (int bj = 0; bj < 2; ++bj) ST16((rowp + bj * HALF), (pack8(acc[ai][bj][m][0], acc[ai][bj][m][1]))); }
        } else if (pn < 40) {
            const int colt = (pn - 36) * BM;
#pragma unroll
            for (int ai = 0; ai < 2; ++ai)
#pragma unroll
                for (int m = 0; m < 4; ++m) { bf16_t* rowp = SZ + (size_t)(row0 + ai * HALF + m * 16) * NZA + colt + lc;
#pragma unroll
                    for (int bj = 0; bj < 2; ++bj) ST16((rowp + bj * HALF), (pack8(acc[ai][bj][m][0], acc[ai][bj][m][1]))); }
        } else if (pn < 72) {
            int chl = 16 * wc + 4 * fq; asm volatile("" : "+v"(chl));
            const int ct = pn - 40, chb = 64 * ct + chl, pm = upm;
            const f32x4 w0 = *(const f32x4*)(cw + chb), w1 = *(const f32x4*)(cw + NCV + chb), w2 = *(const f32x4*)(cw + 2 * NCV + chb);
#pragma unroll
            for (int ai = 0; ai < 2; ++ai)
#pragma unroll
                for (int m = 0; m < 4; ++m) { const f32x4 pv = acc[ai][0][m][1] * acc[ai][1][m][0];
                    const int gi = 8 * ai + 4 * wr + m;
                    if (fr >= 14) { *(LAS f32x4*)(halo + (size_t)(((gi * 2 + (fr - 14)) * 64 + chl) * 4)) = pv;
                        if (gi == 15) *(f32x4*)(HP + ((size_t)(pm * 2 + (fr - 14)) * NCV + chb)) = pv; } }
            asm volatile("s_waitcnt lgkmcnt(0)" ::: "memory"); __builtin_amdgcn_s_barrier(); asm volatile("" ::: "memory");
#pragma unroll
            for (int ai = 0; ai < 2; ++ai)
#pragma unroll
                for (int m = 0; m < 4; ++m) {
                    const int gi = 8 * ai + 4 * wr + m; const int gp = gi > 0 ? gi - 1 : 0;
                    f32x4 H0 = *(const LAS f32x4*)(halo + (size_t)(((gp * 2 + 0) * 64 + chl) * 4)), H1 = *(const LAS f32x4*)(halo + (size_t)(((gp * 2 + 1) * 64 + chl) * 4));
                    if (gi == 0) { H0 = (f32x4){0.f, 0.f, 0.f, 0.f}; H1 = H0; }
                    const f32x4 Hs = (fr == 1) ? H1 : H0, pvv = acc[ai][0][m][1] * acc[ai][1][m][0];
                    f32x4 Pm1, Pm2, qv;
#pragma unroll
                    for (int j = 0; j < 4; ++j) {
                        const float pj = pvv[j], h1j = H1[j], hsj = Hs[j];
                        Pm1[j] = dpp_row_shr<0x111>(h1j, pj); Pm2[j] = dpp_row_shr<0x112>(hsj, pj);
                        qv[j] = acc[ai][0][m][0][j] * silu_f(acc[ai][1][m][1][j]); }
                    const f32x4 uu = w2 * pvv + w1 * Pm1 + w0 * Pm2, rv = qv * uu;
                    const size_t ro = (size_t)(row0 + ai * HALF + m * 16) * NCV + chb;
                    u32x2 rw; rw.x = cvt_pk_bf16(rv[0], rv[1]); rw.y = cvt_pk_bf16(rv[2], rv[3]);
                    ST8((R + ro), (rw));
                    if (gi == 0 && fr < 2 && pm > 0) { *(f32x4*)(FXQ + ((size_t)(pm * 2 + fr) * NCV + chb)) = qv; *(f32x4*)(FXU + ((size_t)(pm * 2 + fr) * NCV + chb)) = uu; }
                }
        } else {
            const int colt = (pn - 72) * HALF;
#pragma unroll
            for (int ai = 0; ai < 2; ++ai)
#pragma unroll
                for (int m = 0; m < 4; ++m) { const size_t ro = (size_t)(row0 + ai * HALF + m * 16) * D + colt + lc;
                    f32x4 r[2], c[2];
#pragma unroll
                    for (int n = 0; n < 2; ++n)
#pragma unroll
                        for (int j = 0; j < 4; ++j) { const float pc = 1.0f + __builtin_amdgcn_exp2f(-acc[ai][1][m][n][j] * LOG2E), pa = 1.0f + __builtin_amdgcn_exp2f(-acc[ai][0][m][n][j] * LOG2E);
                            const float t = __builtin_amdgcn_rcpf(pa * pc); c[n][j] = pa * t; r[n][j] = pc * pc * t; }
                    ST16((SGA + ro), (pack8(r[0], r[1]))); ST16((SGC + ro), (pack8(c[0], c[1]))); }
        }
    }
};
struct EpiMerge {
    static constexpr bool PERM = true;
    bf16_t* O; const bf16_t* RHO; const bf16_t* SC; int ldc;
    __device__ __forceinline__ size_t lane_off(const Unit& u, int wr, int wc, int fr, int fq, int ai) const {
        size_t o = (size_t)(u.pm * BM + wr * 64 + fr + ai * HALF) * ldc + u.pn * BM + wc * 32 + 8 * fq; asm volatile("" : "+v"(o)); return o; }
    __device__ __forceinline__ void scale(f32x4 (&acc)[2][2][4][2], const Unit& u, int wr, int wc, int fr, int fq, bool is_mid) const {
        const bf16_t* G = is_mid ? RHO : SC;
#pragma unroll
        for (int ai = 0; ai < 2; ++ai) {
            const bf16_t* p = G + lane_off(u, wr, wc, fr, fq, ai);
            u32x4 gw[4][2];
#pragma unroll
            for (int m = 0; m < 4; ++m)
#pragma unroll
                for (int bj = 0; bj < 2; ++bj) gw[m][bj] = *(const u32x4*)(p + (size_t)m * 16 * ldc + bj * HALF);
#pragma unroll
            for (int m = 0; m < 4; ++m)
#pragma unroll
                for (int bj = 0; bj < 2; ++bj) { f32x4 g0, g1; unpack8(gw[m][bj], g0, g1); acc[ai][bj][m][0] *= g0; acc[ai][bj][m][1] *= g1; }
        }
    }
    template <int AI> __device__ __forceinline__ void scale_half(f32x4 (&acc)[2][2][4][2], const Unit& u, int wr, int wc, int fr, int fq, bool is_mid) const {
        asm volatile("" ::: "memory");
        const bf16_t* p = (is_mid ? RHO : SC) + lane_off(u, wr, wc, fr, fq, AI);
        u32x4 gw[4][2];
#pragma unroll
        for (int m = 0; m < 4; ++m)
#pragma unroll
            for (int bj = 0; bj < 2; ++bj) gw[m][bj] = *(const u32x4*)(p + (size_t)m * 16 * ldc + bj * HALF);
#pragma unroll
        for (int m = 0; m < 4; ++m)
#pragma unroll
            for (int bj = 0; bj < 2; ++bj) { f32x4 g0, g1; unpack8(gw[m][bj], g0, g1); acc[AI][bj][m][0] *= g0; acc[AI][bj][m][1] *= g1; }
    }
    template <int AI> __device__ __forceinline__ void half(const f32x4 (&acc)[2][2][4][2], const Unit& u, int wr, int wc, int fr, int fq) const {
        bf16_t* q = O + lane_off(u, wr, wc, fr, fq, AI);
#pragma unroll
        for (int m = 0; m < 4; ++m)
#pragma unroll
            for (int bj = 0; bj < 2; ++bj) *(u32x4*)(q + (size_t)m * 16 * ldc + bj * HALF) = pack8(acc[AI][bj][m][0], acc[AI][bj][m][1]);
    }
    __device__ __forceinline__ void mid(f32x4 (&)[2][2][4][2], const Unit&, int, int, int, int) const {}
    __device__ __forceinline__ void operator()(const f32x4 (&acc)[2][2][4][2], const Unit& u, int wr, int wc, int fr, int fq) const {
#pragma unroll
        for (int ai = 0; ai < 2; ++ai) {
            bf16_t* q = O + lane_off(u, wr, wc, fr, fq, ai);
#pragma unroll
            for (int m = 0; m < 4; ++m)
#pragma unroll
                for (int bj = 0; bj < 2; ++bj) *(u32x4*)(q + (size_t)m * 16 * ldc + bj * HALF) = pack8(acc[ai][bj][m][0], acc[ai][bj][m][1]);
        }
    }
};
struct EpiBf16 {
    static constexpr bool PERM = true;
    __device__ __forceinline__ void mid(f32x4 (&)[2][2][4][2], const Unit&, int, int, int, int) const {}
    bf16_t* O; int ldc;
    template <int AI> __device__ __forceinline__ void half(const f32x4 (&acc)[2][2][4][2], const Unit& u, int wr, int wc, int fr, int fq) const {
        int lro = wr * 64 + fr, lc = wc * 32 + 8 * fq; asm volatile("" : "+v"(lro), "+v"(lc));
        const int row0 = u.pm * BM + lro + AI * HALF, col0 = u.pn * BM + lc;
#pragma unroll
        for (int m = 0; m < 4; ++m) { bf16_t* rowp = O + (size_t)(row0 + m * 16) * ldc + col0;
#pragma unroll
            for (int bj = 0; bj < 2; ++bj) *(u32x4*)(rowp + bj * HALF) = pack8(acc[AI][bj][m][0], acc[AI][bj][m][1]); }
    }
    __device__ __forceinline__ void operator()(const f32x4 (&acc)[2][2][4][2], const Unit& u, int wr, int wc, int fr, int fq) const {
        const int row0 = u.pm * BM + wr * 64 + fr, col0 = u.pn * BM + wc * 32 + 8 * fq;
#pragma unroll
        for (int ai = 0; ai < 2; ++ai)
#pragma unroll
            for (int m = 0; m < 4; ++m) { bf16_t* rowp = O + (size_t)(row0 + ai * HALF + m * 16) * ldc + col0;
#pragma unroll
                for (int bj = 0; bj < 2; ++bj) *(u32x4*)(rowp + bj * HALF) = pack8(acc[ai][bj][m][0], acc[ai][bj][m][1]); }
    }
};
struct SegOrder2 {
    StaticOrder so; const char *A0, *B0, *A1, *B1; size_t tstep; int nt0, nt1;
    __device__ __forceinline__ bool seg(int s_, Seg& o) const { Unit u; if (!so.next(s_ >> 1, u)) return false; const int h = s_ & 1;
        o.A = (h ? A1 : A0) + (size_t)u.pm * tstep; o.B = (h ? B1 : B0) + (size_t)u.pn * tstep; o.nt = h ? nt1 : nt0; o.mid = !h; o.u = u; rfl_seg(o); return true; }
};
}

#ifndef PG8_SP2
#define PG8_SP2 true
#endif
#ifndef PG8_ALIGN
#define PG8_ALIGN true
#endif

constexpr int NWAVES = 8;
#ifndef MK_N_LAUNCHES
#define MK_N_LAUNCHES 1
#endif
constexpr int NPHASES = 8;
constexpr int N_LAUNCHES = MK_N_LAUNCHES;

constexpr int CW_BAR = 4096, CW_MODCNT = 8000;
#define XCD_BAR_WORDS 3456

constexpr int RING_BYTES = 131072;
constexpr int LDSCTL_OFF = RING_BYTES, MISC_OFF = LDSCTL_OFF + 320, HALO_OFF = RING_BYTES + 1024;
constexpr int LDS_BYTES = 147456;

typedef GAS unsigned gu32;
#define RLX_AGENT __ATOMIC_RELAXED, __HIP_MEMORY_SCOPE_AGENT

#define XB_TMO      128
#define XB_XCNT(j)  (256  + 64 * (j))
#define XB_XSUB(j)  (1280 + 64 * (j))
#define XB_XGEN(j)  (2304 + 64 * (j))
#define XB_TOP      3328
#define XB_TOPGEN   3392
#define XB_SPIN_CAP (1u << 18)

__device__ __forceinline__ unsigned xb_ld(unsigned* p)              { return __hip_atomic_load(p, __ATOMIC_RELAXED, __HIP_MEMORY_SCOPE_AGENT); }
__device__ __forceinline__ unsigned xb_add(unsigned* p, unsigned v) { return __hip_atomic_fetch_add(p, v, __ATOMIC_RELAXED, __HIP_MEMORY_SCOPE_AGENT); }
__device__ __forceinline__ unsigned xb_xcc_id() { return (unsigned)__builtin_amdgcn_s_getreg((3 << 11) | 20) & 0xFu; }
#define XB_SPIN(cond, bar) do { unsigned _sp = 0; while (cond) { __builtin_amdgcn_s_sleep(1); \
    if ((++_sp & 255u) == 0u) { if (xb_ld(&(bar)[XB_TMO])) break; if (_sp > XB_SPIN_CAP) { atomicAdd(&(bar)[XB_TMO], 1u); break; } } } } while (0)

struct XcdBarrier { unsigned* bar; unsigned x; volatile LAS unsigned* st; };

__device__ __forceinline__ XcdBarrier xcd_barrier_post(unsigned* bar, volatile LAS unsigned* st) {
    XcdBarrier b; b.bar = bar; b.x = xb_xcc_id(); b.st = st;
    if (threadIdx.x == 0) (void)xb_add(&bar[XB_XCNT(b.x)], 1u);
    return b;
}
__device__ __forceinline__ void xcd_barrier_complete(unsigned* bar, unsigned x, unsigned& nloc, unsigned& nx) {
    const unsigned G = gridDim.x * gridDim.y * gridDim.z;
    unsigned sum, cnt, mine, sp = 0u;
    for (;;) {
        sum = 0u; cnt = 0u; mine = 0u;
#pragma unroll
        for (unsigned j = 0; j < 16; ++j) { const unsigned c = xb_ld(&bar[XB_XCNT(j)]); sum += c; cnt += (c > 0u) ? 1u : 0u; mine = (j == x) ? c : mine; }
        if (sum == G) break;
        __builtin_amdgcn_s_sleep(1);
        if ((++sp & 255u) == 0u) { if (xb_ld(&bar[XB_TMO])) break; if (sp > XB_SPIN_CAP) { atomicAdd(&bar[XB_TMO], 1u); break; } }
    }
    nloc = mine > 0u ? mine : 1u; nx = cnt > 0u ? cnt : 1u;
}
__device__ __forceinline__ void xcd_barrier(const XcdBarrier& b) {
    asm volatile("s_waitcnt vmcnt(0)" ::: "memory");
    __syncthreads();
    if (threadIdx.x == 0) {
        unsigned* bar = b.bar;
        __builtin_amdgcn_s_waitcnt(0);
        unsigned nloc = b.st[0], nx = b.st[1];
        if (nloc == 0u) { xcd_barrier_complete(bar, b.x, nloc, nx); b.st[0] = nloc; b.st[1] = nx; }
        const unsigned old = xb_add(&bar[XB_XSUB(b.x)], 1u);
        const unsigned gen = old / nloc;
        if (old + 1u == (gen + 1u) * nloc) {
            __builtin_amdgcn_fence(__ATOMIC_RELEASE, "agent");
            asm volatile("s_waitcnt vmcnt(0)" ::: "memory");
            const unsigned og = xb_add(&bar[XB_TOP], 1u);
            const unsigned tg = og / nx;
            if (og + 1u == (tg + 1u) * nx) xb_add(&bar[XB_TOPGEN], 1u);
            else XB_SPIN(xb_ld(&bar[XB_TOPGEN]) == tg, bar);
            __builtin_amdgcn_fence(__ATOMIC_ACQUIRE, "agent");
            xb_add(&bar[XB_XGEN(b.x)], 1u);
            asm volatile("s_waitcnt vmcnt(0)" ::: "memory");
        } else {
            XB_SPIN(xb_ld(&bar[XB_XGEN(b.x)]) == gen, bar);
            __builtin_amdgcn_fence(__ATOMIC_ACQUIRE, "agent");
            asm volatile("s_waitcnt vmcnt(0)" ::: "memory");
        }
    }
    __syncthreads();
}

#define LDS_WAIT() asm volatile("s_waitcnt lgkmcnt(0)" ::: "memory")
__device__ __forceinline__ float wave_sum(float v) {
#pragma unroll
    for (int o = 1; o < 64; o <<= 1) v += __shfl_xor(v, o);
    return v;
}
__device__ __forceinline__ unsigned f2bf(float f) { unsigned u = __builtin_bit_cast(unsigned, f); return (u + 0x7fffu + ((u >> 16) & 1u)) >> 16; }
__device__ __forceinline__ unsigned pk2(float lo, float hi) { return f2bf(lo) | (f2bf(hi) << 16); }

__device__ __forceinline__ int proj_orig_col(int n) {
    const int tile = n >> 8, c = n & 255;
    if (tile < 24) { const int c7 = n & 127, wc = c7 >> 5, fq = (c7 >> 3) & 3, nn = (c7 >> 2) & 1, j = c7 & 3;
        const int dim = (fq == 0) ? (4 * wc + j + 16 * nn) : (32 + wc * 24 + (fq - 1) * 8 + 4 * nn + j); return (n & ~127) + dim; }
    if (tile < 40) return n;
    if (tile < 72) { const int kind = 2 * (c >> 7) + ((c >> 2) & 1), chl = 16 * ((c >> 5) & 3) + 4 * ((c >> 3) & 3) + (c & 3); return 10240 + kind * 2048 + 64 * (tile - 40) + chl; }
    return 18432 + (c >> 7) * 2048 + 128 * (tile - 72) + (c & 127);
}
struct TItem { const float* src; bf16_t* dst; int N; };
__device__ __forceinline__ void t_decode(const float* W, int N, bf16_t* WT, int pitch, bool remap, int item, int lane, TItem& d) {
    const int nblk = N / 32, kb = item / nblk, nb = item % nblk, k0 = 64 * kb, n0 = 32 * nb;
    const int ncol = remap ? proj_orig_col(n0 + (lane & 31)) : n0 + (lane & 31);
    d.src = W + (size_t)(k0 + (lane >> 5)) * N + ncol; d.dst = WT + (size_t)(n0 + (lane >> 3)) * pitch + k0 + 8 * (lane & 7); d.N = N;
}
__device__ __forceinline__ void t_load(const TItem& d, float (&wv)[32]) {
#pragma unroll
    for (int i = 0; i < 32; ++i) wv[i] = d.src[(size_t)(2 * i) * d.N];
}
__device__ __forceinline__ void t_finish(const TItem& d, const float (&wv)[32], int pitch, LAS float* scr, int lane) {
#pragma unroll
    for (int i = 0; i < 32; ++i) scr[(2 * i + (lane >> 5)) * 33 + (lane & 31)] = wv[i];
    LDS_WAIT(); asm volatile("" ::: "memory");
    const int c = lane & 7;
#pragma unroll
    for (int j = 0; j < 4; ++j) { const int n = (lane >> 3) + 8 * j; const LAS float* s = scr + (8 * c) * 33 + n;
        u32x4 o; o.x = pk2(s[0 * 33], s[1 * 33]); o.y = pk2(s[2 * 33], s[3 * 33]); o.z = pk2(s[4 * 33], s[5 * 33]); o.w = pk2(s[6 * 33], s[7 * 33]);
        *(u32x4*)(d.dst + (size_t)(8 * j) * pitch) = o; }
    LDS_WAIT(); asm volatile("" ::: "memory");
}

__device__ __forceinline__ void sincos_f64(float ang, float& s, float& c) {
    const double x = (double)ang;
    const double n = __builtin_rint(x * 0.15915494309189535);
    double r = __builtin_fma(-n, 6.283185307179586, x); r = __builtin_fma(-n, 2.4492935982947064e-16, r);
    const double r2 = r * r;
    double ps = 1.0 / 51090942171709440000.0;
    ps = __builtin_fma(ps, r2, -1.0 / 121645100408832000.0);
    ps = __builtin_fma(ps, r2, 1.0 / 355687428096000.0);
    ps = __builtin_fma(ps, r2, -1.0 / 1307674368000.0);
    ps = __builtin_fma(ps, r2, 1.0 / 6227020800.0);
    ps = __builtin_fma(ps, r2, -1.0 / 39916800.0);
    ps = __builtin_fma(ps, r2, 1.0 / 362880.0);
    ps = __builtin_fma(ps, r2, -1.0 / 5040.0);
    ps = __builtin_fma(ps, r2, 1.0 / 120.0);
    ps = __builtin_fma(ps, r2, -1.0 / 6.0);
    ps = __builtin_fma(ps, r2, 1.0);
    double pc = -1.0 / 1124000727777607680000.0;
    pc = __builtin_fma(pc, r2, 1.0 / 2432902008176640000.0);
    pc = __builtin_fma(pc, r2, -1.0 / 6402373705728000.0);
    pc = __builtin_fma(pc, r2, 1.0 / 20922789888000.0);
    pc = __builtin_fma(pc, r2, -1.0 / 87178291200.0);
    pc = __builtin_fma(pc, r2, 1.0 / 479001600.0);
    pc = __builtin_fma(pc, r2, -1.0 / 3628800.0);
    pc = __builtin_fma(pc, r2, 1.0 / 40320.0);
    pc = __builtin_fma(pc, r2, -1.0 / 720.0);
    pc = __builtin_fma(pc, r2, 1.0 / 24.0);
    pc = __builtin_fma(pc, r2, -0.5);
    pc = __builtin_fma(pc, r2, 1.0);
    s = (float)(r * ps); c = (float)pc;
}

__device__ __forceinline__ unsigned attn_offk(unsigned slot, unsigned row, unsigned ch) { return slot * 32768u + 256u * row + 16u * (ch ^ (row & 15u)); }
__device__ __forceinline__ unsigned attn_offv(unsigned slot, unsigned lrow, unsigned ch) { return 65536u + slot * 32768u + 256u * lrow + 16u * (ch ^ (((lrow & 3u) << 2) | ((lrow >> 2) & 3u))); }
__device__ __forceinline__ unsigned attn_lrow(unsigned k) { return (k & ~31u) | (((k >> 2) & 3u) << 3) | (((k >> 4) & 1u) << 2) | (k & 3u); }

template <bool COMBINE>
__device__ __forceinline__ void attn_chunk(LAS unsigned char* lds, const bf16_t* Qg, const bf16_t* Kg, const bf16_t* Vg, const int dsh, const int hh, const int r, const int n0, const int nblk,
                                           bf16_t* Og, float* LSEg, const bf16_t* O1, const bf16_t* O2, const float* LSE1, const float* LSE2, const bf16_t* SZ, bf16_t* AATT) {
    const int tid = threadIdx.x, lane = tid & 63, wid = __builtin_amdgcn_readfirstlane(tid >> 6), fr = lane & 15, fq = lane >> 4;
    const int sch = tid & 15, srb = tid >> 4;
    const size_t scol = (size_t)hh * 256 + sch * 16;
    u32x4 kreg[4], vreg[4];
#define ATT_LOAD(blk) do { _Pragma("unroll") for (int i = 0; i < 4; ++i) { const size_t p = ((size_t)(128 * (blk) + srb + 32 * i) << dsh) + r; const size_t off = p * 2048 + scol; \
        kreg[i] = *(const u32x4*)((const char*)Kg + off); vreg[i] = *(const u32x4*)((const char*)Vg + off); } } while (0)
#define ATT_WRITE(slot) do { _Pragma("unroll") for (int i = 0; i < 4; ++i) { const unsigned row = srb + 32 * i; \
        *(LAS u32x4*)(lds + attn_offk((slot), row, sch)) = kreg[i]; *(LAS u32x4*)(lds + attn_offv((slot), attn_lrow(row), sch)) = vreg[i]; } } while (0)
    const unsigned q4 = (unsigned)(lane & 15) >> 2, p4 = (unsigned)lane & 3u, parA = (unsigned)wid & 1u, parB = parA ^ 1u;
    unsigned kbase[4], vbA[8], vbB[8];
#pragma unroll
    for (int s_ = 0; s_ < 4; ++s_) kbase[s_] = 256u * fr + 16u * ((unsigned)(4 * s_ + fq) ^ (unsigned)fr);
#pragma unroll
    for (int c = 0; c < 8; ++c) {
        vbA[c] = 65536u + 256u * (((unsigned)fq << 3) | (parA << 2) | q4) + 16u * ((unsigned)(2 * c + (p4 >> 1)) ^ ((q4 << 2) | (((unsigned)fq & 1u) << 1) | parA)) + 8u * (p4 & 1u);
        vbB[c] = 65536u + 256u * (((unsigned)fq << 3) | (parB << 2) | q4) + 16u * ((unsigned)(2 * c + (p4 >> 1)) ^ ((q4 << 2) | (((unsigned)fq & 1u) << 1) | parB)) + 8u * (p4 & 1u);
    }
    if (n0 > 0) { ATT_LOAD(n0 - 1); }
    else {
#pragma unroll
        for (int i = 0; i < 4; ++i) { kreg[i] = (u32x4){0u, 0u, 0u, 0u}; vreg[i] = (u32x4){0u, 0u, 0u, 0u}; } }
    ATT_WRITE((unsigned)((n0 + 1) & 1));
    ATT_LOAD(n0); ATT_WRITE((unsigned)(n0 & 1));
    __syncthreads();
    for (int n = n0; n < n0 + nblk; ++n) {
        const bool more = (n + 1 < n0 + nblk);
        if (more) ATT_LOAD(n + 1);
        const unsigned cs_ = (unsigned)(n & 1), ps_ = cs_ ^ 1u;
        const int lq = 128 * n + 16 * wid + fr; const size_t pq = ((size_t)lq << dsh) + r;
        bf16x8 qf[4];
        { const bf16x8* qp = (const bf16x8*)((const char*)Qg + pq * 2048 + (size_t)hh * 256 + fq * 16);
#pragma unroll
          for (int s = 0; s < 4; ++s) qf[s] = qp[4 * s]; }
        f32x4 S[9];
#pragma unroll
        for (int t = 0; t < 9; ++t) {
            S[t] = (f32x4){0.f, 0.f, 0.f, 0.f};
            const unsigned kr0 = 16 * wid + 16 * t, uo = ((kr0 < 128u) ? ps_ : cs_) * 32768u + 256u * (kr0 & 127u);
#pragma unroll
            for (int s = 0; s < 4; ++s) { const bf16x8 kf = *(const LAS bf16x8*)(lds + (kbase[s] + uo)); S[t] = __builtin_amdgcn_mfma_f32_16x16x32_bf16(kf, qf[s], S[t], 0, 0, 0); }
        }
        const float NEG = -1e30f;
#pragma unroll
        for (int j = 0; j < 4; ++j) { const int ko0 = 4 * fq + j; if (ko0 < fr) S[0][j] = NEG; if (ko0 > fr) S[8][j] = NEG; }
        if (n == 0) {
#pragma unroll
            for (int t = 0; t < 9; ++t)
#pragma unroll
                for (int j = 0; j < 4; ++j) { if (16 * wid + 16 * t + 4 * fq + j < 128) S[t][j] = NEG; }
        }
        float mx = NEG;
#pragma unroll
        for (int t = 0; t < 9; ++t) mx = fmaxf(mx, fmaxf(fmaxf(S[t][0], S[t][1]), fmaxf(S[t][2], S[t][3])));
        mx = fmaxf(mx, __shfl_xor(mx, 16)); mx = fmaxf(mx, __shfl_xor(mx, 32));
        float sum = 0.f;
#pragma unroll
        for (int t = 0; t < 9; ++t)
#pragma unroll
            for (int j = 0; j < 4; ++j) { const float p = __builtin_amdgcn_exp2f(S[t][j] - mx); S[t][j] = p; sum += p; }
        sum += __shfl_xor(sum, 16); sum += __shfl_xor(sum, 32);
        u32x2 o1w[8], o2w[8], szw[8]; float l1 = 0.f, l2 = 0.f;
        if (COMBINE) {
            asm volatile("" ::: "memory");
            const size_t eo = pq * 1024 + hh * 128 + 4 * fq;
#pragma unroll
            for (int c = 0; c < 8; ++c) { o1w[c] = *(const u32x2*)(O1 + eo + 16 * c); o2w[c] = *(const u32x2*)(O2 + eo + 16 * c); szw[c] = *(const u32x2*)(SZ + eo + 16 * c); }
            l1 = LSE1[pq * 8 + hh]; l2 = LSE2[pq * 8 + hh];
        }
        f32x4 O[8];
#pragma unroll
        for (int c = 0; c < 8; ++c) O[c] = (f32x4){0.f, 0.f, 0.f, 0.f};
#pragma unroll
        for (int u = 0; u < 5; ++u) {
            u32x4 pw; pw.x = cvt_pk_bf16(S[2 * u][0], S[2 * u][1]); pw.y = cvt_pk_bf16(S[2 * u][2], S[2 * u][3]);
            if (u < 4) { pw.z = cvt_pk_bf16(S[2 * u + 1][0], S[2 * u + 1][1]); pw.w = cvt_pk_bf16(S[2 * u + 1][2], S[2 * u + 1][3]); } else { pw.z = 0u; pw.w = 0u; }
            const bf16x8 pf = __builtin_bit_cast(bf16x8, pw);
            const unsigned kba = 16 * wid + 32 * u, kbb = kba + 16;
            const unsigned uoa = ((kba < 128u) ? ps_ : cs_) * 32768u + 256u * (kba & 96u), uob = ((kbb < 128u) ? ps_ : cs_) * 32768u + 256u * (kbb & 96u);
#pragma unroll
            for (int c = 0; c < 8; ++c) {
                const s16x4 va = __builtin_amdgcn_ds_read_tr16_b64_v4i16((LAS s16x4*)(lds + (vbA[c] + uoa)));
                const s16x4 vb = __builtin_amdgcn_ds_read_tr16_b64_v4i16((LAS s16x4*)(lds + ((u < 4) ? (vbB[c] + uob) : (vbA[c] + uoa))));
                const bf16x8 vf = __builtin_shufflevector(va, vb, 0, 1, 2, 3, 4, 5, 6, 7);
                O[c] = __builtin_amdgcn_mfma_f32_16x16x32_bf16(vf, pf, O[c], 0, 0, 0);
            }
        }
        const float inv = 1.0f / sum;
        if (!COMBINE) {
            bf16_t* op = Og + pq * 1024 + hh * 128 + 4 * fq;
#pragma unroll
            for (int c = 0; c < 8; ++c) { u32x2 w; w.x = cvt_pk_bf16(O[c][0] * inv, O[c][1] * inv); w.y = cvt_pk_bf16(O[c][2] * inv, O[c][3] * inv); *(u32x2*)(op + 16 * c) = w; }
            if (fq == 0) LSEg[pq * 8 + hh] = mx + __builtin_amdgcn_logf(sum);
        } else {
            const float l0 = mx + __builtin_amdgcn_logf(sum), m3 = fmaxf(l0, fmaxf(l1, l2));
            float w0 = __builtin_amdgcn_exp2f(l0 - m3), w1 = __builtin_amdgcn_exp2f(l1 - m3), w2 = __builtin_amdgcn_exp2f(l2 - m3);
            const float iw = 1.0f / (w0 + w1 + w2); w0 *= iw * inv; w1 *= iw; w2 *= iw;
            bf16_t* ap = AATT + pq * 2048 + hh * 128 + 4 * fq;
#pragma unroll
            for (int c = 0; c < 8; ++c) {
                const f32x4 a1 = (f32x4){bf_lo(o1w[c].x), bf_hi(o1w[c].x), bf_lo(o1w[c].y), bf_hi(o1w[c].y)}, a2 = (f32x4){bf_lo(o2w[c].x), bf_hi(o2w[c].x), bf_lo(o2w[c].y), bf_hi(o2w[c].y)};
                const f32x4 zz = (f32x4){silu_f(bf_lo(szw[c].x)), silu_f(bf_hi(szw[c].x)), silu_f(bf_lo(szw[c].y)), silu_f(bf_hi(szw[c].y))};
                const f32x4 res = (O[c] * w0 + a1 * w1 + a2 * w2) * zz;
                u32x2 w; w.x = cvt_pk_bf16(res[0], res[1]); w.y = cvt_pk_bf16(res[2], res[3]); *(u32x2*)(ap + 16 * c) = w;
            }
        }
        __syncthreads();
        if (more) ATT_WRITE(ps_);
        __syncthreads();
    }
#undef ATT_LOAD
#undef ATT_WRITE
}

struct Args { const float* x; const float* c; const int* pos; const float* g_pre; const float* w_ada; const float* b_ada; const float* w_in; const float* conv_w;
              const float* w_attn_o; const float* w_conv_o; const float* w_o; const float* g_post; float* out; unsigned char* ws; int ph_lo, ph_hi, li, pad; };

__global__ void __launch_bounds__(NWAVES * 64, 2) mk_fwd(Args args) {
    extern __shared__ __attribute__((aligned(16))) unsigned char lds_raw[];
    LAS unsigned char* lds = (LAS unsigned char*)lds_raw;
    volatile LAS unsigned* MISC = (volatile LAS unsigned*)(lds + MISC_OFF);
    const int tid = threadIdx.x, lane = tid & 63, wave = __builtin_amdgcn_readfirstlane(tid >> 6);
    const int G = gridDim.x; const int bx = blockIdx.x; const int vcu = (G % 8 == 0) ? (bx % 8) * (G / 8) + bx / 8 : bx;
    unsigned char* ws = args.ws;
    gu32* ctl = (gu32*)(ws + WS_CTL);
    float* mod = (float*)(ws + WS_MOD); float* cs = (float*)(ws + WS_CS);
    bf16_t* WinT = (bf16_t*)(ws + WS_WIN); bf16_t* WaT = (bf16_t*)(ws + WS_WA); bf16_t* WcT = (bf16_t*)(ws + WS_WC); bf16_t* WoT = (bf16_t*)(ws + WS_WO);
    bf16_t* Hb = (bf16_t*)(ws + WS_H); bf16_t* Qb = (bf16_t*)(ws + WS_Q); bf16_t* Kb = (bf16_t*)(ws + WS_K); bf16_t* Vb = (bf16_t*)(ws + WS_V);
    bf16_t* SZ = (bf16_t*)(ws + WS_SZ); float* HPb = (float*)(ws + WS_FX); float* FXQb = HPb + (size_t)64 * 2 * NCV; float* FXUb = FXQb + (size_t)64 * 2 * NCV;
    bf16_t* SGA = (bf16_t*)args.out; bf16_t* SGC = SGA + (size_t)M * D;
    bf16_t* O1 = (bf16_t*)(ws + WS_O1); bf16_t* O2 = (bf16_t*)(ws + WS_O2); float* LSE = (float*)(ws + WS_LSE);
    bf16_t* AATT = (bf16_t*)(ws + WS_AATT); bf16_t* Rb = (bf16_t*)(ws + WS_R); bf16_t* MG = (bf16_t*)(ws + WS_MG);
    bf16_t* Yb = (bf16_t*)(ws + WS_Y);

    for (int u = tid; u < (LDS_BYTES - LDSCTL_OFF) / 4; u += NWAVES * 64) ((LAS unsigned*)(lds + LDSCTL_OFF))[u] = 0u;
    __syncthreads();
    const int bli = (N_LAUNCHES == 1) ? 0 : args.li;
    XcdBarrier bar; bar.bar = (unsigned*)(ctl + CW_BAR) + bli * XCD_BAR_WORDS; bar.x = 0; bar.st = nullptr;
    if (N_LAUNCHES == 1) bar = xcd_barrier_post((unsigned*)(ctl + CW_BAR), MISC + 8);
    const int lo = args.ph_lo, hi = args.ph_hi;
#define IN(k) (lo <= (k) && (k) < hi)
#define BOTH(k) (IN(k) && IN((k) + 1))
#define GRID_BAR() xcd_barrier(bar)
#ifndef PROBE_REPEAT_MASK
#define PROBE_REPEAT_MASK 0
#endif
#define NREP(k) ((((PROBE_REPEAT_MASK) >> (k)) & 1) + 1)
    const int gw = vcu * NWAVES + wave, NGW = G * NWAVES;
    const int gtid = vcu * (NWAVES * 64) + tid, NT = G * NWAVES * 64;

    if (IN(0)) for (int rep = 0; rep < NREP(0); ++rep) {
        {
            LAS float* red = (LAS float*)lds;
            for (int cbk = bx; cbk < 256; cbk += G) {
                const int c4 = tid % 6, rg = tid / 6;
                f32x4 a = (f32x4){0.f, 0.f, 0.f, 0.f};
                if (rg < 85) {
#pragma unroll 6
                    for (int k = rg; k < D; k += 85) { const float cv = args.c[k]; const f32x4 w = *(const f32x4*)(args.w_ada + (size_t)k * NMOD + cbk * 24 + c4 * 4); a += w * cv; }
                    *(LAS f32x4*)(red + (rg * 6 + c4) * 4) = a; }
                __syncthreads();
                if (tid < 24) { float s = 0.f; for (int i = 0; i < 85; ++i) s += red[(i * 6 + (tid >> 2)) * 4 + (tid & 3)];
                    __hip_atomic_store(mod + cbk * 24 + tid, s + args.b_ada[cbk * 24 + tid], __ATOMIC_RELAXED, __HIP_MEMORY_SCOPE_AGENT); }
                asm volatile("s_waitcnt vmcnt(0)" ::: "memory");
                __syncthreads();
                if (tid == 0) __hip_atomic_fetch_add((unsigned*)(ctl + CW_MODCNT), 1u, __ATOMIC_RELAXED, __HIP_MEMORY_SCOPE_AGENT);
            }
        }
        for (int idx = gtid; idx < M * 16; idx += NT) { const int m = idx >> 4, i = idx & 15; const float ang = (float)args.pos[m] * INVF[i]; float s, c; sincos_f64(ang, s, c); cs[m * 32 + i] = c; cs[m * 32 + 16 + i] = s; }
        {
            LAS float* scr = (LAS float*)(lds + wave * 16384);
            constexpr int I_IN = (D / 64) * (PROJ / 32), I_A = (NZA / 64) * (D / 32), I_C = (NCV / 64) * (D / 32), I_O = (D / 64) * (D / 32);
            constexpr int NITEMS = I_IN + I_A + I_C + I_O;
#define T_DECODE(it_, d_) do { int r_ = (it_); \
                if (r_ < I_IN) t_decode(args.w_in, PROJ, WinT, D, true, r_, lane, d_); \
                else if ((r_ -= I_IN) < I_A) t_decode(args.w_attn_o, D, WaT, D, false, r_, lane, d_); \
                else if ((r_ -= I_A) < I_C) t_decode(args.w_conv_o, D, WcT, D, false, r_, lane, d_); \
                else t_decode(args.w_o, D, WoT, D, false, r_ - I_C, lane, d_); } while (0)
            TItem cur_, nxt_; float wa[32], wb[32];
            int it = gw;
            if (it < NITEMS) { T_DECODE(it, cur_); t_load(cur_, wa); }
            while (it < NITEMS) {
                const int nit = it + NGW;
                if (nit < NITEMS) { T_DECODE(nit, nxt_); t_load(nxt_, wb); }
                t_finish(cur_, wa, D, scr, lane);
                cur_ = nxt_;
#pragma unroll
                for (int i = 0; i < 32; ++i) wa[i] = wb[i];
                it = nit;
            }
#undef T_DECODE
        }
        if (tid == 0) {
            unsigned sp = 0;
            while (__hip_atomic_load((unsigned*)(ctl + CW_MODCNT), __ATOMIC_RELAXED, __HIP_MEMORY_SCOPE_AGENT) < 256u * (unsigned)(rep + 1)) { __builtin_amdgcn_s_sleep(2); if (++sp > (1u << 22)) break; }
            __builtin_amdgcn_fence(__ATOMIC_ACQUIRE, "agent");
            asm volatile("s_waitcnt vmcnt(0)" ::: "memory");
        }
        __syncthreads();
        f32x4 av[4][2], bv[4][2];
#pragma unroll
        for (int j = 0; j < 4; ++j)
#pragma unroll
            for (int h = 0; h < 2; ++h) { const int k = 512 * j + 8 * lane + 4 * h; const f32x4 gp = *(const f32x4*)(args.g_pre + k); f32x4 sc, sh;
#pragma unroll
                for (int e = 0; e < 4; ++e) { sc[e] = __hip_atomic_load(mod + D + k + e, __ATOMIC_RELAXED, __HIP_MEMORY_SCOPE_AGENT); sh[e] = __hip_atomic_load(mod + k + e, __ATOMIC_RELAXED, __HIP_MEMORY_SCOPE_AGENT); }
                av[j][h] = gp * (sc + 1.0f); bv[j][h] = sh; }
        for (int m = gw; m < M; m += NGW) {
            const float* xr = args.x + (size_t)m * D + 8 * lane;
            f32x4 v[4][2]; float ss = 0.f;
#pragma unroll
            for (int j = 0; j < 4; ++j)
#pragma unroll
                for (int h = 0; h < 2; ++h) { v[j][h] = *(const f32x4*)(xr + 512 * j + 4 * h); const f32x4 q = v[j][h] * v[j][h]; ss += (q[0] + q[1]) + (q[2] + q[3]); }
            const float rstd = 1.0f / sqrtf(wave_sum(ss) * (1.0f / D) + EPS);
            bf16_t* hr = Hb + (size_t)m * D + 8 * lane;
#pragma unroll
            for (int j = 0; j < 4; ++j) { const f32x4 h0 = v[j][0] * rstd * av[j][0] + bv[j][0], h1 = v[j][1] * rstd * av[j][1] + bv[j][1]; *(u32x4*)(hr + 512 * j) = pg8::pack8(h0, h1); }
        }
        if (BOTH(0) || rep + 1 < NREP(0)) GRID_BAR();
    }
    if (IN(2)) {
        pg8::SegOrder1 S; S.so.init(M, PROJ, G, bx, NREP(2)); S.A = (const char*)Hb; S.B = (const char*)WinT; S.tstep = (size_t)256 * D * 2; S.nt = D / 64;
        pg8::EpiProj E{ws, SGA, args.conv_w, lds + HALO_OFF};
        pg8::gemm_stream<pg8::EpiProj, pg8::SegOrder1>(lds, D, S, E);
        if (BOTH(2)) GRID_BAR();
    }
    if (IN(3)) for (int rep = 0; rep < NREP(3); ++rep) {
        for (int idx = gtid; idx < 63 * 2 * (NCV / 4); idx += NT) {
            const int c4 = idx % (NCV / 4), pj = idx / (NCV / 4), j = pj & 1, pm = 1 + (pj >> 1), ch = 4 * c4;
            const f32x4 h0 = *(const f32x4*)(HPb + ((size_t)((pm - 1) * 2 + 0) * NCV + ch)), h1 = *(const f32x4*)(HPb + ((size_t)((pm - 1) * 2 + 1) * NCV + ch));
            const f32x4 w0 = *(const f32x4*)(args.conv_w + ch), w1 = *(const f32x4*)(args.conv_w + NCV + ch);
            const f32x4 qv = *(const f32x4*)(FXQb + ((size_t)(pm * 2 + j) * NCV + ch)), uu = *(const f32x4*)(FXUb + ((size_t)(pm * 2 + j) * NCV + ch));
            const f32x4 miss = (j == 0) ? (w1 * h1 + w0 * h0) : (w0 * h1);
            const f32x4 rv = qv * (uu + miss);
            u32x2 rw; rw.x = cvt_pk_bf16(rv[0], rv[1]); rw.y = cvt_pk_bf16(rv[2], rv[3]);
            *(u32x2*)(Rb + ((size_t)(256 * pm + j) * NCV + ch)) = rw;
        }
        for (int chunk = vcu; chunk < 256; chunk += G) {
            int g, hh, r, n0;
            if (chunk < 128) { g = 2; hh = chunk >> 4; r = chunk & 15; n0 = 0; } else { const int idx = chunk - 128; g = 1; hh = idx >> 4; r = (idx & 15) >> 2; n0 = (idx & 3) * 8; }
            const size_t go = (size_t)g * M * 1024;
            attn_chunk<false>(lds, Qb + go, Kb + go, Vb + go, 2 * g, hh, r, n0, 8, (g == 1) ? O1 : O2, LSE + (size_t)g * M * 8, nullptr, nullptr, nullptr, nullptr, nullptr, nullptr);
        }
        if (BOTH(3) || rep + 1 < NREP(3)) GRID_BAR();
    }
    if (IN(4)) for (int rep = 0; rep < NREP(4); ++rep) {
        for (int chunk = vcu; chunk < 256; chunk += G)
            attn_chunk<true>(lds, Qb, Kb, Vb, 0, chunk >> 5, 0, (chunk & 31) * 4, 4, nullptr, nullptr, O1, O2, LSE + (size_t)1 * M * 8, LSE + (size_t)2 * M * 8, SZ, AATT);
        if (BOTH(4) || rep + 1 < NREP(4)) GRID_BAR();
    }
    if (IN(5)) {
        pg8::SegOrder2 S; S.so.init(M, D, G, bx, NREP(5)); S.A0 = (const char*)AATT; S.B0 = (const char*)WaT; S.A1 = (const char*)Rb; S.B1 = (const char*)WcT; S.tstep = (size_t)256 * D * 2; S.nt0 = NZA / 64; S.nt1 = NCV / 64;
        pg8::EpiMerge E{MG, SGA, SGC, D};
        pg8::gemm_stream<pg8::EpiMerge, pg8::SegOrder2, true>(lds, D, S, E);
        if (BOTH(5)) GRID_BAR();
    }
    if (IN(6)) {
        pg8::SegOrder1 S; S.so.init(M, D, G, bx, NREP(6)); S.A = (const char*)MG; S.B = (const char*)WoT; S.tstep = (size_t)256 * D * 2; S.nt = D / 64;
        pg8::EpiBf16 E{Yb, D};
        pg8::gemm_stream<pg8::EpiBf16, pg8::SegOrder1>(lds, D, S, E);
        if (BOTH(6)) GRID_BAR();
    }
    if (IN(7)) {
        f32x4 gv[4][2];
#pragma unroll
        for (int j = 0; j < 4; ++j)
#pragma unroll
            for (int h = 0; h < 2; ++h) { const int k = 512 * j + 8 * lane + 4 * h; gv[j][h] = *(const f32x4*)(mod + 2 * D + k) * *(const f32x4*)(args.g_post + k); }
        for (int m = gw; m < M; m += NGW) {
            const bf16_t* yr = Yb + (size_t)m * D + 8 * lane; const float* xr = args.x + (size_t)m * D + 8 * lane; float* orow = args.out + (size_t)m * D + 8 * lane;
            f32x4 v[4][2], xv[4][2]; u32x4 yw[4]; float ss = 0.f;
#pragma unroll
            for (int j = 0; j < 4; ++j) { yw[j] = *(const u32x4*)(yr + 512 * j); xv[j][0] = *(const f32x4*)(xr + 512 * j); xv[j][1] = *(const f32x4*)(xr + 512 * j + 4); }
#pragma unroll
            for (int j = 0; j < 4; ++j) { pg8::unpack8(yw[j], v[j][0], v[j][1]);
#pragma unroll
                for (int h = 0; h < 2; ++h) { const f32x4 q = v[j][h] * v[j][h]; ss += (q[0] + q[1]) + (q[2] + q[3]); } }
            const float rstd = 1.0f / sqrtf(wave_sum(ss) * (1.0f / D) + EPS);
#pragma unroll
            for (int j = 0; j < 4; ++j)
#pragma unroll
                for (int h = 0; h < 2; ++h) *(f32x4*)(orow + 512 * j + 4 * h) = xv[j][h] + gv[j][h] * (v[j][h] * rstd);
        }
    }
#undef IN
#undef BOTH
#undef GRID_BAR
}

extern "C" void kernel_launch(void* const* d_in, const int* in_sizes, int n_in, void* d_out, int out_size, void* d_ws, size_t ws_size, hipStream_t stream) {
    static int grid = 0;
    if (grid == 0) {
        if (n_in != 12 || in_sizes[0] != M * D || out_size != M * D || ws_size < WS_END) { fprintf(stderr, "kernel_launch: unexpected shapes (n_in %d, in0 %d, out %d, ws %zu); nothing launched\n", n_in, n_in > 0 ? in_sizes[0] : -1, out_size, ws_size); grid = -1; return; }
        int dev = 0, cus = 0;
        if (hipGetDevice(&dev) != hipSuccess || hipDeviceGetAttribute(&cus, hipDeviceAttributeMultiprocessorCount, dev) != hipSuccess) { grid = -1; return; }
        if (hipFuncSetAttribute((const void*)mk_fwd, hipFuncAttributeMaxDynamicSharedMemorySize, LDS_BYTES) != hipSuccess) { fprintf(stderr, "kernel_launch: hipFuncSetAttribute failed\n"); grid = -1; return; }
        (void)hipGetLastError();
        grid = cus;
    }
    if (grid < 0) return;
    if (hipMemsetAsync((char*)d_ws + WS_CTL, 0, CTL_ZERO_BYTES, stream) != hipSuccess) return;
    Args a{};
    a.x = (const float*)d_in[0]; a.c = (const float*)d_in[1]; a.pos = (const int*)d_in[2]; a.g_pre = (const float*)d_in[3]; a.w_ada = (const float*)d_in[4]; a.b_ada = (const float*)d_in[5];
    a.w_in = (const float*)d_in[6]; a.conv_w = (const float*)d_in[7]; a.w_attn_o = (const float*)d_in[8]; a.w_conv_o = (const float*)d_in[9]; a.w_o = (const float*)d_in[10]; a.g_post = (const float*)d_in[11];
    a.out = (float*)d_out; a.ws = (unsigned char*)d_ws;
    for (int li = 0; li < N_LAUNCHES; ++li) {
        a.ph_lo = (N_LAUNCHES == 1) ? 0 : li; a.ph_hi = (N_LAUNCHES == 1) ? NPHASES : li + 1; a.li = li;
        hipLaunchKernelGGL(mk_fwd, dim3(grid), dim3(NWAVES * 64), LDS_BYTES, stream, a);
        if (hipPeekAtLastError() != hipSuccess) break;
    }
}
```

```cpp
#include <hip/hip_runtime.h>
#include <cstdio>
#include <cstdint>

#define GAS __attribute__((address_space(1)))
#define LAS __attribute__((address_space(3)))
typedef unsigned short bf16_t;
typedef short bf16x8 __attribute__((ext_vector_type(8)));
typedef short s16x4 __attribute__((ext_vector_type(4)));
typedef float f32x4 __attribute__((ext_vector_type(4)));
typedef float f32x2 __attribute__((ext_vector_type(2)));
typedef unsigned u32x4 __attribute__((ext_vector_type(4)));
typedef unsigned u32x2 __attribute__((ext_vector_type(2)));

constexpr int M = 16384, D = 2048, NQKV = 3072, NZA = 1024, NCV = 2048, PROJ = 22528, NMOD = 6144;
constexpr float EPS = 1e-6f;
constexpr float LOG2E = 1.4426950408889634f;
constexpr float QSCALE = 0.08838834764831845f * 1.4426950408889634f;

__constant__ float INVF[16] = {1.0f, 0.44036659598350525f, 0.1939227432012558f, 0.08539710193872452f, 0.03760603070259094f, 0.016560440883040428f,
    0.007292664609849453f, 0.0032114461064338684f, 0.0014142135623842478f, 0.0006227724370546639f, 0.00027424818836152554f, 0.00012076973507646471f,
    5.3182957344688475e-05f, 2.34199997066753e-05f, 1.0313385246263351e-05f, 4.541670477919979e-06f};

typedef __bf16 bf16x2_t __attribute__((ext_vector_type(2)));
__device__ __forceinline__ unsigned cvt_pk_bf16(float lo, float hi) { const f32x2 v = {lo, hi}; return __builtin_bit_cast(unsigned, __builtin_convertvector(v, bf16x2_t)); }
__device__ __forceinline__ float bf_lo(unsigned w) { return __builtin_bit_cast(float, w << 16); }
__device__ __forceinline__ float bf_hi(unsigned w) { return __builtin_bit_cast(float, w & 0xffff0000u); }
template <int CTRL> __device__ __forceinline__ float dpp_row_shr(float old, float src) { return __int_as_float(__builtin_amdgcn_update_dpp(__float_as_int(old), __float_as_int(src), CTRL, 0xf, 0xf, false)); }
__device__ __forceinline__ float silu_f(float v) { return v * __builtin_amdgcn_rcpf(1.0f + __builtin_amdgcn_exp2f(-v * LOG2E)); }
__device__ __forceinline__ float sigm_f(float v) { return __builtin_amdgcn_rcpf(1.0f + __builtin_amdgcn_exp2f(-v * LOG2E)); }

constexpr size_t MiB = 1u << 20;
constexpr size_t WS_CTL = 0, CTL_ZERO_BYTES = 32768;
constexpr size_t WS_MOD = 1 * MiB;
constexpr size_t WS_CS = 2 * MiB;
constexpr size_t WS_WIN = 4 * MiB;
constexpr size_t WS_WA = 92 * MiB, WS_WC = 100 * MiB, WS_WO = 108 * MiB;
constexpr size_t WS_H = 116 * MiB;
constexpr size_t WS_Q = 180 * MiB, WS_K = 276 * MiB, WS_V = 372 * MiB;
constexpr size_t WS_SZ = 468 * MiB;
constexpr size_t WS_R = 500 * MiB;
constexpr size_t WS_FX = 564 * MiB;
constexpr size_t WS_O2 = 628 * MiB;
constexpr size_t WS_LSE = 660 * MiB;
constexpr size_t WS_END = 662 * MiB;
constexpr size_t WS_O1 = 148 * MiB;
constexpr size_t WS_AATT = WS_K + 32 * MiB, WS_MG = WS_V + 32 * MiB, WS_Y = WS_R;

#ifndef PG8_A_AUX
#define PG8_A_AUX 0
#endif
#ifndef PG8_B_AUX
#define PG8_B_AUX 0
#endif
namespace pg8 {
constexpr int BM = 256, BK = 64, HALF = 128, HTB = HALF * BK * 2, STAGE_BYTES = 8 * HTB, NXCD = 8, WGM = 8;
__host__ __device__ __forceinline__ int lds_byte(int r, int c) { const int st = (r >> 4) * 2 + (c >> 5), rr = r & 15, cc = c & 31, ob = rr * 64 + cc * 2; return st * 1024 + (ob ^ (((ob >> 9) & 1) << 5)); }
__host__ __device__ __forceinline__ void stage_rc(int b, int& R, int& C) { const int st = b / 1024, sb = b % 1024, swz = sb ^ (((sb >> 9) & 1) << 5); R = (st >> 1) * 16 + swz / 64; C = (st & 1) * 32 + (swz % 64) / 2; }
__host__ __device__ __forceinline__ int perm32(int rho) { const int n = rho >> 4, i = rho & 15; return 8 * (i >> 2) + 4 * n + (i & 3); }

struct Unit { int pm, pn; };
struct Gemm { const bf16_t* A; const bf16_t* Bt; int M, N, K; };

struct StaticOrder {
    int nM, nN, nwg, G, c, rounds, rep;
    __host__ __device__ void init(int M_, int N_, int G_, int c_, int rep_ = 1) { nM = M_ / BM; nN = N_ / BM; nwg = nM * nN; G = G_; c = c_; rounds = (nwg + G - 1) / G; rep = rep_; }
    __host__ __device__ bool next(int i, Unit& u) const {
        if (i >= rounds * rep) return false;
        i = i % rounds;
        const long L = (long)i * G + c; if (L >= nwg) return false;
        int wgid = (int)L; { const int q = nwg / NXCD, r = nwg % NXCD, xcd = wgid % NXCD, off = wgid / NXCD; wgid = (xcd < r ? xcd * (q + 1) : r * (q + 1) + (xcd - r) * q) + off; }
        const int nig = WGM * nN, gid = wgid / nig, fm = gid * WGM, gsz = (nM - fm) < WGM ? (nM - fm) : WGM;
        u.pm = fm + ((wgid % nig) % gsz); u.pn = (wgid % nig) / gsz; return true;
    }
    __device__ __forceinline__ void a_ready(const Unit&) const {}
    __device__ __forceinline__ void done(const Unit&) const {}
};


struct Seg { const char* A; const char* B; int nt; int mid; Unit u; };
__device__ __forceinline__ const char* rfl_ptr(const char* p) { const unsigned long long v = (unsigned long long)p; const unsigned lo = __builtin_amdgcn_readfirstlane((unsigned)v), hi = __builtin_amdgcn_readfirstlane((unsigned)(v >> 32)); return (const char*)(((unsigned long long)hi << 32) | lo); }
__device__ __forceinline__ void rfl_seg(Seg& o) { o.A = rfl_ptr(o.A); o.B = rfl_ptr(o.B); o.nt = __builtin_amdgcn_readfirstlane(o.nt); o.mid = __builtin_amdgcn_readfirstlane(o.mid); o.u.pm = __builtin_amdgcn_readfirstlane(o.u.pm); o.u.pn = __builtin_amdgcn_readfirstlane(o.u.pn); }
constexpr int NSTORE = 16;
template <class Epi, class Sched, bool DUAL = false>
__device__ __forceinline__ void gemm_stream(LAS unsigned char* lds, const int pitch, const Sched& S, const Epi& E) {
    const int tid = threadIdx.x, wid = __builtin_amdgcn_readfirstlane(tid >> 6), lane = tid & 63, wr = wid >> 2, wc = wid & 3, fr = lane & 15, fq = lane >> 4;
    unsigned voffA[2], voffB[2];
#pragma unroll
    for (int i = 0; i < 2; ++i) { int R, C; stage_rc(tid * 16 + i * 8192, R, C); const int Rb = Epi::PERM ? ((R & ~31) + perm32(R & 31)) : R;
        voffA[i] = (unsigned)(R * pitch + C) * 2u; voffB[i] = (unsigned)(Rb * pitch + C) * 2u; }
    const size_t kstep = (size_t)(BK * 2);
    const size_t hstep = (size_t)HALF * pitch * 2;
    const unsigned ldsw = (unsigned)wid * 1024u;
    const int aoff = lds_byte(wr * 64 + fr, fq * 8), boff = lds_byte(wc * 32 + fr, fq * 8);
#define PG8_SA(b, h) (((b) * 2 + (h)) * HTB)
#define PG8_SB(b, h) ((4 + (b) * 2 + (h)) * HTB)
#define PG8_STAGE(bufoff, gbase, voff) do { const char* _gb = (const char*)(gbase); asm volatile("" : "+s"(_gb));   \
        _Pragma("unroll") for (int _i = 0; _i < 2; ++_i) \
        __builtin_amdgcn_global_load_lds((const unsigned*)(_gb + (voff)[_i]), (LAS unsigned*)(lds + (bufoff) + ldsw + _i * 8192), 16, 0, PG8_A_AUX); } while (0)
#define PG8_STAGEB(bufoff, gbase, voff) do { const char* _gb = (const char*)(gbase); asm volatile("" : "+s"(_gb)); \
        _Pragma("unroll") for (int _i = 0; _i < 2; ++_i) \
        __builtin_amdgcn_global_load_lds((const unsigned*)(_gb + (voff)[_i]), (LAS unsigned*)(lds + (bufoff) + ldsw + _i * 8192), 16, 0, PG8_B_AUX); } while (0)
#define PG8_LDA(dst, b, h) do { _Pragma("unroll") for (int m = 0; m < 4; ++m) _Pragma("unroll") for (int k = 0; k < 2; ++k) dst[m][k] = *(const LAS bf16x8*)(lds + PG8_SA(b, h) + aoff + m * 2048 + k * 1024); } while (0)
#define PG8_LDB(dst, b, h) do { _Pragma("unroll") for (int n = 0; n < 2; ++n) _Pragma("unroll") for (int k = 0; k < 2; ++k) dst[n][k] = *(const LAS bf16x8*)(lds + PG8_SB(b, h) + boff + n * 2048 + k * 1024); } while (0)
#define PG8_MMA(ai, bj, At, Bt) do { __builtin_amdgcn_s_setprio(1); _Pragma("unroll") for (int m = 0; m < 4; ++m) _Pragma("unroll") for (int n = 0; n < 2; ++n) _Pragma("unroll") for (int k = 0; k < 2; ++k) \
        acc[ai][bj][m][n] = __builtin_amdgcn_mfma_f32_16x16x32_bf16(Bt[n][k], At[m][k], acc[ai][bj][m][n], 0, 0, 0); __builtin_amdgcn_s_setprio(0); } while (0)
#define PG8_WAIT_V(n) asm volatile("s_waitcnt vmcnt(" #n ")" ::: "memory")
#define PG8_WAIT_VR() PG8_WAIT_V(8)
#define PG8_WAIT_L(n) asm volatile("s_waitcnt lgkmcnt(" #n ")" ::: "memory")
#define PG8_BAR __builtin_amdgcn_s_barrier()
#define PG8_SCHED __builtin_amdgcn_sched_barrier(0)
    Seg cur, nxt; int si = 0;
    if (!S.seg(0, cur)) return;
    f32x4 acc[2][2][4][2];
#pragma unroll
    for (int a = 0; a < 2; ++a)
#pragma unroll
        for (int b = 0; b < 2; ++b)
#pragma unroll
            for (int m = 0; m < 4; ++m)
#pragma unroll
                for (int n = 0; n < 2; ++n) acc[a][b][m][n] = (f32x4){0.f, 0.f, 0.f, 0.f};
    bf16x8 At[4][2], B0[2][2], B1[2][2];
    {
        const char* cA = cur.A; const char* cB = cur.B;
        PG8_STAGEB(PG8_SB(0, 0), cB, voffB); PG8_STAGEB(PG8_SB(0, 1), cB + hstep, voffB); PG8_STAGE(PG8_SA(0, 0), cA, voffA); PG8_STAGE(PG8_SA(0, 1), cA + hstep, voffA);
        if (wr == 1) PG8_BAR;
        PG8_WAIT_V(2); PG8_BAR;
        PG8_STAGEB(PG8_SB(1, 0), cB + kstep, voffB); PG8_STAGE(PG8_SA(1, 0), cA + kstep, voffA); PG8_STAGEB(PG8_SB(1, 1), cB + hstep + kstep, voffB);
        PG8_WAIT_V(6); PG8_BAR;
    }
    bool fresh = true, relax = false;
    for (;;) {
        const bool has_next = S.seg(si + 1, nxt);
        const char* cA = cur.A; const char* cB = cur.B; const int nt = cur.nt;
        const char* nA = has_next ? nxt.A : cA; const char* nB = has_next ? nxt.B : cB;
#pragma nounroll
        for (int t = 0; t < nt; t += 2) {
            const bool first = (t == 0) && !fresh;
            const bool last = (t == nt - 2);
            const char* a1 = cA + (size_t)(t + 1) * kstep;
            const char* a2 = last ? nA : cA + (size_t)(t + 2) * kstep; const char* b2 = last ? nB : cB + (size_t)(t + 2) * kstep;
            const char* a3 = a2 + kstep; const char* b3 = b2 + kstep;
            PG8_LDB(B0, 0, 0); PG8_LDB(B1, 0, 1); PG8_SCHED; PG8_LDA(At, 0, 0); if (!first) PG8_STAGE(PG8_SA(1, 1), a1 + hstep, voffA);
            PG8_WAIT_VR(); PG8_WAIT_L(0); PG8_BAR; PG8_MMA(0, 0, At, B0); PG8_MMA(0, 1, At, B1); PG8_BAR; PG8_SCHED;
            PG8_LDA(At, 0, 1); PG8_STAGEB(PG8_SB(0, 0), b2, voffB); PG8_STAGEB(PG8_SB(0, 1), b2 + hstep, voffB); PG8_STAGE(PG8_SA(0, 0), a2, voffA);
            PG8_WAIT_VR(); PG8_WAIT_L(0); PG8_BAR; PG8_MMA(1, 0, At, B0); PG8_MMA(1, 1, At, B1); PG8_BAR; PG8_SCHED;
            PG8_LDB(B0, 1, 0); PG8_LDB(B1, 1, 1); PG8_SCHED; PG8_LDA(At, 1, 0); PG8_STAGE(PG8_SA(0, 1), a2 + hstep, voffA);
            PG8_WAIT_VR(); PG8_WAIT_L(0); PG8_BAR; PG8_MMA(0, 0, At, B0); PG8_MMA(0, 1, At, B1); PG8_BAR; PG8_SCHED;
            PG8_LDA(At, 1, 1); PG8_STAGEB(PG8_SB(1, 0), b3, voffB); PG8_STAGEB(PG8_SB(1, 1), b3 + hstep, voffB); PG8_STAGE(PG8_SA(1, 0), a3, voffA);
            PG8_WAIT_V(8); PG8_WAIT_L(0); PG8_BAR; PG8_MMA(1, 0, At, B0); PG8_MMA(1, 1, At, B1); PG8_BAR; PG8_SCHED;
        }
        if (wr == 0) PG8_BAR;
        PG8_STAGE(PG8_SA(1, 1), nA + kstep + hstep, voffA);
        PG8_SCHED;
        if constexpr (DUAL) E.scale(acc, cur.u, wr, wc, fr, fq, cur.mid != 0);
        if (DUAL && cur.mid) { relax = false; }
        else {
            E(acc, cur.u, wr, wc, fr, fq); relax = true;
#pragma unroll
            for (int a = 0; a < 2; ++a)
#pragma unroll
                for (int b = 0; b < 2; ++b)
#pragma unroll
                    for (int m = 0; m < 4; ++m)
#pragma unroll
                        for (int n = 0; n < 2; ++n) acc[a][b][m][n] = (f32x4){0.f, 0.f, 0.f, 0.f};
        }
        PG8_SCHED;
        if (!has_next) break;
        cur = nxt; ++si; fresh = false;
        if (wr == 1) PG8_BAR;
    }
    PG8_WAIT_V(0);
    PG8_BAR;
#undef PG8_SA
#undef PG8_SB
#undef PG8_STAGE
#undef PG8_STAGEB
#undef PG8_LDA
#undef PG8_LDB
#undef PG8_MMA
#undef PG8_WAIT_V
#undef PG8_WAIT_VR
#undef PG8_WAIT_L
#undef PG8_BAR
#undef PG8_SCHED
}
struct SegOrder1 {
    StaticOrder so; const char* A; const char* B; size_t tstep; int nt;
    __device__ __forceinline__ bool seg(int s, Seg& o) const { Unit u; if (!so.next(s, u)) return false; o.A = A + (size_t)u.pm * tstep; o.B = B + (size_t)u.pn * tstep; o.nt = nt; o.mid = 0; o.u = u; rfl_seg(o); return true; }
};

__device__ __forceinline__ u32x4 pack8(const f32x4 v0, const f32x4 v1) { u32x4 w; w.x = cvt_pk_bf16(v0[0], v0[1]); w.y = cvt_pk_bf16(v0[2], v0[3]); w.z = cvt_pk_bf16(v1[0], v1[1]); w.w = cvt_pk_bf16(v1[2], v1[3]); return w; }
__device__ __forceinline__ void unpack8(const u32x4 w, f32x4& v0, f32x4& v1) { v0 = (f32x4){bf_lo(w.x), bf_hi(w.x), bf_lo(w.y), bf_hi(w.y)}; v1 = (f32x4){bf_lo(w.z), bf_hi(w.z), bf_lo(w.w), bf_hi(w.w)}; }

#ifdef NT_STORES
#define ST16(p, v) __builtin_nontemporal_store((v), (u32x4*)(p))
#define ST8(p, v) __builtin_nontemporal_store((v), (u32x2*)(p))
#else
#define ST16(p, v) (*(u32x4*)(p) = (v))
#define ST8(p, v) (*(u32x2*)(p) = (v))
#endif
struct EpiProj {
    static constexpr bool PERM = true;
    __device__ __forceinline__ void mid(f32x4 (&)[2][2][4][2], const Unit&, int, int, int, int) const {}
    unsigned char* ws; bf16_t* SGA; const float* cw; LAS unsigned char* halo;
    __device__ __forceinline__ void operator()(const f32x4 (&acc)[2][2][4][2], const Unit& u, int wr, int wc, int fr, int fq) const {
        const int pn = u.pn; const int row0 = u.pm * BM + wr * 64 + fr; const int lc = wc * 32 + 8 * fq;
        bf16_t* const Q = (bf16_t*)(ws + WS_Q); bf16_t* const Kb = (bf16_t*)(ws + WS_K); bf16_t* const V = (bf16_t*)(ws + WS_V); bf16_t* const SZ = (bf16_t*)(ws + WS_SZ); bf16_t* const R = (bf16_t*)(ws + WS_R);
        bf16_t* const SGC = SGA + (size_t)M * D; const float* const cs = (const float*)(ws + WS_CS);
        float* const HP = (float*)(ws + WS_FX); float* const FXQ = HP + (size_t)64 * 2 * NCV; float* const FXU = FXQ + (size_t)64 * 2 * NCV;
        if (pn < 24) {
            const bool isq = pn < 12; const int tq = isq ? pn : pn - 12; bf16_t* base = (isq ? Q : Kb) + (size_t)(tq >> 2) * M * 1024; const int colt = (tq & 3) * BM; const float sc = isq ? QSCALE : 1.0f;
            const bool rot = (fq == 0);
            f32x4 cv[2][4], sv[2][4];
#pragma unroll
            for (int ai = 0; ai < 2; ++ai)
#pragma unroll
                for (int m = 0; m < 4; ++m) { const float* cr = cs + (size_t)(row0 + ai * HALF + m * 16) * 32 + 4 * wc; cv[ai][m] = *(const f32x4*)cr; sv[ai][m] = *(const f32x4*)(cr + 16); }
#pragma unroll
            for (int ai = 0; ai < 2; ++ai)
#pragma unroll
                for (int m = 0; m < 4; ++m) {
                    const f32x4 c = rot ? cv[ai][m] * sc : (f32x4){sc, sc, sc, sc}, sn = rot ? sv[ai][m] * sc : (f32x4){0.f, 0.f, 0.f, 0.f};
                    bf16_t* rowp = base + (size_t)(row0 + ai * HALF + m * 16) * 1024 + colt + lc;
#pragma unroll
                    for (int bj = 0; bj < 2; ++bj) { const f32x4 v0 = acc[ai][bj][m][0], v1 = acc[ai][bj][m][1];
                        ST16((rowp + bj * HALF), (pack8(v0 * c - v1 * sn, v0 * sn + v1 * c))); }
                }
        } else if (pn < 36) {
            const int tv = pn - 24, colt = (tv & 3) * BM; bf16_t* vbase = V + (size_t)(tv >> 2) * M * 1024;
#pragma unroll
            for (int ai = 0; ai < 2; ++ai)
#pragma unroll
                for (int m = 0; m < 4; ++m) { bf16_t* rowp = vbase + (size_t)(row0 + ai * HALF + m * 16) * 1024 + colt + lc;
#pragma unroll
                    for (int bj = 0; bj < 2; ++bj) ST16((rowp + bj * HALF), (pack8(acc[ai][bj][m][0], acc[ai][bj][m][1]))); }
        } else if (pn < 40) {
            const int colt = (pn - 36) * BM;
#pragma unroll
            for (int ai = 0; ai < 2; ++ai)
#pragma unroll
                for (int m = 0; m < 4; ++m) { bf16_t* rowp = SZ + (size_t)(row0 + ai * HALF + m * 16) * NZA + colt + lc;
#pragma unroll
                    for (int bj = 0; bj < 2; ++bj) ST16((rowp + bj * HALF), (pack8(acc[ai][bj][m][0], acc[ai][bj][m][1]))); }
        } else if (pn < 72) {
            int chl = 16 * wc + 4 * fq; asm volatile("" : "+v"(chl));
            const int ct = pn - 40, chb = 64 * ct + chl, pm = u.pm;
            const f32x4 w0 = *(const f32x4*)(cw + chb), w1 = *(const f32x4*)(cw + NCV + chb), w2 = *(const f32x4*)(cw + 2 * NCV + chb);
#pragma unroll
            for (int ai = 0; ai < 2; ++ai)
#pragma unroll
                for (int m = 0; m < 4; ++m) { const f32x4 pv = acc[ai][0][m][1] * acc[ai][1][m][0];
                    const int gi = 8 * ai + 4 * wr + m;
                    if (fr >= 14) { *(LAS f32x4*)(halo + (size_t)(((gi * 2 + (fr - 14)) * 64 + chl) * 4)) = pv;
                        if (gi == 15) *(f32x4*)(HP + ((size_t)(pm * 2 + (fr - 14)) * NCV + chb)) = pv; } }
            asm volatile("s_waitcnt lgkmcnt(0)" ::: "memory"); __builtin_amdgcn_s_barrier(); asm volatile("" ::: "memory");
#pragma unroll
            for (int ai = 0; ai < 2; ++ai)
#pragma unroll
                for (int m = 0; m < 4; ++m) {
                    const int gi = 8 * ai + 4 * wr + m; const int gp = gi > 0 ? gi - 1 : 0;
                    f32x4 H0 = *(const LAS f32x4*)(halo + (size_t)(((gp * 2 + 0) * 64 + chl) * 4)), H1 = *(const LAS f32x4*)(halo + (size_t)(((gp * 2 + 1) * 64 + chl) * 4));
                    if (gi == 0) { H0 = (f32x4){0.f, 0.f, 0.f, 0.f}; H1 = H0; }
                    const f32x4 Hs = (fr == 1) ? H1 : H0, pvv = acc[ai][0][m][1] * acc[ai][1][m][0];
                    f32x4 Pm1, Pm2, qv;
#pragma unroll
                    for (int j = 0; j < 4; ++j) {
                        const float pj = pvv[j], h1j = H1[j], hsj = Hs[j];
                        Pm1[j] = dpp_row_shr<0x111>(h1j, pj); Pm2[j] = dpp_row_shr<0x112>(hsj, pj);
                        qv[j] = acc[ai][0][m][0][j] * silu_f(acc[ai][1][m][1][j]); }
                    const f32x4 uu = w2 * pvv + w1 * Pm1 + w0 * Pm2, rv = qv * uu;
                    const size_t ro = (size_t)(row0 + ai * HALF + m * 16) * NCV + chb;
                    u32x2 rw; rw.x = cvt_pk_bf16(rv[0], rv[1]); rw.y = cvt_pk_bf16(rv[2], rv[3]);
                    ST8((R + ro), (rw));
                    if (gi == 0 && fr < 2 && pm > 0) { *(f32x4*)(FXQ + ((size_t)(pm * 2 + fr) * NCV + chb)) = qv; *(f32x4*)(FXU + ((size_t)(pm * 2 + fr) * NCV + chb)) = uu; }
                }
        } else {
            const int colt = (pn - 72) * HALF;
#pragma unroll
            for (int ai = 0; ai < 2; ++ai)
#pragma unroll
                for (int m = 0; m < 4; ++m) { const size_t ro = (size_t)(row0 + ai * HALF + m * 16) * D + colt + lc;
                    f32x4 r[2], c[2];
#pragma unroll
                    for (int n = 0; n < 2; ++n)
#pragma unroll
                        for (int j = 0; j < 4; ++j) { const float pc = 1.0f + __builtin_amdgcn_exp2f(-acc[ai][1][m][n][j] * LOG2E), pa = 1.0f + __builtin_amdgcn_exp2f(-acc[ai][0][m][n][j] * LOG2E);
                            const float t = __builtin_amdgcn_rcpf(pa * pc); c[n][j] = pa * t; r[n][j] = pc * pc * t; }
                    ST16((SGA + ro), (pack8(r[0], r[1]))); ST16((SGC + ro), (pack8(c[0], c[1]))); }
        }
    }
};
struct EpiMerge {
    static constexpr bool PERM = true;
    bf16_t* O; const bf16_t* RHO; const bf16_t* SC; int ldc;
    __device__ __forceinline__ size_t lane_off(const Unit& u, int wr, int wc, int fr, int fq, int ai) const {
        size_t o = (size_t)(u.pm * BM + wr * 64 + fr + ai * HALF) * ldc + u.pn * BM + wc * 32 + 8 * fq; asm volatile("" : "+v"(o)); return o; }
    __device__ __forceinline__ void scale(f32x4 (&acc)[2][2][4][2], const Unit& u, int wr, int wc, int fr, int fq, bool is_mid) const {
        const bf16_t* G = is_mid ? RHO : SC;
#pragma unroll
        for (int ai = 0; ai < 2; ++ai) {
            const bf16_t* p = G + lane_off(u, wr, wc, fr, fq, ai);
            u32x4 gw[4][2];
#pragma unroll
            for (int m = 0; m < 4; ++m)
#pragma unroll
                for (int bj = 0; bj < 2; ++bj) gw[m][bj] = *(const u32x4*)(p + (size_t)m * 16 * ldc + bj * HALF);
#pragma unroll
            for (int m = 0; m < 4; ++m)
#pragma unroll
                for (int bj = 0; bj < 2; ++bj) { f32x4 g0, g1; unpack8(gw[m][bj], g0, g1); acc[ai][bj][m][0] *= g0; acc[ai][bj][m][1] *= g1; }
        }
    }
    __device__ __forceinline__ void mid(f32x4 (&)[2][2][4][2], const Unit&, int, int, int, int) const {}
    __device__ __forceinline__ void operator()(const f32x4 (&acc)[2][2][4][2], const Unit& u, int wr, int wc, int fr, int fq) const {
#pragma unroll
        for (int ai = 0; ai < 2; ++ai) {
            bf16_t* q = O + lane_off(u, wr, wc, fr, fq, ai);
#pragma unroll
            for (int m = 0; m < 4; ++m)
#pragma unroll
                for (int bj = 0; bj < 2; ++bj) *(u32x4*)(q + (size_t)m * 16 * ldc + bj * HALF) = pack8(acc[ai][bj][m][0], acc[ai][bj][m][1]);
        }
    }
};
struct EpiBf16 {
    static constexpr bool PERM = true;
    __device__ __forceinline__ void mid(f32x4 (&)[2][2][4][2], const Unit&, int, int, int, int) const {}
    bf16_t* O; int ldc;
    __device__ __forceinline__ void operator()(const f32x4 (&acc)[2][2][4][2], const Unit& u, int wr, int wc, int fr, int fq) const {
        const int row0 = u.pm * BM + wr * 64 + fr, col0 = u.pn * BM + wc * 32 + 8 * fq;
#pragma unroll
        for (int ai = 0; ai < 2; ++ai)
#pragma unroll
            for (int m = 0; m < 4; ++m) { bf16_t* rowp = O + (size_t)(row0 + ai * HALF + m * 16) * ldc + col0;
#pragma unroll
                for (int bj = 0; bj < 2; ++bj) *(u32x4*)(rowp + bj * HALF) = pack8(acc[ai][bj][m][0], acc[ai][bj][m][1]); }
    }
};
struct SegOrder2 {
    StaticOrder so; const char *A0, *B0, *A1, *B1; size_t tstep; int nt0, nt1;
    __device__ __forceinline__ bool seg(int s_, Seg& o) const { Unit u; if (!so.next(s_ >> 1, u)) return false; const int h = s_ & 1;
        o.A = (h ? A1 : A0) + (size_t)u.pm * tstep; o.B = (h ? B1 : B0) + (size_t)u.pn * tstep; o.nt = h ? nt1 : nt0; o.mid = !h; o.u = u; rfl_seg(o); return true; }
};
}

#ifndef PG8_SP2
#define PG8_SP2 true
#endif
#ifndef PG8_ALIGN
#define PG8_ALIGN true
#endif

constexpr int NWAVES = 8;
#ifndef MK_N_LAUNCHES
#define MK_N_LAUNCHES 1
#endif
constexpr int NPHASES = 8;
constexpr int N_LAUNCHES = MK_N_LAUNCHES;

constexpr int CW_BAR = 4096, CW_MODCNT = 8000;
#define XCD_BAR_WORDS 3456

constexpr int RING_BYTES = 131072;
constexpr int LDSCTL_OFF = RING_BYTES, MISC_OFF = LDSCTL_OFF + 320, HALO_OFF = RING_BYTES + 1024;
constexpr int LDS_BYTES = 147456;

typedef GAS unsigned gu32;
#define RLX_AGENT __ATOMIC_RELAXED, __HIP_MEMORY_SCOPE_AGENT

#define XB_TMO      128
#define XB_XCNT(j)  (256  + 64 * (j))
#define XB_XSUB(j)  (1280 + 64 * (j))
#define XB_XGEN(j)  (2304 + 64 * (j))
#define XB_TOP      3328
#define XB_TOPGEN   3392
#define XB_SPIN_CAP (1u << 18)

__device__ __forceinline__ unsigned xb_ld(unsigned* p)              { return __hip_atomic_load(p, __ATOMIC_RELAXED, __HIP_MEMORY_SCOPE_AGENT); }
__device__ __forceinline__ unsigned xb_add(unsigned* p, unsigned v) { return __hip_atomic_fetch_add(p, v, __ATOMIC_RELAXED, __HIP_MEMORY_SCOPE_AGENT); }
__device__ __forceinline__ unsigned xb_xcc_id() { return (unsigned)__builtin_amdgcn_s_getreg((3 << 11) | 20) & 0xFu; }
#define XB_SPIN(cond, bar) do { unsigned _sp = 0; while (cond) { __builtin_amdgcn_s_sleep(1); \
    if ((++_sp & 255u) == 0u) { if (xb_ld(&(bar)[XB_TMO])) break; if (_sp > XB_SPIN_CAP) { atomicAdd(&(bar)[XB_TMO], 1u); break; } } } } while (0)

struct XcdBarrier { unsigned* bar; unsigned x; volatile LAS unsigned* st; };

__device__ __forceinline__ XcdBarrier xcd_barrier_post(unsigned* bar, volatile LAS unsigned* st) {
    XcdBarrier b; b.bar = bar; b.x = xb_xcc_id(); b.st = st;
    if (threadIdx.x == 0) (void)xb_add(&bar[XB_XCNT(b.x)], 1u);
    return b;
}
__device__ __forceinline__ void xcd_barrier_complete(unsigned* bar, unsigned x, unsigned& nloc, unsigned& nx) {
    const unsigned G = gridDim.x * gridDim.y * gridDim.z;
    unsigned sum, cnt, mine, sp = 0u;
    for (;;) {
        sum = 0u; cnt = 0u; mine = 0u;
#pragma unroll
        for (unsigned j = 0; j < 16; ++j) { const unsigned c = xb_ld(&bar[XB_XCNT(j)]); sum += c; cnt += (c > 0u) ? 1u : 0u; mine = (j == x) ? c : mine; }
        if (sum == G) break;
        __builtin_amdgcn_s_sleep(1);
        if ((++sp & 255u) == 0u) { if (xb_ld(&bar[XB_TMO])) break; if (sp > XB_SPIN_CAP) { atomicAdd(&bar[XB_TMO], 1u); break; } }
    }
    nloc = mine > 0u ? mine : 1u; nx = cnt > 0u ? cnt : 1u;
}
__device__ __forceinline__ void xcd_barrier(const XcdBarrier& b) {
    asm volatile("s_waitcnt vmcnt(0)" ::: "memory");
    __syncthreads();
    if (threadIdx.x == 0) {
        unsigned* bar = b.bar;
        __builtin_amdgcn_s_waitcnt(0);
        unsigned nloc = b.st[0], nx = b.st[1];
        if (nloc == 0u) { xcd_barrier_complete(bar, b.x, nloc, nx); b.st[0] = nloc; b.st[1] = nx; }
        const unsigned old = xb_add(&bar[XB_XSUB(b.x)], 1u);
        const unsigned gen = old / nloc;
        if (old + 1u == (gen + 1u) * nloc) {
            __builtin_amdgcn_fence(__ATOMIC_RELEASE, "agent");
            asm volatile("s_waitcnt vmcnt(0)" ::: "memory");
            const unsigned og = xb_add(&bar[XB_TOP], 1u);
            const unsigned tg = og / nx;
            if (og + 1u == (tg + 1u) * nx) xb_add(&bar[XB_TOPGEN], 1u);
            else XB_SPIN(xb_ld(&bar[XB_TOPGEN]) == tg, bar);
            __builtin_amdgcn_fence(__ATOMIC_ACQUIRE, "agent");
            xb_add(&bar[XB_XGEN(b.x)], 1u);
            asm volatile("s_waitcnt vmcnt(0)" ::: "memory");
        } else {
            XB_SPIN(xb_ld(&bar[XB_XGEN(b.x)]) == gen, bar);
            __builtin_amdgcn_fence(__ATOMIC_ACQUIRE, "agent");
            asm volatile("s_waitcnt vmcnt(0)" ::: "memory");
        }
    }
    __syncthreads();
}

#define LDS_WAIT() asm volatile("s_waitcnt lgkmcnt(0)" ::: "memory")
__device__ __forceinline__ float wave_sum(float v) {
#pragma unroll
    for (int o = 1; o < 64; o <<= 1) v += __shfl_xor(v, o);
    return v;
}
__device__ __forceinline__ unsigned f2bf(float f) { unsigned u = __builtin_bit_cast(unsigned, f); return (u + 0x7fffu + ((u >> 16) & 1u)) >> 16; }
__device__ __forceinline__ unsigned pk2(float lo, float hi) { return f2bf(lo) | (f2bf(hi) << 16); }

__device__ __forceinline__ int proj_orig_col(int n) {
    const int tile = n >> 8, c = n & 255;
    if (tile < 24) { const int c7 = n & 127, wc = c7 >> 5, fq = (c7 >> 3) & 3, nn = (c7 >> 2) & 1, j = c7 & 3;
        const int dim = (fq == 0) ? (4 * wc + j + 16 * nn) : (32 + wc * 24 + (fq - 1) * 8 + 4 * nn + j); return (n & ~127) + dim; }
    if (tile < 40) return n;
    if (tile < 72) { const int kind = 2 * (c >> 7) + ((c >> 2) & 1), chl = 16 * ((c >> 5) & 3) + 4 * ((c >> 3) & 3) + (c & 3); return 10240 + kind * 2048 + 64 * (tile - 40) + chl; }
    return 18432 + (c >> 7) * 2048 + 128 * (tile - 72) + (c & 127);
}
struct TItem { const float* src; bf16_t* dst; int N; };
__device__ __forceinline__ void t_decode(const float* W, int N, bf16_t* WT, int pitch, bool remap, int item, int lane, TItem& d) {
    const int nblk = N / 32, kb = item / nblk, nb = item % nblk, k0 = 64 * kb, n0 = 32 * nb;
    const int ncol = remap ? proj_orig_col(n0 + (lane & 31)) : n0 + (lane & 31);
    d.src = W + (size_t)(k0 + (lane >> 5)) * N + ncol; d.dst = WT + (size_t)(n0 + (lane >> 3)) * pitch + k0 + 8 * (lane & 7); d.N = N;
}
__device__ __forceinline__ void t_load(const TItem& d, float (&wv)[32]) {
#pragma unroll
    for (int i = 0; i < 32; ++i) wv[i] = d.src[(size_t)(2 * i) * d.N];
}
__device__ __forceinline__ void t_finish(const TItem& d, const float (&wv)[32], int pitch, LAS float* scr, int lane) {
#pragma unroll
    for (int i = 0; i < 32; ++i) scr[(2 * i + (lane >> 5)) * 33 + (lane & 31)] = wv[i];
    LDS_WAIT(); asm volatile("" ::: "memory");
    const int c = lane & 7;
#pragma unroll
    for (int j = 0; j < 4; ++j) { const int n = (lane >> 3) + 8 * j; const LAS float* s = scr + (8 * c) * 33 + n;
        u32x4 o; o.x = pk2(s[0 * 33], s[1 * 33]); o.y = pk2(s[2 * 33], s[3 * 33]); o.z = pk2(s[4 * 33], s[5 * 33]); o.w = pk2(s[6 * 33], s[7 * 33]);
        *(u32x4*)(d.dst + (size_t)(8 * j) * pitch) = o; }
    LDS_WAIT(); asm volatile("" ::: "memory");
}

__device__ __forceinline__ void sincos_f64(float ang, float& s, float& c) {
    const double x = (double)ang;
    const double n = __builtin_rint(x * 0.15915494309189535);
    double r = __builtin_fma(-n, 6.283185307179586, x); r = __builtin_fma(-n, 2.4492935982947064e-16, r);
    const double r2 = r * r;
    double ps = 1.0 / 51090942171709440000.0;
    ps = __builtin_fma(ps, r2, -1.0 / 121645100408832000.0);
    ps = __builtin_fma(ps, r2, 1.0 / 355687428096000.0);
    ps = __builtin_fma(ps, r2, -1.0 / 1307674368000.0);
    ps = __builtin_fma(ps, r2, 1.0 / 6227020800.0);
    ps = __builtin_fma(ps, r2, -1.0 / 39916800.0);
    ps = __builtin_fma(ps, r2, 1.0 / 362880.0);
    ps = __builtin_fma(ps, r2, -1.0 / 5040.0);
    ps = __builtin_fma(ps, r2, 1.0 / 120.0);
    ps = __builtin_fma(ps, r2, -1.0 / 6.0);
    ps = __builtin_fma(ps, r2, 1.0);
    double pc = -1.0 / 1124000727777607680000.0;
    pc = __builtin_fma(pc, r2, 1.0 / 2432902008176640000.0);
    pc = __builtin_fma(pc, r2, -1.0 / 6402373705728000.0);
    pc = __builtin_fma(pc, r2, 1.0 / 20922789888000.0);
    pc = __builtin_fma(pc, r2, -1.0 / 87178291200.0);
    pc = __builtin_fma(pc, r2, 1.0 / 479001600.0);
    pc = __builtin_fma(pc, r2, -1.0 / 3628800.0);
    pc = __builtin_fma(pc, r2, 1.0 / 40320.0);
    pc = __builtin_fma(pc, r2, -1.0 / 720.0);
    pc = __builtin_fma(pc, r2, 1.0 / 24.0);
    pc = __builtin_fma(pc, r2, -0.5);
    pc = __builtin_fma(pc, r2, 1.0);
    s = (float)(r * ps); c = (float)pc;
}

__device__ __forceinline__ unsigned attn_offk(unsigned slot, unsigned row, unsigned ch) { return slot * 32768u + 256u * row + 16u * (ch ^ (row & 15u)); }
__device__ __forceinline__ unsigned attn_offv(unsigned slot, unsigned lrow, unsigned ch) { return 65536u + slot * 32768u + 256u * lrow + 16u * (ch ^ (((lrow & 3u) << 2) | ((lrow >> 2) & 3u))); }
__device__ __forceinline__ unsigned attn_lrow(unsigned k) { return (k & ~31u) | (((k >> 2) & 3u) << 3) | (((k >> 4) & 1u) << 2) | (k & 3u); }

template <bool COMBINE>
__device__ __forceinline__ void attn_chunk(LAS unsigned char* lds, const bf16_t* Qg, const bf16_t* Kg, const bf16_t* Vg, const int dsh, const int hh, const int r, const int n0, const int nblk,
                                           bf16_t* Og, float* LSEg, const bf16_t* O1, const bf16_t* O2, const float* LSE1, const float* LSE2, const bf16_t* SZ, bf16_t* AATT) {
    int tid = threadIdx.x; asm volatile("" : "+v"(tid));
    const int lane = tid & 63, wid = __builtin_amdgcn_readfirstlane(tid >> 6), fr = lane & 15, fq = lane >> 4;
    const int sch = tid & 15, srb = tid >> 4;
    const size_t scol = (size_t)hh * 256 + sch * 16;
    u32x4 kreg[4], vreg[4];
#define ATT_LOAD(blk) do { _Pragma("unroll") for (int i = 0; i < 4; ++i) { const size_t p = ((size_t)(128 * (blk) + srb + 32 * i) << dsh) + r; const size_t off = p * 2048 + scol; \
        kreg[i] = *(const u32x4*)((const char*)Kg + off); vreg[i] = *(const u32x4*)((const char*)Vg + off); } } while (0)
#define ATT_WRITE(slot) do { _Pragma("unroll") for (int i = 0; i < 4; ++i) { const unsigned row = srb + 32 * i; \
        *(LAS u32x4*)(lds + attn_offk((slot), row, sch)) = kreg[i]; *(LAS u32x4*)(lds + attn_offv((slot), attn_lrow(row), sch)) = vreg[i]; } } while (0)
    const unsigned q4 = (unsigned)(lane & 15) >> 2, p4 = (unsigned)lane & 3u, parA = (unsigned)wid & 1u, parB = parA ^ 1u;
    unsigned kbase[4], vbA[8], vbB[8];
#pragma unroll
    for (int s_ = 0; s_ < 4; ++s_) kbase[s_] = 256u * fr + 16u * ((unsigned)(4 * s_ + fq) ^ (unsigned)fr);
#pragma unroll
    for (int c = 0; c < 8; ++c) {
        vbA[c] = 65536u + 256u * (((unsigned)fq << 3) | (parA << 2) | q4) + 16u * ((unsigned)(2 * c + (p4 >> 1)) ^ ((q4 << 2) | (((unsigned)fq & 1u) << 1) | parA)) + 8u * (p4 & 1u);
        vbB[c] = 65536u + 256u * (((unsigned)fq << 3) | (parB << 2) | q4) + 16u * ((unsigned)(2 * c + (p4 >> 1)) ^ ((q4 << 2) | (((unsigned)fq & 1u) << 1) | parB)) + 8u * (p4 & 1u);
    }
    if (n0 > 0) { ATT_LOAD(n0 - 1); }
    else {
#pragma unroll
        for (int i = 0; i < 4; ++i) { kreg[i] = (u32x4){0u, 0u, 0u, 0u}; vreg[i] = (u32x4){0u, 0u, 0u, 0u}; } }
    ATT_WRITE((unsigned)((n0 + 1) & 1));
    ATT_LOAD(n0); ATT_WRITE((unsigned)(n0 & 1));
    bf16x8 qf[4], qn[4];
#define ATT_LOADQ(dst, blk) do { const size_t pq_ = ((size_t)(128 * (blk) + 16 * wid + fr) << dsh) + r; const bf16x8* qp = (const bf16x8*)((const char*)Qg + pq_ * 2048 + (size_t)hh * 256 + fq * 16); \
        _Pragma("unroll") for (int s = 0; s < 4; ++s) dst[s] = qp[4 * s]; } while (0)
    ATT_LOADQ(qf, n0);
    __syncthreads();
    for (int n = n0; n < n0 + nblk; ++n) {
        const bool more = (n + 1 < n0 + nblk);
        if (more) { ATT_LOAD(n + 1); ATT_LOADQ(qn, n + 1); }
        const unsigned cs_ = (unsigned)(n & 1), ps_ = cs_ ^ 1u;
        const int lq = 128 * n + 16 * wid + fr; const size_t pq = ((size_t)lq << dsh) + r;
        f32x4 S[9];
#pragma unroll
        for (int t = 0; t < 9; ++t) {
            S[t] = (f32x4){0.f, 0.f, 0.f, 0.f};
            const unsigned kr0 = 16 * wid + 16 * t, uo = ((kr0 < 128u) ? ps_ : cs_) * 32768u + 256u * (kr0 & 127u);
#pragma unroll
            for (int s = 0; s < 4; ++s) { const bf16x8 kf = *(const LAS bf16x8*)(lds + (kbase[s] + uo)); S[t] = __builtin_amdgcn_mfma_f32_16x16x32_bf16(kf, qf[s], S[t], 0, 0, 0); }
        }
        const float NEG = -1e30f;
#pragma unroll
        for (int j = 0; j < 4; ++j) { const int ko0 = 4 * fq + j; if (ko0 < fr) S[0][j] = NEG; if (ko0 > fr) S[8][j] = NEG; }
        if (n == 0) {
#pragma unroll
            for (int t = 0; t < 9; ++t)
#pragma unroll
                for (int j = 0; j < 4; ++j) { if (16 * wid + 16 * t + 4 * fq + j < 128) S[t][j] = NEG; }
        }
        float mx = NEG;
#pragma unroll
        for (int t = 0; t < 9; ++t) mx = fmaxf(mx, fmaxf(fmaxf(S[t][0], S[t][1]), fmaxf(S[t][2], S[t][3])));
        mx = fmaxf(mx, __shfl_xor(mx, 16)); mx = fmaxf(mx, __shfl_xor(mx, 32));
        float sum = 0.f;
#pragma unroll
        for (int t = 0; t < 9; ++t)
#pragma unroll
            for (int j = 0; j < 4; ++j) { const float p = __builtin_amdgcn_exp2f(S[t][j] - mx); S[t][j] = p; sum += p; }
        sum += __shfl_xor(sum, 16); sum += __shfl_xor(sum, 32);
        u32x2 o1w[8], o2w[8], szw[8]; float l1 = 0.f, l2 = 0.f;
        if (COMBINE) {
            asm volatile("" ::: "memory");
            const size_t eo = pq * 1024 + hh * 128 + 4 * fq;
#pragma unroll
            for (int c = 0; c < 8; ++c) { o1w[c] = *(const u32x2*)(O1 + eo + 16 * c); o2w[c] = *(const u32x2*)(O2 + eo + 16 * c); szw[c] = *(const u32x2*)(SZ + eo + 16 * c); }
            l1 = LSE1[pq * 8 + hh]; l2 = LSE2[pq * 8 + hh];
        }
        f32x4 O[8];
#pragma unroll
        for (int c = 0; c < 8; ++c) O[c] = (f32x4){0.f, 0.f, 0.f, 0.f};
#pragma unroll
        for (int u = 0; u < 5; ++u) {
            u32x4 pw; pw.x = cvt_pk_bf16(S[2 * u][0], S[2 * u][1]); pw.y = cvt_pk_bf16(S[2 * u][2], S[2 * u][3]);
            if (u < 4) { pw.z = cvt_pk_bf16(S[2 * u + 1][0], S[2 * u + 1][1]); pw.w = cvt_pk_bf16(S[2 * u + 1][2], S[2 * u + 1][3]); } else { pw.z = 0u; pw.w = 0u; }
            const bf16x8 pf = __builtin_bit_cast(bf16x8, pw);
            const unsigned kba = 16 * wid + 32 * u, kbb = kba + 16;
            const unsigned uoa = ((kba < 128u) ? ps_ : cs_) * 32768u + 256u * (kba & 96u), uob = ((kbb < 128u) ? ps_ : cs_) * 32768u + 256u * (kbb & 96u);
#pragma unroll
            for (int c = 0; c < 8; ++c) {
                const s16x4 va = __builtin_amdgcn_ds_read_tr16_b64_v4i16((LAS s16x4*)(lds + (vbA[c] + uoa)));
                const s16x4 vb = __builtin_amdgcn_ds_read_tr16_b64_v4i16((LAS s16x4*)(lds + ((u < 4) ? (vbB[c] + uob) : (vbA[c] + uoa))));
                const bf16x8 vf = __builtin_shufflevector(va, vb, 0, 1, 2, 3, 4, 5, 6, 7);
                O[c] = __builtin_amdgcn_mfma_f32_16x16x32_bf16(vf, pf, O[c], 0, 0, 0);
            }
        }
        const float inv = 1.0f / sum;
        if (!COMBINE) {
            bf16_t* op = Og + pq * 1024 + hh * 128 + 4 * fq;
#pragma unroll
            for (int c = 0; c < 8; ++c) { u32x2 w; w.x = cvt_pk_bf16(O[c][0] * inv, O[c][1] * inv); w.y = cvt_pk_bf16(O[c][2] * inv, O[c][3] * inv); *(u32x2*)(op + 16 * c) = w; }
            if (fq == 0) LSEg[pq * 8 + hh] = mx + __builtin_amdgcn_logf(sum);
        } else {
            const float l0 = mx + __builtin_amdgcn_logf(sum), m3 = fmaxf(l0, fmaxf(l1, l2));
            float w0 = __builtin_amdgcn_exp2f(l0 - m3), w1 = __builtin_amdgcn_exp2f(l1 - m3), w2 = __builtin_amdgcn_exp2f(l2 - m3);
            const float iw = 1.0f / (w0 + w1 + w2); w0 *= iw * inv; w1 *= iw; w2 *= iw;
            bf16_t* ap = AATT + pq * 2048 + hh * 128 + 4 * fq;
#pragma unroll
            for (int c = 0; c < 8; ++c) {
                const f32x4 a1 = (f32x4){bf_lo(o1w[c].x), bf_hi(o1w[c].x), bf_lo(o1w[c].y), bf_hi(o1w[c].y)}, a2 = (f32x4){bf_lo(o2w[c].x), bf_hi(o2w[c].x), bf_lo(o2w[c].y), bf_hi(o2w[c].y)};
                const f32x4 zz = (f32x4){silu_f(bf_lo(szw[c].x)), silu_f(bf_hi(szw[c].x)), silu_f(bf_lo(szw[c].y)), silu_f(bf_hi(szw[c].y))};
                const f32x4 res = (O[c] * w0 + a1 * w1 + a2 * w2) * zz;
                u32x2 w; w.x = cvt_pk_bf16(res[0], res[1]); w.y = cvt_pk_bf16(res[2], res[3]); *(u32x2*)(ap + 16 * c) = w;
            }
        }
        __syncthreads();
        if (more) { ATT_WRITE(ps_);
#pragma unroll
            for (int s = 0; s < 4; ++s) qf[s] = qn[s]; }
        __syncthreads();
    }
#undef ATT_LOADQ
#undef ATT_LOAD
#undef ATT_WRITE
}

struct Args { const float* x; const float* c; const int* pos; const float* g_pre; const float* w_ada; const float* b_ada; const float* w_in; const float* conv_w;
              const float* w_attn_o; const float* w_conv_o; const float* w_o; const float* g_post; float* out; unsigned char* ws; int ph_lo, ph_hi, li, pad; };

__global__ void __launch_bounds__(NWAVES * 64, 2) mk_fwd(Args args) {
    extern __shared__ __attribute__((aligned(16))) unsigned char lds_raw[];
    LAS unsigned char* lds = (LAS unsigned char*)lds_raw;
    volatile LAS unsigned* MISC = (volatile LAS unsigned*)(lds + MISC_OFF);
    const int tid = threadIdx.x, lane = tid & 63, wave = __builtin_amdgcn_readfirstlane(tid >> 6);
    const int G = gridDim.x; const int bx = blockIdx.x; const int vcu = (G % 8 == 0) ? (bx % 8) * (G / 8) + bx / 8 : bx;
    unsigned char* ws = args.ws;
    gu32* ctl = (gu32*)(ws + WS_CTL);
    float* mod = (float*)(ws + WS_MOD); float* cs = (float*)(ws + WS_CS);
    bf16_t* WinT = (bf16_t*)(ws + WS_WIN); bf16_t* WaT = (bf16_t*)(ws + WS_WA); bf16_t* WcT = (bf16_t*)(ws + WS_WC); bf16_t* WoT = (bf16_t*)(ws + WS_WO);
    bf16_t* Hb = (bf16_t*)(ws + WS_H); bf16_t* Qb = (bf16_t*)(ws + WS_Q); bf16_t* Kb = (bf16_t*)(ws + WS_K); bf16_t* Vb = (bf16_t*)(ws + WS_V);
    bf16_t* SZ = (bf16_t*)(ws + WS_SZ); float* HPb = (float*)(ws + WS_FX); float* FXQb = HPb + (size_t)64 * 2 * NCV; float* FXUb = FXQb + (size_t)64 * 2 * NCV;
    bf16_t* SGA = (bf16_t*)args.out; bf16_t* SGC = SGA + (size_t)M * D;
    bf16_t* O1 = (bf16_t*)(ws + WS_O1); bf16_t* O2 = (bf16_t*)(ws + WS_O2); float* LSE = (float*)(ws + WS_LSE);
    bf16_t* AATT = (bf16_t*)(ws + WS_AATT); bf16_t* Rb = (bf16_t*)(ws + WS_R); bf16_t* MG = (bf16_t*)(ws + WS_MG);
    bf16_t* Yb = (bf16_t*)(ws + WS_Y);

    for (int u = tid; u < (LDS_BYTES - LDSCTL_OFF) / 4; u += NWAVES * 64) ((LAS unsigned*)(lds + LDSCTL_OFF))[u] = 0u;
    __syncthreads();
    const int bli = (N_LAUNCHES == 1) ? 0 : args.li;
    XcdBarrier bar; bar.bar = (unsigned*)(ctl + CW_BAR) + bli * XCD_BAR_WORDS; bar.x = 0; bar.st = nullptr;
    if (N_LAUNCHES == 1) bar = xcd_barrier_post((unsigned*)(ctl + CW_BAR), MISC + 8);
    const int lo = args.ph_lo, hi = args.ph_hi;
#define IN(k) (lo <= (k) && (k) < hi)
#define BOTH(k) (IN(k) && IN((k) + 1))
#define GRID_BAR() xcd_barrier(bar)
#ifndef PROBE_REPEAT_MASK
#define PROBE_REPEAT_MASK 0
#endif
#define NREP(k) ((((PROBE_REPEAT_MASK) >> (k)) & 1) + 1)
    const int gw = vcu * NWAVES + wave, NGW = G * NWAVES;
    const int gtid = vcu * (NWAVES * 64) + tid, NT = G * NWAVES * 64;

    if (IN(0)) for (int rep = 0; rep < NREP(0); ++rep) {
        {
            LAS float* red = (LAS float*)lds;
            for (int cbk = bx; cbk < 256; cbk += G) {
                const int c4 = tid % 6, rg = tid / 6;
                f32x4 a = (f32x4){0.f, 0.f, 0.f, 0.f};
                if (rg < 85) {
#pragma unroll 6
                    for (int k = rg; k < D; k += 85) { const float cv = args.c[k]; const f32x4 w = *(const f32x4*)(args.w_ada + (size_t)k * NMOD + cbk * 24 + c4 * 4); a += w * cv; }
                    *(LAS f32x4*)(red + (rg * 6 + c4) * 4) = a; }
                __syncthreads();
                if (tid < 24) { float s = 0.f; for (int i = 0; i < 85; ++i) s += red[(i * 6 + (tid >> 2)) * 4 + (tid & 3)];
                    __hip_atomic_store(mod + cbk * 24 + tid, s + args.b_ada[cbk * 24 + tid], __ATOMIC_RELAXED, __HIP_MEMORY_SCOPE_AGENT); }
                asm volatile("s_waitcnt vmcnt(0)" ::: "memory");
                __syncthreads();
                if (tid == 0) __hip_atomic_fetch_add((unsigned*)(ctl + CW_MODCNT), 1u, __ATOMIC_RELAXED, __HIP_MEMORY_SCOPE_AGENT);
            }
        }
        for (int idx = gtid; idx < M * 16; idx += NT) { const int m = idx >> 4, i = idx & 15; const float ang = (float)args.pos[m] * INVF[i]; float s, c; sincos_f64(ang, s, c); cs[m * 32 + i] = c; cs[m * 32 + 16 + i] = s; }
        {
            LAS float* scr = (LAS float*)(lds + wave * 16384);
            constexpr int I_IN = (D / 64) * (PROJ / 32), I_A = (NZA / 64) * (D / 32), I_C = (NCV / 64) * (D / 32), I_O = (D / 64) * (D / 32);
            constexpr int NITEMS = I_IN + I_A + I_C + I_O;
#define T_DECODE(it_, d_) do { int r_ = (it_); \
                if (r_ < I_IN) t_decode(args.w_in, PROJ, WinT, D, true, r_, lane, d_); \
                else if ((r_ -= I_IN) < I_A) t_decode(args.w_attn_o, D, WaT, D, false, r_, lane, d_); \
                else if ((r_ -= I_A) < I_C) t_decode(args.w_conv_o, D, WcT, D, false, r_, lane, d_); \
                else t_decode(args.w_o, D, WoT, D, false, r_ - I_C, lane, d_); } while (0)
            TItem cur_, nxt_; float wa[32], wb[32];
            int it = gw;
            if (it < NITEMS) { T_DECODE(it, cur_); t_load(cur_, wa); }
            while (it < NITEMS) {
                const int nit = it + NGW;
                if (nit < NITEMS) { T_DECODE(nit, nxt_); t_load(nxt_, wb); }
                t_finish(cur_, wa, D, scr, lane);
                cur_ = nxt_;
#pragma unroll
                for (int i = 0; i < 32; ++i) wa[i] = wb[i];
                it = nit;
            }
#undef T_DECODE
        }
        if (tid == 0) {
            unsigned sp = 0;
            while (__hip_atomic_load((unsigned*)(ctl + CW_MODCNT), __ATOMIC_RELAXED, __HIP_MEMORY_SCOPE_AGENT) < 256u * (unsigned)(rep + 1)) { __builtin_amdgcn_s_sleep(2); if (++sp > (1u << 22)) break; }
            __builtin_amdgcn_fence(__ATOMIC_ACQUIRE, "agent");
            asm volatile("s_waitcnt vmcnt(0)" ::: "memory");
        }
        __syncthreads();
        f32x4 av[4][2], bv[4][2];
#pragma unroll
        for (int j = 0; j < 4; ++j)
#pragma unroll
            for (int h = 0; h < 2; ++h) { const int k = 512 * j + 8 * lane + 4 * h; const f32x4 gp = *(const f32x4*)(args.g_pre + k); f32x4 sc, sh;
#pragma unroll
                for (int e = 0; e < 4; ++e) { sc[e] = __hip_atomic_load(mod + D + k + e, __ATOMIC_RELAXED, __HIP_MEMORY_SCOPE_AGENT); sh[e] = __hip_atomic_load(mod + k + e, __ATOMIC_RELAXED, __HIP_MEMORY_SCOPE_AGENT); }
                av[j][h] = gp * (sc + 1.0f); bv[j][h] = sh; }
        for (int m = gw; m < M; m += NGW) {
            const float* xr = args.x + (size_t)m * D + 8 * lane;
            f32x4 v[4][2]; float ss = 0.f;
#pragma unroll
            for (int j = 0; j < 4; ++j)
#pragma unroll
                for (int h = 0; h < 2; ++h) { v[j][h] = *(const f32x4*)(xr + 512 * j + 4 * h); const f32x4 q = v[j][h] * v[j][h]; ss += (q[0] + q[1]) + (q[2] + q[3]); }
            const float rstd = 1.0f / sqrtf(wave_sum(ss) * (1.0f / D) + EPS);
            bf16_t* hr = Hb + (size_t)m * D + 8 * lane;
#pragma unroll
            for (int j = 0; j < 4; ++j) { const f32x4 h0 = v[j][0] * rstd * av[j][0] + bv[j][0], h1 = v[j][1] * rstd * av[j][1] + bv[j][1]; *(u32x4*)(hr + 512 * j) = pg8::pack8(h0, h1); }
        }
        if (BOTH(0) || rep + 1 < NREP(0)) GRID_BAR();
    }
    if (IN(2)) {
        pg8::SegOrder1 S; S.so.init(M, PROJ, G, bx, NREP(2)); S.A = (const char*)Hb; S.B = (const char*)WinT; S.tstep = (size_t)256 * D * 2; S.nt = D / 64;
        pg8::EpiProj E{ws, SGA, args.conv_w, lds + HALO_OFF};
        pg8::gemm_stream<pg8::EpiProj, pg8::SegOrder1>(lds, D, S, E);
        if (BOTH(2)) GRID_BAR();
    }
    if (IN(3)) for (int rep = 0; rep < NREP(3); ++rep) {
        for (int idx = gtid; idx < 63 * 2 * (NCV / 4); idx += NT) {
            const int c4 = idx % (NCV / 4), pj = idx / (NCV / 4), j = pj & 1, pm = 1 + (pj >> 1), ch = 4 * c4;
            const f32x4 h0 = *(const f32x4*)(HPb + ((size_t)((pm - 1) * 2 + 0) * NCV + ch)), h1 = *(const f32x4*)(HPb + ((size_t)((pm - 1) * 2 + 1) * NCV + ch));
            const f32x4 w0 = *(const f32x4*)(args.conv_w + ch), w1 = *(const f32x4*)(args.conv_w + NCV + ch);
            const f32x4 qv = *(const f32x4*)(FXQb + ((size_t)(pm * 2 + j) * NCV + ch)), uu = *(const f32x4*)(FXUb + ((size_t)(pm * 2 + j) * NCV + ch));
            const f32x4 miss = (j == 0) ? (w1 * h1 + w0 * h0) : (w0 * h1);
            const f32x4 rv = qv * (uu + miss);
            u32x2 rw; rw.x = cvt_pk_bf16(rv[0], rv[1]); rw.y = cvt_pk_bf16(rv[2], rv[3]);
            *(u32x2*)(Rb + ((size_t)(256 * pm + j) * NCV + ch)) = rw;
        }
        for (int chunk = vcu; chunk < 256; chunk += G) {
            int g, hh, r, n0;
            if (chunk < 128) { g = 2; hh = chunk >> 4; r = chunk & 15; n0 = 0; } else { const int idx = chunk - 128; g = 1; hh = idx >> 4; r = (idx & 15) >> 2; n0 = (idx & 3) * 8; }
            const size_t go = (size_t)g * M * 1024;
            attn_chunk<false>(lds, Qb + go, Kb + go, Vb + go, 2 * g, hh, r, n0, 8, (g == 1) ? O1 : O2, LSE + (size_t)g * M * 8, nullptr, nullptr, nullptr, nullptr, nullptr, nullptr);
        }
        if (BOTH(3) || rep + 1 < NREP(3)) GRID_BAR();
    }
    if (IN(4)) for (int rep = 0; rep < NREP(4); ++rep) {
        for (int chunk = vcu; chunk < 256; chunk += G)
            attn_chunk<true>(lds, Qb, Kb, Vb, 0, chunk >> 5, 0, (chunk & 31) * 4, 4, nullptr, nullptr, O1, O2, LSE + (size_t)1 * M * 8, LSE + (size_t)2 * M * 8, SZ, AATT);
        if (BOTH(4) || rep + 1 < NREP(4)) GRID_BAR();
    }
    if (IN(5)) {
        pg8::SegOrder2 S; S.so.init(M, D, G, bx, NREP(5)); S.A0 = (const char*)AATT; S.B0 = (const char*)WaT; S.A1 = (const char*)Rb; S.B1 = (const char*)WcT; S.tstep = (size_t)256 * D * 2; S.nt0 = NZA / 64; S.nt1 = NCV / 64;
        pg8::EpiMerge E{MG, SGA, SGC, D};
        pg8::gemm_stream<pg8::EpiMerge, pg8::SegOrder2, true>(lds, D, S, E);
        if (BOTH(5)) GRID_BAR();
    }
    if (IN(6)) {
        pg8::SegOrder1 S; S.so.init(M, D, G, bx, NREP(6)); S.A = (const char*)MG; S.B = (const char*)WoT; S.tstep = (size_t)256 * D * 2; S.nt = D / 64;
        pg8::EpiBf16 E{Yb, D};
        pg8::gemm_stream<pg8::EpiBf16, pg8::SegOrder1>(lds, D, S, E);
        if (BOTH(6)) GRID_BAR();
    }
    if (IN(7)) {
        f32x4 gv[4][2];
#pragma unroll
        for (int j = 0; j < 4; ++j)
#pragma unroll
            for (int h = 0; h < 2; ++h) { const int k = 512 * j + 8 * lane + 4 * h; gv[j][h] = *(const f32x4*)(mod + 2 * D + k) * *(const f32x4*)(args.g_post + k); }
        for (int m = gw; m < M; m += NGW) {
            const bf16_t* yr = Yb + (size_t)m * D + 8 * lane; const float* xr = args.x + (size_t)m * D + 8 * lane; float* orow = args.out + (size_t)m * D + 8 * lane;
            f32x4 v[4][2], xv[4][2]; u32x4 yw[4]; float ss = 0.f;
#pragma unroll
            for (int j = 0; j < 4; ++j) { yw[j] = *(const u32x4*)(yr + 512 * j); xv[j][0] = *(const f32x4*)(xr + 512 * j); xv[j][1] = *(const f32x4*)(xr + 512 * j + 4); }
#pragma unroll
            for (int j = 0; j < 4; ++j) { pg8::unpack8(yw[j], v[j][0], v[j][1]);
#pragma unroll
                for (int h = 0; h < 2; ++h) { const f32x4 q = v[j][h] * v[j][h]; ss += (q[0] + q[1]) + (q[2] + q[3]); } }
            const float rstd = 1.0f / sqrtf(wave_sum(ss) * (1.0f / D) + EPS);
#pragma unroll
            for (int j = 0; j < 4; ++j)
#pragma unroll
                for (int h = 0; h < 2; ++h) *(f32x4*)(orow + 512 * j + 4 * h) = xv[j][h] + gv[j][h] * (v[j][h] * rstd);
        }
    }
#undef IN
#undef BOTH
#undef GRID_BAR
}

extern "C" void kernel_launch(void* const* d_in, const int* in_sizes, int n_in, void* d_out, int out_size, void* d_ws, size_t ws_size, hipStream_t stream) {
    static int grid = 0;
    if (grid == 0) {
        if (n_in != 12 || in_sizes[0] != M * D || out_size != M * D || ws_size < WS_END) { fprintf(stderr, "kernel_launch: unexpected shapes (n_in %d, in0 %d, out %d, ws %zu); nothing launched\n", n_in, n_in > 0 ? in_sizes[0] : -1, out_size, ws_size); grid = -1; return; }
        int dev = 0, cus = 0;
        if (hipGetDevice(&dev) != hipSuccess || hipDeviceGetAttribute(&cus, hipDeviceAttributeMultiprocessorCount, dev) != hipSuccess) { grid = -1; return; }
        if (hipFuncSetAttribute((const void*)mk_fwd, hipFuncAttributeMaxDynamicSharedMemorySize, LDS_BYTES) != hipSuccess) { fprintf(stderr, "kernel_launch: hipFuncSetAttribute failed\n"); grid = -1; return; }
        (void)hipGetLastError();
        grid = cus;
    }
    if (grid < 0) return;
    if (hipMemsetAsync((char*)d_ws + WS_CTL, 0, CTL_ZERO_BYTES, stream) != hipSuccess) return;
    Args a{};
    a.x = (const float*)d_in[0]; a.c = (const float*)d_in[1]; a.pos = (const int*)d_in[2]; a.g_pre = (const float*)d_in[3]; a.w_ada = (const float*)d_in[4]; a.b_ada = (const float*)d_in[5];
    a.w_in = (const float*)d_in[6]; a.conv_w = (const float*)d_in[7]; a.w_attn_o = (const float*)d_in[8]; a.w_conv_o = (const float*)d_in[9]; a.w_o = (const float*)d_in[10]; a.g_post = (const float*)d_in[11];
    a.out = (float*)d_out; a.ws = (unsigned char*)d_ws;
    for (int li = 0; li < N_LAUNCHES; ++li) {
        a.ph_lo = (N_LAUNCHES == 1) ? 0 : li; a.ph_hi = (N_LAUNCHES == 1) ? NPHASES : li + 1; a.li = li;
        hipLaunchKernelGGL(mk_fwd, dim3(grid), dim3(NWAVES * 64), LDS_BYTES, stream, a);
        if (hipPeekAtLastError() != hipSuccess) break;
    }
}
```

```cpp
#include <hip/hip_runtime.h>
#include <cstdio>
#include <cstdint>

#define GAS __attribute__((address_space(1)))
#define LAS __attribute__((address_space(3)))
typedef unsigned short bf16_t;
typedef short bf16x8 __attribute__((ext_vector_type(8)));
typedef short s16x4 __attribute__((ext_vector_type(4)));
typedef float f32x4 __attribute__((ext_vector_type(4)));
typedef float f32x2 __attribute__((ext_vector_type(2)));
typedef unsigned u32x4 __attribute__((ext_vector_type(4)));
typedef unsigned u32x2 __attribute__((ext_vector_type(2)));

constexpr int M = 16384, D = 2048, NQKV = 3072, NZA = 1024, NCV = 2048, PROJ = 22528, NMOD = 6144;
constexpr float EPS = 1e-6f;
constexpr float LOG2E = 1.4426950408889634f;
constexpr float QSCALE = 0.08838834764831845f * 1.4426950408889634f;

__constant__ float INVF[16] = {1.0f, 0.44036659598350525f, 0.1939227432012558f, 0.08539710193872452f, 0.03760603070259094f, 0.016560440883040428f,
    0.007292664609849453f, 0.0032114461064338684f, 0.0014142135623842478f, 0.0006227724370546639f, 0.00027424818836152554f, 0.00012076973507646471f,
    5.3182957344688475e-05f, 2.34199997066753e-05f, 1.0313385246263351e-05f, 4.541670477919979e-06f};

typedef __bf16 bf16x2_t __attribute__((ext_vector_type(2)));
__device__ __forceinline__ unsigned cvt_pk_bf16(float lo, float hi) { const f32x2 v = {lo, hi}; return __builtin_bit_cast(unsigned, __builtin_convertvector(v, bf16x2_t)); }
__device__ __forceinline__ float bf_lo(unsigned w) { return __builtin_bit_cast(float, w << 16); }
__device__ __forceinline__ float bf_hi(unsigned w) { return __builtin_bit_cast(float, w & 0xffff0000u); }
template <int CTRL> __device__ __forceinline__ float dpp_row_shr(float old, float src) { return __int_as_float(__builtin_amdgcn_update_dpp(__float_as_int(old), __float_as_int(src), CTRL, 0xf, 0xf, false)); }
__device__ __forceinline__ float silu_f(float v) { return v * __builtin_amdgcn_rcpf(1.0f + __builtin_amdgcn_exp2f(-v * LOG2E)); }
__device__ __forceinline__ float sigm_f(float v) { return __builtin_amdgcn_rcpf(1.0f + __builtin_amdgcn_exp2f(-v * LOG2E)); }

constexpr size_t MiB = 1u << 20;
constexpr size_t WS_CTL = 0, CTL_ZERO_BYTES = 32768;
constexpr size_t WS_MOD = 1 * MiB;
constexpr size_t WS_CS = 2 * MiB;
constexpr size_t WS_WIN = 4 * MiB;
constexpr size_t WS_WA = 92 * MiB, WS_WC = 100 * MiB, WS_WO = 108 * MiB;
constexpr size_t WS_H = 116 * MiB;
constexpr size_t WS_Q = 180 * MiB, WS_K = 276 * MiB, WS_V = 372 * MiB;
constexpr size_t WS_SZ = 468 * MiB;
constexpr size_t WS_R = 500 * MiB;
constexpr size_t WS_FX = 564 * MiB;
constexpr size_t WS_O2 = 628 * MiB;
constexpr size_t WS_LSE = 660 * MiB;
constexpr size_t WS_END = 662 * MiB;
constexpr size_t WS_O1 = 148 * MiB;
constexpr size_t WS_AATT = WS_K + 32 * MiB, WS_MG = WS_V + 32 * MiB, WS_Y = WS_R;

#ifndef PG8_A_AUX
#define PG8_A_AUX 0
#endif
#ifndef PG8_B_AUX
#define PG8_B_AUX 0
#endif
namespace pg8 {
constexpr int BM = 256, BK = 64, HALF = 128, HTB = HALF * BK * 2, STAGE_BYTES = 8 * HTB, NXCD = 8, WGM = 8;
__host__ __device__ __forceinline__ int lds_byte(int r, int c) { const int st = (r >> 4) * 2 + (c >> 5), rr = r & 15, cc = c & 31, ob = rr * 64 + cc * 2; return st * 1024 + (ob ^ (((ob >> 9) & 1) << 5)); }
__host__ __device__ __forceinline__ void stage_rc(int b, int& R, int& C) { const int st = b / 1024, sb = b % 1024, swz = sb ^ (((sb >> 9) & 1) << 5); R = (st >> 1) * 16 + swz / 64; C = (st & 1) * 32 + (swz % 64) / 2; }
__host__ __device__ __forceinline__ int perm32(int rho) { const int n = rho >> 4, i = rho & 15; return 8 * (i >> 2) + 4 * n + (i & 3); }

struct Unit { int pm, pn; };
struct Gemm { const bf16_t* A; const bf16_t* Bt; int M, N, K; };

struct StaticOrder {
    int nM, nN, nwg, G, c, rounds, rep;
    __host__ __device__ void init(int M_, int N_, int G_, int c_, int rep_ = 1) { nM = M_ / BM; nN = N_ / BM; nwg = nM * nN; G = G_; c = c_; rounds = (nwg + G - 1) / G; rep = rep_; }
    __host__ __device__ bool next(int i, Unit& u) const {
        if (i >= rounds * rep) return false;
        i = i % rounds;
        const long L = (long)i * G + c; if (L >= nwg) return false;
        int wgid = (int)L; { const int q = nwg / NXCD, r = nwg % NXCD, xcd = wgid % NXCD, off = wgid / NXCD; wgid = (xcd < r ? xcd * (q + 1) : r * (q + 1) + (xcd - r) * q) + off; }
        const int nig = WGM * nN, gid = wgid / nig, fm = gid * WGM, gsz = (nM - fm) < WGM ? (nM - fm) : WGM;
        u.pm = fm + ((wgid % nig) % gsz); u.pn = (wgid % nig) / gsz; return true;
    }
    __device__ __forceinline__ void a_ready(const Unit&) const {}
    __device__ __forceinline__ void done(const Unit&) const {}
};


struct Seg { const char* A; const char* B; int nt; int mid; Unit u; };
__device__ __forceinline__ const char* rfl_ptr(const char* p) { const unsigned long long v = (unsigned long long)p; const unsigned lo = __builtin_amdgcn_readfirstlane((unsigned)v), hi = __builtin_amdgcn_readfirstlane((unsigned)(v >> 32)); return (const char*)(((unsigned long long)hi << 32) | lo); }
__device__ __forceinline__ void rfl_seg(Seg& o) { o.A = rfl_ptr(o.A); o.B = rfl_ptr(o.B); o.nt = __builtin_amdgcn_readfirstlane(o.nt); o.mid = __builtin_amdgcn_readfirstlane(o.mid); o.u.pm = __builtin_amdgcn_readfirstlane(o.u.pm); o.u.pn = __builtin_amdgcn_readfirstlane(o.u.pn); }
constexpr int NSTORE = 16;
template <class Epi, class Sched, bool DUAL = false>
__device__ __forceinline__ void gemm_stream(LAS unsigned char* lds, const int pitch, const Sched& S, const Epi& E) {
    const int tid = threadIdx.x, wid = __builtin_amdgcn_readfirstlane(tid >> 6), lane = tid & 63, wr = wid >> 2, wc = wid & 3, fr = lane & 15, fq = lane >> 4;
    unsigned voffA[2], voffB[2];
#pragma unroll
    for (int i = 0; i < 2; ++i) { int R, C; stage_rc(tid * 16 + i * 8192, R, C); const int Rb = Epi::PERM ? ((R & ~31) + perm32(R & 31)) : R;
        voffA[i] = (unsigned)(R * pitch + C) * 2u; voffB[i] = (unsigned)(Rb * pitch + C) * 2u; }
    const size_t kstep = (size_t)(BK * 2);
    const size_t hstep = (size_t)HALF * pitch * 2;
    const unsigned ldsw = (unsigned)wid * 1024u;
    const int aoff = lds_byte(wr * 64 + fr, fq * 8), boff = lds_byte(wc * 32 + fr, fq * 8);
#define PG8_SA(b, h) (((b) * 2 + (h)) * HTB)
#define PG8_SB(b, h) ((4 + (b) * 2 + (h)) * HTB)
#define PG8_STAGE(bufoff, gbase, voff) do { const char* _gb = (const char*)(gbase); asm volatile("" : "+s"(_gb));   \
        _Pragma("unroll") for (int _i = 0; _i < 2; ++_i) \
        __builtin_amdgcn_global_load_lds((const unsigned*)(_gb + (voff)[_i]), (LAS unsigned*)(lds + (bufoff) + ldsw + _i * 8192), 16, 0, PG8_A_AUX); } while (0)
#define PG8_STAGEB(bufoff, gbase, voff) do { const char* _gb = (const char*)(gbase); asm volatile("" : "+s"(_gb)); \
        _Pragma("unroll") for (int _i = 0; _i < 2; ++_i) \
        __builtin_amdgcn_global_load_lds((const unsigned*)(_gb + (voff)[_i]), (LAS unsigned*)(lds + (bufoff) + ldsw + _i * 8192), 16, 0, PG8_B_AUX); } while (0)
#define PG8_LDA(dst, b, h) do { _Pragma("unroll") for (int m = 0; m < 4; ++m) _Pragma("unroll") for (int k = 0; k < 2; ++k) dst[m][k] = *(const LAS bf16x8*)(lds + PG8_SA(b, h) + aoff + m * 2048 + k * 1024); } while (0)
#define PG8_LDB(dst, b, h) do { _Pragma("unroll") for (int n = 0; n < 2; ++n) _Pragma("unroll") for (int k = 0; k < 2; ++k) dst[n][k] = *(const LAS bf16x8*)(lds + PG8_SB(b, h) + boff + n * 2048 + k * 1024); } while (0)
#define PG8_MMA(ai, bj, At, Bt) do { __builtin_amdgcn_s_setprio(1); _Pragma("unroll") for (int m = 0; m < 4; ++m) _Pragma("unroll") for (int n = 0; n < 2; ++n) _Pragma("unroll") for (int k = 0; k < 2; ++k) \
        acc[ai][bj][m][n] = __builtin_amdgcn_mfma_f32_16x16x32_bf16(Bt[n][k], At[m][k], acc[ai][bj][m][n], 0, 0, 0); __builtin_amdgcn_s_setprio(0); } while (0)
#define PG8_WAIT_V(n) asm volatile("s_waitcnt vmcnt(" #n ")" ::: "memory")
#define PG8_WAIT_VR() PG8_WAIT_V(8)
#define PG8_WAIT_L(n) asm volatile("s_waitcnt lgkmcnt(" #n ")" ::: "memory")
#define PG8_BAR __builtin_amdgcn_s_barrier()
#define PG8_SCHED __builtin_amdgcn_sched_barrier(0)
    Seg cur, nxt; int si = 0;
    if (!S.seg(0, cur)) return;
    f32x4 acc[2][2][4][2];
#pragma unroll
    for (int a = 0; a < 2; ++a)
#pragma unroll
        for (int b = 0; b < 2; ++b)
#pragma unroll
            for (int m = 0; m < 4; ++m)
#pragma unroll
                for (int n = 0; n < 2; ++n) acc[a][b][m][n] = (f32x4){0.f, 0.f, 0.f, 0.f};
    bf16x8 At[4][2], B0[2][2], B1[2][2];
    {
        const char* cA = cur.A; const char* cB = cur.B;
        PG8_STAGEB(PG8_SB(0, 0), cB, voffB); PG8_STAGEB(PG8_SB(0, 1), cB + hstep, voffB); PG8_STAGE(PG8_SA(0, 0), cA, voffA); PG8_STAGE(PG8_SA(0, 1), cA + hstep, voffA);
        if (wr == 1) PG8_BAR;
        PG8_WAIT_V(2); PG8_BAR;
        PG8_STAGEB(PG8_SB(1, 0), cB + kstep, voffB); PG8_STAGE(PG8_SA(1, 0), cA + kstep, voffA); PG8_STAGEB(PG8_SB(1, 1), cB + hstep + kstep, voffB);
        PG8_WAIT_V(6); PG8_BAR;
    }
    bool fresh = true, relax = false;
    for (;;) {
        const bool has_next = S.seg(si + 1, nxt);
        const char* cA = cur.A; const char* cB = cur.B; const int nt = cur.nt;
        const char* nA = has_next ? nxt.A : cA; const char* nB = has_next ? nxt.B : cB;
#pragma nounroll
        for (int t = 0; t < nt; t += 2) {
            const bool first = (t == 0) && !fresh;
            const bool last = (t == nt - 2);
            const char* a1 = cA + (size_t)(t + 1) * kstep;
            const char* a2 = last ? nA : cA + (size_t)(t + 2) * kstep; const char* b2 = last ? nB : cB + (size_t)(t + 2) * kstep;
            const char* a3 = a2 + kstep; const char* b3 = b2 + kstep;
            PG8_LDB(B0, 0, 0); PG8_LDB(B1, 0, 1); PG8_SCHED; PG8_LDA(At, 0, 0); if (!first) PG8_STAGE(PG8_SA(1, 1), a1 + hstep, voffA);
            PG8_WAIT_VR(); PG8_WAIT_L(0); PG8_BAR; PG8_MMA(0, 0, At, B0); PG8_MMA(0, 1, At, B1); PG8_BAR; PG8_SCHED;
            PG8_LDA(At, 0, 1); PG8_STAGEB(PG8_SB(0, 0), b2, voffB); PG8_STAGEB(PG8_SB(0, 1), b2 + hstep, voffB); PG8_STAGE(PG8_SA(0, 0), a2, voffA);
            PG8_WAIT_VR(); PG8_WAIT_L(0); PG8_BAR; PG8_MMA(1, 0, At, B0); PG8_MMA(1, 1, At, B1); PG8_BAR; PG8_SCHED;
            PG8_LDB(B0, 1, 0); PG8_LDB(B1, 1, 1); PG8_SCHED; PG8_LDA(At, 1, 0); PG8_STAGE(PG8_SA(0, 1), a2 + hstep, voffA);
            PG8_WAIT_VR(); PG8_WAIT_L(0); PG8_BAR; PG8_MMA(0, 0, At, B0); PG8_MMA(0, 1, At, B1); PG8_BAR; PG8_SCHED;
            PG8_LDA(At, 1, 1); PG8_STAGEB(PG8_SB(1, 0), b3, voffB); PG8_STAGEB(PG8_SB(1, 1), b3 + hstep, voffB); PG8_STAGE(PG8_SA(1, 0), a3, voffA);
            PG8_WAIT_V(8); PG8_WAIT_L(0); PG8_BAR; PG8_MMA(1, 0, At, B0); PG8_MMA(1, 1, At, B1); PG8_BAR; PG8_SCHED;
        }
        if (wr == 0) PG8_BAR;
        PG8_STAGE(PG8_SA(1, 1), nA + kstep + hstep, voffA);
        PG8_SCHED;
        if constexpr (DUAL) E.scale(acc, cur.u, wr, wc, fr, fq, cur.mid != 0);
        if (DUAL && cur.mid) { relax = false; }
        else {
            E(acc, cur.u, wr, wc, fr, fq); relax = true;
#pragma unroll
            for (int a = 0; a < 2; ++a)
#pragma unroll
                for (int b = 0; b < 2; ++b)
#pragma unroll
                    for (int m = 0; m < 4; ++m)
#pragma unroll
                        for (int n = 0; n < 2; ++n) acc[a][b][m][n] = (f32x4){0.f, 0.f, 0.f, 0.f};
        }
        PG8_SCHED;
        if (!has_next) break;
        cur = nxt; ++si; fresh = false;
        if (wr == 1) PG8_BAR;
    }
    PG8_WAIT_V(0);
    PG8_BAR;
#undef PG8_SA
#undef PG8_SB
#undef PG8_STAGE
#undef PG8_STAGEB
#undef PG8_LDA
#undef PG8_LDB
#undef PG8_MMA
#undef PG8_WAIT_V
#undef PG8_WAIT_VR
#undef PG8_WAIT_L
#undef PG8_BAR
#undef PG8_SCHED
}
struct SegOrder1 {
    StaticOrder so; const char* A; const char* B; size_t tstep; int nt;
    __device__ __forceinline__ bool seg(int s, Seg& o) const { Unit u; if (!so.next(s, u)) return false; o.A = A + (size_t)u.pm * tstep; o.B = B + (size_t)u.pn * tstep; o.nt = nt; o.mid = 0; o.u = u; rfl_seg(o); return true; }
};

__device__ __forceinline__ u32x4 pack8(const f32x4 v0, const f32x4 v1) { u32x4 w; w.x = cvt_pk_bf16(v0[0], v0[1]); w.y = cvt_pk_bf16(v0[2], v0[3]); w.z = cvt_pk_bf16(v1[0], v1[1]); w.w = cvt_pk_bf16(v1[2], v1[3]); return w; }
__device__ __forceinline__ void unpack8(const u32x4 w, f32x4& v0, f32x4& v1) { v0 = (f32x4){bf_lo(w.x), bf_hi(w.x), bf_lo(w.y), bf_hi(w.y)}; v1 = (f32x4){bf_lo(w.z), bf_hi(w.z), bf_lo(w.w), bf_hi(w.w)}; }

#ifdef NT_STORES
#define ST16(p, v) __builtin_nontemporal_store((v), (u32x4*)(p))
#define ST8(p, v) __builtin_nontemporal_store((v), (u32x2*)(p))
#else
#define ST16(p, v) (*(u32x4*)(p) = (v))
#define ST8(p, v) (*(u32x2*)(p) = (v))
#endif
__device__ __forceinline__ int attn_row(int t, int g2) { return (t & ((1 << g2) - 1)) * (M >> g2) + (t >> g2); }
struct EpiProj {
    static constexpr bool PERM = true;
    __device__ __forceinline__ void mid(f32x4 (&)[2][2][4][2], const Unit&, int, int, int, int) const {}
    unsigned char* ws; bf16_t* SGA; const float* cw; LAS unsigned char* halo;
    __device__ __forceinline__ void operator()(const f32x4 (&acc)[2][2][4][2], const Unit& u, int wr, int wc, int fr, int fq) const {
        int pn = u.pn, upm = u.pm; asm volatile("" : "+s"(pn), "+s"(upm));
        const int row0 = upm * BM + wr * 64 + fr; const int lc = wc * 32 + 8 * fq;
        bf16_t* const Q = (bf16_t*)(ws + WS_Q); bf16_t* const Kb = (bf16_t*)(ws + WS_K); bf16_t* const V = (bf16_t*)(ws + WS_V); bf16_t* const SZ = (bf16_t*)(ws + WS_SZ); bf16_t* const R = (bf16_t*)(ws + WS_R);
        bf16_t* const SGC = SGA + (size_t)M * D; const float* const cs = (const float*)(ws + WS_CS);
        float* const HP = (float*)(ws + WS_FX); float* const FXQ = HP + (size_t)64 * 2 * NCV; float* const FXU = FXQ + (size_t)64 * 2 * NCV;
        if (pn < 24) {
            const bool isq = pn < 12; const int tq = isq ? pn : pn - 12, g2 = (tq >> 2) * 2; bf16_t* base = (isq ? Q : Kb) + (size_t)(tq >> 2) * M * 1024 + (size_t)((tq & 3) * 2) * M * 128; const float sc = isq ? QSCALE : 1.0f;
            const bool rot = (fq == 0);
            f32x4 cv[2][4], sv[2][4];
#pragma unroll
            for (int ai = 0; ai < 2; ++ai)
#pragma unroll
                for (int m = 0; m < 4; ++m) { const float* cr = cs + (size_t)(row0 + ai * HALF + m * 16) * 32 + 4 * wc; cv[ai][m] = *(const f32x4*)cr; sv[ai][m] = *(const f32x4*)(cr + 16); }
#pragma unroll
            for (int ai = 0; ai < 2; ++ai)
#pragma unroll
                for (int m = 0; m < 4; ++m) {
                    const f32x4 c = rot ? cv[ai][m] * sc : (f32x4){sc, sc, sc, sc}, sn = rot ? sv[ai][m] * sc : (f32x4){0.f, 0.f, 0.f, 0.f};
                    bf16_t* rowp = base + (size_t)attn_row(row0 + ai * HALF + m * 16, g2) * 128 + lc;
#pragma unroll
                    for (int bj = 0; bj < 2; ++bj) { const f32x4 v0 = acc[ai][bj][m][0], v1 = acc[ai][bj][m][1];
                        ST16((rowp + (size_t)bj * M * 128), (pack8(v0 * c - v1 * sn, v0 * sn + v1 * c))); }
                }
        } else if (pn < 36) {
            const int tv = pn - 24, g2 = (tv >> 2) * 2; bf16_t* vbase = V + (size_t)(tv >> 2) * M * 1024 + (size_t)((tv & 3) * 2) * M * 128;
#pragma unroll
            for (int ai = 0; ai < 2; ++ai)
#pragma unroll
                for (int m = 0; m < 4; ++m) { bf16_t* rowp = vbase + (size_t)attn_row(row0 + ai * HALF + m * 16, g2) * 128 + lc;
#pragma unroll
                    for (int bj = 0; bj < 2; ++bj) ST16((rowp + (size_t)bj * M * 128), (pack8(acc[ai][bj][m][0], acc[ai][bj][m][1]))); }
        } else if (pn < 40) {
            const int colt = (pn - 36) * BM;
#pragma unroll
            for (int ai = 0; ai < 2; ++ai)
#pragma unroll
                for (int m = 0; m < 4; ++m) { bf16_t* rowp = SZ + (size_t)(row0 + ai * HALF + m * 16) * NZA + colt + lc;
#pragma unroll
                    for (int bj = 0; bj < 2; ++bj) ST16((rowp + bj * HALF), (pack8(acc[ai][bj][m][0], acc[ai][bj][m][1]))); }
        } else if (pn < 72) {
            int chl = 16 * wc + 4 * fq, frh = fr - 14; asm volatile("" : "+v"(chl), "+v"(frh));
            const int ct = pn - 40, chb = 64 * ct + chl, pm = upm;
            const f32x4 w0 = *(const f32x4*)(cw + chb), w1 = *(const f32x4*)(cw + NCV + chb), w2 = *(const f32x4*)(cw + 2 * NCV + chb);
#pragma unroll
            for (int ai = 0; ai < 2; ++ai)
#pragma unroll
                for (int m = 0; m < 4; ++m) { const f32x4 pv = acc[ai][0][m][1] * acc[ai][1][m][0];
                    const int gi = 8 * ai + 4 * wr + m;
                    if (fr >= 14) { *(LAS f32x4*)(halo + (size_t)(((gi * 2 + frh) * 64 + chl) * 4)) = pv;
                        if (gi == 15) *(f32x4*)(HP + ((size_t)(pm * 2 + frh) * NCV + chb)) = pv; } }
            asm volatile("s_waitcnt lgkmcnt(0)" ::: "memory"); __builtin_amdgcn_s_barrier(); asm volatile("" ::: "memory");
#pragma unroll
            for (int ai = 0; ai < 2; ++ai)
#pragma unroll
                for (int m = 0; m < 4; ++m) {
                    const int gi = 8 * ai + 4 * wr + m; const int gp = gi > 0 ? gi - 1 : 0;
                    f32x4 H0 = *(const LAS f32x4*)(halo + (size_t)(((gp * 2 + 0) * 64 + chl) * 4)), H1 = *(const LAS f32x4*)(halo + (size_t)(((gp * 2 + 1) * 64 + chl) * 4));
                    if (gi == 0) { H0 = (f32x4){0.f, 0.f, 0.f, 0.f}; H1 = H0; }
                    const f32x4 Hs = (fr == 1) ? H1 : H0, pvv = acc[ai][0][m][1] * acc[ai][1][m][0];
                    f32x4 Pm1, Pm2, qv;
#pragma unroll
                    for (int j = 0; j < 4; ++j) {
                        const float pj = pvv[j], h1j = H1[j], hsj = Hs[j];
                        Pm1[j] = dpp_row_shr<0x111>(h1j, pj); Pm2[j] = dpp_row_shr<0x112>(hsj, pj);
                        qv[j] = acc[ai][0][m][0][j] * silu_f(acc[ai][1][m][1][j]); }
                    const f32x4 uu = w2 * pvv + w1 * Pm1 + w0 * Pm2, rv = qv * uu;
                    const size_t ro = (size_t)(row0 + ai * HALF + m * 16) * NCV + chb;
                    u32x2 rw; rw.x = cvt_pk_bf16(rv[0], rv[1]); rw.y = cvt_pk_bf16(rv[2], rv[3]);
                    ST8((R + ro), (rw));
                    if (gi == 0 && fr < 2 && pm > 0) { *(f32x4*)(FXQ + ((size_t)(pm * 2 + fr) * NCV + chb)) = qv; *(f32x4*)(FXU + ((size_t)(pm * 2 + fr) * NCV + chb)) = uu; }
                }
        } else {
            const int colt = (pn - 72) * HALF;
#pragma unroll
            for (int ai = 0; ai < 2; ++ai)
#pragma unroll
                for (int m = 0; m < 4; ++m) { const size_t ro = (size_t)(row0 + ai * HALF + m * 16) * D + colt + lc;
                    f32x4 r[2], c[2];
#pragma unroll
                    for (int n = 0; n < 2; ++n)
#pragma unroll
                        for (int j = 0; j < 4; ++j) { const float pc = 1.0f + __builtin_amdgcn_exp2f(-acc[ai][1][m][n][j] * LOG2E), pa = 1.0f + __builtin_amdgcn_exp2f(-acc[ai][0][m][n][j] * LOG2E);
                            const float t = __builtin_amdgcn_rcpf(pa * pc); c[n][j] = pa * t; r[n][j] = pc * pc * t; }
                    ST16((SGA + ro), (pack8(r[0], r[1]))); ST16((SGC + ro), (pack8(c[0], c[1]))); }
        }
    }
};
struct EpiMerge {
    static constexpr bool PERM = true;
    bf16_t* O; const bf16_t* RHO; const bf16_t* SC; int ldc;
    __device__ __forceinline__ size_t lane_off(const Unit& u, int wr, int wc, int fr, int fq, int ai) const {
        size_t o = (size_t)(u.pm * BM + wr * 64 + fr + ai * HALF) * ldc + u.pn * BM + wc * 32 + 8 * fq; asm volatile("" : "+v"(o)); return o; }
    __device__ __forceinline__ void scale(f32x4 (&acc)[2][2][4][2], const Unit& u, int wr, int wc, int fr, int fq, bool is_mid) const {
        const bf16_t* G = is_mid ? RHO : SC;
#pragma unroll
        for (int ai = 0; ai < 2; ++ai) {
            const bf16_t* p = G + lane_off(u, wr, wc, fr, fq, ai);
            u32x4 gw[4][2];
#pragma unroll
            for (int m = 0; m < 4; ++m)
#pragma unroll
                for (int bj = 0; bj < 2; ++bj) gw[m][bj] = *(const u32x4*)(p + (size_t)m * 16 * ldc + bj * HALF);
#pragma unroll
            for (int m = 0; m < 4; ++m)
#pragma unroll
                for (int bj = 0; bj < 2; ++bj) { f32x4 g0, g1; unpack8(gw[m][bj], g0, g1); acc[ai][bj][m][0] *= g0; acc[ai][bj][m][1] *= g1; }
        }
    }
    __device__ __forceinline__ void mid(f32x4 (&)[2][2][4][2], const Unit&, int, int, int, int) const {}
    __device__ __forceinline__ void operator()(const f32x4 (&acc)[2][2][4][2], const Unit& u, int wr, int wc, int fr, int fq) const {
#pragma unroll
        for (int ai = 0; ai < 2; ++ai) {
            bf16_t* q = O + lane_off(u, wr, wc, fr, fq, ai);
#pragma unroll
            for (int m = 0; m < 4; ++m)
#pragma unroll
                for (int bj = 0; bj < 2; ++bj) *(u32x4*)(q + (size_t)m * 16 * ldc + bj * HALF) = pack8(acc[ai][bj][m][0], acc[ai][bj][m][1]);
        }
    }
};
struct EpiBf16 {
    static constexpr bool PERM = true;
    __device__ __forceinline__ void mid(f32x4 (&)[2][2][4][2], const Unit&, int, int, int, int) const {}
    bf16_t* O; int ldc;
    __device__ __forceinline__ void operator()(const f32x4 (&acc)[2][2][4][2], const Unit& u, int wr, int wc, int fr, int fq) const {
        const int row0 = u.pm * BM + wr * 64 + fr, col0 = u.pn * BM + wc * 32 + 8 * fq;
#pragma unroll
        for (int ai = 0; ai < 2; ++ai)
#pragma unroll
            for (int m = 0; m < 4; ++m) { bf16_t* rowp = O + (size_t)(row0 + ai * HALF + m * 16) * ldc + col0;
#pragma unroll
                for (int bj = 0; bj < 2; ++bj) *(u32x4*)(rowp + bj * HALF) = pack8(acc[ai][bj][m][0], acc[ai][bj][m][1]); }
    }
};
struct SegOrder2 {
    StaticOrder so; const char *A0, *B0, *A1, *B1; size_t tstep; int nt0, nt1;
    __device__ __forceinline__ bool seg(int s_, Seg& o) const { Unit u; if (!so.next(s_ >> 1, u)) return false; const int h = s_ & 1;
        o.A = (h ? A1 : A0) + (size_t)u.pm * tstep; o.B = (h ? B1 : B0) + (size_t)u.pn * tstep; o.nt = h ? nt1 : nt0; o.mid = !h; o.u = u; rfl_seg(o); return true; }
};
}

#ifndef PG8_SP2
#define PG8_SP2 true
#endif
#ifndef PG8_ALIGN
#define PG8_ALIGN true
#endif

constexpr int NWAVES = 8;
#ifndef MK_N_LAUNCHES
#define MK_N_LAUNCHES 1
#endif
constexpr int NPHASES = 8;
constexpr int N_LAUNCHES = MK_N_LAUNCHES;

constexpr int CW_BAR = 4096, CW_MODCNT = 8000;
#define XCD_BAR_WORDS 3456

constexpr int RING_BYTES = 131072;
constexpr int LDSCTL_OFF = RING_BYTES, MISC_OFF = LDSCTL_OFF + 320, HALO_OFF = RING_BYTES + 1024;
constexpr int LDS_BYTES = 147456;

typedef GAS unsigned gu32;
#define RLX_AGENT __ATOMIC_RELAXED, __HIP_MEMORY_SCOPE_AGENT

#define XB_TMO      128
#define XB_XCNT(j)  (256  + 64 * (j))
#define XB_XSUB(j)  (1280 + 64 * (j))
#define XB_XGEN(j)  (2304 + 64 * (j))
#define XB_TOP      3328
#define XB_TOPGEN   3392
#define XB_SPIN_CAP (1u << 18)

__device__ __forceinline__ unsigned xb_ld(unsigned* p)              { return __hip_atomic_load(p, __ATOMIC_RELAXED, __HIP_MEMORY_SCOPE_AGENT); }
__device__ __forceinline__ unsigned xb_add(unsigned* p, unsigned v) { return __hip_atomic_fetch_add(p, v, __ATOMIC_RELAXED, __HIP_MEMORY_SCOPE_AGENT); }
__device__ __forceinline__ unsigned xb_xcc_id() { return (unsigned)__builtin_amdgcn_s_getreg((3 << 11) | 20) & 0xFu; }
#define XB_SPIN(cond, bar) do { unsigned _sp = 0; while (cond) { __builtin_amdgcn_s_sleep(1); \
    if ((++_sp & 255u) == 0u) { if (xb_ld(&(bar)[XB_TMO])) break; if (_sp > XB_SPIN_CAP) { atomicAdd(&(bar)[XB_TMO], 1u); break; } } } } while (0)

struct XcdBarrier { unsigned* bar; unsigned x; volatile LAS unsigned* st; };

__device__ __forceinline__ XcdBarrier xcd_barrier_post(unsigned* bar, volatile LAS unsigned* st) {
    XcdBarrier b; b.bar = bar; b.x = xb_xcc_id(); b.st = st;
    if (threadIdx.x == 0) (void)xb_add(&bar[XB_XCNT(b.x)], 1u);
    return b;
}
__device__ __forceinline__ void xcd_barrier_complete(unsigned* bar, unsigned x, unsigned& nloc, unsigned& nx) {
    const unsigned G = gridDim.x * gridDim.y * gridDim.z;
    unsigned sum, cnt, mine, sp = 0u;
    for (;;) {
        sum = 0u; cnt = 0u; mine = 0u;
#pragma unroll
        for (unsigned j = 0; j < 16; ++j) { const unsigned c = xb_ld(&bar[XB_XCNT(j)]); sum += c; cnt += (c > 0u) ? 1u : 0u; mine = (j == x) ? c : mine; }
        if (sum == G) break;
        __builtin_amdgcn_s_sleep(1);
        if ((++sp & 255u) == 0u) { if (xb_ld(&bar[XB_TMO])) break; if (sp > XB_SPIN_CAP) { atomicAdd(&bar[XB_TMO], 1u); break; } }
    }
    nloc = mine > 0u ? mine : 1u; nx = cnt > 0u ? cnt : 1u;
}
__device__ __forceinline__ void xcd_barrier(const XcdBarrier& b) {
    asm volatile("s_waitcnt vmcnt(0)" ::: "memory");
    __syncthreads();
    if (threadIdx.x == 0) {
        unsigned* bar = b.bar;
        __builtin_amdgcn_s_waitcnt(0);
        unsigned nloc = b.st[0], nx = b.st[1];
        if (nloc == 0u) { xcd_barrier_complete(bar, b.x, nloc, nx); b.st[0] = nloc; b.st[1] = nx; }
        const unsigned old = xb_add(&bar[XB_XSUB(b.x)], 1u);
        const unsigned gen = old / nloc;
        if (old + 1u == (gen + 1u) * nloc) {
            __builtin_amdgcn_fence(__ATOMIC_RELEASE, "agent");
            asm volatile("s_waitcnt vmcnt(0)" ::: "memory");
            const unsigned og = xb_add(&bar[XB_TOP], 1u);
            const unsigned tg = og / nx;
            if (og + 1u == (tg + 1u) * nx) xb_add(&bar[XB_TOPGEN], 1u);
            else XB_SPIN(xb_ld(&bar[XB_TOPGEN]) == tg, bar);
            __builtin_amdgcn_fence(__ATOMIC_ACQUIRE, "agent");
            xb_add(&bar[XB_XGEN(b.x)], 1u);
            asm volatile("s_waitcnt vmcnt(0)" ::: "memory");
        } else {
            XB_SPIN(xb_ld(&bar[XB_XGEN(b.x)]) == gen, bar);
            __builtin_amdgcn_fence(__ATOMIC_ACQUIRE, "agent");
            asm volatile("s_waitcnt vmcnt(0)" ::: "memory");
        }
    }
    __syncthreads();
}

#define LDS_WAIT() asm volatile("s_waitcnt lgkmcnt(0)" ::: "memory")
__device__ __forceinline__ float wave_sum(float v) {
#pragma unroll
    for (int o = 1; o < 64; o <<= 1) v += __shfl_xor(v, o);
    return v;
}
__device__ __forceinline__ unsigned f2bf(float f) { unsigned u = __builtin_bit_cast(unsigned, f); return (u + 0x7fffu + ((u >> 16) & 1u)) >> 16; }
__device__ __forceinline__ unsigned pk2(float lo, float hi) { return f2bf(lo) | (f2bf(hi) << 16); }

__device__ __forceinline__ int proj_orig_col(int n) {
    const int tile = n >> 8, c = n & 255;
    if (tile < 24) { const int c7 = n & 127, wc = c7 >> 5, fq = (c7 >> 3) & 3, nn = (c7 >> 2) & 1, j = c7 & 3;
        const int dim = (fq == 0) ? (4 * wc + j + 16 * nn) : (32 + wc * 24 + (fq - 1) * 8 + 4 * nn + j); return (n & ~127) + dim; }
    if (tile < 40) return n;
    if (tile < 72) { const int kind = 2 * (c >> 7) + ((c >> 2) & 1), chl = 16 * ((c >> 5) & 3) + 4 * ((c >> 3) & 3) + (c & 3); return 10240 + kind * 2048 + 64 * (tile - 40) + chl; }
    return 18432 + (c >> 7) * 2048 + 128 * (tile - 72) + (c & 127);
}
struct TItem { const float* src; bf16_t* dst; int N; };
__device__ __forceinline__ void t_decode(const float* W, int N, bf16_t* WT, int pitch, bool remap, int item, int lane, TItem& d) {
    const int nblk = N / 32, kb = item / nblk, nb = item % nblk, k0 = 64 * kb, n0 = 32 * nb;
    const int ncol = remap ? proj_orig_col(n0 + (lane & 31)) : n0 + (lane & 31);
    d.src = W + (size_t)(k0 + (lane >> 5)) * N + ncol; d.dst = WT + (size_t)(n0 + (lane >> 3)) * pitch + k0 + 8 * (lane & 7); d.N = N;
}
__device__ __forceinline__ void t_load(const TItem& d, float (&wv)[32]) {
#pragma unroll
    for (int i = 0; i < 32; ++i) wv[i] = d.src[(size_t)(2 * i) * d.N];
}
__device__ __forceinline__ void t_finish(const TItem& d, const float (&wv)[32], int pitch, LAS float* scr, int lane) {
#pragma unroll
    for (int i = 0; i < 32; ++i) scr[(2 * i + (lane >> 5)) * 33 + (lane & 31)] = wv[i];
    LDS_WAIT(); asm volatile("" ::: "memory");
    const int c = lane & 7;
#pragma unroll
    for (int j = 0; j < 4; ++j) { const int n = (lane >> 3) + 8 * j; const LAS float* s = scr + (8 * c) * 33 + n;
        u32x4 o; o.x = pk2(s[0 * 33], s[1 * 33]); o.y = pk2(s[2 * 33], s[3 * 33]); o.z = pk2(s[4 * 33], s[5 * 33]); o.w = pk2(s[6 * 33], s[7 * 33]);
        *(u32x4*)(d.dst + (size_t)(8 * j) * pitch) = o; }
    LDS_WAIT(); asm volatile("" ::: "memory");
}

__device__ __forceinline__ void sincos_f64(float ang, float& s, float& c) {
    const double x = (double)ang;
    const double n = __builtin_rint(x * 0.15915494309189535);
    double r = __builtin_fma(-n, 6.283185307179586, x); r = __builtin_fma(-n, 2.4492935982947064e-16, r);
    const double r2 = r * r;
    double ps = 1.0 / 51090942171709440000.0;
    ps = __builtin_fma(ps, r2, -1.0 / 121645100408832000.0);
    ps = __builtin_fma(ps, r2, 1.0 / 355687428096000.0);
    ps = __builtin_fma(ps, r2, -1.0 / 1307674368000.0);
    ps = __builtin_fma(ps, r2, 1.0 / 6227020800.0);
    ps = __builtin_fma(ps, r2, -1.0 / 39916800.0);
    ps = __builtin_fma(ps, r2, 1.0 / 362880.0);
    ps = __builtin_fma(ps, r2, -1.0 / 5040.0);
    ps = __builtin_fma(ps, r2, 1.0 / 120.0);
    ps = __builtin_fma(ps, r2, -1.0 / 6.0);
    ps = __builtin_fma(ps, r2, 1.0);
    double pc = -1.0 / 1124000727777607680000.0;
    pc = __builtin_fma(pc, r2, 1.0 / 2432902008176640000.0);
    pc = __builtin_fma(pc, r2, -1.0 / 6402373705728000.0);
    pc = __builtin_fma(pc, r2, 1.0 / 20922789888000.0);
    pc = __builtin_fma(pc, r2, -1.0 / 87178291200.0);
    pc = __builtin_fma(pc, r2, 1.0 / 479001600.0);
    pc = __builtin_fma(pc, r2, -1.0 / 3628800.0);
    pc = __builtin_fma(pc, r2, 1.0 / 40320.0);
    pc = __builtin_fma(pc, r2, -1.0 / 720.0);
    pc = __builtin_fma(pc, r2, 1.0 / 24.0);
    pc = __builtin_fma(pc, r2, -0.5);
    pc = __builtin_fma(pc, r2, 1.0);
    s = (float)(r * ps); c = (float)pc;
}

__device__ __forceinline__ unsigned attn_offk(unsigned slot, unsigned row, unsigned ch) { return slot * 32768u + 256u * row + 16u * (ch ^ (row & 15u)); }
__device__ __forceinline__ unsigned attn_offv(unsigned slot, unsigned lrow, unsigned ch) { return 65536u + slot * 32768u + 256u * lrow + 16u * (ch ^ (((lrow & 3u) << 2) | ((lrow >> 2) & 3u))); }
__device__ __forceinline__ unsigned attn_lrow(unsigned k) { return (k & ~31u) | (((k >> 2) & 3u) << 3) | (((k >> 4) & 1u) << 2) | (k & 3u); }

template <bool COMBINE>
__device__ __forceinline__ void attn_chunk(LAS unsigned char* lds, const bf16_t* Qg, const bf16_t* Kg, const bf16_t* Vg, const int dsh, const int hh, const int r, const int n0, const int nblk,
                                           bf16_t* Og, float* LSEg, const bf16_t* O1, const bf16_t* O2, const float* LSE1, const float* LSE2, const bf16_t* SZ, bf16_t* AATT) {
    int tid = threadIdx.x; asm volatile("" : "+v"(tid));
    const int lane = tid & 63, wid = __builtin_amdgcn_readfirstlane(tid >> 6), fr = lane & 15, fq = lane >> 4;
    const int sch = tid & 15, srb = tid >> 4;
    const size_t rowb = (size_t)hh * M + (size_t)r * (M >> dsh);
    u32x4 kreg[4], vreg[4];
#define ATT_LOAD(blk) do { _Pragma("unroll") for (int i = 0; i < 4; ++i) { const size_t off = (rowb + (size_t)(128 * (blk) + srb + 32 * i)) * 256 + sch * 16; \
        kreg[i] = *(const u32x4*)((const char*)Kg + off); vreg[i] = *(const u32x4*)((const char*)Vg + off); } } while (0)
#define ATT_WRITE(slot) do { _Pragma("unroll") for (int i = 0; i < 4; ++i) { const unsigned row = srb + 32 * i; \
        *(LAS u32x4*)(lds + attn_offk((slot), row, sch)) = kreg[i]; *(LAS u32x4*)(lds + attn_offv((slot), attn_lrow(row), sch)) = vreg[i]; } } while (0)
    const unsigned q4 = (unsigned)(lane & 15) >> 2, p4 = (unsigned)lane & 3u, parA = (unsigned)wid & 1u, parB = parA ^ 1u;
    unsigned kbase[4], vbA[8], vbB[8];
#pragma unroll
    for (int s_ = 0; s_ < 4; ++s_) kbase[s_] = 256u * fr + 16u * ((unsigned)(4 * s_ + fq) ^ (unsigned)fr);
#pragma unroll
    for (int c = 0; c < 8; ++c) {
        vbA[c] = 65536u + 256u * (((unsigned)fq << 3) | (parA << 2) | q4) + 16u * ((unsigned)(2 * c + (p4 >> 1)) ^ ((q4 << 2) | (((unsigned)fq & 1u) << 1) | parA)) + 8u * (p4 & 1u);
        vbB[c] = 65536u + 256u * (((unsigned)fq << 3) | (parB << 2) | q4) + 16u * ((unsigned)(2 * c + (p4 >> 1)) ^ ((q4 << 2) | (((unsigned)fq & 1u) << 1) | parB)) + 8u * (p4 & 1u);
    }
    if (n0 > 0) { ATT_LOAD(n0 - 1); }
    else {
#pragma unroll
        for (int i = 0; i < 4; ++i) { kreg[i] = (u32x4){0u, 0u, 0u, 0u}; vreg[i] = (u32x4){0u, 0u, 0u, 0u}; } }
    ATT_WRITE((unsigned)((n0 + 1) & 1));
    ATT_LOAD(n0); ATT_WRITE((unsigned)(n0 & 1));
    __syncthreads();
    for (int n = n0; n < n0 + nblk; ++n) {
        const bool more = (n + 1 < n0 + nblk);
        if (more) ATT_LOAD(n + 1);
        const unsigned cs_ = (unsigned)(n & 1), ps_ = cs_ ^ 1u;
        const int lq = 128 * n + 16 * wid + fr; const size_t pq = ((size_t)lq << dsh) + r;
        bf16x8 qf[4];
        { const bf16x8* qp = (const bf16x8*)((const char*)Qg + (rowb + (size_t)lq) * 256 + fq * 16);
#pragma unroll
          for (int s = 0; s < 4; ++s) qf[s] = qp[4 * s]; }
        f32x4 S[9];
#pragma unroll
        for (int t = 0; t < 9; ++t) {
            S[t] = (f32x4){0.f, 0.f, 0.f, 0.f};
            const unsigned kr0 = 16 * wid + 16 * t, uo = ((kr0 < 128u) ? ps_ : cs_) * 32768u + 256u * (kr0 & 127u);
#pragma unroll
            for (int s = 0; s < 4; ++s) { const bf16x8 kf = *(const LAS bf16x8*)(lds + (kbase[s] + uo)); S[t] = __builtin_amdgcn_mfma_f32_16x16x32_bf16(kf, qf[s], S[t], 0, 0, 0); }
        }
        const float NEG = -1e30f;
#pragma unroll
        for (int j = 0; j < 4; ++j) { const int ko0 = 4 * fq + j; if (ko0 < fr) S[0][j] = NEG; if (ko0 > fr) S[8][j] = NEG; }
        if (n == 0) {
#pragma unroll
            for (int t = 0; t < 9; ++t)
#pragma unroll
                for (int j = 0; j < 4; ++j) { if (16 * wid + 16 * t + 4 * fq + j < 128) S[t][j] = NEG; }
        }
        float mx = NEG;
#pragma unroll
        for (int t = 0; t < 9; ++t) mx = fmaxf(mx, fmaxf(fmaxf(S[t][0], S[t][1]), fmaxf(S[t][2], S[t][3])));
        mx = fmaxf(mx, __shfl_xor(mx, 16)); mx = fmaxf(mx, __shfl_xor(mx, 32));
        float sum = 0.f;
#pragma unroll
        for (int t = 0; t < 9; ++t)
#pragma unroll
            for (int j = 0; j < 4; ++j) { const float p = __builtin_amdgcn_exp2f(S[t][j] - mx); S[t][j] = p; sum += p; }
        sum += __shfl_xor(sum, 16); sum += __shfl_xor(sum, 32);
        u32x2 o1w[8], o2w[8], szw[8]; float l1 = 0.f, l2 = 0.f;
        if (COMBINE) {
            asm volatile("" ::: "memory");
            const size_t eo = pq * 1024 + hh * 128 + 4 * fq;
#pragma unroll
            for (int c = 0; c < 8; ++c) { o1w[c] = *(const u32x2*)(O1 + eo + 16 * c); o2w[c] = *(const u32x2*)(O2 + eo + 16 * c); szw[c] = *(const u32x2*)(SZ + eo + 16 * c); }
            l1 = LSE1[pq * 8 + hh]; l2 = LSE2[pq * 8 + hh];
        }
        f32x4 O[8];
#pragma unroll
        for (int c = 0; c < 8; ++c) O[c] = (f32x4){0.f, 0.f, 0.f, 0.f};
#pragma unroll
        for (int u = 0; u < 5; ++u) {
            u32x4 pw; pw.x = cvt_pk_bf16(S[2 * u][0], S[2 * u][1]); pw.y = cvt_pk_bf16(S[2 * u][2], S[2 * u][3]);
            if (u < 4) { pw.z = cvt_pk_bf16(S[2 * u + 1][0], S[2 * u + 1][1]); pw.w = cvt_pk_bf16(S[2 * u + 1][2], S[2 * u + 1][3]); } else { pw.z = 0u; pw.w = 0u; }
            const bf16x8 pf = __builtin_bit_cast(bf16x8, pw);
            const unsigned kba = 16 * wid + 32 * u, kbb = kba + 16;
            const unsigned uoa = ((kba < 128u) ? ps_ : cs_) * 32768u + 256u * (kba & 96u), uob = ((kbb < 128u) ? ps_ : cs_) * 32768u + 256u * (kbb & 96u);
#pragma unroll
            for (int c = 0; c < 8; ++c) {
                const s16x4 va = __builtin_amdgcn_ds_read_tr16_b64_v4i16((LAS s16x4*)(lds + (vbA[c] + uoa)));
                const s16x4 vb = __builtin_amdgcn_ds_read_tr16_b64_v4i16((LAS s16x4*)(lds + ((u < 4) ? (vbB[c] + uob) : (vbA[c] + uoa))));
                const bf16x8 vf = __builtin_shufflevector(va, vb, 0, 1, 2, 3, 4, 5, 6, 7);
                O[c] = __builtin_amdgcn_mfma_f32_16x16x32_bf16(vf, pf, O[c], 0, 0, 0);
            }
        }
        const float inv = 1.0f / sum;
        if (!COMBINE) {
            bf16_t* op = Og + pq * 1024 + hh * 128 + 4 * fq;
#pragma unroll
            for (int c = 0; c < 8; ++c) { u32x2 w; w.x = cvt_pk_bf16(O[c][0] * inv, O[c][1] * inv); w.y = cvt_pk_bf16(O[c][2] * inv, O[c][3] * inv); *(u32x2*)(op + 16 * c) = w; }
            if (fq == 0) LSEg[pq * 8 + hh] = mx + __builtin_amdgcn_logf(sum);
        } else {
            const float l0 = mx + __builtin_amdgcn_logf(sum), m3 = fmaxf(l0, fmaxf(l1, l2));
            float w0 = __builtin_amdgcn_exp2f(l0 - m3), w1 = __builtin_amdgcn_exp2f(l1 - m3), w2 = __builtin_amdgcn_exp2f(l2 - m3);
            const float iw = 1.0f / (w0 + w1 + w2); w0 *= iw * inv; w1 *= iw; w2 *= iw;
            bf16_t* ap = AATT + pq * 2048 + hh * 128 + 4 * fq;
#pragma unroll
            for (int c = 0; c < 8; ++c) {
                const f32x4 a1 = (f32x4){bf_lo(o1w[c].x), bf_hi(o1w[c].x), bf_lo(o1w[c].y), bf_hi(o1w[c].y)}, a2 = (f32x4){bf_lo(o2w[c].x), bf_hi(o2w[c].x), bf_lo(o2w[c].y), bf_hi(o2w[c].y)};
                const f32x4 zz = (f32x4){silu_f(bf_lo(szw[c].x)), silu_f(bf_hi(szw[c].x)), silu_f(bf_lo(szw[c].y)), silu_f(bf_hi(szw[c].y))};
                const f32x4 res = (O[c] * w0 + a1 * w1 + a2 * w2) * zz;
                u32x2 w; w.x = cvt_pk_bf16(res[0], res[1]); w.y = cvt_pk_bf16(res[2], res[3]); *(u32x2*)(ap + 16 * c) = w;
            }
        }
        __syncthreads();
        if (more) ATT_WRITE(ps_);
        __syncthreads();
    }
#undef ATT_LOAD
#undef ATT_WRITE
}

struct Args { const float* x; const float* c; const int* pos; const float* g_pre; const float* w_ada; const float* b_ada; const float* w_in; const float* conv_w;
              const float* w_attn_o; const float* w_conv_o; const float* w_o; const float* g_post; float* out; unsigned char* ws; int ph_lo, ph_hi, li, pad; };

__global__ void __launch_bounds__(NWAVES * 64, 2) mk_fwd(Args args) {
    extern __shared__ __attribute__((aligned(16))) unsigned char lds_raw[];
    LAS unsigned char* lds = (LAS unsigned char*)lds_raw;
    volatile LAS unsigned* MISC = (volatile LAS unsigned*)(lds + MISC_OFF);
    const int tid = threadIdx.x, lane = tid & 63, wave = __builtin_amdgcn_readfirstlane(tid >> 6);
    const int G = gridDim.x; const int bx = blockIdx.x; const int vcu = (G % 8 == 0) ? (bx % 8) * (G / 8) + bx / 8 : bx;
    unsigned char* ws = args.ws;
    gu32* ctl = (gu32*)(ws + WS_CTL);
    float* mod = (float*)(ws + WS_MOD); float* cs = (float*)(ws + WS_CS);
    bf16_t* WinT = (bf16_t*)(ws + WS_WIN); bf16_t* WaT = (bf16_t*)(ws + WS_WA); bf16_t* WcT = (bf16_t*)(ws + WS_WC); bf16_t* WoT = (bf16_t*)(ws + WS_WO);
    bf16_t* Hb = (bf16_t*)(ws + WS_H); bf16_t* Qb = (bf16_t*)(ws + WS_Q); bf16_t* Kb = (bf16_t*)(ws + WS_K); bf16_t* Vb = (bf16_t*)(ws + WS_V);
    bf16_t* SZ = (bf16_t*)(ws + WS_SZ); float* HPb = (float*)(ws + WS_FX); float* FXQb = HPb + (size_t)64 * 2 * NCV; float* FXUb = FXQb + (size_t)64 * 2 * NCV;
    bf16_t* SGA = (bf16_t*)args.out; bf16_t* SGC = SGA + (size_t)M * D;
    bf16_t* O1 = (bf16_t*)(ws + WS_O1); bf16_t* O2 = (bf16_t*)(ws + WS_O2); float* LSE = (float*)(ws + WS_LSE);
    bf16_t* AATT = (bf16_t*)(ws + WS_AATT); bf16_t* Rb = (bf16_t*)(ws + WS_R); bf16_t* MG = (bf16_t*)(ws + WS_MG);
    bf16_t* Yb = (bf16_t*)(ws + WS_Y);

    for (int u = tid; u < (LDS_BYTES - LDSCTL_OFF) / 4; u += NWAVES * 64) ((LAS unsigned*)(lds + LDSCTL_OFF))[u] = 0u;
    __syncthreads();
    const int bli = (N_LAUNCHES == 1) ? 0 : args.li;
    XcdBarrier bar; bar.bar = (unsigned*)(ctl + CW_BAR) + bli * XCD_BAR_WORDS; bar.x = 0; bar.st = nullptr;
    if (N_LAUNCHES == 1) bar = xcd_barrier_post((unsigned*)(ctl + CW_BAR), MISC + 8);
    const int lo = args.ph_lo, hi = args.ph_hi;
#define IN(k) (lo <= (k) && (k) < hi)
#define BOTH(k) (IN(k) && IN((k) + 1))
#define GRID_BAR() xcd_barrier(bar)
#ifndef PROBE_REPEAT_MASK
#define PROBE_REPEAT_MASK 0
#endif
#ifndef PROBE_REPEAT_N
#define PROBE_REPEAT_N 1
#endif
#define NREP(k) ((((PROBE_REPEAT_MASK) >> (k)) & 1) * (PROBE_REPEAT_N) + 1)
    const int gw = vcu * NWAVES + wave, NGW = G * NWAVES;
    const int gtid = vcu * (NWAVES * 64) + tid, NT = G * NWAVES * 64;

    if (IN(0)) for (int rep = 0; rep < NREP(0); ++rep) {
        {
            LAS float* red = (LAS float*)lds;
            for (int cbk = bx; cbk < 256; cbk += G) {
                const int c4 = tid % 6, rg = tid / 6;
                f32x4 a = (f32x4){0.f, 0.f, 0.f, 0.f};
                if (rg < 85) {
#pragma unroll 6
                    for (int k = rg; k < D; k += 85) { const float cv = args.c[k]; const f32x4 w = *(const f32x4*)(args.w_ada + (size_t)k * NMOD + cbk * 24 + c4 * 4); a += w * cv; }
                    *(LAS f32x4*)(red + (rg * 6 + c4) * 4) = a; }
                __syncthreads();
                if (tid < 24) { float s = 0.f; for (int i = 0; i < 85; ++i) s += red[(i * 6 + (tid >> 2)) * 4 + (tid & 3)];
                    __hip_atomic_store(mod + cbk * 24 + tid, s + args.b_ada[cbk * 24 + tid], __ATOMIC_RELAXED, __HIP_MEMORY_SCOPE_AGENT); }
                asm volatile("s_waitcnt vmcnt(0)" ::: "memory");
                __syncthreads();
                if (tid == 0) __hip_atomic_fetch_add((unsigned*)(ctl + CW_MODCNT), 1u, __ATOMIC_RELAXED, __HIP_MEMORY_SCOPE_AGENT);
            }
        }
        for (int idx = gtid; idx < M * 16; idx += NT) { const int m = idx >> 4, i = idx & 15; const float ang = (float)args.pos[m] * INVF[i]; float s, c; sincos_f64(ang, s, c); cs[m * 32 + i] = c; cs[m * 32 + 16 + i] = s; }
        {
            LAS float* scr = (LAS float*)(lds + wave * 16384);
            constexpr int I_IN = (D / 64) * (PROJ / 32), I_A = (NZA / 64) * (D / 32), I_C = (NCV / 64) * (D / 32), I_O = (D / 64) * (D / 32);
            constexpr int NITEMS = I_IN + I_A + I_C + I_O;
#define T_DECODE(it_, d_) do { int r_ = (it_); \
                if (r_ < I_IN) t_decode(args.w_in, PROJ, WinT, D, true, r_, lane, d_); \
                else if ((r_ -= I_IN) < I_A) t_decode(args.w_attn_o, D, WaT, D, false, r_, lane, d_); \
                else if ((r_ -= I_A) < I_C) t_decode(args.w_conv_o, D, WcT, D, false, r_, lane, d_); \
                else t_decode(args.w_o, D, WoT, D, false, r_ - I_C, lane, d_); } while (0)
            TItem cur_, nxt_; float wa[32], wb[32];
            int it = gw;
            if (it < NITEMS) { T_DECODE(it, cur_); t_load(cur_, wa); }
            while (it < NITEMS) {
                const int nit = it + NGW;
                if (nit < NITEMS) { T_DECODE(nit, nxt_); t_load(nxt_, wb); }
                t_finish(cur_, wa, D, scr, lane);
                cur_ = nxt_;
#pragma unroll
                for (int i = 0; i < 32; ++i) wa[i] = wb[i];
                it = nit;
            }
#undef T_DECODE
        }
        if (tid == 0) {
            unsigned sp = 0;
            while (__hip_atomic_load((unsigned*)(ctl + CW_MODCNT), __ATOMIC_RELAXED, __HIP_MEMORY_SCOPE_AGENT) < 256u * (unsigned)(rep + 1)) { __builtin_amdgcn_s_sleep(2); if (++sp > (1u << 22)) break; }
            __builtin_amdgcn_fence(__ATOMIC_ACQUIRE, "agent");
            asm volatile("s_waitcnt vmcnt(0)" ::: "memory");
        }
        __syncthreads();
        f32x4 av[4][2], bv[4][2];
#pragma unroll
        for (int j = 0; j < 4; ++j)
#pragma unroll
            for (int h = 0; h < 2; ++h) { const int k = 512 * j + 8 * lane + 4 * h; const f32x4 gp = *(const f32x4*)(args.g_pre + k); f32x4 sc, sh;
#pragma unroll
                for (int e = 0; e < 4; ++e) { sc[e] = __hip_atomic_load(mod + D + k + e, __ATOMIC_RELAXED, __HIP_MEMORY_SCOPE_AGENT); sh[e] = __hip_atomic_load(mod + k + e, __ATOMIC_RELAXED, __HIP_MEMORY_SCOPE_AGENT); }
                av[j][h] = gp * (sc + 1.0f); bv[j][h] = sh; }
        for (int m = gw; m < M; m += NGW) {
            const float* xr = args.x + (size_t)m * D + 8 * lane;
            f32x4 v[4][2]; float ss = 0.f;
#pragma unroll
            for (int j = 0; j < 4; ++j)
#pragma unroll
                for (int h = 0; h < 2; ++h) { v[j][h] = *(const f32x4*)(xr + 512 * j + 4 * h); const f32x4 q = v[j][h] * v[j][h]; ss += (q[0] + q[1]) + (q[2] + q[3]); }
            const float rstd = 1.0f / sqrtf(wave_sum(ss) * (1.0f / D) + EPS);
            bf16_t* hr = Hb + (size_t)m * D + 8 * lane;
#pragma unroll
            for (int j = 0; j < 4; ++j) { const f32x4 h0 = v[j][0] * rstd * av[j][0] + bv[j][0], h1 = v[j][1] * rstd * av[j][1] + bv[j][1]; *(u32x4*)(hr + 512 * j) = pg8::pack8(h0, h1); }
        }
        if (BOTH(0) || rep + 1 < NREP(0)) GRID_BAR();
    }
    if (IN(2)) {
        pg8::SegOrder1 S; S.so.init(M, PROJ, G, bx, NREP(2)); S.A = (const char*)Hb; S.B = (const char*)WinT; S.tstep = (size_t)256 * D * 2; S.nt = D / 64;
        pg8::EpiProj E{ws, SGA, args.conv_w, lds + HALO_OFF};
        pg8::gemm_stream<pg8::EpiProj, pg8::SegOrder1>(lds, D, S, E);
        if (BOTH(2)) GRID_BAR();
    }
    if (IN(3)) for (int rep = 0; rep < NREP(3); ++rep) {
        for (int idx = gtid; idx < 63 * 2 * (NCV / 4); idx += NT) {
            const int c4 = idx % (NCV / 4), pj = idx / (NCV / 4), j = pj & 1, pm = 1 + (pj >> 1), ch = 4 * c4;
            const f32x4 h0 = *(const f32x4*)(HPb + ((size_t)((pm - 1) * 2 + 0) * NCV + ch)), h1 = *(const f32x4*)(HPb + ((size_t)((pm - 1) * 2 + 1) * NCV + ch));
            const f32x4 w0 = *(const f32x4*)(args.conv_w + ch), w1 = *(const f32x4*)(args.conv_w + NCV + ch);
            const f32x4 qv = *(const f32x4*)(FXQb + ((size_t)(pm * 2 + j) * NCV + ch)), uu = *(const f32x4*)(FXUb + ((size_t)(pm * 2 + j) * NCV + ch));
            const f32x4 miss = (j == 0) ? (w1 * h1 + w0 * h0) : (w0 * h1);
            const f32x4 rv = qv * (uu + miss);
            u32x2 rw; rw.x = cvt_pk_bf16(rv[0], rv[1]); rw.y = cvt_pk_bf16(rv[2], rv[3]);
            *(u32x2*)(Rb + ((size_t)(256 * pm + j) * NCV + ch)) = rw;
        }
        for (int chunk = vcu; chunk < 256; chunk += G) {
            int g, hh, r, n0;
            if (chunk < 128) { g = 2; hh = chunk >> 4; r = chunk & 15; n0 = 0; } else { const int idx = chunk - 128; g = 1; hh = idx >> 4; r = (idx & 15) >> 2; n0 = (idx & 3) * 8; }
            const size_t go = (size_t)g * M * 1024;
            attn_chunk<false>(lds, Qb + go, Kb + go, Vb + go, 2 * g, hh, r, n0, 8, (g == 1) ? O1 : O2, LSE + (size_t)g * M * 8, nullptr, nullptr, nullptr, nullptr, nullptr, nullptr);
        }
        if (BOTH(3) || rep + 1 < NREP(3)) GRID_BAR();
    }
    if (IN(4)) for (int rep = 0; rep < NREP(4); ++rep) {
        for (int chunk = vcu; chunk < 256; chunk += G)
            attn_chunk<true>(lds, Qb, Kb, Vb, 0, chunk >> 5, 0, (chunk & 31) * 4, 4, nullptr, nullptr, O1, O2, LSE + (size_t)1 * M * 8, LSE + (size_t)2 * M * 8, SZ, AATT);
        if (BOTH(4) || rep + 1 < NREP(4)) GRID_BAR();
    }
    if (IN(5)) {
        pg8::SegOrder2 S; S.so.init(M, D, G, bx, NREP(5)); S.A0 = (const char*)AATT; S.B0 = (const char*)WaT; S.A1 = (const char*)Rb; S.B1 = (const char*)WcT; S.tstep = (size_t)256 * D * 2; S.nt0 = NZA / 64; S.nt1 = NCV / 64;
        pg8::EpiMerge E{MG, SGA, SGC, D};
        pg8::gemm_stream<pg8::EpiMerge, pg8::SegOrder2, true>(lds, D, S, E);
        if (BOTH(5)) GRID_BAR();
    }
    if (IN(6)) {
        pg8::SegOrder1 S; S.so.init(M, D, G, bx, NREP(6)); S.A = (const char*)MG; S.B = (const char*)WoT; S.tstep = (size_t)256 * D * 2; S.nt = D / 64;
        pg8::EpiBf16 E{Yb, D};
        pg8::gemm_stream<pg8::EpiBf16, pg8::SegOrder1>(lds, D, S, E);
        if (BOTH(6)) GRID_BAR();
    }
    if (IN(7)) {
        f32x4 gv[4][2];
#pragma unroll
        for (int j = 0; j < 4; ++j)
#pragma unroll
            for (int h = 0; h < 2; ++h) { const int k = 512 * j + 8 * lane + 4 * h; gv[j][h] = *(const f32x4*)(mod + 2 * D + k) * *(const f32x4*)(args.g_post + k); }
        for (int m = gw; m < M; m += NGW) {
            const bf16_t* yr = Yb + (size_t)m * D + 8 * lane; const float* xr = args.x + (size_t)m * D + 8 * lane; float* orow = args.out + (size_t)m * D + 8 * lane;
            f32x4 v[4][2], xv[4][2]; u32x4 yw[4]; float ss = 0.f;
#pragma unroll
            for (int j = 0; j < 4; ++j) { yw[j] = *(const u32x4*)(yr + 512 * j); xv[j][0] = *(const f32x4*)(xr + 512 * j); xv[j][1] = *(const f32x4*)(xr + 512 * j + 4); }
#pragma unroll
            for (int j = 0; j < 4; ++j) { pg8::unpack8(yw[j], v[j][0], v[j][1]);
#pragma unroll
                for (int h = 0; h < 2; ++h) { const f32x4 q = v[j][h] * v[j][h]; ss += (q[0] + q[1]) + (q[2] + q[3]); } }
            const float rstd = 1.0f / sqrtf(wave_sum(ss) * (1.0f / D) + EPS);
#pragma unroll
            for (int j = 0; j < 4; ++j)
#pragma unroll
                for (int h = 0; h < 2; ++h) *(f32x4*)(orow + 512 * j + 4 * h) = xv[j][h] + gv[j][h] * (v[j][h] * rstd);
        }
    }
#undef IN
#undef BOTH
#undef GRID_BAR
}

extern "C" void kernel_launch(void* const* d_in, const int* in_sizes, int n_in, void* d_out, int out_size, void* d_ws, size_t ws_size, hipStream_t stream) {
    static int grid = 0;
    if (grid == 0) {
        if (n_in != 12 || in_sizes[0] != M * D || out_size != M * D || ws_size < WS_END) { fprintf(stderr, "kernel_launch: unexpected shapes (n_in %d, in0 %d, out %d, ws %zu); nothing launched\n", n_in, n_in > 0 ? in_sizes[0] : -1, out_size, ws_size); grid = -1; return; }
        int dev = 0, cus = 0;
        if (hipGetDevice(&dev) != hipSuccess || hipDeviceGetAttribute(&cus, hipDeviceAttributeMultiprocessorCount, dev) != hipSuccess) { grid = -1; return; }
        if (hipFuncSetAttribute((const void*)mk_fwd, hipFuncAttributeMaxDynamicSharedMemorySize, LDS_BYTES) != hipSuccess) { fprintf(stderr, "kernel_launch: hipFuncSetAttribute failed\n"); grid = -1; return; }
        (void)hipGetLastError();
        grid = cus;
    }
    if (grid < 0) return;
    if (hipMemsetAsync((char*)d_ws + WS_CTL, 0, CTL_ZERO_BYTES, stream) != hipSuccess) return;
    Args a{};
    a.x = (const float*)d_in[0]; a.c = (const float*)d_in[1]; a.pos = (const int*)d_in[2]; a.g_pre = (const float*)d_in[3]; a.w_ada = (const float*)d_in[4]; a.b_ada = (const float*)d_in[5];
    a.w_in = (const float*)d_in[6]; a.conv_w = (const float*)d_in[7]; a.w_attn_o = (const float*)d_in[8]; a.w_conv_o = (const float*)d_in[9]; a.w_o = (const float*)d_in[10]; a.g_post = (const float*)d_in[11];
    a.out = (float*)d_out; a.ws = (unsigned char*)d_ws;
    for (int li = 0; li < N_LAUNCHES; ++li) {
        a.ph_lo = (N_LAUNCHES == 1) ? 0 : li; a.ph_hi = (N_LAUNCHES == 1) ? NPHASES : li + 1; a.li = li;
        hipLaunchKernelGGL(mk_fwd, dim3(grid), dim3(NWAVES * 64), LDS_BYTES, stream, a);
        if (hipPeekAtLastError() != hipSuccess) break;
    }
}
```

```cpp
#include <hip/hip_runtime.h>
#include <cstdio>
#include <cstdint>

#define GAS __attribute__((address_space(1)))
#define LAS __attribute__((address_space(3)))
typedef unsigned short bf16_t;
typedef short bf16x8 __attribute__((ext_vector_type(8)));
typedef short s16x4 __attribute__((ext_vector_type(4)));
typedef float f32x4 __attribute__((ext_vector_type(4)));
typedef float f32x2 __attribute__((ext_vector_type(2)));
typedef unsigned u32x4 __attribute__((ext_vector_type(4)));
typedef unsigned u32x2 __attribute__((ext_vector_type(2)));

constexpr int M = 16384, D = 2048, NQKV = 3072, NZA = 1024, NCV = 2048, PROJ = 22528, NMOD = 6144;
constexpr float EPS = 1e-6f;
constexpr float LOG2E = 1.4426950408889634f;
constexpr float QSCALE = 0.08838834764831845f * 1.4426950408889634f;

__constant__ float INVF[16] = {1.0f, 0.44036659598350525f, 0.1939227432012558f, 0.08539710193872452f, 0.03760603070259094f, 0.016560440883040428f,
    0.007292664609849453f, 0.0032114461064338684f, 0.0014142135623842478f, 0.0006227724370546639f, 0.00027424818836152554f, 0.00012076973507646471f,
    5.3182957344688475e-05f, 2.34199997066753e-05f, 1.0313385246263351e-05f, 4.541670477919979e-06f};

typedef __bf16 bf16x2_t __attribute__((ext_vector_type(2)));
__device__ __forceinline__ unsigned cvt_pk_bf16(float lo, float hi) { const f32x2 v = {lo, hi}; return __builtin_bit_cast(unsigned, __builtin_convertvector(v, bf16x2_t)); }
__device__ __forceinline__ float bf_lo(unsigned w) { return __builtin_bit_cast(float, w << 16); }
__device__ __forceinline__ float bf_hi(unsigned w) { return __builtin_bit_cast(float, w & 0xffff0000u); }
template <int CTRL> __device__ __forceinline__ float dpp_row_shr(float old, float src) { return __int_as_float(__builtin_amdgcn_update_dpp(__float_as_int(old), __float_as_int(src), CTRL, 0xf, 0xf, false)); }
__device__ __forceinline__ float silu_f(float v) { return v * __builtin_amdgcn_rcpf(1.0f + __builtin_amdgcn_exp2f(-v * LOG2E)); }
__device__ __forceinline__ float sigm_f(float v) { return __builtin_amdgcn_rcpf(1.0f + __builtin_amdgcn_exp2f(-v * LOG2E)); }

constexpr size_t MiB = 1u << 20;
constexpr size_t WS_CTL = 0, CTL_ZERO_BYTES = 32768;
constexpr size_t WS_MOD = 1 * MiB;
constexpr size_t WS_CS = 2 * MiB;
constexpr size_t WS_WIN = 4 * MiB;
constexpr size_t WS_WA = 92 * MiB, WS_WC = 100 * MiB, WS_WO = 108 * MiB;
constexpr size_t WS_H = 116 * MiB;
constexpr size_t WS_Q = 180 * MiB, WS_K = 276 * MiB, WS_V = 372 * MiB;
constexpr size_t WS_SZ = 468 * MiB;
constexpr size_t WS_R = 500 * MiB;
constexpr size_t WS_FX = 564 * MiB;
constexpr size_t WS_O2 = 628 * MiB;
constexpr size_t WS_LSE = 660 * MiB;
constexpr size_t WS_END = 662 * MiB;
constexpr size_t WS_O1 = 148 * MiB;
constexpr size_t WS_AATT = WS_K + 32 * MiB, WS_MG = WS_V + 32 * MiB, WS_Y = WS_R;

#ifndef PG8_A_AUX
#define PG8_A_AUX 0
#endif
#ifndef PG8_B_AUX
#define PG8_B_AUX 0
#endif
namespace pg8 {
constexpr int BM = 256, BK = 64, HALF = 128, HTB = HALF * BK * 2, STAGE_BYTES = 8 * HTB, NXCD = 8, WGM = 8;
__host__ __device__ __forceinline__ int lds_byte(int r, int c) { const int st = (r >> 4) * 2 + (c >> 5), rr = r & 15, cc = c & 31, ob = rr * 64 + cc * 2; return st * 1024 + (ob ^ (((ob >> 9) & 1) << 5)); }
__host__ __device__ __forceinline__ void stage_rc(int b, int& R, int& C) { const int st = b / 1024, sb = b % 1024, swz = sb ^ (((sb >> 9) & 1) << 5); R = (st >> 1) * 16 + swz / 64; C = (st & 1) * 32 + (swz % 64) / 2; }
__host__ __device__ __forceinline__ int perm32(int rho) { const int n = rho >> 4, i = rho & 15; return 8 * (i >> 2) + 4 * n + (i & 3); }

struct Unit { int pm, pn; };
struct Gemm { const bf16_t* A; const bf16_t* Bt; int M, N, K; };

struct StaticOrder {
    int nM, nN, nwg, G, c, rounds, rep;
    __host__ __device__ void init(int M_, int N_, int G_, int c_, int rep_ = 1) { nM = M_ / BM; nN = N_ / BM; nwg = nM * nN; G = G_; c = c_; rounds = (nwg + G - 1) / G; rep = rep_; }
    __host__ __device__ bool next(int i, Unit& u) const {
        if (i >= rounds * rep) return false;
        i = i % rounds;
        const long L = (long)i * G + c; if (L >= nwg) return false;
        int wgid = (int)L; { const int q = nwg / NXCD, r = nwg % NXCD, xcd = wgid % NXCD, off = wgid / NXCD; wgid = (xcd < r ? xcd * (q + 1) : r * (q + 1) + (xcd - r) * q) + off; }
        const int nig = WGM * nN, gid = wgid / nig, fm = gid * WGM, gsz = (nM - fm) < WGM ? (nM - fm) : WGM;
        u.pm = fm + ((wgid % nig) % gsz); u.pn = (wgid % nig) / gsz; return true;
    }
    __device__ __forceinline__ void a_ready(const Unit&) const {}
    __device__ __forceinline__ void done(const Unit&) const {}
};


struct Seg { const char* A; const char* B; int nt; int mid; Unit u; };
__device__ __forceinline__ const char* rfl_ptr(const char* p) { const unsigned long long v = (unsigned long long)p; const unsigned lo = __builtin_amdgcn_readfirstlane((unsigned)v), hi = __builtin_amdgcn_readfirstlane((unsigned)(v >> 32)); return (const char*)(((unsigned long long)hi << 32) | lo); }
__device__ __forceinline__ void rfl_seg(Seg& o) { o.A = rfl_ptr(o.A); o.B = rfl_ptr(o.B); o.nt = __builtin_amdgcn_readfirstlane(o.nt); o.mid = __builtin_amdgcn_readfirstlane(o.mid); o.u.pm = __builtin_amdgcn_readfirstlane(o.u.pm); o.u.pn = __builtin_amdgcn_readfirstlane(o.u.pn); }
constexpr int NSTORE = 16;
template <class Epi, class Sched, bool DUAL = false>
__device__ __forceinline__ void gemm_stream(LAS unsigned char* lds, const int pitch, const Sched& S, const Epi& E) {
    const int tid = threadIdx.x, wid = __builtin_amdgcn_readfirstlane(tid >> 6), lane = tid & 63, wr = wid >> 2, wc = wid & 3, fr = lane & 15, fq = lane >> 4;
    unsigned voffA[2], voffB[2];
#pragma unroll
    for (int i = 0; i < 2; ++i) { int R, C; stage_rc(tid * 16 + i * 8192, R, C); const int Rb = Epi::PERM ? ((R & ~31) + perm32(R & 31)) : R;
        voffA[i] = (unsigned)(R * pitch + C) * 2u; voffB[i] = (unsigned)(Rb * pitch + C) * 2u; }
    const size_t kstep = (size_t)(BK * 2);
    const size_t hstep = (size_t)HALF * pitch * 2;
    const unsigned ldsw = (unsigned)wid * 1024u;
    const int aoff = lds_byte(wr * 64 + fr, fq * 8), boff = lds_byte(wc * 32 + fr, fq * 8);
#define PG8_SA(b, h) (((b) * 2 + (h)) * HTB)
#define PG8_SB(b, h) ((4 + (b) * 2 + (h)) * HTB)
#define PG8_STAGE(bufoff, gbase, voff) do { const char* _gb = (const char*)(gbase); asm volatile("" : "+s"(_gb));   \
        _Pragma("unroll") for (int _i = 0; _i < 2; ++_i) \
        __builtin_amdgcn_global_load_lds((const unsigned*)(_gb + (voff)[_i]), (LAS unsigned*)(lds + (bufoff) + ldsw + _i * 8192), 16, 0, PG8_A_AUX); } while (0)
#define PG8_STAGEB(bufoff, gbase, voff) do { const char* _gb = (const char*)(gbase); asm volatile("" : "+s"(_gb)); \
        _Pragma("unroll") for (int _i = 0; _i < 2; ++_i) \
        __builtin_amdgcn_global_load_lds((const unsigned*)(_gb + (voff)[_i]), (LAS unsigned*)(lds + (bufoff) + ldsw + _i * 8192), 16, 0, PG8_B_AUX); } while (0)
#define PG8_LDA(dst, b, h) do { _Pragma("unroll") for (int m = 0; m < 4; ++m) _Pragma("unroll") for (int k = 0; k < 2; ++k) dst[m][k] = *(const LAS bf16x8*)(lds + PG8_SA(b, h) + aoff + m * 2048 + k * 1024); } while (0)
#define PG8_LDB(dst, b, h) do { _Pragma("unroll") for (int n = 0; n < 2; ++n) _Pragma("unroll") for (int k = 0; k < 2; ++k) dst[n][k] = *(const LAS bf16x8*)(lds + PG8_SB(b, h) + boff + n * 2048 + k * 1024); } while (0)
#define PG8_MMA(ai, bj, At, Bt) do { __builtin_amdgcn_s_setprio(1); _Pragma("unroll") for (int m = 0; m < 4; ++m) _Pragma("unroll") for (int n = 0; n < 2; ++n) _Pragma("unroll") for (int k = 0; k < 2; ++k) \
        acc[ai][bj][m][n] = __builtin_amdgcn_mfma_f32_16x16x32_bf16(Bt[n][k], At[m][k], acc[ai][bj][m][n], 0, 0, 0); __builtin_amdgcn_s_setprio(0); } while (0)
#define PG8_WAIT_V(n) asm volatile("s_waitcnt vmcnt(" #n ")" ::: "memory")
#define PG8_WAIT_VR() PG8_WAIT_V(8)
#define PG8_WAIT_L(n) asm volatile("s_waitcnt lgkmcnt(" #n ")" ::: "memory")
#define PG8_BAR __builtin_amdgcn_s_barrier()
#define PG8_SCHED __builtin_amdgcn_sched_barrier(0)
    Seg cur, nxt; int si = 0;
    if (!S.seg(0, cur)) return;
    f32x4 acc[2][2][4][2];
#pragma unroll
    for (int a = 0; a < 2; ++a)
#pragma unroll
        for (int b = 0; b < 2; ++b)
#pragma unroll
            for (int m = 0; m < 4; ++m)
#pragma unroll
                for (int n = 0; n < 2; ++n) acc[a][b][m][n] = (f32x4){0.f, 0.f, 0.f, 0.f};
    bf16x8 At[4][2], B0[2][2], B1[2][2];
    {
        const char* cA = cur.A; const char* cB = cur.B;
        PG8_STAGEB(PG8_SB(0, 0), cB, voffB); PG8_STAGEB(PG8_SB(0, 1), cB + hstep, voffB); PG8_STAGE(PG8_SA(0, 0), cA, voffA); PG8_STAGE(PG8_SA(0, 1), cA + hstep, voffA);
        if (wr == 1) PG8_BAR;
        PG8_WAIT_V(2); PG8_BAR;
        PG8_STAGEB(PG8_SB(1, 0), cB + kstep, voffB); PG8_STAGE(PG8_SA(1, 0), cA + kstep, voffA); PG8_STAGEB(PG8_SB(1, 1), cB + hstep + kstep, voffB);
        PG8_WAIT_V(6); PG8_BAR;
    }
    bool fresh = true, relax = false;
    for (;;) {
        const bool has_next = S.seg(si + 1, nxt);
        const char* cA = cur.A; const char* cB = cur.B; const int nt = cur.nt;
        const char* nA = has_next ? nxt.A : cA; const char* nB = has_next ? nxt.B : cB;
#pragma nounroll
        for (int t = 0; t < nt; t += 2) {
            const bool first = (t == 0) && !fresh;
            const bool last = (t == nt - 2);
            const char* a1 = cA + (size_t)(t + 1) * kstep;
            const char* a2 = last ? nA : cA + (size_t)(t + 2) * kstep; const char* b2 = last ? nB : cB + (size_t)(t + 2) * kstep;
            const char* a3 = a2 + kstep; const char* b3 = b2 + kstep;
            PG8_LDB(B0, 0, 0); PG8_LDB(B1, 0, 1); PG8_SCHED; PG8_LDA(At, 0, 0); if (!first) PG8_STAGE(PG8_SA(1, 1), a1 + hstep, voffA);
            PG8_WAIT_VR(); PG8_WAIT_L(0); PG8_BAR; PG8_MMA(0, 0, At, B0); PG8_MMA(0, 1, At, B1); PG8_BAR; PG8_SCHED;
            PG8_LDA(At, 0, 1); PG8_STAGEB(PG8_SB(0, 0), b2, voffB); PG8_STAGEB(PG8_SB(0, 1), b2 + hstep, voffB); PG8_STAGE(PG8_SA(0, 0), a2, voffA);
            PG8_WAIT_VR(); PG8_WAIT_L(0); PG8_BAR; PG8_MMA(1, 0, At, B0); PG8_MMA(1, 1, At, B1); PG8_BAR; PG8_SCHED;
            PG8_LDB(B0, 1, 0); PG8_LDB(B1, 1, 1); PG8_SCHED; PG8_LDA(At, 1, 0); PG8_STAGE(PG8_SA(0, 1), a2 + hstep, voffA);
            PG8_WAIT_VR(); PG8_WAIT_L(0); PG8_BAR; PG8_MMA(0, 0, At, B0); PG8_MMA(0, 1, At, B1); PG8_BAR; PG8_SCHED;
            PG8_LDA(At, 1, 1); PG8_STAGEB(PG8_SB(1, 0), b3, voffB); PG8_STAGEB(PG8_SB(1, 1), b3 + hstep, voffB); PG8_STAGE(PG8_SA(1, 0), a3, voffA);
            PG8_WAIT_V(8); PG8_WAIT_L(0); PG8_BAR; PG8_MMA(1, 0, At, B0); PG8_MMA(1, 1, At, B1); PG8_BAR; PG8_SCHED;
        }
        if (wr == 0) PG8_BAR;
        PG8_STAGE(PG8_SA(1, 1), nA + kstep + hstep, voffA);
        PG8_SCHED;
        if constexpr (DUAL) E.scale(acc, cur.u, wr, wc, fr, fq, cur.mid != 0);
        if (DUAL && cur.mid) { relax = false; }
        else {
            E(acc, cur.u, wr, wc, fr, fq); relax = true;
#pragma unroll
            for (int a = 0; a < 2; ++a)
#pragma unroll
                for (int b = 0; b < 2; ++b)
#pragma unroll
                    for (int m = 0; m < 4; ++m)
#pragma unroll
                        for (int n = 0; n < 2; ++n) acc[a][b][m][n] = (f32x4){0.f, 0.f, 0.f, 0.f};
        }
        PG8_SCHED;
        if (!has_next) break;
        cur = nxt; ++si; fresh = false;
        if (wr == 1) PG8_BAR;
    }
    PG8_WAIT_V(0);
    PG8_BAR;
#undef PG8_SA
#undef PG8_SB
#undef PG8_STAGE
#undef PG8_STAGEB
#undef PG8_LDA
#undef PG8_LDB
#undef PG8_MMA
#undef PG8_WAIT_V
#undef PG8_WAIT_VR
#undef PG8_WAIT_L
#undef PG8_BAR
#undef PG8_SCHED
}
struct SegOrder1 {
    StaticOrder so; const char* A; const char* B; size_t tstep; int nt;
    __device__ __forceinline__ bool seg(int s, Seg& o) const { Unit u; if (!so.next(s, u)) return false; o.A = A + (size_t)u.pm * tstep; o.B = B + (size_t)u.pn * tstep; o.nt = nt; o.mid = 0; o.u = u; rfl_seg(o); return true; }
};

__device__ __forceinline__ u32x4 pack8(const f32x4 v0, const f32x4 v1) { u32x4 w; w.x = cvt_pk_bf16(v0[0], v0[1]); w.y = cvt_pk_bf16(v0[2], v0[3]); w.z = cvt_pk_bf16(v1[0], v1[1]); w.w = cvt_pk_bf16(v1[2], v1[3]); return w; }
__device__ __forceinline__ void unpack8(const u32x4 w, f32x4& v0, f32x4& v1) { v0 = (f32x4){bf_lo(w.x), bf_hi(w.x), bf_lo(w.y), bf_hi(w.y)}; v1 = (f32x4){bf_lo(w.z), bf_hi(w.z), bf_lo(w.w), bf_hi(w.w)}; }

#ifdef NT_STORES
#define ST16(p, v) __builtin_nontemporal_store((v), (u32x4*)(p))
#define ST8(p, v) __builtin_nontemporal_store((v), (u32x2*)(p))
#else
#define ST16(p, v) (*(u32x4*)(p) = (v))
#define ST8(p, v) (*(u32x2*)(p) = (v))
#endif
struct EpiProj {
    static constexpr bool PERM = true;
    __device__ __forceinline__ void mid(f32x4 (&)[2][2][4][2], const Unit&, int, int, int, int) const {}
    unsigned char* ws; bf16_t* SGA; const float* cw; LAS unsigned char* halo;
    __device__ __forceinline__ void operator()(const f32x4 (&acc)[2][2][4][2], const Unit& u, int wr, int wc, int fr, int fq) const {
        int pn = u.pn, upm = u.pm; asm volatile("" : "+s"(pn), "+s"(upm));
        const int row0 = upm * BM + wr * 64 + fr; const int lc = wc * 32 + 8 * fq;
        bf16_t* const Q = (bf16_t*)(ws + WS_Q); bf16_t* const Kb = (bf16_t*)(ws + WS_K); bf16_t* const V = (bf16_t*)(ws + WS_V); bf16_t* const SZ = (bf16_t*)(ws + WS_SZ); bf16_t* const R = (bf16_t*)(ws + WS_R);
        bf16_t* const SGC = SGA + (size_t)M * D; const float* const cs = (const float*)(ws + WS_CS);
        float* const HP = (float*)(ws + WS_FX); float* const FXQ = HP + (size_t)64 * 2 * NCV; float* const FXU = FXQ + (size_t)64 * 2 * NCV;
        if (pn < 24) {
            const bool isq = pn < 12; const int tq = isq ? pn : pn - 12; bf16_t* base = (isq ? Q : Kb) + (size_t)(tq >> 2) * M * 1024; const int colt = (tq & 3) * BM; const float sc = isq ? QSCALE : 1.0f;
            const bool rot = (fq == 0);
            f32x4 cv[2][4], sv[2][4];
#pragma unroll
            for (int ai = 0; ai < 2; ++ai)
#pragma unroll
                for (int m = 0; m < 4; ++m) { const float* cr = cs + (size_t)(row0 + ai * HALF + m * 16) * 32 + 4 * wc; cv[ai][m] = *(const f32x4*)cr; sv[ai][m] = *(const f32x4*)(cr + 16); }
#pragma unroll
            for (int ai = 0; ai < 2; ++ai)
#pragma unroll
                for (int m = 0; m < 4; ++m) {
                    const f32x4 c = rot ? cv[ai][m] * sc : (f32x4){sc, sc, sc, sc}, sn = rot ? sv[ai][m] * sc : (f32x4){0.f, 0.f, 0.f, 0.f};
                    bf16_t* rowp = base + (size_t)(row0 + ai * HALF + m * 16) * 1024 + colt + lc;
#pragma unroll
                    for (int bj = 0; bj < 2; ++bj) { const f32x4 v0 = acc[ai][bj][m][0], v1 = acc[ai][bj][m][1];
                        ST16((rowp + bj * HALF), (pack8(v0 * c - v1 * sn, v0 * sn + v1 * c))); }
                }
        } else if (pn < 36) {
            const int tv = pn - 24, colt = (tv & 3) * BM; bf16_t* vbase = V + (size_t)(tv >> 2) * M * 1024;
#pragma unroll
            for (int ai = 0; ai < 2; ++ai)
#pragma unroll
                for (int m = 0; m < 4; ++m) { bf16_t* rowp = vbase + (size_t)(row0 + ai * HALF + m * 16) * 1024 + colt + lc;
#pragma unroll
                    for (int bj = 0; bj < 2; ++bj) ST16((rowp + bj * HALF), (pack8(acc[ai][bj][m][0], acc[ai][bj][m][1]))); }
        } else if (pn < 40) {
            const int colt = (pn - 36) * BM;
#pragma unroll
            for (int ai = 0; ai < 2; ++ai)
#pragma unroll
                for (int m = 0; m < 4; ++m) { bf16_t* rowp = SZ + (size_t)(row0 + ai * HALF + m * 16) * NZA + colt + lc;
#pragma unroll
                    for (int bj = 0; bj < 2; ++bj) ST16((rowp + bj * HALF), (pack8(acc[ai][bj][m][0], acc[ai][bj][m][1]))); }
        } else if (pn < 72) {
            int chl = 16 * wc + 4 * fq, frh = fr - 14; asm volatile("" : "+v"(chl), "+v"(frh));
            const int ct = pn - 40, chb = 64 * ct + chl, pm = upm;
            const f32x4 w0 = *(const f32x4*)(cw + chb), w1 = *(const f32x4*)(cw + NCV + chb), w2 = *(const f32x4*)(cw + 2 * NCV + chb);
#pragma unroll
            for (int ai = 0; ai < 2; ++ai)
#pragma unroll
                for (int m = 0; m < 4; ++m) { const f32x4 pv = acc[ai][0][m][1] * acc[ai][1][m][0];
                    const int gi = 8 * ai + 4 * wr + m;
                    if (fr >= 14) { *(LAS f32x4*)(halo + (size_t)(((gi * 2 + frh) * 64 + chl) * 4)) = pv;
                        if (gi == 15) *(f32x4*)(HP + ((size_t)(pm * 2 + frh) * NCV + chb)) = pv; } }
            asm volatile("s_waitcnt lgkmcnt(0)" ::: "memory"); __builtin_amdgcn_s_barrier(); asm volatile("" ::: "memory");
#pragma unroll
            for (int ai = 0; ai < 2; ++ai)
#pragma unroll
                for (int m = 0; m < 4; ++m) {
                    const int gi = 8 * ai + 4 * wr + m; const int gp = gi > 0 ? gi - 1 : 0;
                    f32x4 H0 = *(const LAS f32x4*)(halo + (size_t)(((gp * 2 + 0) * 64 + chl) * 4)), H1 = *(const LAS f32x4*)(halo + (size_t)(((gp * 2 + 1) * 64 + chl) * 4));
                    if (gi == 0) { H0 = (f32x4){0.f, 0.f, 0.f, 0.f}; H1 = H0; }
                    const f32x4 Hs = (fr == 1) ? H1 : H0, pvv = acc[ai][0][m][1] * acc[ai][1][m][0];
                    f32x4 Pm1, Pm2, qv;
#pragma unroll
                    for (int j = 0; j < 4; ++j) {
                        const float pj = pvv[j], h1j = H1[j], hsj = Hs[j];
                        Pm1[j] = dpp_row_shr<0x111>(h1j, pj); Pm2[j] = dpp_row_shr<0x112>(hsj, pj);
                        qv[j] = acc[ai][0][m][0][j] * silu_f(acc[ai][1][m][1][j]); }
                    const f32x4 uu = w2 * pvv + w1 * Pm1 + w0 * Pm2, rv = qv * uu;
                    const size_t ro = (size_t)(row0 + ai * HALF + m * 16) * NCV + chb;
                    u32x2 rw; rw.x = cvt_pk_bf16(rv[0], rv[1]); rw.y = cvt_pk_bf16(rv[2], rv[3]);
                    ST8((R + ro), (rw));
                    if (gi == 0 && fr < 2 && pm > 0) { *(f32x4*)(FXQ + ((size_t)(pm * 2 + fr) * NCV + chb)) = qv; *(f32x4*)(FXU + ((size_t)(pm * 2 + fr) * NCV + chb)) = uu; }
                }
        } else {
            const int colt = (pn - 72) * HALF;
#pragma unroll
            for (int ai = 0; ai < 2; ++ai)
#pragma unroll
                for (int m = 0; m < 4; ++m) { const size_t ro = (size_t)(row0 + ai * HALF + m * 16) * D + colt + lc;
                    f32x4 r[2], c[2];
#pragma unroll
                    for (int n = 0; n < 2; ++n)
#pragma unroll
                        for (int j = 0; j < 4; ++j) { const float pc = 1.0f + __builtin_amdgcn_exp2f(-acc[ai][1][m][n][j] * LOG2E), pa = 1.0f + __builtin_amdgcn_exp2f(-acc[ai][0][m][n][j] * LOG2E);
                            const float t = __builtin_amdgcn_rcpf(pa * pc); c[n][j] = pa * t; r[n][j] = pc * pc * t; }
                    ST16((SGA + ro), (pack8(r[0], r[1]))); ST16((SGC + ro), (pack8(c[0], c[1]))); }
        }
    }
};
struct EpiMerge {
    static constexpr bool PERM = true;
    bf16_t* O; const bf16_t* RHO; const bf16_t* SC; int ldc;
    __device__ __forceinline__ size_t lane_off(const Unit& u, int wr, int wc, int fr, int fq, int ai) const {
        size_t o = (size_t)(u.pm * BM + wr * 64 + fr + ai * HALF) * ldc + u.pn * BM + wc * 32 + 8 * fq; asm volatile("" : "+v"(o)); return o; }
    __device__ __forceinline__ void scale(f32x4 (&acc)[2][2][4][2], const Unit& u, int wr, int wc, int fr, int fq, bool is_mid) const {
        const bf16_t* G = is_mid ? RHO : SC;
#pragma unroll
        for (int ai = 0; ai < 2; ++ai) {
            const bf16_t* p = G + lane_off(u, wr, wc, fr, fq, ai);
            u32x4 gw[4][2];
#pragma unroll
            for (int m = 0; m < 4; ++m)
#pragma unroll
                for (int bj = 0; bj < 2; ++bj) gw[m][bj] = *(const u32x4*)(p + (size_t)m * 16 * ldc + bj * HALF);
#pragma unroll
            for (int m = 0; m < 4; ++m)
#pragma unroll
                for (int bj = 0; bj < 2; ++bj) { f32x4 g0, g1; unpack8(gw[m][bj], g0, g1); acc[ai][bj][m][0] *= g0; acc[ai][bj][m][1] *= g1; }
        }
    }
    __device__ __forceinline__ void mid(f32x4 (&)[2][2][4][2], const Unit&, int, int, int, int) const {}
    __device__ __forceinline__ void operator()(const f32x4 (&acc)[2][2][4][2], const Unit& u, int wr, int wc, int fr, int fq) const {
#pragma unroll
        for (int ai = 0; ai < 2; ++ai) {
            bf16_t* q = O + lane_off(u, wr, wc, fr, fq, ai);
#pragma unroll
            for (int m = 0; m < 4; ++m)
#pragma unroll
                for (int bj = 0; bj < 2; ++bj) *(u32x4*)(q + (size_t)m * 16 * ldc + bj * HALF) = pack8(acc[ai][bj][m][0], acc[ai][bj][m][1]);
        }
    }
};
struct EpiBf16 {
    static constexpr bool PERM = true;
    __device__ __forceinline__ void mid(f32x4 (&)[2][2][4][2], const Unit&, int, int, int, int) const {}
    bf16_t* O; int ldc;
    __device__ __forceinline__ void operator()(const f32x4 (&acc)[2][2][4][2], const Unit& u, int wr, int wc, int fr, int fq) const {
        const int row0 = u.pm * BM + wr * 64 + fr, col0 = u.pn * BM + wc * 32 + 8 * fq;
#pragma unroll
        for (int ai = 0; ai < 2; ++ai)
#pragma unroll
            for (int m = 0; m < 4; ++m) { bf16_t* rowp = O + (size_t)(row0 + ai * HALF + m * 16) * ldc + col0;
#pragma unroll
                for (int bj = 0; bj < 2; ++bj) *(u32x4*)(rowp + bj * HALF) = pack8(acc[ai][bj][m][0], acc[ai][bj][m][1]); }
    }
};
struct SegOrder2 {
    StaticOrder so; const char *A0, *B0, *A1, *B1; size_t tstep; int nt0, nt1;
    __device__ __forceinline__ bool seg(int s_, Seg& o) const { Unit u; if (!so.next(s_ >> 1, u)) return false; const int h = s_ & 1;
        o.A = (h ? A1 : A0) + (size_t)u.pm * tstep; o.B = (h ? B1 : B0) + (size_t)u.pn * tstep; o.nt = h ? nt1 : nt0; o.mid = !h; o.u = u; rfl_seg(o); return true; }
};
}

#ifndef PG8_SP2
#define PG8_SP2 true
#endif
#ifndef PG8_ALIGN
#define PG8_ALIGN true
#endif

constexpr int NWAVES = 8;
#ifndef MK_N_LAUNCHES
#define MK_N_LAUNCHES 1
#endif
constexpr int NPHASES = 8;
constexpr int N_LAUNCHES = MK_N_LAUNCHES;

constexpr int CW_BAR = 4096, CW_MODCNT = 8000;
#define XCD_BAR_WORDS 3456

constexpr int RING_BYTES = 131072;
constexpr int LDSCTL_OFF = RING_BYTES, MISC_OFF = LDSCTL_OFF + 320, HALO_OFF = RING_BYTES + 1024;
constexpr int LDS_BYTES = 147456;

typedef GAS unsigned gu32;
#define RLX_AGENT __ATOMIC_RELAXED, __HIP_MEMORY_SCOPE_AGENT

#define XB_TMO      128
#define XB_XCNT(j)  (256  + 64 * (j))
#define XB_XSUB(j)  (1280 + 64 * (j))
#define XB_XGEN(j)  (2304 + 64 * (j))
#define XB_TOP      3328
#define XB_TOPGEN   3392
#define XB_SPIN_CAP (1u << 18)

__device__ __forceinline__ unsigned xb_ld(unsigned* p)              { return __hip_atomic_load(p, __ATOMIC_RELAXED, __HIP_MEMORY_SCOPE_AGENT); }
__device__ __forceinline__ unsigned xb_add(unsigned* p, unsigned v) { return __hip_atomic_fetch_add(p, v, __ATOMIC_RELAXED, __HIP_MEMORY_SCOPE_AGENT); }
__device__ __forceinline__ unsigned xb_xcc_id() { return (unsigned)__builtin_amdgcn_s_getreg((3 << 11) | 20) & 0xFu; }
#define XB_SPIN(cond, bar) do { unsigned _sp = 0; while (cond) { __builtin_amdgcn_s_sleep(1); \
    if ((++_sp & 255u) == 0u) { if (xb_ld(&(bar)[XB_TMO])) break; if (_sp > XB_SPIN_CAP) { atomicAdd(&(bar)[XB_TMO], 1u); break; } } } } while (0)

struct XcdBarrier { unsigned* bar; unsigned x; volatile LAS unsigned* st; };

__device__ __forceinline__ XcdBarrier xcd_barrier_post(unsigned* bar, volatile LAS unsigned* st) {
    XcdBarrier b; b.bar = bar; b.x = xb_xcc_id(); b.st = st;
    if (threadIdx.x == 0) (void)xb_add(&bar[XB_XCNT(b.x)], 1u);
    return b;
}
__device__ __forceinline__ void xcd_barrier_complete(unsigned* bar, unsigned x, unsigned& nloc, unsigned& nx) {
    const unsigned G = gridDim.x * gridDim.y * gridDim.z;
    unsigned sum, cnt, mine, sp = 0u;
    for (;;) {
        sum = 0u; cnt = 0u; mine = 0u;
#pragma unroll
        for (unsigned j = 0; j < 16; ++j) { const unsigned c = xb_ld(&bar[XB_XCNT(j)]); sum += c; cnt += (c > 0u) ? 1u : 0u; mine = (j == x) ? c : mine; }
        if (sum == G) break;
        __builtin_amdgcn_s_sleep(1);
        if ((++sp & 255u) == 0u) { if (xb_ld(&bar[XB_TMO])) break; if (sp > XB_SPIN_CAP) { atomicAdd(&bar[XB_TMO], 1u); break; } }
    }
    nloc = mine > 0u ? mine : 1u; nx = cnt > 0u ? cnt : 1u;
}
__device__ __forceinline__ void xcd_barrier(const XcdBarrier& b) {
    asm volatile("s_waitcnt vmcnt(0)" ::: "memory");
    __syncthreads();
    if (threadIdx.x == 0) {
        unsigned* bar = b.bar;
        __builtin_amdgcn_s_waitcnt(0);
        unsigned nloc = b.st[0], nx = b.st[1];
        if (nloc == 0u) { xcd_barrier_complete(bar, b.x, nloc, nx); b.st[0] = nloc; b.st[1] = nx; }
        const unsigned old = xb_add(&bar[XB_XSUB(b.x)], 1u);
        const unsigned gen = old / nloc;
        if (old + 1u == (gen + 1u) * nloc) {
            __builtin_amdgcn_fence(__ATOMIC_RELEASE, "agent");
            asm volatile("s_waitcnt vmcnt(0)" ::: "memory");
            const unsigned og = xb_add(&bar[XB_TOP], 1u);
            const unsigned tg = og / nx;
            if (og + 1u == (tg + 1u) * nx) xb_add(&bar[XB_TOPGEN], 1u);
            else XB_SPIN(xb_ld(&bar[XB_TOPGEN]) == tg, bar);
            __builtin_amdgcn_fence(__ATOMIC_ACQUIRE, "agent");
            xb_add(&bar[XB_XGEN(b.x)], 1u);
            asm volatile("s_waitcnt vmcnt(0)" ::: "memory");
        } else {
            XB_SPIN(xb_ld(&bar[XB_XGEN(b.x)]) == gen, bar);
            __builtin_amdgcn_fence(__ATOMIC_ACQUIRE, "agent");
            asm volatile("s_waitcnt vmcnt(0)" ::: "memory");
        }
    }
    __syncthreads();
}

#define LDS_WAIT() asm volatile("s_waitcnt lgkmcnt(0)" ::: "memory")
__device__ __forceinline__ float wave_sum(float v) {
#pragma unroll
    for (int o = 1; o < 64; o <<= 1) v += __shfl_xor(v, o);
    return v;
}
__device__ __forceinline__ unsigned f2bf(float f) { unsigned u = __builtin_bit_cast(unsigned, f); return (u + 0x7fffu + ((u >> 16) & 1u)) >> 16; }
__device__ __forceinline__ unsigned pk2(float lo, float hi) { return f2bf(lo) | (f2bf(hi) << 16); }

__device__ __forceinline__ int proj_orig_col(int n) {
    const int tile = n >> 8, c = n & 255;
    if (tile < 24) { const int c7 = n & 127, wc = c7 >> 5, fq = (c7 >> 3) & 3, nn = (c7 >> 2) & 1, j = c7 & 3;
        const int dim = (fq == 0) ? (4 * wc + j + 16 * nn) : (32 + wc * 24 + (fq - 1) * 8 + 4 * nn + j); return (n & ~127) + dim; }
    if (tile < 40) return n;
    if (tile < 72) { const int kind = 2 * (c >> 7) + ((c >> 2) & 1), chl = 16 * ((c >> 5) & 3) + 4 * ((c >> 3) & 3) + (c & 3); return 10240 + kind * 2048 + 64 * (tile - 40) + chl; }
    return 18432 + (c >> 7) * 2048 + 128 * (tile - 72) + (c & 127);
}
struct TItem { const float* src; bf16_t* dst; int N; };
__device__ __forceinline__ void t_decode(const float* W, int N, bf16_t* WT, int pitch, bool remap, int item, int lane, TItem& d) {
    const int nblk = N / 32, kb = item / nblk, nb = item % nblk, k0 = 64 * kb, n0 = 32 * nb;
    const int ncol = remap ? proj_orig_col(n0 + (lane & 31)) : n0 + (lane & 31);
    d.src = W + (size_t)(k0 + (lane >> 5)) * N + ncol; d.dst = WT + (size_t)(n0 + (lane >> 3)) * pitch + k0 + 8 * (lane & 7); d.N = N;
}
__device__ __forceinline__ void t_load(const TItem& d, float (&wv)[32]) {
#pragma unroll
    for (int i = 0; i < 32; ++i) wv[i] = d.src[(size_t)(2 * i) * d.N];
}
__device__ __forceinline__ void t_finish(const TItem& d, const float (&wv)[32], int pitch, LAS float* scr, int lane) {
#pragma unroll
    for (int i = 0; i < 32; ++i) scr[(2 * i + (lane >> 5)) * 33 + (lane & 31)] = wv[i];
    LDS_WAIT(); asm volatile("" ::: "memory");
    const int c = lane & 7;
#pragma unroll
    for (int j = 0; j < 4; ++j) { const int n = (lane >> 3) + 8 * j; const LAS float* s = scr + (8 * c) * 33 + n;
        u32x4 o; o.x = pk2(s[0 * 33], s[1 * 33]); o.y = pk2(s[2 * 33], s[3 * 33]); o.z = pk2(s[4 * 33], s[5 * 33]); o.w = pk2(s[6 * 33], s[7 * 33]);
        *(u32x4*)(d.dst + (size_t)(8 * j) * pitch) = o; }
    LDS_WAIT(); asm volatile("" ::: "memory");
}

__device__ __forceinline__ void sincos_f64(float ang, float& s, float& c) {
    const double x = (double)ang;
    const double n = __builtin_rint(x * 0.15915494309189535);
    double r = __builtin_fma(-n, 6.283185307179586, x); r = __builtin_fma(-n, 2.4492935982947064e-16, r);
    const double r2 = r * r;
    double ps = 1.0 / 51090942171709440000.0;
    ps = __builtin_fma(ps, r2, -1.0 / 121645100408832000.0);
    ps = __builtin_fma(ps, r2, 1.0 / 355687428096000.0);
    ps = __builtin_fma(ps, r2, -1.0 / 1307674368000.0);
    ps = __builtin_fma(ps, r2, 1.0 / 6227020800.0);
    ps = __builtin_fma(ps, r2, -1.0 / 39916800.0);
    ps = __builtin_fma(ps, r2, 1.0 / 362880.0);
    ps = __builtin_fma(ps, r2, -1.0 / 5040.0);
    ps = __builtin_fma(ps, r2, 1.0 / 120.0);
    ps = __builtin_fma(ps, r2, -1.0 / 6.0);
    ps = __builtin_fma(ps, r2, 1.0);
    double pc = -1.0 / 1124000727777607680000.0;
    pc = __builtin_fma(pc, r2, 1.0 / 2432902008176640000.0);
    pc = __builtin_fma(pc, r2, -1.0 / 6402373705728000.0);
    pc = __builtin_fma(pc, r2, 1.0 / 20922789888000.0);
    pc = __builtin_fma(pc, r2, -1.0 / 87178291200.0);
    pc = __builtin_fma(pc, r2, 1.0 / 479001600.0);
    pc = __builtin_fma(pc, r2, -1.0 / 3628800.0);
    pc = __builtin_fma(pc, r2, 1.0 / 40320.0);
    pc = __builtin_fma(pc, r2, -1.0 / 720.0);
    pc = __builtin_fma(pc, r2, 1.0 / 24.0);
    pc = __builtin_fma(pc, r2, -0.5);
    pc = __builtin_fma(pc, r2, 1.0);
    s = (float)(r * ps); c = (float)pc;
}

__device__ __forceinline__ unsigned attn_offk(unsigned slot, unsigned row, unsigned ch) { return slot * 32768u + 256u * row + 16u * (ch ^ (row & 15u)); }
__device__ __forceinline__ unsigned attn_offv(unsigned slot, unsigned lrow, unsigned ch) { return 65536u + slot * 32768u + 256u * lrow + 16u * (ch ^ (((lrow & 3u) << 2) | ((lrow >> 2) & 3u))); }
__device__ __forceinline__ unsigned attn_lrow(unsigned k) { return (k & ~31u) | (((k >> 2) & 3u) << 3) | (((k >> 4) & 1u) << 2) | (k & 3u); }

template <bool COMBINE>
__device__ __forceinline__ void attn_chunk(LAS unsigned char* lds, const bf16_t* Qg, const bf16_t* Kg, const bf16_t* Vg, const int dsh, const int hh, const int r, const int n0, const int nblk,
                                           bf16_t* Og, float* LSEg, const bf16_t* O1, const bf16_t* O2, const float* LSE1, const float* LSE2, const bf16_t* SZ, bf16_t* AATT) {
    int tid = threadIdx.x; asm volatile("" : "+v"(tid));
    const int lane = tid & 63, wid = __builtin_amdgcn_readfirstlane(tid >> 6), fr = lane & 15, fq = lane >> 4;
    const int sch = tid & 15, srb = tid >> 4;
    const size_t scol = (size_t)hh * 256 + sch * 16;
    u32x4 kreg[4], vreg[4];
#define ATT_LOAD(blk) do { _Pragma("unroll") for (int i = 0; i < 4; ++i) { const size_t p = ((size_t)(128 * (blk) + srb + 32 * i) << dsh) + r; const size_t off = p * 2048 + scol; \
        kreg[i] = *(const u32x4*)((const char*)Kg + off); vreg[i] = *(const u32x4*)((const char*)Vg + off); } } while (0)
#define ATT_WRITE(slot) do { _Pragma("unroll") for (int i = 0; i < 4; ++i) { const unsigned row = srb + 32 * i; \
        *(LAS u32x4*)(lds + attn_offk((slot), row, sch)) = kreg[i]; *(LAS u32x4*)(lds + attn_offv((slot), attn_lrow(row), sch)) = vreg[i]; } } while (0)
    const unsigned q4 = (unsigned)(lane & 15) >> 2, p4 = (unsigned)lane & 3u, parA = (unsigned)wid & 1u, parB = parA ^ 1u;
    unsigned kbase[4], vbA[8], vbB[8];
#pragma unroll
    for (int s_ = 0; s_ < 4; ++s_) kbase[s_] = 256u * fr + 16u * ((unsigned)(4 * s_ + fq) ^ (unsigned)fr);
#pragma unroll
    for (int c = 0; c < 8; ++c) {
        vbA[c] = 65536u + 256u * (((unsigned)fq << 3) | (parA << 2) | q4) + 16u * ((unsigned)(2 * c + (p4 >> 1)) ^ ((q4 << 2) | (((unsigned)fq & 1u) << 1) | parA)) + 8u * (p4 & 1u);
        vbB[c] = 65536u + 256u * (((unsigned)fq << 3) | (parB << 2) | q4) + 16u * ((unsigned)(2 * c + (p4 >> 1)) ^ ((q4 << 2) | (((unsigned)fq & 1u) << 1) | parB)) + 8u * (p4 & 1u);
    }
    if (n0 > 0) { ATT_LOAD(n0 - 1); }
    else {
#pragma unroll
        for (int i = 0; i < 4; ++i) { kreg[i] = (u32x4){0u, 0u, 0u, 0u}; vreg[i] = (u32x4){0u, 0u, 0u, 0u}; } }
    ATT_WRITE((unsigned)((n0 + 1) & 1));
    ATT_LOAD(n0); ATT_WRITE((unsigned)(n0 & 1));
    __syncthreads();
    for (int n = n0; n < n0 + nblk; ++n) {
        const bool more = (n + 1 < n0 + nblk);
        if (more) ATT_LOAD(n + 1);
        const unsigned cs_ = (unsigned)(n & 1), ps_ = cs_ ^ 1u;
        const int lq = 128 * n + 16 * wid + fr; const size_t pq = ((size_t)lq << dsh) + r;
        bf16x8 qf[4];
        { const bf16x8* qp = (const bf16x8*)((const char*)Qg + pq * 2048 + (size_t)hh * 256 + fq * 16);
#pragma unroll
          for (int s = 0; s < 4; ++s) qf[s] = qp[4 * s]; }
        f32x4 S[9];
#pragma unroll
        for (int t = 0; t < 9; ++t) {
            S[t] = (f32x4){0.f, 0.f, 0.f, 0.f};
            const unsigned kr0 = 16 * wid + 16 * t, uo = ((kr0 < 128u) ? ps_ : cs_) * 32768u + 256u * (kr0 & 127u);
#pragma unroll
            for (int s = 0; s < 4; ++s) { const bf16x8 kf = *(const LAS bf16x8*)(lds + (kbase[s] + uo)); S[t] = __builtin_amdgcn_mfma_f32_16x16x32_bf16(kf, qf[s], S[t], 0, 0, 0); }
        }
        const float NEG = -1e30f;
#pragma unroll
        for (int j = 0; j < 4; ++j) { const int ko0 = 4 * fq + j; if (ko0 < fr) S[0][j] = NEG; if (ko0 > fr) S[8][j] = NEG; }
        if (n == 0) {
#pragma unroll
            for (int t = 0; t < 9; ++t)
#pragma unroll
                for (int j = 0; j < 4; ++j) { if (16 * wid + 16 * t + 4 * fq + j < 128) S[t][j] = NEG; }
        }
        float mx = NEG;
#pragma unroll
        for (int t = 0; t < 9; ++t) mx = fmaxf(mx, fmaxf(fmaxf(S[t][0], S[t][1]), fmaxf(S[t][2], S[t][3])));
        mx = fmaxf(mx, __shfl_xor(mx, 16)); mx = fmaxf(mx, __shfl_xor(mx, 32));
        float sum = 0.f;
#pragma unroll
        for (int t = 0; t < 9; ++t)
#pragma unroll
            for (int j = 0; j < 4; ++j) { const float p = __builtin_amdgcn_exp2f(S[t][j] - mx); S[t][j] = p; sum += p; }
        sum += __shfl_xor(sum, 16); sum += __shfl_xor(sum, 32);
        u32x2 o1w[8], o2w[8], szw[8]; float l1 = 0.f, l2 = 0.f;
        if (COMBINE) {
            asm volatile("" ::: "memory");
            const size_t eo = pq * 1024 + hh * 128 + 4 * fq;
#pragma unroll
            for (int c = 0; c < 8; ++c) { o1w[c] = *(const u32x2*)(O1 + eo + 16 * c); o2w[c] = *(const u32x2*)(O2 + eo + 16 * c); szw[c] = *(const u32x2*)(SZ + eo + 16 * c); }
            l1 = LSE1[pq * 8 + hh]; l2 = LSE2[pq * 8 + hh];
        }
        f32x4 O[8];
#pragma unroll
        for (int c = 0; c < 8; ++c) O[c] = (f32x4){0.f, 0.f, 0.f, 0.f};
#pragma unroll
        for (int u = 0; u < 5; ++u) {
            u32x4 pw; pw.x = cvt_pk_bf16(S[2 * u][0], S[2 * u][1]); pw.y = cvt_pk_bf16(S[2 * u][2], S[2 * u][3]);
            if (u < 4) { pw.z = cvt_pk_bf16(S[2 * u + 1][0], S[2 * u + 1][1]); pw.w = cvt_pk_bf16(S[2 * u + 1][2], S[2 * u + 1][3]); } else { pw.z = 0u; pw.w = 0u; }
            const bf16x8 pf = __builtin_bit_cast(bf16x8, pw);
            const unsigned kba = 16 * wid + 32 * u, kbb = kba + 16;
            const unsigned uoa = ((kba < 128u) ? ps_ : cs_) * 32768u + 256u * (kba & 96u), uob = ((kbb < 128u) ? ps_ : cs_) * 32768u + 256u * (kbb & 96u);
#pragma unroll
            for (int c = 0; c < 8; ++c) {
                const s16x4 va = __builtin_amdgcn_ds_read_tr16_b64_v4i16((LAS s16x4*)(lds + (vbA[c] + uoa)));
                const s16x4 vb = __builtin_amdgcn_ds_read_tr16_b64_v4i16((LAS s16x4*)(lds + ((u < 4) ? (vbB[c] + uob) : (vbA[c] + uoa))));
                const bf16x8 vf = __builtin_shufflevector(va, vb, 0, 1, 2, 3, 4, 5, 6, 7);
                O[c] = __builtin_amdgcn_mfma_f32_16x16x32_bf16(vf, pf, O[c], 0, 0, 0);
            }
        }
        const float inv = 1.0f / sum;
        if (!COMBINE) {
            bf16_t* op = Og + pq * 1024 + hh * 128 + 4 * fq;
#pragma unroll
            for (int c = 0; c < 8; ++c) { u32x2 w; w.x = cvt_pk_bf16(O[c][0] * inv, O[c][1] * inv); w.y = cvt_pk_bf16(O[c][2] * inv, O[c][3] * inv); *(u32x2*)(op + 16 * c) = w; }
            if (fq == 0) LSEg[pq * 8 + hh] = mx + __builtin_amdgcn_logf(sum);
        } else {
            const float l0 = mx + __builtin_amdgcn_logf(sum), m3 = fmaxf(l0, fmaxf(l1, l2));
            float w0 = __builtin_amdgcn_exp2f(l0 - m3), w1 = __builtin_amdgcn_exp2f(l1 - m3), w2 = __builtin_amdgcn_exp2f(l2 - m3);
            const float iw = 1.0f / (w0 + w1 + w2); w0 *= iw * inv; w1 *= iw; w2 *= iw;
            bf16_t* ap = AATT + pq * 2048 + hh * 128 + 4 * fq;
#pragma unroll
            for (int c = 0; c < 8; ++c) {
                const f32x4 a1 = (f32x4){bf_lo(o1w[c].x), bf_hi(o1w[c].x), bf_lo(o1w[c].y), bf_hi(o1w[c].y)}, a2 = (f32x4){bf_lo(o2w[c].x), bf_hi(o2w[c].x), bf_lo(o2w[c].y), bf_hi(o2w[c].y)};
                const f32x4 zz = (f32x4){silu_f(bf_lo(szw[c].x)), silu_f(bf_hi(szw[c].x)), silu_f(bf_lo(szw[c].y)), silu_f(bf_hi(szw[c].y))};
                const f32x4 res = (O[c] * w0 + a1 * w1 + a2 * w2) * zz;
                u32x2 w; w.x = cvt_pk_bf16(res[0], res[1]); w.y = cvt_pk_bf16(res[2], res[3]); *(u32x2*)(ap + 16 * c) = w;
            }
        }
        __syncthreads();
        if (more) ATT_WRITE(ps_);
        __syncthreads();
    }
#undef ATT_LOAD
#undef ATT_WRITE
}

struct Args { const float* x; const float* c; const int* pos; const float* g_pre; const float* w_ada; const float* b_ada; const float* w_in; const float* conv_w;
              const float* w_attn_o; const float* w_conv_o; const float* w_o; const float* g_post; float* out; unsigned char* ws; int ph_lo, ph_hi, li, pad; };

__global__ void __launch_bounds__(NWAVES * 64, 2) mk_fwd(Args args) {
    extern __shared__ __attribute__((aligned(16))) unsigned char lds_raw[];
    LAS unsigned char* lds = (LAS unsigned char*)lds_raw;
    volatile LAS unsigned* MISC = (volatile LAS unsigned*)(lds + MISC_OFF);
    const int tid = threadIdx.x, lane = tid & 63, wave = __builtin_amdgcn_readfirstlane(tid >> 6);
    const int G = gridDim.x; const int bx = blockIdx.x; const int vcu = (G % 8 == 0) ? (bx % 8) * (G / 8) + bx / 8 : bx;
    unsigned char* ws = args.ws;
    gu32* ctl = (gu32*)(ws + WS_CTL);
    float* mod = (float*)(ws + WS_MOD); float* cs = (float*)(ws + WS_CS);
    bf16_t* WinT = (bf16_t*)(ws + WS_WIN); bf16_t* WaT = (bf16_t*)(ws + WS_WA); bf16_t* WcT = (bf16_t*)(ws + WS_WC); bf16_t* WoT = (bf16_t*)(ws + WS_WO);
    bf16_t* Hb = (bf16_t*)(ws + WS_H); bf16_t* Qb = (bf16_t*)(ws + WS_Q); bf16_t* Kb = (bf16_t*)(ws + WS_K); bf16_t* Vb = (bf16_t*)(ws + WS_V);
    bf16_t* SZ = (bf16_t*)(ws + WS_SZ); float* HPb = (float*)(ws + WS_FX); float* FXQb = HPb + (size_t)64 * 2 * NCV; float* FXUb = FXQb + (size_t)64 * 2 * NCV;
    bf16_t* SGA = (bf16_t*)args.out; bf16_t* SGC = SGA + (size_t)M * D;
    bf16_t* O1 = (bf16_t*)(ws + WS_O1); bf16_t* O2 = (bf16_t*)(ws + WS_O2); float* LSE = (float*)(ws + WS_LSE);
    bf16_t* AATT = (bf16_t*)(ws + WS_AATT); bf16_t* Rb = (bf16_t*)(ws + WS_R); bf16_t* MG = (bf16_t*)(ws + WS_MG);
    bf16_t* Yb = (bf16_t*)(ws + WS_Y);

    for (int u = tid; u < (LDS_BYTES - LDSCTL_OFF) / 4; u += NWAVES * 64) ((LAS unsigned*)(lds + LDSCTL_OFF))[u] = 0u;
    __syncthreads();
    const int bli = (N_LAUNCHES == 1) ? 0 : args.li;
    XcdBarrier bar; bar.bar = (unsigned*)(ctl + CW_BAR) + bli * XCD_BAR_WORDS; bar.x = 0; bar.st = nullptr;
    if (N_LAUNCHES == 1) bar = xcd_barrier_post((unsigned*)(ctl + CW_BAR), MISC + 8);
    const int lo = args.ph_lo, hi = args.ph_hi;
#define IN(k) (lo <= (k) && (k) < hi)
#define BOTH(k) (IN(k) && IN((k) + 1))
#define GRID_BAR() xcd_barrier(bar)
#ifndef PROBE_REPEAT_MASK
#define PROBE_REPEAT_MASK 0
#endif
#ifndef PROBE_REPEAT_N
#define PROBE_REPEAT_N 1
#endif
#define NREP(k) ((((PROBE_REPEAT_MASK) >> (k)) & 1) * (PROBE_REPEAT_N) + 1)
    const int gw = vcu * NWAVES + wave, NGW = G * NWAVES;
    const int gtid = vcu * (NWAVES * 64) + tid, NT = G * NWAVES * 64;

    if (IN(0)) for (int rep = 0; rep < NREP(0); ++rep) {
        {
            LAS float* red = (LAS float*)lds;
            for (int cbk = bx; cbk < 256; cbk += G) {
                const int c4 = tid % 6, rg = tid / 6;
                f32x4 a = (f32x4){0.f, 0.f, 0.f, 0.f};
                if (rg < 85) {
#pragma unroll 6
                    for (int k = rg; k < D; k += 85) { const float cv = args.c[k]; const f32x4 w = *(const f32x4*)(args.w_ada + (size_t)k * NMOD + cbk * 24 + c4 * 4); a += w * cv; }
                    *(LAS f32x4*)(red + (rg * 6 + c4) * 4) = a; }
                __syncthreads();
                if (tid < 24) { float s = 0.f; for (int i = 0; i < 85; ++i) s += red[(i * 6 + (tid >> 2)) * 4 + (tid & 3)];
                    __hip_atomic_store(mod + cbk * 24 + tid, s + args.b_ada[cbk * 24 + tid], __ATOMIC_RELAXED, __HIP_MEMORY_SCOPE_AGENT); }
                asm volatile("s_waitcnt vmcnt(0)" ::: "memory");
                __syncthreads();
                if (tid == 0) __hip_atomic_fetch_add((unsigned*)(ctl + CW_MODCNT), 1u, __ATOMIC_RELAXED, __HIP_MEMORY_SCOPE_AGENT);
            }
        }
        for (int idx = gtid; idx < M * 16; idx += NT) { const int m = idx >> 4, i = idx & 15; const float ang = (float)args.pos[m] * INVF[i]; float s, c; sincos_f64(ang, s, c); cs[m * 32 + i] = c; cs[m * 32 + 16 + i] = s; }
        {
            LAS float* scr = (LAS float*)(lds + wave * 16384);
            constexpr int I_IN = (D / 64) * (PROJ / 32), I_A = (NZA / 64) * (D / 32), I_C = (NCV / 64) * (D / 32), I_O = (D / 64) * (D / 32);
            constexpr int NITEMS = I_IN + I_A + I_C + I_O;
#define T_DECODE(it_, d_) do { int r_ = (it_); \
                if (r_ < I_IN) t_decode(args.w_in, PROJ, WinT, D, true, r_, lane, d_); \
                else if ((r_ -= I_IN) < I_A) t_decode(args.w_attn_o, D, WaT, D, false, r_, lane, d_); \
                else if ((r_ -= I_A) < I_C) t_decode(args.w_conv_o, D, WcT, D, false, r_, lane, d_); \
                else t_decode(args.w_o, D, WoT, D, false, r_ - I_C, lane, d_); } while (0)
            TItem cur_, nxt_; float wa[32], wb[32];
            int it = gw;
            if (it < NITEMS) { T_DECODE(it, cur_); t_load(cur_, wa); }
            while (it < NITEMS) {
                const int nit = it + NGW;
                if (nit < NITEMS) { T_DECODE(nit, nxt_); t_load(nxt_, wb); }
                t_finish(cur_, wa, D, scr, lane);
                cur_ = nxt_;
#pragma unroll
                for (int i = 0; i < 32; ++i) wa[i] = wb[i];
                it = nit;
            }
#undef T_DECODE
        }
        if (tid == 0) {
            unsigned sp = 0;
            while (__hip_atomic_load((unsigned*)(ctl + CW_MODCNT), __ATOMIC_RELAXED, __HIP_MEMORY_SCOPE_AGENT) < 256u * (unsigned)(rep + 1)) { __builtin_amdgcn_s_sleep(2); if (++sp > (1u << 22)) break; }
            __builtin_amdgcn_fence(__ATOMIC_ACQUIRE, "agent");
            asm volatile("s_waitcnt vmcnt(0)" ::: "memory");
        }
        __syncthreads();
        f32x4 av[4][2], bv[4][2];
#pragma unroll
        for (int j = 0; j < 4; ++j)
#pragma unroll
            for (int h = 0; h < 2; ++h) { const int k = 512 * j + 8 * lane + 4 * h; const f32x4 gp = *(const f32x4*)(args.g_pre + k); f32x4 sc, sh;
#pragma unroll
                for (int e = 0; e < 4; ++e) { sc[e] = __hip_atomic_load(mod + D + k + e, __ATOMIC_RELAXED, __HIP_MEMORY_SCOPE_AGENT); sh[e] = __hip_atomic_load(mod + k + e, __ATOMIC_RELAXED, __HIP_MEMORY_SCOPE_AGENT); }
                av[j][h] = gp * (sc + 1.0f); bv[j][h] = sh; }
        for (int m = gw; m < M; m += NGW) {
            const float* xr = args.x + (size_t)m * D + 8 * lane;
            f32x4 v[4][2]; float ss = 0.f;
#pragma unroll
            for (int j = 0; j < 4; ++j)
#pragma unroll
                for (int h = 0; h < 2; ++h) { v[j][h] = *(const f32x4*)(xr + 512 * j + 4 * h); const f32x4 q = v[j][h] * v[j][h]; ss += (q[0] + q[1]) + (q[2] + q[3]); }
            const float rstd = 1.0f / sqrtf(wave_sum(ss) * (1.0f / D) + EPS);
            bf16_t* hr = Hb + (size_t)m * D + 8 * lane;
#pragma unroll
            for (int j = 0; j < 4; ++j) { const f32x4 h0 = v[j][0] * rstd * av[j][0] + bv[j][0], h1 = v[j][1] * rstd * av[j][1] + bv[j][1]; *(u32x4*)(hr + 512 * j) = pg8::pack8(h0, h1); }
        }
        if (BOTH(0) || rep + 1 < NREP(0)) GRID_BAR();
    }
    if (IN(2)) {
        pg8::SegOrder1 S; S.so.init(M, PROJ, G, bx, NREP(2)); S.A = (const char*)Hb; S.B = (const char*)WinT; S.tstep = (size_t)256 * D * 2; S.nt = D / 64;
        pg8::EpiProj E{ws, SGA, args.conv_w, lds + HALO_OFF};
        pg8::gemm_stream<pg8::EpiProj, pg8::SegOrder1>(lds, D, S, E);
        if (BOTH(2)) GRID_BAR();
    }
    if (IN(3)) for (int rep = 0; rep < NREP(3); ++rep) {
        for (int idx = gtid; idx < 63 * 2 * (NCV / 4); idx += NT) {
            const int c4 = idx % (NCV / 4), pj = idx / (NCV / 4), j = pj & 1, pm = 1 + (pj >> 1), ch = 4 * c4;
            const f32x4 h0 = *(const f32x4*)(HPb + ((size_t)((pm - 1) * 2 + 0) * NCV + ch)), h1 = *(const f32x4*)(HPb + ((size_t)((pm - 1) * 2 + 1) * NCV + ch));
            const f32x4 w0 = *(const f32x4*)(args.conv_w + ch), w1 = *(const f32x4*)(args.conv_w + NCV + ch);
            const f32x4 qv = *(const f32x4*)(FXQb + ((size_t)(pm * 2 + j) * NCV + ch)), uu = *(const f32x4*)(FXUb + ((size_t)(pm * 2 + j) * NCV + ch));
            const f32x4 miss = (j == 0) ? (w1 * h1 + w0 * h0) : (w0 * h1);
            const f32x4 rv = qv * (uu + miss);
            u32x2 rw; rw.x = cvt_pk_bf16(rv[0], rv[1]); rw.y = cvt_pk_bf16(rv[2], rv[3]);
            *(u32x2*)(Rb + ((size_t)(256 * pm + j) * NCV + ch)) = rw;
        }
        for (int chunk = vcu; chunk < 256; chunk += G) {
            int g, hh, r, n0;
            if (chunk < 128) { g = 2; hh = chunk >> 4; r = chunk & 15; n0 = 0; } else { const int idx = chunk - 128; g = 1; hh = idx >> 4; r = (idx & 15) >> 2; n0 = (idx & 3) * 8; }
            const size_t go = (size_t)g * M * 1024;
            attn_chunk<false>(lds, Qb + go, Kb + go, Vb + go, 2 * g, hh, r, n0, 8, (g == 1) ? O1 : O2, LSE + (size_t)g * M * 8, nullptr, nullptr, nullptr, nullptr, nullptr, nullptr);
        }
        if (BOTH(3) || rep + 1 < NREP(3)) GRID_BAR();
    }
    if (IN(4)) for (int rep = 0; rep < NREP(4); ++rep) {
        for (int chunk = vcu; chunk < 256; chunk += G)
            attn_chunk<true>(lds, Qb, Kb, Vb, 0, chunk >> 5, 0, (chunk & 31) * 4, 4, nullptr, nullptr, O1, O2, LSE + (size_t)1 * M * 8, LSE + (size_t)2 * M * 8, SZ, AATT);
        if (BOTH(4) || rep + 1 < NREP(4)) GRID_BAR();
    }
    if (IN(5)) {
        pg8::SegOrder2 S; S.so.init(M, D, G, bx, NREP(5)); S.A0 = (const char*)AATT; S.B0 = (const char*)WaT; S.A1 = (const char*)Rb; S.B1 = (const char*)WcT; S.tstep = (size_t)256 * D * 2; S.nt0 = NZA / 64; S.nt1 = NCV / 64;
        pg8::EpiMerge E{MG, SGA, SGC, D};
        pg8::gemm_stream<pg8::EpiMerge, pg8::SegOrder2, true>(lds, D, S, E);
        if (BOTH(5)) GRID_BAR();
    }
    if (IN(6)) {
        pg8::SegOrder1 S; S.so.init(M, D, G, bx, NREP(6)); S.A = (const char*)MG; S.B = (const char*)WoT; S.tstep = (size_t)256 * D * 2; S.nt = D / 64;
        pg8::EpiBf16 E{Yb, D};
        pg8::gemm_stream<pg8::EpiBf16, pg8::SegOrder1>(lds, D, S, E);
        if (BOTH(6)) GRID_BAR();
    }
    if (IN(7)) {
        f32x4 gv[4][2];
#pragma unroll
        for (int j = 0; j < 4; ++j)
#pragma unroll
            for (int h = 0; h < 2; ++h) { const int k = 512 * j + 8 * lane + 4 * h; gv[j][h] = *(const f32x4*)(mod + 2 * D + k) * *(const f32x4*)(args.g_post + k); }
        for (int m = gw; m < M; m += NGW) {
            const bf16_t* yr = Yb + (size_t)m * D + 8 * lane; const float* xr = args.x + (size_t)m * D + 8 * lane; float* orow = args.out + (size_t)m * D + 8 * lane;
            f32x4 v[4][2], xv[4][2]; u32x4 yw[4]; float ss = 0.f;
#pragma unroll
            for (int j = 0; j < 4; ++j) { yw[j] = *(const u32x4*)(yr + 512 * j); xv[j][0] = *(const f32x4*)(xr + 512 * j); xv[j][1] = *(const f32x4*)(xr + 512 * j + 4); }
#pragma unroll
            for (int j = 0; j < 4; ++j) { pg8::unpack8(yw[j], v[j][0], v[j][1]);
#pragma unroll
                for (int h = 0; h < 2; ++h) { const f32x4 q = v[j][h] * v[j][h]; ss += (q[0] + q[1]) + (q[2] + q[3]); } }
            const float rstd = 1.0f / sqrtf(wave_sum(ss) * (1.0f / D) + EPS);
#pragma unroll
            for (int j = 0; j < 4; ++j)
#pragma unroll
                for (int h = 0; h < 2; ++h) *(f32x4*)(orow + 512 * j + 4 * h) = xv[j][h] + gv[j][h] * (v[j][h] * rstd);
        }
    }
#undef IN
#undef BOTH
#undef GRID_BAR
}

extern "C" void kernel_launch(void* const* d_in, const int* in_sizes, int n_in, void* d_out, int out_size, void* d_ws, size_t ws_size, hipStream_t stream) {
    static int grid = 0;
    if (grid == 0) {
        if (n_in != 12 || in_sizes[0] != M * D || out_size != M * D || ws_size < WS_END) { fprintf(stderr, "kernel_launch: unexpected shapes (n_in %d, in0 %d, out %d, ws %zu); nothing launched\n", n_in, n_in > 0 ? in_sizes[0] : -1, out_size, ws_size); grid = -1; return; }
        int dev = 0, cus = 0;
        if (hipGetDevice(&dev) != hipSuccess || hipDeviceGetAttribute(&cus, hipDeviceAttributeMultiprocessorCount, dev) != hipSuccess) { grid = -1; return; }
        if (hipFuncSetAttribute((const void*)mk_fwd, hipFuncAttributeMaxDynamicSharedMemorySize, LDS_BYTES) != hipSuccess) { fprintf(stderr, "kernel_launch: hipFuncSetAttribute failed\n"); grid = -1; return; }
        (void)hipGetLastError();
        grid = cus;
    }
    if (grid < 0) return;
    if (hipMemsetAsync((char*)d_ws + WS_CTL, 0, CTL_ZERO_BYTES, stream) != hipSuccess) return;
    Args a{};
    a.x = (const float*)d_in[0]; a.c = (const float*)d_in[1]; a.pos = (const int*)d_in[2]; a.g_pre = (const float*)d_in[3]; a.w_ada = (const float*)d_in[4]; a.b_ada = (const float*)d_in[5];
    a.w_in = (const float*)d_in[6]; a.conv_w = (const float*)d_in[7]; a.w_attn_o = (const float*)d_in[8]; a.w_conv_o = (const float*)d_in[9]; a.w_o = (const float*)d_in[10]; a.g_post = (const float*)d_in[11];
    a.out = (float*)d_out; a.ws = (unsigned char*)d_ws;
    for (int li = 0; li < N_LAUNCHES; ++li) {
        a.ph_lo = (N_LAUNCHES == 1) ? 0 : li; a.ph_hi = (N_LAUNCHES == 1) ? NPHASES : li + 1; a.li = li;
        hipLaunchKernelGGL(mk_fwd, dim3(grid), dim3(NWAVES * 64), LDS_BYTES, stream, a);
        if (hipPeekAtLastError() != hipSuccess) break;
    }
}
```

```cpp
#include <hip/hip_runtime.h>
#include <cstdio>
#include <cstdint>

#define GAS __attribute__((address_space(1)))
#define LAS __attribute__((address_space(3)))
typedef unsigned short bf16_t;
typedef short bf16x8 __attribute__((ext_vector_type(8)));
typedef short s16x4 __attribute__((ext_vector_type(4)));
typedef float f32x4 __attribute__((ext_vector_type(4)));
typedef float f32x2 __attribute__((ext_vector_type(2)));
typedef unsigned u32x4 __attribute__((ext_vector_type(4)));
typedef unsigned u32x2 __attribute__((ext_vector_type(2)));

constexpr int M = 16384, D = 2048, NQKV = 3072, NZA = 1024, NCV = 2048, PROJ = 22528, NMOD = 6144;
constexpr float EPS = 1e-6f;
constexpr float LOG2E = 1.4426950408889634f;
constexpr float QSCALE = 0.08838834764831845f * 1.4426950408889634f;

__constant__ float INVF[16] = {1.0f, 0.44036659598350525f, 0.1939227432012558f, 0.08539710193872452f, 0.03760603070259094f, 0.016560440883040428f,
    0.007292664609849453f, 0.0032114461064338684f, 0.0014142135623842478f, 0.0006227724370546639f, 0.00027424818836152554f, 0.00012076973507646471f,
    5.3182957344688475e-05f, 2.34199997066753e-05f, 1.0313385246263351e-05f, 4.541670477919979e-06f};

typedef __bf16 bf16x2_t __attribute__((ext_vector_type(2)));
__device__ __forceinline__ unsigned cvt_pk_bf16(float lo, float hi) { const f32x2 v = {lo, hi}; return __builtin_bit_cast(unsigned, __builtin_convertvector(v, bf16x2_t)); }
__device__ __forceinline__ float bf_lo(unsigned w) { return __builtin_bit_cast(float, w << 16); }
__device__ __forceinline__ float bf_hi(unsigned w) { return __builtin_bit_cast(float, w & 0xffff0000u); }
template <int CTRL> __device__ __forceinline__ float dpp_row_shr(float old, float src) { return __int_as_float(__builtin_amdgcn_update_dpp(__float_as_int(old), __float_as_int(src), CTRL, 0xf, 0xf, false)); }
__device__ __forceinline__ float silu_f(float v) { return v * __builtin_amdgcn_rcpf(1.0f + __builtin_amdgcn_exp2f(-v * LOG2E)); }
__device__ __forceinline__ float sigm_f(float v) { return __builtin_amdgcn_rcpf(1.0f + __builtin_amdgcn_exp2f(-v * LOG2E)); }

constexpr size_t MiB = 1u << 20;
constexpr size_t WS_CTL = 0, CTL_ZERO_BYTES = 32768;
constexpr size_t WS_MOD = 1 * MiB;
constexpr size_t WS_CS = 2 * MiB;
constexpr size_t WS_WIN = 4 * MiB;
constexpr size_t WS_WA = 92 * MiB, WS_WC = 100 * MiB, WS_WO = 108 * MiB;
constexpr size_t WS_H = 116 * MiB;
constexpr size_t WS_Q = 180 * MiB, WS_K = 276 * MiB, WS_V = 372 * MiB;
constexpr size_t WS_SZ = 468 * MiB;
constexpr size_t WS_R = 500 * MiB;
constexpr size_t WS_FX = 564 * MiB;
constexpr size_t WS_O2 = 628 * MiB;
constexpr size_t WS_LSE = 660 * MiB;
constexpr size_t WS_END = 662 * MiB;
constexpr size_t WS_O1 = 148 * MiB;
constexpr size_t WS_AATT = WS_K + 32 * MiB, WS_MG = WS_V + 32 * MiB, WS_Y = WS_R;

#ifndef PG8_A_AUX
#define PG8_A_AUX 0
#endif
#ifndef PG8_B_AUX
#define PG8_B_AUX 0
#endif
namespace pg8 {
constexpr int BM = 256, BK = 64, HALF = 128, HTB = HALF * BK * 2, STAGE_BYTES = 8 * HTB, NXCD = 8, WGM = 8;
__host__ __device__ __forceinline__ int lds_byte(int r, int c) { const int st = (r >> 4) * 2 + (c >> 5), rr = r & 15, cc = c & 31, ob = rr * 64 + cc * 2; return st * 1024 + (ob ^ (((ob >> 9) & 1) << 5)); }
__host__ __device__ __forceinline__ void stage_rc(int b, int& R, int& C) { const int st = b / 1024, sb = b % 1024, swz = sb ^ (((sb >> 9) & 1) << 5); R = (st >> 1) * 16 + swz / 64; C = (st & 1) * 32 + (swz % 64) / 2; }
__host__ __device__ __forceinline__ int perm32(int rho) { const int n = rho >> 4, i = rho & 15; return 8 * (i >> 2) + 4 * n + (i & 3); }

struct Unit { int pm, pn; };
struct Gemm { const bf16_t* A; const bf16_t* Bt; int M, N, K; };

struct StaticOrder {
    int nM, nN, nwg, G, c, rounds, rep;
    __host__ __device__ void init(int M_, int N_, int G_, int c_, int rep_ = 1) { nM = M_ / BM; nN = N_ / BM; nwg = nM * nN; G = G_; c = c_; rounds = (nwg + G - 1) / G; rep = rep_; }
    __host__ __device__ bool next(int i, Unit& u) const {
        if (i >= rounds * rep) return false;
        i = i % rounds;
        const long L = (long)i * G + c; if (L >= nwg) return false;
        int wgid = (int)L; { const int q = nwg / NXCD, r = nwg % NXCD, xcd = wgid % NXCD, off = wgid / NXCD; wgid = (xcd < r ? xcd * (q + 1) : r * (q + 1) + (xcd - r) * q) + off; }
        const int nig = WGM * nN, gid = wgid / nig, fm = gid * WGM, gsz = (nM - fm) < WGM ? (nM - fm) : WGM;
        u.pm = fm + ((wgid % nig) % gsz); u.pn = (wgid % nig) / gsz; return true;
    }
    __device__ __forceinline__ void a_ready(const Unit&) const {}
    __device__ __forceinline__ void done(const Unit&) const {}
};


struct Seg { const char* A; const char* B; int nt; int mid; Unit u; };
__device__ __forceinline__ const char* rfl_ptr(const char* p) { const unsigned long long v = (unsigned long long)p; const unsigned lo = __builtin_amdgcn_readfirstlane((unsigned)v), hi = __builtin_amdgcn_readfirstlane((unsigned)(v >> 32)); return (const char*)(((unsigned long long)hi << 32) | lo); }
__device__ __forceinline__ void rfl_seg(Seg& o) { o.A = rfl_ptr(o.A); o.B = rfl_ptr(o.B); o.nt = __builtin_amdgcn_readfirstlane(o.nt); o.mid = __builtin_amdgcn_readfirstlane(o.mid); o.u.pm = __builtin_amdgcn_readfirstlane(o.u.pm); o.u.pn = __builtin_amdgcn_readfirstlane(o.u.pn); }
constexpr int NSTORE = 16;
template <class Epi, class Sched, bool DUAL = false>
__device__ __forceinline__ void gemm_stream(LAS unsigned char* lds, const int pitch, const Sched& S, const Epi& E) {
    const int tid = threadIdx.x, wid = __builtin_amdgcn_readfirstlane(tid >> 6), lane = tid & 63, wr = wid >> 2, wc = wid & 3, fr = lane & 15, fq = lane >> 4;
    unsigned voffA[2], voffB[2];
#pragma unroll
    for (int i = 0; i < 2; ++i) { int R, C; stage_rc(tid * 16 + i * 8192, R, C); const int Rb = Epi::PERM ? ((R & ~31) + perm32(R & 31)) : R;
        voffA[i] = (unsigned)(R * pitch + C) * 2u; voffB[i] = (unsigned)(Rb * pitch + C) * 2u; }
    const size_t kstep = (size_t)(BK * 2);
    const size_t hstep = (size_t)HALF * pitch * 2;
    const unsigned ldsw = (unsigned)wid * 1024u;
    const int aoff = lds_byte(wr * 64 + fr, fq * 8), boff = lds_byte(wc * 32 + fr, fq * 8);
#define PG8_SA(b, h) (((b) * 2 + (h)) * HTB)
#define PG8_SB(b, h) ((4 + (b) * 2 + (h)) * HTB)
#define PG8_STAGE(bufoff, gbase, voff) do { const char* _gb = (const char*)(gbase); asm volatile("" : "+s"(_gb));   \
        _Pragma("unroll") for (int _i = 0; _i < 2; ++_i) { asm volatile("" : "+v"((voff)[_i]));   \
        __builtin_amdgcn_global_load_lds((const unsigned*)(_gb + (voff)[_i]), (LAS unsigned*)(lds + (bufoff) + ldsw + _i * 8192), 16, 0, PG8_A_AUX); } } while (0)
#define PG8_STAGEB(bufoff, gbase, voff) do { const char* _gb = (const char*)(gbase); asm volatile("" : "+s"(_gb)); \
        _Pragma("unroll") for (int _i = 0; _i < 2; ++_i) { asm volatile("" : "+v"((voff)[_i])); \
        __builtin_amdgcn_global_load_lds((const unsigned*)(_gb + (voff)[_i]), (LAS unsigned*)(lds + (bufoff) + ldsw + _i * 8192), 16, 0, PG8_B_AUX); } } while (0)
#define PG8_LDA(dst, b, h) do { _Pragma("unroll") for (int m = 0; m < 4; ++m) _Pragma("unroll") for (int k = 0; k < 2; ++k) dst[m][k] = *(const LAS bf16x8*)(lds + PG8_SA(b, h) + aoff + m * 2048 + k * 1024); } while (0)
#define PG8_LDB(dst, b, h) do { _Pragma("unroll") for (int n = 0; n < 2; ++n) _Pragma("unroll") for (int k = 0; k < 2; ++k) dst[n][k] = *(const LAS bf16x8*)(lds + PG8_SB(b, h) + boff + n * 2048 + k * 1024); } while (0)
#define PG8_MMA(ai, bj, At, Bt) do { __builtin_amdgcn_s_setprio(1); _Pragma("unroll") for (int m = 0; m < 4; ++m) _Pragma("unroll") for (int n = 0; n < 2; ++n) _Pragma("unroll") for (int k = 0; k < 2; ++k) \
        acc[ai][bj][m][n] = __builtin_amdgcn_mfma_f32_16x16x32_bf16(Bt[n][k], At[m][k], acc[ai][bj][m][n], 0, 0, 0); __builtin_amdgcn_s_setprio(0); } while (0)
#define PG8_WAIT_V(n) asm volatile("s_waitcnt vmcnt(" #n ")" ::: "memory")
#define PG8_WAIT_VR() PG8_WAIT_V(8)
#define PG8_WAIT_L(n) asm volatile("s_waitcnt lgkmcnt(" #n ")" ::: "memory")
#define PG8_BAR __builtin_amdgcn_s_barrier()
#define PG8_SCHED __builtin_amdgcn_sched_barrier(0)
    Seg cur, nxt; int si = 0;
    if (!S.seg(0, cur)) return;
    f32x4 acc[2][2][4][2];
#pragma unroll
    for (int a = 0; a < 2; ++a)
#pragma unroll
        for (int b = 0; b < 2; ++b)
#pragma unroll
            for (int m = 0; m < 4; ++m)
#pragma unroll
                for (int n = 0; n < 2; ++n) acc[a][b][m][n] = (f32x4){0.f, 0.f, 0.f, 0.f};
    bf16x8 At[4][2], B0[2][2], B1[2][2];
    {
        const char* cA = cur.A; const char* cB = cur.B;
        PG8_STAGEB(PG8_SB(0, 0), cB, voffB); PG8_STAGEB(PG8_SB(0, 1), cB + hstep, voffB); PG8_STAGE(PG8_SA(0, 0), cA, voffA); PG8_STAGE(PG8_SA(0, 1), cA + hstep, voffA);
        if (wr == 1) PG8_BAR;
        PG8_WAIT_V(2); PG8_BAR;
        PG8_STAGEB(PG8_SB(1, 0), cB + kstep, voffB); PG8_STAGE(PG8_SA(1, 0), cA + kstep, voffA); PG8_STAGEB(PG8_SB(1, 1), cB + hstep + kstep, voffB);
        PG8_WAIT_V(6); PG8_BAR;
    }
    bool fresh = true, relax = false;
    for (;;) {
        const bool has_next = S.seg(si + 1, nxt);
        const char* cA = cur.A; const char* cB = cur.B; const int nt = cur.nt;
        const char* nA = has_next ? nxt.A : cA; const char* nB = has_next ? nxt.B : cB;
#pragma nounroll
        for (int t = 0; t < nt; t += 2) {
            const bool first = (t == 0) && !fresh;
            const bool last = (t == nt - 2);
            const char* a1 = cA + (size_t)(t + 1) * kstep;
            const char* a2 = last ? nA : cA + (size_t)(t + 2) * kstep; const char* b2 = last ? nB : cB + (size_t)(t + 2) * kstep;
            const char* a3 = a2 + kstep; const char* b3 = b2 + kstep;
            PG8_LDB(B0, 0, 0); PG8_LDB(B1, 0, 1); PG8_SCHED; PG8_LDA(At, 0, 0); if (!first) PG8_STAGE(PG8_SA(1, 1), a1 + hstep, voffA);
            PG8_WAIT_VR(); PG8_WAIT_L(0); PG8_BAR; PG8_MMA(0, 0, At, B0); PG8_MMA(0, 1, At, B1); PG8_BAR; PG8_SCHED;
            PG8_LDA(At, 0, 1); PG8_STAGEB(PG8_SB(0, 0), b2, voffB); PG8_STAGEB(PG8_SB(0, 1), b2 + hstep, voffB); PG8_STAGE(PG8_SA(0, 0), a2, voffA);
            PG8_WAIT_VR(); PG8_WAIT_L(0); PG8_BAR; PG8_MMA(1, 0, At, B0); PG8_MMA(1, 1, At, B1); PG8_BAR; PG8_SCHED;
            PG8_LDB(B0, 1, 0); PG8_LDB(B1, 1, 1); PG8_SCHED; PG8_LDA(At, 1, 0); PG8_STAGE(PG8_SA(0, 1), a2 + hstep, voffA);
            PG8_WAIT_VR(); PG8_WAIT_L(0); PG8_BAR; PG8_MMA(0, 0, At, B0); PG8_MMA(0, 1, At, B1); PG8_BAR; PG8_SCHED;
            PG8_LDA(At, 1, 1); PG8_STAGEB(PG8_SB(1, 0), b3, voffB); PG8_STAGEB(PG8_SB(1, 1), b3 + hstep, voffB); PG8_STAGE(PG8_SA(1, 0), a3, voffA);
            PG8_WAIT_V(8); PG8_WAIT_L(0); PG8_BAR; PG8_MMA(1, 0, At, B0); PG8_MMA(1, 1, At, B1); PG8_BAR; PG8_SCHED;
        }
        if (wr == 0) PG8_BAR;
        PG8_STAGE(PG8_SA(1, 1), nA + kstep + hstep, voffA);
        PG8_SCHED;
        if constexpr (DUAL) E.scale(acc, cur.u, wr, wc, fr, fq, cur.mid != 0);
        if (DUAL && cur.mid) { relax = false; }
        else {
            E(acc, cur.u, wr, wc, fr, fq); relax = true;
#pragma unroll
            for (int a = 0; a < 2; ++a)
#pragma unroll
                for (int b = 0; b < 2; ++b)
#pragma unroll
                    for (int m = 0; m < 4; ++m)
#pragma unroll
                        for (int n = 0; n < 2; ++n) acc[a][b][m][n] = (f32x4){0.f, 0.f, 0.f, 0.f};
        }
        PG8_SCHED;
        if (!has_next) break;
        cur = nxt; ++si; fresh = false;
        if (wr == 1) PG8_BAR;
    }
    PG8_WAIT_V(0);
    PG8_BAR;
#undef PG8_SA
#undef PG8_SB
#undef PG8_STAGE
#undef PG8_STAGEB
#undef PG8_LDA
#undef PG8_LDB
#undef PG8_MMA
#undef PG8_WAIT_V
#undef PG8_WAIT_VR
#undef PG8_WAIT_L
#undef PG8_BAR
#undef PG8_SCHED
}
struct SegOrder1 {
    StaticOrder so; const char* A; const char* B; size_t tstep; int nt;
    __device__ __forceinline__ bool seg(int s, Seg& o) const { Unit u; if (!so.next(s, u)) return false; o.A = A + (size_t)u.pm * tstep; o.B = B + (size_t)u.pn * tstep; o.nt = nt; o.mid = 0; o.u = u; rfl_seg(o); return true; }
};

__device__ __forceinline__ u32x4 pack8(const f32x4 v0, const f32x4 v1) { u32x4 w; w.x = cvt_pk_bf16(v0[0], v0[1]); w.y = cvt_pk_bf16(v0[2], v0[3]); w.z = cvt_pk_bf16(v1[0], v1[1]); w.w = cvt_pk_bf16(v1[2], v1[3]); return w; }
__device__ __forceinline__ void unpack8(const u32x4 w, f32x4& v0, f32x4& v1) { v0 = (f32x4){bf_lo(w.x), bf_hi(w.x), bf_lo(w.y), bf_hi(w.y)}; v1 = (f32x4){bf_lo(w.z), bf_hi(w.z), bf_lo(w.w), bf_hi(w.w)}; }

#ifdef NT_STORES
#define ST16(p, v) __builtin_nontemporal_store((v), (u32x4*)(p))
#define ST8(p, v) __builtin_nontemporal_store((v), (u32x2*)(p))
#else
#define ST16(p, v) (*(u32x4*)(p) = (v))
#define ST8(p, v) (*(u32x2*)(p) = (v))
#endif
struct EpiProj {
    static constexpr bool PERM = true;
    __device__ __forceinline__ void mid(f32x4 (&)[2][2][4][2], const Unit&, int, int, int, int) const {}
    unsigned char* ws; bf16_t* SGA; const float* cw; LAS unsigned char* halo;
    __device__ __forceinline__ void operator()(const f32x4 (&acc)[2][2][4][2], const Unit& u, int wr, int wc, int fr, int fq) const {
        int pn = u.pn, upm = u.pm; asm volatile("" : "+s"(pn), "+s"(upm));
        const int row0 = upm * BM + wr * 64 + fr; const int lc = wc * 32 + 8 * fq;
        bf16_t* const Q = (bf16_t*)(ws + WS_Q); bf16_t* const Kb = (bf16_t*)(ws + WS_K); bf16_t* const V = (bf16_t*)(ws + WS_V); bf16_t* const SZ = (bf16_t*)(ws + WS_SZ); bf16_t* const R = (bf16_t*)(ws + WS_R);
        bf16_t* const SGC = SGA + (size_t)M * D; const float* const cs = (const float*)(ws + WS_CS);
        float* const HP = (float*)(ws + WS_FX); float* const FXQ = HP + (size_t)64 * 2 * NCV; float* const FXU = FXQ + (size_t)64 * 2 * NCV;
        if (pn < 24) {
            const bool isq = pn < 12; const int tq = isq ? pn : pn - 12; bf16_t* base = (isq ? Q : Kb) + (size_t)(tq >> 2) * M * 1024; const int colt = (tq & 3) * BM; const float sc = isq ? QSCALE : 1.0f;
            const bool rot = (fq == 0);
            f32x4 cv[2][4], sv[2][4];
#pragma unroll
            for (int ai = 0; ai < 2; ++ai)
#pragma unroll
                for (int m = 0; m < 4; ++m) { const float* cr = cs + (size_t)(row0 + ai * HALF + m * 16) * 32 + 4 * wc; cv[ai][m] = *(const f32x4*)cr; sv[ai][m] = *(const f32x4*)(cr + 16); }
#pragma unroll
            for (int ai = 0; ai < 2; ++ai)
#pragma unroll
                for (int m = 0; m < 4; ++m) {
                    const f32x4 c = rot ? cv[ai][m] * sc : (f32x4){sc, sc, sc, sc}, sn = rot ? sv[ai][m] * sc : (f32x4){0.f, 0.f, 0.f, 0.f};
                    bf16_t* rowp = base + (size_t)(row0 + ai * HALF + m * 16) * 1024 + colt + lc;
#pragma unroll
                    for (int bj = 0; bj < 2; ++bj) { const f32x4 v0 = acc[ai][bj][m][0], v1 = acc[ai][bj][m][1];
                        ST16((rowp + bj * HALF), (pack8(v0 * c - v1 * sn, v0 * sn + v1 * c))); }
                }
        } else if (pn < 36) {
            const int tv = pn - 24, colt = (tv & 3) * BM; bf16_t* vbase = V + (size_t)(tv >> 2) * M * 1024;
#pragma unroll
            for (int ai = 0; ai < 2; ++ai)
#pragma unroll
                for (int m = 0; m < 4; ++m) { bf16_t* rowp = vbase + (size_t)(row0 + ai * HALF + m * 16) * 1024 + colt + lc;
#pragma unroll
                    for (int bj = 0; bj < 2; ++bj) ST16((rowp + bj * HALF), (pack8(acc[ai][bj][m][0], acc[ai][bj][m][1]))); }
        } else if (pn < 40) {
            const int colt = (pn - 36) * BM;
#pragma unroll
            for (int ai = 0; ai < 2; ++ai)
#pragma unroll
                for (int m = 0; m < 4; ++m) { bf16_t* rowp = SZ + (size_t)(row0 + ai * HALF + m * 16) * NZA + colt + lc;
#pragma unroll
                    for (int bj = 0; bj < 2; ++bj) ST16((rowp + bj * HALF), (pack8(acc[ai][bj][m][0], acc[ai][bj][m][1]))); }
        } else if (pn < 72) {
            int chl = 16 * wc + 4 * fq, frh = fr - 14; asm volatile("" : "+v"(chl), "+v"(frh));
            const int ct = pn - 40, chb = 64 * ct + chl, pm = upm;
            const f32x4 w0 = *(const f32x4*)(cw + chb), w1 = *(const f32x4*)(cw + NCV + chb), w2 = *(const f32x4*)(cw + 2 * NCV + chb);
#pragma unroll
            for (int ai = 0; ai < 2; ++ai)
#pragma unroll
                for (int m = 0; m < 4; ++m) { const f32x4 pv = acc[ai][0][m][1] * acc[ai][1][m][0];
                    const int gi = 8 * ai + 4 * wr + m;
                    if (fr >= 14) { *(LAS f32x4*)(halo + (size_t)(((gi * 2 + frh) * 64 + chl) * 4)) = pv;
                        if (gi == 15) *(f32x4*)(HP + ((size_t)(pm * 2 + frh) * NCV + chb)) = pv; } }
            asm volatile("s_waitcnt lgkmcnt(0)" ::: "memory"); __builtin_amdgcn_s_barrier(); asm volatile("" ::: "memory");
#pragma unroll
            for (int ai = 0; ai < 2; ++ai)
#pragma unroll
                for (int m = 0; m < 4; ++m) {
                    const int gi = 8 * ai + 4 * wr + m; const int gp = gi > 0 ? gi - 1 : 0;
                    f32x4 H0 = *(const LAS f32x4*)(halo + (size_t)(((gp * 2 + 0) * 64 + chl) * 4)), H1 = *(const LAS f32x4*)(halo + (size_t)(((gp * 2 + 1) * 64 + chl) * 4));
                    if (gi == 0) { H0 = (f32x4){0.f, 0.f, 0.f, 0.f}; H1 = H0; }
                    const f32x4 Hs = (fr == 1) ? H1 : H0, pvv = acc[ai][0][m][1] * acc[ai][1][m][0];
                    f32x4 Pm1, Pm2, qv;
#pragma unroll
                    for (int j = 0; j < 4; ++j) {
                        const float pj = pvv[j], h1j = H1[j], hsj = Hs[j];
                        Pm1[j] = dpp_row_shr<0x111>(h1j, pj); Pm2[j] = dpp_row_shr<0x112>(hsj, pj);
                        qv[j] = acc[ai][0][m][0][j] * silu_f(acc[ai][1][m][1][j]); }
                    const f32x4 uu = w2 * pvv + w1 * Pm1 + w0 * Pm2, rv = qv * uu;
                    const size_t ro = (size_t)(row0 + ai * HALF + m * 16) * NCV + chb;
                    u32x2 rw; rw.x = cvt_pk_bf16(rv[0], rv[1]); rw.y = cvt_pk_bf16(rv[2], rv[3]);
                    ST8((R + ro), (rw));
                    if (gi == 0 && fr < 2 && pm > 0) { *(f32x4*)(FXQ + ((size_t)(pm * 2 + fr) * NCV + chb)) = qv; *(f32x4*)(FXU + ((size_t)(pm * 2 + fr) * NCV + chb)) = uu; }
                }
        } else {
            const int colt = (pn - 72) * HALF;
#pragma unroll
            for (int ai = 0; ai < 2; ++ai)
#pragma unroll
                for (int m = 0; m < 4; ++m) { const size_t ro = (size_t)(row0 + ai * HALF + m * 16) * D + colt + lc;
                    f32x4 r[2], c[2];
#pragma unroll
                    for (int n = 0; n < 2; ++n)
#pragma unroll
                        for (int j = 0; j < 4; ++j) { const float pc = 1.0f + __builtin_amdgcn_exp2f(-acc[ai][1][m][n][j] * LOG2E), pa = 1.0f + __builtin_amdgcn_exp2f(-acc[ai][0][m][n][j] * LOG2E);
                            const float t = __builtin_amdgcn_rcpf(pa * pc); c[n][j] = pa * t; r[n][j] = pc * pc * t; }
                    ST16((SGA + ro), (pack8(r[0], r[1]))); ST16((SGC + ro), (pack8(c[0], c[1]))); }
        }
    }
};
struct EpiMerge {
    static constexpr bool PERM = true;
    bf16_t* O; const bf16_t* RHO; const bf16_t* SC; int ldc;
    __device__ __forceinline__ size_t lane_off(const Unit& u, int wr, int wc, int fr, int fq, int ai) const {
        size_t o = (size_t)(u.pm * BM + wr * 64 + fr + ai * HALF) * ldc + u.pn * BM + wc * 32 + 8 * fq; asm volatile("" : "+v"(o)); return o; }
    __device__ __forceinline__ void scale(f32x4 (&acc)[2][2][4][2], const Unit& u, int wr, int wc, int fr, int fq, bool is_mid) const {
        const bf16_t* G = is_mid ? RHO : SC;
#pragma unroll
        for (int ai = 0; ai < 2; ++ai) {
            const bf16_t* p = G + lane_off(u, wr, wc, fr, fq, ai);
            u32x4 gw[4][2];
#pragma unroll
            for (int m = 0; m < 4; ++m)
#pragma unroll
                for (int bj = 0; bj < 2; ++bj) gw[m][bj] = *(const u32x4*)(p + (size_t)m * 16 * ldc + bj * HALF);
#pragma unroll
            for (int m = 0; m < 4; ++m)
#pragma unroll
                for (int bj = 0; bj < 2; ++bj) { f32x4 g0, g1; unpack8(gw[m][bj], g0, g1); acc[ai][bj][m][0] *= g0; acc[ai][bj][m][1] *= g1; }
        }
    }
    __device__ __forceinline__ void mid(f32x4 (&)[2][2][4][2], const Unit&, int, int, int, int) const {}
    __device__ __forceinline__ void operator()(const f32x4 (&acc)[2][2][4][2], const Unit& u, int wr, int wc, int fr, int fq) const {
#pragma unroll
        for (int ai = 0; ai < 2; ++ai) {
            bf16_t* q = O + lane_off(u, wr, wc, fr, fq, ai);
#pragma unroll
            for (int m = 0; m < 4; ++m)
#pragma unroll
                for (int bj = 0; bj < 2; ++bj) *(u32x4*)(q + (size_t)m * 16 * ldc + bj * HALF) = pack8(acc[ai][bj][m][0], acc[ai][bj][m][1]);
        }
    }
};
struct EpiBf16 {
    static constexpr bool PERM = true;
    __device__ __forceinline__ void mid(f32x4 (&)[2][2][4][2], const Unit&, int, int, int, int) const {}
    bf16_t* O; int ldc;
    __device__ __forceinline__ void operator()(const f32x4 (&acc)[2][2][4][2], const Unit& u, int wr, int wc, int fr, int fq) const {
        const int row0 = u.pm * BM + wr * 64 + fr, col0 = u.pn * BM + wc * 32 + 8 * fq;
#pragma unroll
        for (int ai = 0; ai < 2; ++ai)
#pragma unroll
            for (int m = 0; m < 4; ++m) { bf16_t* rowp = O + (size_t)(row0 + ai * HALF + m * 16) * ldc + col0;
#pragma unroll
                for (int bj = 0; bj < 2; ++bj) *(u32x4*)(rowp + bj * HALF) = pack8(acc[ai][bj][m][0], acc[ai][bj][m][1]); }
    }
};
struct SegOrder2 {
    StaticOrder so; const char *A0, *B0, *A1, *B1; size_t tstep; int nt0, nt1;
    __device__ __forceinline__ bool seg(int s_, Seg& o) const { Unit u; if (!so.next(s_ >> 1, u)) return false; const int h = s_ & 1;
        o.A = (h ? A1 : A0) + (size_t)u.pm * tstep; o.B = (h ? B1 : B0) + (size_t)u.pn * tstep; o.nt = h ? nt1 : nt0; o.mid = !h; o.u = u; rfl_seg(o); return true; }
};
}

#ifndef PG8_SP2
#define PG8_SP2 true
#endif
#ifndef PG8_ALIGN
#define PG8_ALIGN true
#endif

constexpr int NWAVES = 8;
#ifndef MK_N_LAUNCHES
#define MK_N_LAUNCHES 1
#endif
constexpr int NPHASES = 8;
constexpr int N_LAUNCHES = MK_N_LAUNCHES;

constexpr int CW_BAR = 4096, CW_MODCNT = 8000;
#define XCD_BAR_WORDS 3456

constexpr int RING_BYTES = 131072;
constexpr int LDSCTL_OFF = RING_BYTES, MISC_OFF = LDSCTL_OFF + 320, HALO_OFF = RING_BYTES + 1024;
constexpr int LDS_BYTES = 147456;

typedef GAS unsigned gu32;
#define RLX_AGENT __ATOMIC_RELAXED, __HIP_MEMORY_SCOPE_AGENT

#define XB_TMO      128
#define XB_XCNT(j)  (256  + 64 * (j))
#define XB_XSUB(j)  (1280 + 64 * (j))
#define XB_XGEN(j)  (2304 + 64 * (j))
#define XB_TOP      3328
#define XB_TOPGEN   3392
#define XB_SPIN_CAP (1u << 18)

__device__ __forceinline__ unsigned xb_ld(unsigned* p)              { return __hip_atomic_load(p, __ATOMIC_RELAXED, __HIP_MEMORY_SCOPE_AGENT); }
__device__ __forceinline__ unsigned xb_add(unsigned* p, unsigned v) { return __hip_atomic_fetch_add(p, v, __ATOMIC_RELAXED, __HIP_MEMORY_SCOPE_AGENT); }
__device__ __forceinline__ unsigned xb_xcc_id() { return (unsigned)__builtin_amdgcn_s_getreg((3 << 11) | 20) & 0xFu; }
#define XB_SPIN(cond, bar) do { unsigned _sp = 0; while (cond) { __builtin_amdgcn_s_sleep(1); \
    if ((++_sp & 255u) == 0u) { if (xb_ld(&(bar)[XB_TMO])) break; if (_sp > XB_SPIN_CAP) { atomicAdd(&(bar)[XB_TMO], 1u); break; } } } } while (0)

struct XcdBarrier { unsigned* bar; unsigned x; volatile LAS unsigned* st; };

__device__ __forceinline__ XcdBarrier xcd_barrier_post(unsigned* bar, volatile LAS unsigned* st) {
    XcdBarrier b; b.bar = bar; b.x = xb_xcc_id(); b.st = st;
    if (threadIdx.x == 0) (void)xb_add(&bar[XB_XCNT(b.x)], 1u);
    return b;
}
__device__ __forceinline__ void xcd_barrier_complete(unsigned* bar, unsigned x, unsigned& nloc, unsigned& nx) {
    const unsigned G = gridDim.x * gridDim.y * gridDim.z;
    unsigned sum, cnt, mine, sp = 0u;
    for (;;) {
        sum = 0u; cnt = 0u; mine = 0u;
#pragma unroll
        for (unsigned j = 0; j < 16; ++j) { const unsigned c = xb_ld(&bar[XB_XCNT(j)]); sum += c; cnt += (c > 0u) ? 1u : 0u; mine = (j == x) ? c : mine; }
        if (sum == G) break;
        __builtin_amdgcn_s_sleep(1);
        if ((++sp & 255u) == 0u) { if (xb_ld(&bar[XB_TMO])) break; if (sp > XB_SPIN_CAP) { atomicAdd(&bar[XB_TMO], 1u); break; } }
    }
    nloc = mine > 0u ? mine : 1u; nx = cnt > 0u ? cnt : 1u;
}
__device__ __forceinline__ void xcd_barrier(const XcdBarrier& b) {
    asm volatile("s_waitcnt vmcnt(0)" ::: "memory");
    __syncthreads();
    if (threadIdx.x == 0) {
        unsigned* bar = b.bar;
        __builtin_amdgcn_s_waitcnt(0);
        unsigned nloc = b.st[0], nx = b.st[1];
        if (nloc == 0u) { xcd_barrier_complete(bar, b.x, nloc, nx); b.st[0] = nloc; b.st[1] = nx; }
        const unsigned old = xb_add(&bar[XB_XSUB(b.x)], 1u);
        const unsigned gen = old / nloc;
        if (old + 1u == (gen + 1u) * nloc) {
            __builtin_amdgcn_fence(__ATOMIC_RELEASE, "agent");
            asm volatile("s_waitcnt vmcnt(0)" ::: "memory");
            const unsigned og = xb_add(&bar[XB_TOP], 1u);
            const unsigned tg = og / nx;
            if (og + 1u == (tg + 1u) * nx) xb_add(&bar[XB_TOPGEN], 1u);
            else XB_SPIN(xb_ld(&bar[XB_TOPGEN]) == tg, bar);
            __builtin_amdgcn_fence(__ATOMIC_ACQUIRE, "agent");
            xb_add(&bar[XB_XGEN(b.x)], 1u);
            asm volatile("s_waitcnt vmcnt(0)" ::: "memory");
        } else {
            XB_SPIN(xb_ld(&bar[XB_XGEN(b.x)]) == gen, bar);
            __builtin_amdgcn_fence(__ATOMIC_ACQUIRE, "agent");
            asm volatile("s_waitcnt vmcnt(0)" ::: "memory");
        }
    }
    __syncthreads();
}

#define LDS_WAIT() asm volatile("s_waitcnt lgkmcnt(0)" ::: "memory")
__device__ __forceinline__ float wave_sum(float v) {
#pragma unroll
    for (int o = 1; o < 64; o <<= 1) v += __shfl_xor(v, o);
    return v;
}
__device__ __forceinline__ unsigned f2bf(float f) { unsigned u = __builtin_bit_cast(unsigned, f); return (u + 0x7fffu + ((u >> 16) & 1u)) >> 16; }
__device__ __forceinline__ unsigned pk2(float lo, float hi) { return f2bf(lo) | (f2bf(hi) << 16); }

__device__ __forceinline__ int proj_orig_col(int n) {
    const int tile = n >> 8, c = n & 255;
    if (tile < 24) { const int c7 = n & 127, wc = c7 >> 5, fq = (c7 >> 3) & 3, nn = (c7 >> 2) & 1, j = c7 & 3;
        const int dim = (fq == 0) ? (4 * wc + j + 16 * nn) : (32 + wc * 24 + (fq - 1) * 8 + 4 * nn + j); return (n & ~127) + dim; }
    if (tile < 40) return n;
    if (tile < 72) { const int kind = 2 * (c >> 7) + ((c >> 2) & 1), chl = 16 * ((c >> 5) & 3) + 4 * ((c >> 3) & 3) + (c & 3); return 10240 + kind * 2048 + 64 * (tile - 40) + chl; }
    return 18432 + (c >> 7) * 2048 + 128 * (tile - 72) + (c & 127);
}
struct TItem { const float* src; bf16_t* dst; int N; };
__device__ __forceinline__ void t_decode(const float* W, int N, bf16_t* WT, int pitch, bool remap, int item, int lane, TItem& d) {
    const int nblk = N / 32, kb = item / nblk, nb = item % nblk, k0 = 64 * kb, n0 = 32 * nb;
    const int ncol = remap ? proj_orig_col(n0 + (lane & 31)) : n0 + (lane & 31);
    d.src = W + (size_t)(k0 + (lane >> 5)) * N + ncol; d.dst = WT + (size_t)(n0 + (lane >> 3)) * pitch + k0 + 8 * (lane & 7); d.N = N;
}
__device__ __forceinline__ void t_load(const TItem& d, float (&wv)[32]) {
#pragma unroll
    for (int i = 0; i < 32; ++i) wv[i] = d.src[(size_t)(2 * i) * d.N];
}
__device__ __forceinline__ void t_finish(const TItem& d, const float (&wv)[32], int pitch, LAS float* scr, int lane) {
#pragma unroll
    for (int i = 0; i < 32; ++i) scr[(2 * i + (lane >> 5)) * 33 + (lane & 31)] = wv[i];
    LDS_WAIT(); asm volatile("" ::: "memory");
    const int c = lane & 7;
#pragma unroll
    for (int j = 0; j < 4; ++j) { const int n = (lane >> 3) + 8 * j; const LAS float* s = scr + (8 * c) * 33 + n;
        u32x4 o; o.x = pk2(s[0 * 33], s[1 * 33]); o.y = pk2(s[2 * 33], s[3 * 33]); o.z = pk2(s[4 * 33], s[5 * 33]); o.w = pk2(s[6 * 33], s[7 * 33]);
        *(u32x4*)(d.dst + (size_t)(8 * j) * pitch) = o; }
    LDS_WAIT(); asm volatile("" ::: "memory");
}

__device__ __forceinline__ void sincos_f64(float ang, float& s, float& c) {
    const double x = (double)ang;
    const double n = __builtin_rint(x * 0.15915494309189535);
    double r = __builtin_fma(-n, 6.283185307179586, x); r = __builtin_fma(-n, 2.4492935982947064e-16, r);
    const double r2 = r * r;
    double ps = 1.0 / 51090942171709440000.0;
    ps = __builtin_fma(ps, r2, -1.0 / 121645100408832000.0);
    ps = __builtin_fma(ps, r2, 1.0 / 355687428096000.0);
    ps = __builtin_fma(ps, r2, -1.0 / 1307674368000.0);
    ps = __builtin_fma(ps, r2, 1.0 / 6227020800.0);
    ps = __builtin_fma(ps, r2, -1.0 / 39916800.0);
    ps = __builtin_fma(ps, r2, 1.0 / 362880.0);
    ps = __builtin_fma(ps, r2, -1.0 / 5040.0);
    ps = __builtin_fma(ps, r2, 1.0 / 120.0);
    ps = __builtin_fma(ps, r2, -1.0 / 6.0);
    ps = __builtin_fma(ps, r2, 1.0);
    double pc = -1.0 / 1124000727777607680000.0;
    pc = __builtin_fma(pc, r2, 1.0 / 2432902008176640000.0);
    pc = __builtin_fma(pc, r2, -1.0 / 6402373705728000.0);
    pc = __builtin_fma(pc, r2, 1.0 / 20922789888000.0);
    pc = __builtin_fma(pc, r2, -1.0 / 87178291200.0);
    pc = __builtin_fma(pc, r2, 1.0 / 479001600.0);
    pc = __builtin_fma(pc, r2, -1.0 / 3628800.0);
    pc = __builtin_fma(pc, r2, 1.0 / 40320.0);
    pc = __builtin_fma(pc, r2, -1.0 / 720.0);
    pc = __builtin_fma(pc, r2, 1.0 / 24.0);
    pc = __builtin_fma(pc, r2, -0.5);
    pc = __builtin_fma(pc, r2, 1.0);
    s = (float)(r * ps); c = (float)pc;
}

__device__ __forceinline__ unsigned attn_offk(unsigned slot, unsigned row, unsigned ch) { return slot * 32768u + 256u * row + 16u * (ch ^ (row & 15u)); }
__device__ __forceinline__ unsigned attn_offv(unsigned slot, unsigned lrow, unsigned ch) { return 65536u + slot * 32768u + 256u * lrow + 16u * (ch ^ (((lrow & 3u) << 2) | ((lrow >> 2) & 3u))); }
__device__ __forceinline__ unsigned attn_lrow(unsigned k) { return (k & ~31u) | (((k >> 2) & 3u) << 3) | (((k >> 4) & 1u) << 2) | (k & 3u); }

template <bool COMBINE>
__device__ __forceinline__ void attn_chunk(LAS unsigned char* lds, const bf16_t* Qg, const bf16_t* Kg, const bf16_t* Vg, const int dsh, const int hh, const int r, const int n0, const int nblk,
                                           bf16_t* Og, float* LSEg, const bf16_t* O1, const bf16_t* O2, const float* LSE1, const float* LSE2, const bf16_t* SZ, bf16_t* AATT) {
    int tid = threadIdx.x; asm volatile("" : "+v"(tid));
    const int lane = tid & 63, wid = __builtin_amdgcn_readfirstlane(tid >> 6), fr = lane & 15, fq = lane >> 4;
    const int sch = tid & 15, srb = tid >> 4;
    const size_t scol = (size_t)hh * 256 + sch * 16;
    u32x4 kreg[4], vreg[4];
#define ATT_LOAD(blk) do { _Pragma("unroll") for (int i = 0; i < 4; ++i) { const size_t p = ((size_t)(128 * (blk) + srb + 32 * i) << dsh) + r; const size_t off = p * 2048 + scol; \
        kreg[i] = *(const u32x4*)((const char*)Kg + off); vreg[i] = *(const u32x4*)((const char*)Vg + off); } } while (0)
#define ATT_WRITE(slot) do { _Pragma("unroll") for (int i = 0; i < 4; ++i) { const unsigned row = srb + 32 * i; \
        *(LAS u32x4*)(lds + attn_offk((slot), row, sch)) = kreg[i]; *(LAS u32x4*)(lds + attn_offv((slot), attn_lrow(row), sch)) = vreg[i]; } } while (0)
    const unsigned q4 = (unsigned)(lane & 15) >> 2, p4 = (unsigned)lane & 3u, parA = (unsigned)wid & 1u, parB = parA ^ 1u;
    unsigned kbase[4], vbA[8], vbB[8];
#pragma unroll
    for (int s_ = 0; s_ < 4; ++s_) kbase[s_] = 256u * fr + 16u * ((unsigned)(4 * s_ + fq) ^ (unsigned)fr);
#pragma unroll
    for (int c = 0; c < 8; ++c) {
        vbA[c] = 65536u + 256u * (((unsigned)fq << 3) | (parA << 2) | q4) + 16u * ((unsigned)(2 * c + (p4 >> 1)) ^ ((q4 << 2) | (((unsigned)fq & 1u) << 1) | parA)) + 8u * (p4 & 1u);
        vbB[c] = 65536u + 256u * (((unsigned)fq << 3) | (parB << 2) | q4) + 16u * ((unsigned)(2 * c + (p4 >> 1)) ^ ((q4 << 2) | (((unsigned)fq & 1u) << 1) | parB)) + 8u * (p4 & 1u);
    }
    if (n0 > 0) { ATT_LOAD(n0 - 1); }
    else {
#pragma unroll
        for (int i = 0; i < 4; ++i) { kreg[i] = (u32x4){0u, 0u, 0u, 0u}; vreg[i] = (u32x4){0u, 0u, 0u, 0u}; } }
    ATT_WRITE((unsigned)((n0 + 1) & 1));
    ATT_LOAD(n0); ATT_WRITE((unsigned)(n0 & 1));
    __syncthreads();
    for (int n = n0; n < n0 + nblk; ++n) {
        const bool more = (n + 1 < n0 + nblk);
        if (more) ATT_LOAD(n + 1);
        const unsigned cs_ = (unsigned)(n & 1), ps_ = cs_ ^ 1u;
        const int lq = 128 * n + 16 * wid + fr; const size_t pq = ((size_t)lq << dsh) + r;
        bf16x8 qf[4];
        { const bf16x8* qp = (const bf16x8*)((const char*)Qg + pq * 2048 + (size_t)hh * 256 + fq * 16);
#pragma unroll
          for (int s = 0; s < 4; ++s) qf[s] = qp[4 * s]; }
        f32x4 S[9];
#pragma unroll
        for (int t = 0; t < 9; ++t) {
            S[t] = (f32x4){0.f, 0.f, 0.f, 0.f};
            const unsigned kr0 = 16 * wid + 16 * t, uo = ((kr0 < 128u) ? ps_ : cs_) * 32768u + 256u * (kr0 & 127u);
#pragma unroll
            for (int s = 0; s < 4; ++s) { const bf16x8 kf = *(const LAS bf16x8*)(lds + (kbase[s] + uo)); S[t] = __builtin_amdgcn_mfma_f32_16x16x32_bf16(kf, qf[s], S[t], 0, 0, 0); }
        }
        const float NEG = -1e30f;
#pragma unroll
        for (int j = 0; j < 4; ++j) { const int ko0 = 4 * fq + j; if (ko0 < fr) S[0][j] = NEG; if (ko0 > fr) S[8][j] = NEG; }
        if (n == 0) {
#pragma unroll
            for (int t = 0; t < 9; ++t)
#pragma unroll
                for (int j = 0; j < 4; ++j) { if (16 * wid + 16 * t + 4 * fq + j < 128) S[t][j] = NEG; }
        }
        float mx = NEG;
#pragma unroll
        for (int t = 0; t < 9; ++t) mx = fmaxf(mx, fmaxf(fmaxf(S[t][0], S[t][1]), fmaxf(S[t][2], S[t][3])));
        mx = fmaxf(mx, __shfl_xor(mx, 16)); mx = fmaxf(mx, __shfl_xor(mx, 32));
        float sum = 0.f;
#pragma unroll
        for (int t = 0; t < 9; ++t)
#pragma unroll
            for (int j = 0; j < 4; ++j) { const float p = __builtin_amdgcn_exp2f(S[t][j] - mx); S[t][j] = p; sum += p; }
        sum += __shfl_xor(sum, 16); sum += __shfl_xor(sum, 32);
        u32x2 o1w[8], o2w[8], szw[8]; float l1 = 0.f, l2 = 0.f;
        if (COMBINE) {
            asm volatile("" ::: "memory");
            const size_t eo = pq * 1024 + hh * 128 + 4 * fq;
#pragma unroll
            for (int c = 0; c < 8; ++c) { o1w[c] = *(const u32x2*)(O1 + eo + 16 * c); o2w[c] = *(const u32x2*)(O2 + eo + 16 * c); szw[c] = *(const u32x2*)(SZ + eo + 16 * c); }
            l1 = LSE1[pq * 8 + hh]; l2 = LSE2[pq * 8 + hh];
        }
        f32x4 O[8];
#pragma unroll
        for (int c = 0; c < 8; ++c) O[c] = (f32x4){0.f, 0.f, 0.f, 0.f};
#pragma unroll
        for (int u = 0; u < 5; ++u) {
            u32x4 pw; pw.x = cvt_pk_bf16(S[2 * u][0], S[2 * u][1]); pw.y = cvt_pk_bf16(S[2 * u][2], S[2 * u][3]);
            if (u < 4) { pw.z = cvt_pk_bf16(S[2 * u + 1][0], S[2 * u + 1][1]); pw.w = cvt_pk_bf16(S[2 * u + 1][2], S[2 * u + 1][3]); } else { pw.z = 0u; pw.w = 0u; }
            const bf16x8 pf = __builtin_bit_cast(bf16x8, pw);
            const unsigned kba = 16 * wid + 32 * u, kbb = kba + 16;
            const unsigned uoa = ((kba < 128u) ? ps_ : cs_) * 32768u + 256u * (kba & 96u), uob = ((kbb < 128u) ? ps_ : cs_) * 32768u + 256u * (kbb & 96u);
#pragma unroll
            for (int c = 0; c < 8; ++c) {
                const s16x4 va = __builtin_amdgcn_ds_read_tr16_b64_v4i16((LAS s16x4*)(lds + (vbA[c] + uoa)));
                const s16x4 vb = __builtin_amdgcn_ds_read_tr16_b64_v4i16((LAS s16x4*)(lds + ((u < 4) ? (vbB[c] + uob) : (vbA[c] + uoa))));
                const bf16x8 vf = __builtin_shufflevector(va, vb, 0, 1, 2, 3, 4, 5, 6, 7);
                O[c] = __builtin_amdgcn_mfma_f32_16x16x32_bf16(vf, pf, O[c], 0, 0, 0);
            }
        }
        const float inv = 1.0f / sum;
        if (!COMBINE) {
            bf16_t* op = Og + pq * 1024 + hh * 128 + 4 * fq;
#pragma unroll
            for (int c = 0; c < 8; ++c) { u32x2 w; w.x = cvt_pk_bf16(O[c][0] * inv, O[c][1] * inv); w.y = cvt_pk_bf16(O[c][2] * inv, O[c][3] * inv); *(u32x2*)(op + 16 * c) = w; }
            if (fq == 0) LSEg[pq * 8 + hh] = mx + __builtin_amdgcn_logf(sum);
        } else {
            const float l0 = mx + __builtin_amdgcn_logf(sum), m3 = fmaxf(l0, fmaxf(l1, l2));
            float w0 = __builtin_amdgcn_exp2f(l0 - m3), w1 = __builtin_amdgcn_exp2f(l1 - m3), w2 = __builtin_amdgcn_exp2f(l2 - m3);
            const float iw = 1.0f / (w0 + w1 + w2); w0 *= iw * inv; w1 *= iw; w2 *= iw;
            bf16_t* ap = AATT + pq * 2048 + hh * 128 + 4 * fq;
#pragma unroll
            for (int c = 0; c < 8; ++c) {
                const f32x4 a1 = (f32x4){bf_lo(o1w[c].x), bf_hi(o1w[c].x), bf_lo(o1w[c].y), bf_hi(o1w[c].y)}, a2 = (f32x4){bf_lo(o2w[c].x), bf_hi(o2w[c].x), bf_lo(o2w[c].y), bf_hi(o2w[c].y)};
                const f32x4 zz = (f32x4){silu_f(bf_lo(szw[c].x)), silu_f(bf_hi(szw[c].x)), silu_f(bf_lo(szw[c].y)), silu_f(bf_hi(szw[c].y))};
                const f32x4 res = (O[c] * w0 + a1 * w1 + a2 * w2) * zz;
                u32x2 w; w.x = cvt_pk_bf16(res[0], res[1]); w.y = cvt_pk_bf16(res[2], res[3]); *(u32x2*)(ap + 16 * c) = w;
            }
        }
        __syncthreads();
        if (more) ATT_WRITE(ps_);
        __syncthreads();
    }
#undef ATT_LOAD
#undef ATT_WRITE
}

struct Args { const float* x; const float* c; const int* pos; const float* g_pre; const float* w_ada; const float* b_ada; const float* w_in; const float* conv_w;
              const float* w_attn_o; const float* w_conv_o; const float* w_o; const float* g_post; float* out; unsigned char* ws; int ph_lo, ph_hi, li, pad; };

__global__ void __launch_bounds__(NWAVES * 64, 2) mk_fwd(Args args) {
    extern __shared__ __attribute__((aligned(16))) unsigned char lds_raw[];
    LAS unsigned char* lds = (LAS unsigned char*)lds_raw;
    volatile LAS unsigned* MISC = (volatile LAS unsigned*)(lds + MISC_OFF);
    const int tid = threadIdx.x, lane = tid & 63, wave = __builtin_amdgcn_readfirstlane(tid >> 6);
    const int G = gridDim.x; const int bx = blockIdx.x; const int vcu = (G % 8 == 0) ? (bx % 8) * (G / 8) + bx / 8 : bx;
    unsigned char* ws = args.ws;
    gu32* ctl = (gu32*)(ws + WS_CTL);
    float* mod = (float*)(ws + WS_MOD); float* cs = (float*)(ws + WS_CS);
    bf16_t* WinT = (bf16_t*)(ws + WS_WIN); bf16_t* WaT = (bf16_t*)(ws + WS_WA); bf16_t* WcT = (bf16_t*)(ws + WS_WC); bf16_t* WoT = (bf16_t*)(ws + WS_WO);
    bf16_t* Hb = (bf16_t*)(ws + WS_H); bf16_t* Qb = (bf16_t*)(ws + WS_Q); bf16_t* Kb = (bf16_t*)(ws + WS_K); bf16_t* Vb = (bf16_t*)(ws + WS_V);
    bf16_t* SZ = (bf16_t*)(ws + WS_SZ); float* HPb = (float*)(ws + WS_FX); float* FXQb = HPb + (size_t)64 * 2 * NCV; float* FXUb = FXQb + (size_t)64 * 2 * NCV;
    bf16_t* SGA = (bf16_t*)args.out; bf16_t* SGC = SGA + (size_t)M * D;
    bf16_t* O1 = (bf16_t*)(ws + WS_O1); bf16_t* O2 = (bf16_t*)(ws + WS_O2); float* LSE = (float*)(ws + WS_LSE);
    bf16_t* AATT = (bf16_t*)(ws + WS_AATT); bf16_t* Rb = (bf16_t*)(ws + WS_R); bf16_t* MG = (bf16_t*)(ws + WS_MG);
    bf16_t* Yb = (bf16_t*)(ws + WS_Y);

    for (int u = tid; u < (LDS_BYTES - LDSCTL_OFF) / 4; u += NWAVES * 64) ((LAS unsigned*)(lds + LDSCTL_OFF))[u] = 0u;
    __syncthreads();
    const int bli = (N_LAUNCHES == 1) ? 0 : args.li;
    XcdBarrier bar; bar.bar = (unsigned*)(ctl + CW_BAR) + bli * XCD_BAR_WORDS; bar.x = 0; bar.st = nullptr;
    if (N_LAUNCHES == 1) bar = xcd_barrier_post((unsigned*)(ctl + CW_BAR), MISC + 8);
    const int lo = args.ph_lo, hi = args.ph_hi;
#define IN(k) (lo <= (k) && (k) < hi)
#define BOTH(k) (IN(k) && IN((k) + 1))
#define GRID_BAR() xcd_barrier(bar)
#ifndef PROBE_REPEAT_MASK
#define PROBE_REPEAT_MASK 0
#endif
#ifndef PROBE_REPEAT_N
#define PROBE_REPEAT_N 1
#endif
#define NREP(k) ((((PROBE_REPEAT_MASK) >> (k)) & 1) * (PROBE_REPEAT_N) + 1)
    const int gw = vcu * NWAVES + wave, NGW = G * NWAVES;
    const int gtid = vcu * (NWAVES * 64) + tid, NT = G * NWAVES * 64;

    if (IN(0)) for (int rep = 0; rep < NREP(0); ++rep) {
        {
            LAS float* red = (LAS float*)lds;
            for (int cbk = bx; cbk < 256; cbk += G) {
                const int c4 = tid % 6, rg = tid / 6;
                f32x4 a = (f32x4){0.f, 0.f, 0.f, 0.f};
                if (rg < 85) {
#pragma unroll 6
                    for (int k = rg; k < D; k += 85) { const float cv = args.c[k]; const f32x4 w = *(const f32x4*)(args.w_ada + (size_t)k * NMOD + cbk * 24 + c4 * 4); a += w * cv; }
                    *(LAS f32x4*)(red + (rg * 6 + c4) * 4) = a; }
                __syncthreads();
                if (tid < 24) { float s = 0.f; for (int i = 0; i < 85; ++i) s += red[(i * 6 + (tid >> 2)) * 4 + (tid & 3)];
                    __hip_atomic_store(mod + cbk * 24 + tid, s + args.b_ada[cbk * 24 + tid], __ATOMIC_RELAXED, __HIP_MEMORY_SCOPE_AGENT); }
                asm volatile("s_waitcnt vmcnt(0)" ::: "memory");
                __syncthreads();
                if (tid == 0) __hip_atomic_fetch_add((unsigned*)(ctl + CW_MODCNT), 1u, __ATOMIC_RELAXED, __HIP_MEMORY_SCOPE_AGENT);
            }
        }
        for (int idx = gtid; idx < M * 16; idx += NT) { const int m = idx >> 4, i = idx & 15; const float ang = (float)args.pos[m] * INVF[i]; float s, c; sincos_f64(ang, s, c); cs[m * 32 + i] = c; cs[m * 32 + 16 + i] = s; }
        {
            LAS float* scr = (LAS float*)(lds + wave * 16384);
            constexpr int I_IN = (D / 64) * (PROJ / 32), I_A = (NZA / 64) * (D / 32), I_C = (NCV / 64) * (D / 32), I_O = (D / 64) * (D / 32);
            constexpr int NITEMS = I_IN + I_A + I_C + I_O;
#define T_DECODE(it_, d_) do { int r_ = (it_); \
                if (r_ < I_IN) t_decode(args.w_in, PROJ, WinT, D, true, r_, lane, d_); \
                else if ((r_ -= I_IN) < I_A) t_decode(args.w_attn_o, D, WaT, D, false, r_, lane, d_); \
                else if ((r_ -= I_A) < I_C) t_decode(args.w_conv_o, D, WcT, D, false, r_, lane, d_); \
                else t_decode(args.w_o, D, WoT, D, false, r_ - I_C, lane, d_); } while (0)
            TItem cur_, nxt_; float wa[32], wb[32];
            int it = gw;
            if (it < NITEMS) { T_DECODE(it, cur_); t_load(cur_, wa); }
            while (it < NITEMS) {
                const int nit = it + NGW;
                if (nit < NITEMS) { T_DECODE(nit, nxt_); t_load(nxt_, wb); }
                t_finish(cur_, wa, D, scr, lane);
                cur_ = nxt_;
#pragma unroll
                for (int i = 0; i < 32; ++i) wa[i] = wb[i];
                it = nit;
            }
#undef T_DECODE
        }
        if (tid == 0) {
            unsigned sp = 0;
            while (__hip_atomic_load((unsigned*)(ctl + CW_MODCNT), __ATOMIC_RELAXED, __HIP_MEMORY_SCOPE_AGENT) < 256u * (unsigned)(rep + 1)) { __builtin_amdgcn_s_sleep(2); if (++sp > (1u << 22)) break; }
            __builtin_amdgcn_fence(__ATOMIC_ACQUIRE, "agent");
            asm volatile("s_waitcnt vmcnt(0)" ::: "memory");
        }
        __syncthreads();
        f32x4 av[4][2], bv[4][2];
#pragma unroll
        for (int j = 0; j < 4; ++j)
#pragma unroll
            for (int h = 0; h < 2; ++h) { const int k = 512 * j + 8 * lane + 4 * h; const f32x4 gp = *(const f32x4*)(args.g_pre + k); f32x4 sc, sh;
#pragma unroll
                for (int e = 0; e < 4; ++e) { sc[e] = __hip_atomic_load(mod + D + k + e, __ATOMIC_RELAXED, __HIP_MEMORY_SCOPE_AGENT); sh[e] = __hip_atomic_load(mod + k + e, __ATOMIC_RELAXED, __HIP_MEMORY_SCOPE_AGENT); }
                av[j][h] = gp * (sc + 1.0f); bv[j][h] = sh; }
        for (int m = gw; m < M; m += NGW) {
            const float* xr = args.x + (size_t)m * D + 8 * lane;
            f32x4 v[4][2]; float ss = 0.f;
#pragma unroll
            for (int j = 0; j < 4; ++j)
#pragma unroll
                for (int h = 0; h < 2; ++h) { v[j][h] = *(const f32x4*)(xr + 512 * j + 4 * h); const f32x4 q = v[j][h] * v[j][h]; ss += (q[0] + q[1]) + (q[2] + q[3]); }
            const float rstd = 1.0f / sqrtf(wave_sum(ss) * (1.0f / D) + EPS);
            bf16_t* hr = Hb + (size_t)m * D + 8 * lane;
#pragma unroll
            for (int j = 0; j < 4; ++j) { const f32x4 h0 = v[j][0] * rstd * av[j][0] + bv[j][0], h1 = v[j][1] * rstd * av[j][1] + bv[j][1]; *(u32x4*)(hr + 512 * j) = pg8::pack8(h0, h1); }
        }
        if (BOTH(0) || rep + 1 < NREP(0)) GRID_BAR();
    }
    if (IN(2)) {
        pg8::SegOrder1 S; S.so.init(M, PROJ, G, bx, NREP(2)); S.A = (const char*)Hb; S.B = (const char*)WinT; S.tstep = (size_t)256 * D * 2; S.nt = D / 64;
        pg8::EpiProj E{ws, SGA, args.conv_w, lds + HALO_OFF};
        pg8::gemm_stream<pg8::EpiProj, pg8::SegOrder1>(lds, D, S, E);
        if (BOTH(2)) GRID_BAR();
    }
    if (IN(3)) for (int rep = 0; rep < NREP(3); ++rep) {
        for (int idx = gtid; idx < 63 * 2 * (NCV / 4); idx += NT) {
            const int c4 = idx % (NCV / 4), pj = idx / (NCV / 4), j = pj & 1, pm = 1 + (pj >> 1), ch = 4 * c4;
            const f32x4 h0 = *(const f32x4*)(HPb + ((size_t)((pm - 1) * 2 + 0) * NCV + ch)), h1 = *(const f32x4*)(HPb + ((size_t)((pm - 1) * 2 + 1) * NCV + ch));
            const f32x4 w0 = *(const f32x4*)(args.conv_w + ch), w1 = *(const f32x4*)(args.conv_w + NCV + ch);
            const f32x4 qv = *(const f32x4*)(FXQb + ((size_t)(pm * 2 + j) * NCV + ch)), uu = *(const f32x4*)(FXUb + ((size_t)(pm * 2 + j) * NCV + ch));
            const f32x4 miss = (j == 0) ? (w1 * h1 + w0 * h0) : (w0 * h1);
            const f32x4 rv = qv * (uu + miss);
            u32x2 rw; rw.x = cvt_pk_bf16(rv[0], rv[1]); rw.y = cvt_pk_bf16(rv[2], rv[3]);
            *(u32x2*)(Rb + ((size_t)(256 * pm + j) * NCV + ch)) = rw;
        }
        for (int chunk = vcu; chunk < 256; chunk += G) {
            int g, hh, r, n0;
            if (chunk < 128) { g = 2; hh = chunk >> 4; r = chunk & 15; n0 = 0; } else { const int idx = chunk - 128; g = 1; hh = idx >> 4; r = (idx & 15) >> 2; n0 = (idx & 3) * 8; }
            const size_t go = (size_t)g * M * 1024;
            attn_chunk<false>(lds, Qb + go, Kb + go, Vb + go, 2 * g, hh, r, n0, 8, (g == 1) ? O1 : O2, LSE + (size_t)g * M * 8, nullptr, nullptr, nullptr, nullptr, nullptr, nullptr);
        }
        if (BOTH(3) || rep + 1 < NREP(3)) GRID_BAR();
    }
    if (IN(4)) for (int rep = 0; rep < NREP(4); ++rep) {
        for (int chunk = vcu; chunk < 256; chunk += G)
            attn_chunk<true>(lds, Qb, Kb, Vb, 0, chunk >> 5, 0, (chunk & 31) * 4, 4, nullptr, nullptr, O1, O2, LSE + (size_t)1 * M * 8, LSE + (size_t)2 * M * 8, SZ, AATT);
        if (BOTH(4) || rep + 1 < NREP(4)) GRID_BAR();
    }
    if (IN(5)) {
        pg8::SegOrder2 S; S.so.init(M, D, G, bx, NREP(5)); S.A0 = (const char*)AATT; S.B0 = (const char*)WaT; S.A1 = (const char*)Rb; S.B1 = (const char*)WcT; S.tstep = (size_t)256 * D * 2; S.nt0 = NZA / 64; S.nt1 = NCV / 64;
        pg8::EpiMerge E{MG, SGA, SGC, D};
        pg8::gemm_stream<pg8::EpiMerge, pg8::SegOrder2, true>(lds, D, S, E);
        if (BOTH(5)) GRID_BAR();
    }
    if (IN(6)) {
        pg8::SegOrder1 S; S.so.init(M, D, G, bx, NREP(6)); S.A = (const char*)MG; S.B = (const char*)WoT; S.tstep = (size_t)256 * D * 2; S.nt = D / 64;
        pg8::EpiBf16 E{Yb, D};
        pg8::gemm_stream<pg8::EpiBf16, pg8::SegOrder1>(lds, D, S, E);
        if (BOTH(6)) GRID_BAR();
    }
    if (IN(7)) {
        f32x4 gv[4][2];
#pragma unroll
        for (int j = 0; j < 4; ++j)
#pragma unroll
            for (int h = 0; h < 2; ++h) { const int k = 512 * j + 8 * lane + 4 * h; gv[j][h] = *(const f32x4*)(mod + 2 * D + k) * *(const f32x4*)(args.g_post + k); }
        for (int m = gw; m < M; m += NGW) {
            const bf16_t* yr = Yb + (size_t)m * D + 8 * lane; const float* xr = args.x + (size_t)m * D + 8 * lane; float* orow = args.out + (size_t)m * D + 8 * lane;
            f32x4 v[4][2], xv[4][2]; u32x4 yw[4]; float ss = 0.f;
#pragma unroll
            for (int j = 0; j < 4; ++j) { yw[j] = *(const u32x4*)(yr + 512 * j); xv[j][0] = *(const f32x4*)(xr + 512 * j); xv[j][1] = *(const f32x4*)(xr + 512 * j + 4); }
#pragma unroll
            for (int j = 0; j < 4; ++j) { pg8::unpack8(yw[j], v[j][0], v[j][1]);
#pragma unroll
                for (int h = 0; h < 2; ++h) { const f32x4 q = v[j][h] * v[j][h]; ss += (q[0] + q[1]) + (q[2] + q[3]); } }
            const float rstd = 1.0f / sqrtf(wave_sum(ss) * (1.0f / D) + EPS);
#pragma unroll
            for (int j = 0; j < 4; ++j)
#pragma unroll
                for (int h = 0; h < 2; ++h) *(f32x4*)(orow + 512 * j + 4 * h) = xv[j][h] + gv[j][h] * (v[j][h] * rstd);
        }
    }
#undef IN
#undef BOTH
#undef GRID_BAR
}

extern "C" void kernel_launch(void* const* d_in, const int* in_sizes, int n_in, void* d_out, int out_size, void* d_ws, size_t ws_size, hipStream_t stream) {
    static int grid = 0;
    if (grid == 0) {
        if (n_in != 12 || in_sizes[0] != M * D || out_size != M * D || ws_size < WS_END) { fprintf(stderr, "kernel_launch: unexpected shapes (n_in %d, in0 %d, out %d, ws %zu); nothing launched\n", n_in, n_in > 0 ? in_sizes[0] : -1, out_size, ws_size); grid = -1; return; }
        int dev = 0, cus = 0;
        if (hipGetDevice(&dev) != hipSuccess || hipDeviceGetAttribute(&cus, hipDeviceAttributeMultiprocessorCount, dev) != hipSuccess) { grid = -1; return; }
        if (hipFuncSetAttribute((const void*)mk_fwd, hipFuncAttributeMaxDynamicSharedMemorySize, LDS_BYTES) != hipSuccess) { fprintf(stderr, "kernel_launch: hipFuncSetAttribute failed\n"); grid = -1; return; }
        (void)hipGetLastError();
        grid = cus;
    }
    if (grid < 0) return;
    if (hipMemsetAsync((char*)d_ws + WS_CTL, 0, CTL_ZERO_BYTES, stream) != hipSuccess) return;
    Args a{};
    a.x = (const float*)d_in[0]; a.c = (const float*)d_in[1]; a.pos = (const int*)d_in[2]; a.g_pre = (const float*)d_in[3]; a.w_ada = (const float*)d_in[4]; a.b_ada = (const float*)d_in[5];
    a.w_in = (const float*)d_in[6]; a.conv_w = (const float*)d_in[7]; a.w_attn_o = (const float*)d_in[8]; a.w_conv_o = (const float*)d_in[9]; a.w_o = (const float*)d_in[10]; a.g_post = (const float*)d_in[11];
    a.out = (float*)d_out; a.ws = (unsigned char*)d_ws;
    for (int li = 0; li < N_LAUNCHES; ++li) {
        a.ph_lo = (N_LAUNCHES == 1) ? 0 : li; a.ph_hi = (N_LAUNCHES == 1) ? NPHASES : li + 1; a.li = li;
        hipLaunchKernelGGL(mk_fwd, dim3(grid), dim3(NWAVES * 64), LDS_BYTES, stream, a);
        if (hipPeekAtLastError() != hipSuccess) break;
    }
}
```

```cpp
#include <hip/hip_runtime.h>
#include <cstdio>
#include <cstdint>

#define GAS __attribute__((address_space(1)))
#define LAS __attribute__((address_space(3)))
typedef unsigned short bf16_t;
typedef short bf16x8 __attribute__((ext_vector_type(8)));
typedef short s16x4 __attribute__((ext_vector_type(4)));
typedef float f32x4 __attribute__((ext_vector_type(4)));
typedef float f32x2 __attribute__((ext_vector_type(2)));
typedef unsigned u32x4 __attribute__((ext_vector_type(4)));
typedef unsigned u32x2 __attribute__((ext_vector_type(2)));

constexpr int M = 16384, D = 2048, NQKV = 3072, NZA = 1024, NCV = 2048, PROJ = 22528, NMOD = 6144;
constexpr float EPS = 1e-6f;
constexpr float LOG2E = 1.4426950408889634f;
constexpr float QSCALE = 0.08838834764831845f * 1.4426950408889634f;

__constant__ float INVF[16] = {1.0f, 0.44036659598350525f, 0.1939227432012558f, 0.08539710193872452f, 0.03760603070259094f, 0.016560440883040428f,
    0.007292664609849453f, 0.0032114461064338684f, 0.0014142135623842478f, 0.0006227724370546639f, 0.00027424818836152554f, 0.00012076973507646471f,
    5.3182957344688475e-05f, 2.34199997066753e-05f, 1.0313385246263351e-05f, 4.541670477919979e-06f};

typedef __bf16 bf16x2_t __attribute__((ext_vector_type(2)));
__device__ __forceinline__ unsigned cvt_pk_bf16(float lo, float hi) { const f32x2 v = {lo, hi}; return __builtin_bit_cast(unsigned, __builtin_convertvector(v, bf16x2_t)); }
__device__ __forceinline__ float bf_lo(unsigned w) { return __builtin_bit_cast(float, w << 16); }
__device__ __forceinline__ float bf_hi(unsigned w) { return __builtin_bit_cast(float, w & 0xffff0000u); }
template <int CTRL> __device__ __forceinline__ float dpp_row_shr(float old, float src) { return __int_as_float(__builtin_amdgcn_update_dpp(__float_as_int(old), __float_as_int(src), CTRL, 0xf, 0xf, false)); }
__device__ __forceinline__ float silu_f(float v) { return v * __builtin_amdgcn_rcpf(1.0f + __builtin_amdgcn_exp2f(-v * LOG2E)); }
__device__ __forceinline__ float sigm_f(float v) { return __builtin_amdgcn_rcpf(1.0f + __builtin_amdgcn_exp2f(-v * LOG2E)); }

constexpr size_t MiB = 1u << 20;
constexpr size_t WS_CTL = 0, CTL_ZERO_BYTES = 32768;
constexpr size_t WS_MOD = 1 * MiB;
constexpr size_t WS_CS = 2 * MiB;
constexpr size_t WS_WIN = 4 * MiB;
constexpr size_t WS_WA = 92 * MiB, WS_WC = 100 * MiB, WS_WO = 108 * MiB;
constexpr size_t WS_H = 116 * MiB;
constexpr size_t WS_Q = 180 * MiB, WS_K = 276 * MiB, WS_V = 372 * MiB;
constexpr size_t WS_SZ = 468 * MiB;
constexpr size_t WS_R = 500 * MiB;
constexpr size_t WS_FX = 564 * MiB;
constexpr size_t WS_O2 = 628 * MiB;
constexpr size_t WS_LSE = 660 * MiB;
constexpr size_t WS_END = 662 * MiB;
constexpr size_t WS_O1 = 148 * MiB;
constexpr size_t WS_AATT = WS_K + 32 * MiB, WS_MG = WS_V + 32 * MiB, WS_Y = WS_R;

#ifndef PG8_A_AUX
#define PG8_A_AUX 0
#endif
#ifndef PG8_B_AUX
#define PG8_B_AUX 0
#endif
namespace pg8 {
constexpr int BM = 256, BK = 64, HALF = 128, HTB = HALF * BK * 2, STAGE_BYTES = 8 * HTB, NXCD = 8, WGM = 8;
__host__ __device__ __forceinline__ int lds_byte(int r, int c) { const int st = (r >> 4) * 2 + (c >> 5), rr = r & 15, cc = c & 31, ob = rr * 64 + cc * 2; return st * 1024 + (ob ^ (((ob >> 9) & 1) << 5)); }
__host__ __device__ __forceinline__ void stage_rc(int b, int& R, int& C) { const int st = b / 1024, sb = b % 1024, swz = sb ^ (((sb >> 9) & 1) << 5); R = (st >> 1) * 16 + swz / 64; C = (st & 1) * 32 + (swz % 64) / 2; }
__host__ __device__ __forceinline__ int perm32(int rho) { const int n = rho >> 4, i = rho & 15; return 8 * (i >> 2) + 4 * n + (i & 3); }

struct Unit { int pm, pn; };
struct Gemm { const bf16_t* A; const bf16_t* Bt; int M, N, K; };

struct StaticOrder {
    int nM, nN, nwg, G, c, rounds, rep;
    __host__ __device__ void init(int M_, int N_, int G_, int c_, int rep_ = 1) { nM = M_ / BM; nN = N_ / BM; nwg = nM * nN; G = G_; c = c_; rounds = (nwg + G - 1) / G; rep = rep_; }
    __host__ __device__ bool next(int i, Unit& u) const {
        if (i >= rounds * rep) return false;
        i = i % rounds;
        const long L = (long)i * G + c; if (L >= nwg) return false;
        int wgid = (int)L; { const int q = nwg / NXCD, r = nwg % NXCD, xcd = wgid % NXCD, off = wgid / NXCD; wgid = (xcd < r ? xcd * (q + 1) : r * (q + 1) + (xcd - r) * q) + off; }
        const int nig = WGM * nN, gid = wgid / nig, fm = gid * WGM, gsz = (nM - fm) < WGM ? (nM - fm) : WGM;
        u.pm = fm + ((wgid % nig) % gsz); u.pn = (wgid % nig) / gsz; return true;
    }
    __device__ __forceinline__ void a_ready(const Unit&) const {}
    __device__ __forceinline__ void done(const Unit&) const {}
};


struct Seg { const char* A; const char* B; int nt; int mid; Unit u; };
__device__ __forceinline__ const char* rfl_ptr(const char* p) { const unsigned long long v = (unsigned long long)p; const unsigned lo = __builtin_amdgcn_readfirstlane((unsigned)v), hi = __builtin_amdgcn_readfirstlane((unsigned)(v >> 32)); return (const char*)(((unsigned long long)hi << 32) | lo); }
__device__ __forceinline__ void rfl_seg(Seg& o) { o.A = rfl_ptr(o.A); o.B = rfl_ptr(o.B); o.nt = __builtin_amdgcn_readfirstlane(o.nt); o.mid = __builtin_amdgcn_readfirstlane(o.mid); o.u.pm = __builtin_amdgcn_readfirstlane(o.u.pm); o.u.pn = __builtin_amdgcn_readfirstlane(o.u.pn); }
constexpr int NSTORE = 16;
template <class Epi, class Sched, bool DUAL = false>
__device__ __forceinline__ void gemm_stream(LAS unsigned char* lds, const int pitch, const Sched& S, const Epi& E) {
    const int tid = threadIdx.x, wid = __builtin_amdgcn_readfirstlane(tid >> 6), lane = tid & 63, wr = wid >> 2, wc = wid & 3, fr = lane & 15, fq = lane >> 4;
    unsigned voffA[2], voffB[2];
#pragma unroll
    for (int i = 0; i < 2; ++i) { int R, C; stage_rc(tid * 16 + i * 8192, R, C); const int Rb = Epi::PERM ? ((R & ~31) + perm32(R & 31)) : R;
        voffA[i] = (unsigned)(R * pitch + C) * 2u; voffB[i] = (unsigned)(Rb * pitch + C) * 2u; }
    const size_t kstep = (size_t)(BK * 2);
    const size_t hstep = (size_t)HALF * pitch * 2;
    const unsigned ldsw = (unsigned)wid * 1024u;
    const int aoff = lds_byte(wr * 64 + fr, fq * 8), boff = lds_byte(wc * 32 + fr, fq * 8);
#define PG8_SA(b, h) (((b) * 2 + (h)) * HTB)
#define PG8_SB(b, h) ((4 + (b) * 2 + (h)) * HTB)
#define PG8_STAGE(bufoff, gbase, voff) do { const char* _gb = (const char*)(gbase); asm volatile("" : "+s"(_gb));   \
        _Pragma("unroll") for (int _i = 0; _i < 2; ++_i) { asm volatile("" : "+v"((voff)[_i]));   \
        __builtin_amdgcn_global_load_lds((const unsigned*)(_gb + (voff)[_i]), (LAS unsigned*)(lds + (bufoff) + ldsw + _i * 8192), 16, 0, PG8_A_AUX); } } while (0)
#define PG8_STAGEB(bufoff, gbase, voff) do { const char* _gb = (const char*)(gbase); asm volatile("" : "+s"(_gb)); \
        _Pragma("unroll") for (int _i = 0; _i < 2; ++_i) { asm volatile("" : "+v"((voff)[_i])); \
        __builtin_amdgcn_global_load_lds((const unsigned*)(_gb + (voff)[_i]), (LAS unsigned*)(lds + (bufoff) + ldsw + _i * 8192), 16, 0, PG8_B_AUX); } } while (0)
#define PG8_LDA(dst, b, h) do { _Pragma("unroll") for (int m = 0; m < 4; ++m) _Pragma("unroll") for (int k = 0; k < 2; ++k) dst[m][k] = *(const LAS bf16x8*)(lds + PG8_SA(b, h) + aoff + m * 2048 + k * 1024); } while (0)
#define PG8_LDB(dst, b, h) do { _Pragma("unroll") for (int n = 0; n < 2; ++n) _Pragma("unroll") for (int k = 0; k < 2; ++k) dst[n][k] = *(const LAS bf16x8*)(lds + PG8_SB(b, h) + boff + n * 2048 + k * 1024); } while (0)
#define PG8_MMA(ai, bj, At, Bt) do { __builtin_amdgcn_s_setprio(1); _Pragma("unroll") for (int m = 0; m < 4; ++m) _Pragma("unroll") for (int n = 0; n < 2; ++n) _Pragma("unroll") for (int k = 0; k < 2; ++k) \
        acc[ai][bj][m][n] = __builtin_amdgcn_mfma_f32_16x16x32_bf16(Bt[n][k], At[m][k], acc[ai][bj][m][n], 0, 0, 0); __builtin_amdgcn_s_setprio(0); } while (0)
#define PG8_WAIT_V(n) asm volatile("s_waitcnt vmcnt(" #n ")" ::: "memory")
#define PG8_WAIT_VR() PG8_WAIT_V(8)
#define PG8_WAIT_L(n) asm volatile("s_waitcnt lgkmcnt(" #n ")" ::: "memory")
#define PG8_BAR __builtin_amdgcn_s_barrier()
#define PG8_SCHED __builtin_amdgcn_sched_barrier(0)
    Seg cur, nxt; int si = 0;
    if (!S.seg(0, cur)) return;
    f32x4 acc[2][2][4][2];
#pragma unroll
    for (int a = 0; a < 2; ++a)
#pragma unroll
        for (int b = 0; b < 2; ++b)
#pragma unroll
            for (int m = 0; m < 4; ++m)
#pragma unroll
                for (int n = 0; n < 2; ++n) acc[a][b][m][n] = (f32x4){0.f, 0.f, 0.f, 0.f};
    bf16x8 At[4][2], B0[2][2], B1[2][2];
    {
        const char* cA = cur.A; const char* cB = cur.B;
        PG8_STAGEB(PG8_SB(0, 0), cB, voffB); PG8_STAGEB(PG8_SB(0, 1), cB + hstep, voffB); PG8_STAGE(PG8_SA(0, 0), cA, voffA); PG8_STAGE(PG8_SA(0, 1), cA + hstep, voffA);
        if (wr == 1) PG8_BAR;
        PG8_WAIT_V(2); PG8_BAR;
        PG8_STAGEB(PG8_SB(1, 0), cB + kstep, voffB); PG8_STAGE(PG8_SA(1, 0), cA + kstep, voffA); PG8_STAGEB(PG8_SB(1, 1), cB + hstep + kstep, voffB);
        PG8_WAIT_V(6); PG8_BAR;
    }
    bool fresh = true, relax = false;
    for (;;) {
        const bool has_next = S.seg(si + 1, nxt);
        const char* cA = cur.A; const char* cB = cur.B; const int nt = cur.nt;
        const char* nA = has_next ? nxt.A : cA; const char* nB = has_next ? nxt.B : cB;
#pragma nounroll
        for (int t = 0; t < nt; t += 2) {
            const bool first = (t == 0) && !fresh;
            const bool last = (t == nt - 2);
            const char* a1 = cA + (size_t)(t + 1) * kstep;
            const char* a2 = last ? nA : cA + (size_t)(t + 2) * kstep; const char* b2 = last ? nB : cB + (size_t)(t + 2) * kstep;
            const char* a3 = a2 + kstep; const char* b3 = b2 + kstep;
            PG8_LDB(B0, 0, 0); PG8_LDB(B1, 0, 1); PG8_SCHED; PG8_LDA(At, 0, 0); if (!first) PG8_STAGE(PG8_SA(1, 1), a1 + hstep, voffA);
            PG8_WAIT_VR(); PG8_WAIT_L(0); PG8_BAR; PG8_MMA(0, 0, At, B0); PG8_MMA(0, 1, At, B1); PG8_BAR; PG8_SCHED;
            PG8_LDA(At, 0, 1); PG8_STAGEB(PG8_SB(0, 0), b2, voffB); PG8_STAGEB(PG8_SB(0, 1), b2 + hstep, voffB); PG8_STAGE(PG8_SA(0, 0), a2, voffA);
            PG8_WAIT_VR(); PG8_WAIT_L(0); PG8_BAR; PG8_MMA(1, 0, At, B0); PG8_MMA(1, 1, At, B1); PG8_BAR; PG8_SCHED;
            PG8_LDB(B0, 1, 0); PG8_LDB(B1, 1, 1); PG8_SCHED; PG8_LDA(At, 1, 0); PG8_STAGE(PG8_SA(0, 1), a2 + hstep, voffA);
            PG8_WAIT_VR(); PG8_WAIT_L(0); PG8_BAR; PG8_MMA(0, 0, At, B0); PG8_MMA(0, 1, At, B1); PG8_BAR; PG8_SCHED;
            PG8_LDA(At, 1, 1); PG8_STAGEB(PG8_SB(1, 0), b3, voffB); PG8_STAGEB(PG8_SB(1, 1), b3 + hstep, voffB); PG8_STAGE(PG8_SA(1, 0), a3, voffA);
            PG8_WAIT_V(8); PG8_WAIT_L(0); PG8_BAR; PG8_MMA(1, 0, At, B0); PG8_MMA(1, 1, At, B1); PG8_BAR; PG8_SCHED;
        }
        if (wr == 0) PG8_BAR;
        PG8_STAGE(PG8_SA(1, 1), nA + kstep + hstep, voffA);
        PG8_SCHED;
        if constexpr (DUAL) E.scale(acc, cur.u, wr, wc, fr, fq, cur.mid != 0);
        if (DUAL && cur.mid) { relax = false; }
        else {
            E(acc, cur.u, wr, wc, fr, fq); relax = true;
#pragma unroll
            for (int a = 0; a < 2; ++a)
#pragma unroll
                for (int b = 0; b < 2; ++b)
#pragma unroll
                    for (int m = 0; m < 4; ++m)
#pragma unroll
                        for (int n = 0; n < 2; ++n) acc[a][b][m][n] = (f32x4){0.f, 0.f, 0.f, 0.f};
        }
        PG8_SCHED;
        if (!has_next) break;
        cur = nxt; ++si; fresh = false;
        if (wr == 1) PG8_BAR;
    }
    PG8_WAIT_V(0);
    PG8_BAR;
#undef PG8_SA
#undef PG8_SB
#undef PG8_STAGE
#undef PG8_STAGEB
#undef PG8_LDA
#undef PG8_LDB
#undef PG8_MMA
#undef PG8_WAIT_V
#undef PG8_WAIT_VR
#undef PG8_WAIT_L
#undef PG8_BAR
#undef PG8_SCHED
}
struct SegOrder1 {
    StaticOrder so; const char* A; const char* B; size_t tstep; int nt;
    __device__ __forceinline__ bool seg(int s, Seg& o) const { Unit u; if (!so.next(s, u)) return false; o.A = A + (size_t)u.pm * tstep; o.B = B + (size_t)u.pn * tstep; o.nt = nt; o.mid = 0; o.u = u; rfl_seg(o); return true; }
};

__device__ __forceinline__ u32x4 pack8(const f32x4 v0, const f32x4 v1) { u32x4 w; w.x = cvt_pk_bf16(v0[0], v0[1]); w.y = cvt_pk_bf16(v0[2], v0[3]); w.z = cvt_pk_bf16(v1[0], v1[1]); w.w = cvt_pk_bf16(v1[2], v1[3]); return w; }
__device__ __forceinline__ void unpack8(const u32x4 w, f32x4& v0, f32x4& v1) { v0 = (f32x4){bf_lo(w.x), bf_hi(w.x), bf_lo(w.y), bf_hi(w.y)}; v1 = (f32x4){bf_lo(w.z), bf_hi(w.z), bf_lo(w.w), bf_hi(w.w)}; }

#ifdef NT_STORES
#define ST16(p, v) __builtin_nontemporal_store((v), (u32x4*)(p))
#define ST8(p, v) __builtin_nontemporal_store((v), (u32x2*)(p))
#else
#define ST16(p, v) (*(u32x4*)(p) = (v))
#define ST8(p, v) (*(u32x2*)(p) = (v))
#endif
struct EpiProj {
    static constexpr bool PERM = true;
    __device__ __forceinline__ void mid(f32x4 (&)[2][2][4][2], const Unit&, int, int, int, int) const {}
    unsigned char* ws; bf16_t* SGA; const float* cw; LAS unsigned char* halo;
    __device__ __forceinline__ void operator()(const f32x4 (&acc)[2][2][4][2], const Unit& u, int wr, int wc, int fr, int fq) const {
        int pn = u.pn, upm = u.pm; asm volatile("" : "+s"(pn), "+s"(upm));
        const int row0 = upm * BM + wr * 64 + fr; const int lc = wc * 32 + 8 * fq;
        bf16_t* const Q = (bf16_t*)(ws + WS_Q); bf16_t* const Kb = (bf16_t*)(ws + WS_K); bf16_t* const V = (bf16_t*)(ws + WS_V); bf16_t* const SZ = (bf16_t*)(ws + WS_SZ); bf16_t* const R = (bf16_t*)(ws + WS_R);
        bf16_t* const SGC = SGA + (size_t)M * D; const float* const cs = (const float*)(ws + WS_CS);
        float* const HP = (float*)(ws + WS_FX); float* const FXQ = HP + (size_t)64 * 2 * NCV; float* const FXU = FXQ + (size_t)64 * 2 * NCV;
        if (pn < 24) {
            const bool isq = pn < 12; const int tq = isq ? pn : pn - 12; bf16_t* base = (isq ? Q : Kb) + (size_t)(tq >> 2) * M * 1024; const int colt = (tq & 3) * BM; const float sc = isq ? QSCALE : 1.0f;
            const bool rot = (fq == 0);
            f32x4 cv[2][4], sv[2][4];
#pragma unroll
            for (int ai = 0; ai < 2; ++ai)
#pragma unroll
                for (int m = 0; m < 4; ++m) { const float* cr = cs + (size_t)(row0 + ai * HALF + m * 16) * 32 + 4 * wc; cv[ai][m] = *(const f32x4*)cr; sv[ai][m] = *(const f32x4*)(cr + 16); }
#pragma unroll
            for (int ai = 0; ai < 2; ++ai)
#pragma unroll
                for (int m = 0; m < 4; ++m) {
                    const f32x4 c = rot ? cv[ai][m] * sc : (f32x4){sc, sc, sc, sc}, sn = rot ? sv[ai][m] * sc : (f32x4){0.f, 0.f, 0.f, 0.f};
                    bf16_t* rowp = base + (size_t)(row0 + ai * HALF + m * 16) * 1024 + colt + lc;
#pragma unroll
                    for (int bj = 0; bj < 2; ++bj) { const f32x4 v0 = acc[ai][bj][m][0], v1 = acc[ai][bj][m][1];
                        ST16((rowp + bj * HALF), (pack8(v0 * c - v1 * sn, v0 * sn + v1 * c))); }
                }
        } else if (pn < 36) {
            const int tv = pn - 24, colt = (tv & 3) * BM; bf16_t* vbase = V + (size_t)(tv >> 2) * M * 1024;
#pragma unroll
            for (int ai = 0; ai < 2; ++ai)
#pragma unroll
                for (int m = 0; m < 4; ++m) { bf16_t* rowp = vbase + (size_t)(row0 + ai * HALF + m * 16) * 1024 + colt + lc;
#pragma unroll
                    for (int bj = 0; bj < 2; ++bj) ST16((rowp + bj * HALF), (pack8(acc[ai][bj][m][0], acc[ai][bj][m][1]))); }
        } else if (pn < 40) {
            const int colt = (pn - 36) * BM;
#pragma unroll
            for (int ai = 0; ai < 2; ++ai)
#pragma unroll
                for (int m = 0; m < 4; ++m) { bf16_t* rowp = SZ + (size_t)(row0 + ai * HALF + m * 16) * NZA + colt + lc;
#pragma unroll
                    for (int bj = 0; bj < 2; ++bj) ST16((rowp + bj * HALF), (pack8(acc[ai][bj][m][0], acc[ai][bj][m][1]))); }
        } else if (pn < 72) {
            int chl = 16 * wc + 4 * fq, frh = fr - 14; asm volatile("" : "+v"(chl), "+v"(frh));
            const int ct = pn - 40, chb = 64 * ct + chl, pm = upm;
            const f32x4 w0 = *(const f32x4*)(cw + chb), w1 = *(const f32x4*)(cw + NCV + chb), w2 = *(const f32x4*)(cw + 2 * NCV + chb);
#pragma unroll
            for (int ai = 0; ai < 2; ++ai)
#pragma unroll
                for (int m = 0; m < 4; ++m) { const f32x4 pv = acc[ai][0][m][1] * acc[ai][1][m][0];
                    const int gi = 8 * ai + 4 * wr + m;
                    if (fr >= 14) { *(LAS f32x4*)(halo + (size_t)(((gi * 2 + frh) * 64 + chl) * 4)) = pv;
                        if (gi == 15) *(f32x4*)(HP + ((size_t)(pm * 2 + frh) * NCV + chb)) = pv; } }
            asm volatile("s_waitcnt lgkmcnt(0)" ::: "memory"); __builtin_amdgcn_s_barrier(); asm volatile("" ::: "memory");
#pragma unroll
            for (int ai = 0; ai < 2; ++ai)
#pragma unroll
                for (int m = 0; m < 4; ++m) {
                    const int gi = 8 * ai + 4 * wr + m; const int gp = gi > 0 ? gi - 1 : 0;
                    f32x4 H0 = *(const LAS f32x4*)(halo + (size_t)(((gp * 2 + 0) * 64 + chl) * 4)), H1 = *(const LAS f32x4*)(halo + (size_t)(((gp * 2 + 1) * 64 + chl) * 4));
                    if (gi == 0) { H0 = (f32x4){0.f, 0.f, 0.f, 0.f}; H1 = H0; }
                    const f32x4 Hs = (fr == 1) ? H1 : H0, pvv = acc[ai][0][m][1] * acc[ai][1][m][0];
                    f32x4 Pm1, Pm2, qv;
#pragma unroll
                    for (int j = 0; j < 4; ++j) {
                        const float pj = pvv[j], h1j = H1[j], hsj = Hs[j];
                        Pm1[j] = dpp_row_shr<0x111>(h1j, pj); Pm2[j] = dpp_row_shr<0x112>(hsj, pj);
                        qv[j] = acc[ai][0][m][0][j] * silu_f(acc[ai][1][m][1][j]); }
                    const f32x4 uu = w2 * pvv + w1 * Pm1 + w0 * Pm2, rv = qv * uu;
                    const size_t ro = (size_t)(row0 + ai * HALF + m * 16) * NCV + chb;
                    u32x2 rw; rw.x = cvt_pk_bf16(rv[0], rv[1]); rw.y = cvt_pk_bf16(rv[2], rv[3]);
                    ST8((R + ro), (rw));
                    if (gi == 0 && fr < 2 && pm > 0) { *(f32x4*)(FXQ + ((size_t)(pm * 2 + fr) * NCV + chb)) = qv; *(f32x4*)(FXU + ((size_t)(pm * 2 + fr) * NCV + chb)) = uu; }
                }
        } else {
            const int colt = (pn - 72) * HALF;
#pragma unroll
            for (int ai = 0; ai < 2; ++ai)
#pragma unroll
                for (int m = 0; m < 4; ++m) { const size_t ro = (size_t)(row0 + ai * HALF + m * 16) * D + colt + lc;
                    f32x4 r[2], c[2];
#pragma unroll
                    for (int n = 0; n < 2; ++n)
#pragma unroll
                        for (int j = 0; j < 4; ++j) { const float pc = 1.0f + __builtin_amdgcn_exp2f(-acc[ai][1][m][n][j] * LOG2E), pa = 1.0f + __builtin_amdgcn_exp2f(-acc[ai][0][m][n][j] * LOG2E);
                            const float t = __builtin_amdgcn_rcpf(pa * pc); c[n][j] = pa * t; r[n][j] = pc * pc * t; }
                    ST16((SGA + ro), (pack8(r[0], r[1]))); ST16((SGC + ro), (pack8(c[0], c[1]))); }
        }
    }
};
struct EpiMerge {
    static constexpr bool PERM = true;
    bf16_t* O; const bf16_t* RHO; const bf16_t* SC; int ldc;
    __device__ __forceinline__ size_t lane_off(const Unit& u, int wr, int wc, int fr, int fq, int ai) const {
        size_t o = (size_t)(u.pm * BM + wr * 64 + fr + ai * HALF) * ldc + u.pn * BM + wc * 32 + 8 * fq; asm volatile("" : "+v"(o)); return o; }
    __device__ __forceinline__ void scale(f32x4 (&acc)[2][2][4][2], const Unit& u, int wr, int wc, int fr, int fq, bool is_mid) const {
        const bf16_t* G = is_mid ? RHO : SC;
#pragma unroll
        for (int ai = 0; ai < 2; ++ai) {
            const bf16_t* p = G + lane_off(u, wr, wc, fr, fq, ai);
            u32x4 gw[4][2];
#pragma unroll
            for (int m = 0; m < 4; ++m)
#pragma unroll
                for (int bj = 0; bj < 2; ++bj) gw[m][bj] = *(const u32x4*)(p + (size_t)m * 16 * ldc + bj * HALF);
#pragma unroll
            for (int m = 0; m < 4; ++m)
#pragma unroll
                for (int bj = 0; bj < 2; ++bj) { f32x4 g0, g1; unpack8(gw[m][bj], g0, g1); acc[ai][bj][m][0] *= g0; acc[ai][bj][m][1] *= g1; }
        }
    }
    __device__ __forceinline__ void mid(f32x4 (&)[2][2][4][2], const Unit&, int, int, int, int) const {}
    __device__ __forceinline__ void operator()(const f32x4 (&acc)[2][2][4][2], const Unit& u, int wr, int wc, int fr, int fq) const {
#pragma unroll
        for (int ai = 0; ai < 2; ++ai) {
            bf16_t* q = O + lane_off(u, wr, wc, fr, fq, ai);
#pragma unroll
            for (int m = 0; m < 4; ++m)
#pragma unroll
                for (int bj = 0; bj < 2; ++bj) *(u32x4*)(q + (size_t)m * 16 * ldc + bj * HALF) = pack8(acc[ai][bj][m][0], acc[ai][bj][m][1]);
        }
    }
};
struct EpiBf16 {
    static constexpr bool PERM = true;
    __device__ __forceinline__ void mid(f32x4 (&)[2][2][4][2], const Unit&, int, int, int, int) const {}
    bf16_t* O; int ldc;
    __device__ __forceinline__ void operator()(const f32x4 (&acc)[2][2][4][2], const Unit& u, int wr, int wc, int fr, int fq) const {
        const int row0 = u.pm * BM + wr * 64 + fr, col0 = u.pn * BM + wc * 32 + 8 * fq;
#pragma unroll
        for (int ai = 0; ai < 2; ++ai)
#pragma unroll
            for (int m = 0; m < 4; ++m) { bf16_t* rowp = O + (size_t)(row0 + ai * HALF + m * 16) * ldc + col0;
#pragma unroll
                for (int bj = 0; bj < 2; ++bj) *(u32x4*)(rowp + bj * HALF) = pack8(acc[ai][bj][m][0], acc[ai][bj][m][1]); }
    }
};
struct SegOrder2 {
    StaticOrder so; const char *A0, *B0, *A1, *B1; size_t tstep; int nt0, nt1;
    __device__ __forceinline__ bool seg(int s_, Seg& o) const { Unit u; if (!so.next(s_ >> 1, u)) return false; const int h = s_ & 1;
        o.A = (h ? A1 : A0) + (size_t)u.pm * tstep; o.B = (h ? B1 : B0) + (size_t)u.pn * tstep; o.nt = h ? nt1 : nt0; o.mid = !h; o.u = u; rfl_seg(o); return true; }
};
}

#ifndef PG8_SP2
#define PG8_SP2 true
#endif
#ifndef PG8_ALIGN
#define PG8_ALIGN true
#endif

constexpr int NWAVES = 8;
#ifndef MK_N_LAUNCHES
#define MK_N_LAUNCHES 1
#endif
constexpr int NPHASES = 8;
constexpr int N_LAUNCHES = MK_N_LAUNCHES;

constexpr int CW_BAR = 4096, CW_MODCNT = 8000;
#define XCD_BAR_WORDS 3456

constexpr int RING_BYTES = 131072;
constexpr int LDSCTL_OFF = RING_BYTES, MISC_OFF = LDSCTL_OFF + 320, HALO_OFF = RING_BYTES + 1024;
constexpr int LDS_BYTES = 151552;
constexpr int ATT_STG_OFF = RING_BYTES + 1024, ATT_L0_OFF = ATT_STG_OFF + 16384;

typedef GAS unsigned gu32;
#define RLX_AGENT __ATOMIC_RELAXED, __HIP_MEMORY_SCOPE_AGENT

#define XB_TMO      128
#define XB_XCNT(j)  (256  + 64 * (j))
#define XB_XSUB(j)  (1280 + 64 * (j))
#define XB_XGEN(j)  (2304 + 64 * (j))
#define XB_TOP      3328
#define XB_TOPGEN   3392
#define XB_SPIN_CAP (1u << 18)

__device__ __forceinline__ unsigned xb_ld(unsigned* p)              { return __hip_atomic_load(p, __ATOMIC_RELAXED, __HIP_MEMORY_SCOPE_AGENT); }
__device__ __forceinline__ unsigned xb_add(unsigned* p, unsigned v) { return __hip_atomic_fetch_add(p, v, __ATOMIC_RELAXED, __HIP_MEMORY_SCOPE_AGENT); }
__device__ __forceinline__ unsigned xb_xcc_id() { return (unsigned)__builtin_amdgcn_s_getreg((3 << 11) | 20) & 0xFu; }
#define XB_SPIN(cond, bar) do { unsigned _sp = 0; while (cond) { __builtin_amdgcn_s_sleep(1); \
    if ((++_sp & 255u) == 0u) { if (xb_ld(&(bar)[XB_TMO])) break; if (_sp > XB_SPIN_CAP) { atomicAdd(&(bar)[XB_TMO], 1u); break; } } } } while (0)

struct XcdBarrier { unsigned* bar; unsigned x; volatile LAS unsigned* st; };

__device__ __forceinline__ XcdBarrier xcd_barrier_post(unsigned* bar, volatile LAS unsigned* st) {
    XcdBarrier b; b.bar = bar; b.x = xb_xcc_id(); b.st = st;
    if (threadIdx.x == 0) (void)xb_add(&bar[XB_XCNT(b.x)], 1u);
    return b;
}
__device__ __forceinline__ void xcd_barrier_complete(unsigned* bar, unsigned x, unsigned& nloc, unsigned& nx) {
    const unsigned G = gridDim.x * gridDim.y * gridDim.z;
    unsigned sum, cnt, mine, sp = 0u;
    for (;;) {
        sum = 0u; cnt = 0u; mine = 0u;
#pragma unroll
        for (unsigned j = 0; j < 16; ++j) { const unsigned c = xb_ld(&bar[XB_XCNT(j)]); sum += c; cnt += (c > 0u) ? 1u : 0u; mine = (j == x) ? c : mine; }
        if (sum == G) break;
        __builtin_amdgcn_s_sleep(1);
        if ((++sp & 255u) == 0u) { if (xb_ld(&bar[XB_TMO])) break; if (sp > XB_SPIN_CAP) { atomicAdd(&bar[XB_TMO], 1u); break; } }
    }
    nloc = mine > 0u ? mine : 1u; nx = cnt > 0u ? cnt : 1u;
}
__device__ __forceinline__ void xcd_barrier(const XcdBarrier& b) {
    asm volatile("s_waitcnt vmcnt(0)" ::: "memory");
    __syncthreads();
    if (threadIdx.x == 0) {
        unsigned* bar = b.bar;
        __builtin_amdgcn_s_waitcnt(0);
        unsigned nloc = b.st[0], nx = b.st[1];
        if (nloc == 0u) { xcd_barrier_complete(bar, b.x, nloc, nx); b.st[0] = nloc; b.st[1] = nx; }
        const unsigned old = xb_add(&bar[XB_XSUB(b.x)], 1u);
        const unsigned gen = old / nloc;
        if (old + 1u == (gen + 1u) * nloc) {
            __builtin_amdgcn_fence(__ATOMIC_RELEASE, "agent");
            asm volatile("s_waitcnt vmcnt(0)" ::: "memory");
            const unsigned og = xb_add(&bar[XB_TOP], 1u);
            const unsigned tg = og / nx;
            if (og + 1u == (tg + 1u) * nx) xb_add(&bar[XB_TOPGEN], 1u);
            else XB_SPIN(xb_ld(&bar[XB_TOPGEN]) == tg, bar);
            __builtin_amdgcn_fence(__ATOMIC_ACQUIRE, "agent");
            xb_add(&bar[XB_XGEN(b.x)], 1u);
            asm volatile("s_waitcnt vmcnt(0)" ::: "memory");
        } else {
            XB_SPIN(xb_ld(&bar[XB_XGEN(b.x)]) == gen, bar);
            __builtin_amdgcn_fence(__ATOMIC_ACQUIRE, "agent");
            asm volatile("s_waitcnt vmcnt(0)" ::: "memory");
        }
    }
    __syncthreads();
}

#define LDS_WAIT() asm volatile("s_waitcnt lgkmcnt(0)" ::: "memory")
__device__ __forceinline__ float wave_sum(float v) {
#pragma unroll
    for (int o = 1; o < 64; o <<= 1) v += __shfl_xor(v, o);
    return v;
}
__device__ __forceinline__ unsigned f2bf(float f) { unsigned u = __builtin_bit_cast(unsigned, f); return (u + 0x7fffu + ((u >> 16) & 1u)) >> 16; }
__device__ __forceinline__ unsigned pk2(float lo, float hi) { return f2bf(lo) | (f2bf(hi) << 16); }

__device__ __forceinline__ int proj_orig_col(int n) {
    const int tile = n >> 8, c = n & 255;
    if (tile < 24) { const int c7 = n & 127, wc = c7 >> 5, fq = (c7 >> 3) & 3, nn = (c7 >> 2) & 1, j = c7 & 3;
        const int dim = (fq == 0) ? (4 * wc + j + 16 * nn) : (32 + wc * 24 + (fq - 1) * 8 + 4 * nn + j); return (n & ~127) + dim; }
    if (tile < 40) return n;
    if (tile < 72) { const int kind = 2 * (c >> 7) + ((c >> 2) & 1), chl = 16 * ((c >> 5) & 3) + 4 * ((c >> 3) & 3) + (c & 3); return 10240 + kind * 2048 + 64 * (tile - 40) + chl; }
    return 18432 + (c >> 7) * 2048 + 128 * (tile - 72) + (c & 127);
}
struct TItem { const float* src; bf16_t* dst; int N; };
__device__ __forceinline__ void t_decode(const float* W, int N, bf16_t* WT, int pitch, bool remap, int item, int lane, TItem& d) {
    const int nblk = N / 32, kb = item / nblk, nb = item % nblk, k0 = 64 * kb, n0 = 32 * nb;
    const int ncol = remap ? proj_orig_col(n0 + (lane & 31)) : n0 + (lane & 31);
    d.src = W + (size_t)(k0 + (lane >> 5)) * N + ncol; d.dst = WT + (size_t)(n0 + (lane >> 3)) * pitch + k0 + 8 * (lane & 7); d.N = N;
}
__device__ __forceinline__ void t_load(const TItem& d, float (&wv)[32]) {
#pragma unroll
    for (int i = 0; i < 32; ++i) wv[i] = d.src[(size_t)(2 * i) * d.N];
}
__device__ __forceinline__ void t_finish(const TItem& d, const float (&wv)[32], int pitch, LAS float* scr, int lane) {
#pragma unroll
    for (int i = 0; i < 32; ++i) scr[(2 * i + (lane >> 5)) * 33 + (lane & 31)] = wv[i];
    LDS_WAIT(); asm volatile("" ::: "memory");
    const int c = lane & 7;
#pragma unroll
    for (int j = 0; j < 4; ++j) { const int n = (lane >> 3) + 8 * j; const LAS float* s = scr + (8 * c) * 33 + n;
        u32x4 o; o.x = pk2(s[0 * 33], s[1 * 33]); o.y = pk2(s[2 * 33], s[3 * 33]); o.z = pk2(s[4 * 33], s[5 * 33]); o.w = pk2(s[6 * 33], s[7 * 33]);
        *(u32x4*)(d.dst + (size_t)(8 * j) * pitch) = o; }
    LDS_WAIT(); asm volatile("" ::: "memory");
}

__device__ __forceinline__ void sincos_f64(float ang, float& s, float& c) {
    const double x = (double)ang;
    const double n = __builtin_rint(x * 0.15915494309189535);
    double r = __builtin_fma(-n, 6.283185307179586, x); r = __builtin_fma(-n, 2.4492935982947064e-16, r);
    const double r2 = r * r;
    double ps = 1.0 / 51090942171709440000.0;
    ps = __builtin_fma(ps, r2, -1.0 / 121645100408832000.0);
    ps = __builtin_fma(ps, r2, 1.0 / 355687428096000.0);
    ps = __builtin_fma(ps, r2, -1.0 / 1307674368000.0);
    ps = __builtin_fma(ps, r2, 1.0 / 6227020800.0);
    ps = __builtin_fma(ps, r2, -1.0 / 39916800.0);
    ps = __builtin_fma(ps, r2, 1.0 / 362880.0);
    ps = __builtin_fma(ps, r2, -1.0 / 5040.0);
    ps = __builtin_fma(ps, r2, 1.0 / 120.0);
    ps = __builtin_fma(ps, r2, -1.0 / 6.0);
    ps = __builtin_fma(ps, r2, 1.0);
    double pc = -1.0 / 1124000727777607680000.0;
    pc = __builtin_fma(pc, r2, 1.0 / 2432902008176640000.0);
    pc = __builtin_fma(pc, r2, -1.0 / 6402373705728000.0);
    pc = __builtin_fma(pc, r2, 1.0 / 20922789888000.0);
    pc = __builtin_fma(pc, r2, -1.0 / 87178291200.0);
    pc = __builtin_fma(pc, r2, 1.0 / 479001600.0);
    pc = __builtin_fma(pc, r2, -1.0 / 3628800.0);
    pc = __builtin_fma(pc, r2, 1.0 / 40320.0);
    pc = __builtin_fma(pc, r2, -1.0 / 720.0);
    pc = __builtin_fma(pc, r2, 1.0 / 24.0);
    pc = __builtin_fma(pc, r2, -0.5);
    pc = __builtin_fma(pc, r2, 1.0);
    s = (float)(r * ps); c = (float)pc;
}

__device__ __forceinline__ unsigned attn_offk(unsigned slot, unsigned row, unsigned ch) { return slot * 32768u + 256u * row + 16u * (ch ^ (row & 15u)); }
__device__ __forceinline__ unsigned attn_offv(unsigned slot, unsigned lrow, unsigned ch) { return 65536u + slot * 32768u + 256u * lrow + 16u * (ch ^ (((lrow & 3u) << 2) | ((lrow >> 2) & 3u))); }
__device__ __forceinline__ unsigned attn_lrow(unsigned k) { return (k & ~31u) | (((k >> 2) & 3u) << 3) | (((k >> 4) & 1u) << 2) | (k & 3u); }

template <bool COMBINE>
__device__ __forceinline__ void attn_chunk(LAS unsigned char* lds, const bf16_t* Qg, const bf16_t* Kg, const bf16_t* Vg, const int dsh, const int hh, const int r, const int n0, const int nblk,
                                           bf16_t* Og, float* LSEg, const bf16_t* O1, const bf16_t* O2, const float* LSE1, const float* LSE2, const bf16_t* SZ, bf16_t* AATT) {
    int tid = threadIdx.x; asm volatile("" : "+v"(tid));
    const int lane = tid & 63, wid = __builtin_amdgcn_readfirstlane(tid >> 6), fr = lane & 15, fq = lane >> 4;
    const int sch = tid & 15, srb = tid >> 4;
    const size_t scol = (size_t)hh * 256 + sch * 16;
    u32x4 kreg[4], vreg[4];
#define ATT_LOAD(blk) do { _Pragma("unroll") for (int i = 0; i < 4; ++i) { const size_t p = ((size_t)(128 * (blk) + srb + 32 * i) << dsh) + r; const size_t off = p * 2048 + scol; \
        kreg[i] = *(const u32x4*)((const char*)Kg + off); vreg[i] = *(const u32x4*)((const char*)Vg + off); } } while (0)
#define ATT_WRITE(slot) do { _Pragma("unroll") for (int i = 0; i < 4; ++i) { const unsigned row = srb + 32 * i; \
        *(LAS u32x4*)(lds + attn_offk((slot), row, sch)) = kreg[i]; *(LAS u32x4*)(lds + attn_offv((slot), attn_lrow(row), sch)) = vreg[i]; } } while (0)
    const unsigned q4 = (unsigned)(lane & 15) >> 2, p4 = (unsigned)lane & 3u, parA = (unsigned)wid & 1u, parB = parA ^ 1u;
    unsigned kbase[4], vbA[8], vbB[8];
#pragma unroll
    for (int s_ = 0; s_ < 4; ++s_) kbase[s_] = 256u * fr + 16u * ((unsigned)(4 * s_ + fq) ^ (unsigned)fr);
#pragma unroll
    for (int c = 0; c < 8; ++c) {
        vbA[c] = 65536u + 256u * (((unsigned)fq << 3) | (parA << 2) | q4) + 16u * ((unsigned)(2 * c + (p4 >> 1)) ^ ((q4 << 2) | (((unsigned)fq & 1u) << 1) | parA)) + 8u * (p4 & 1u);
        vbB[c] = 65536u + 256u * (((unsigned)fq << 3) | (parB << 2) | q4) + 16u * ((unsigned)(2 * c + (p4 >> 1)) ^ ((q4 << 2) | (((unsigned)fq & 1u) << 1) | parB)) + 8u * (p4 & 1u);
    }
    if (n0 > 0) { ATT_LOAD(n0 - 1); }
    else {
#pragma unroll
        for (int i = 0; i < 4; ++i) { kreg[i] = (u32x4){0u, 0u, 0u, 0u}; vreg[i] = (u32x4){0u, 0u, 0u, 0u}; } }
    ATT_WRITE((unsigned)((n0 + 1) & 1));
    ATT_LOAD(n0); ATT_WRITE((unsigned)(n0 & 1));
    __syncthreads();
    for (int n = n0; n < n0 + nblk; ++n) {
        const bool more = (n + 1 < n0 + nblk);
        if (more) ATT_LOAD(n + 1);
        const unsigned cs_ = (unsigned)(n & 1), ps_ = cs_ ^ 1u;
        const int lq = 128 * n + 16 * wid + fr; const size_t pq = ((size_t)lq << dsh) + r;
        bf16x8 qf[4];
        { const bf16x8* qp = (const bf16x8*)((const char*)Qg + pq * 2048 + (size_t)hh * 256 + fq * 16);
#pragma unroll
          for (int s = 0; s < 4; ++s) qf[s] = qp[4 * s]; }
        f32x4 S[9];
#pragma unroll
        for (int t = 0; t < 9; ++t) {
            S[t] = (f32x4){0.f, 0.f, 0.f, 0.f};
            const unsigned kr0 = 16 * wid + 16 * t, uo = ((kr0 < 128u) ? ps_ : cs_) * 32768u + 256u * (kr0 & 127u);
#pragma unroll
            for (int s = 0; s < 4; ++s) { const bf16x8 kf = *(const LAS bf16x8*)(lds + (kbase[s] + uo)); S[t] = __builtin_amdgcn_mfma_f32_16x16x32_bf16(kf, qf[s], S[t], 0, 0, 0); }
        }
        const float NEG = -1e30f;
#pragma unroll
        for (int j = 0; j < 4; ++j) { const int ko0 = 4 * fq + j; if (ko0 < fr) S[0][j] = NEG; if (ko0 > fr) S[8][j] = NEG; }
        if (n == 0) {
#pragma unroll
            for (int t = 0; t < 9; ++t)
#pragma unroll
                for (int j = 0; j < 4; ++j) { if (16 * wid + 16 * t + 4 * fq + j < 128) S[t][j] = NEG; }
        }
        float mx = NEG;
#pragma unroll
        for (int t = 0; t < 9; ++t) mx = fmaxf(mx, fmaxf(fmaxf(S[t][0], S[t][1]), fmaxf(S[t][2], S[t][3])));
        mx = fmaxf(mx, __shfl_xor(mx, 16)); mx = fmaxf(mx, __shfl_xor(mx, 32));
        float sum = 0.f;
#pragma unroll
        for (int t = 0; t < 9; ++t)
#pragma unroll
            for (int j = 0; j < 4; ++j) { const float p = __builtin_amdgcn_exp2f(S[t][j] - mx); S[t][j] = p; sum += p; }
        sum += __shfl_xor(sum, 16); sum += __shfl_xor(sum, 32);
        const int rq = lane >> 3, rch = lane & 7;
        size_t tokq[2]; float l1q[2] = {0.f, 0.f}, l2q[2] = {0.f, 0.f};
#pragma unroll
        for (int k = 0; k < 2; ++k) { tokq[k] = ((size_t)(128 * n + 16 * wid + rq + 8 * k) << dsh) + r; if (COMBINE) { l1q[k] = LSE1[tokq[k] * 8 + hh]; l2q[k] = LSE2[tokq[k] * 8 + hh]; } }
        f32x4 O[8];
#pragma unroll
        for (int c = 0; c < 8; ++c) O[c] = (f32x4){0.f, 0.f, 0.f, 0.f};
#pragma unroll
        for (int u = 0; u < 5; ++u) {
            u32x4 pw; pw.x = cvt_pk_bf16(S[2 * u][0], S[2 * u][1]); pw.y = cvt_pk_bf16(S[2 * u][2], S[2 * u][3]);
            if (u < 4) { pw.z = cvt_pk_bf16(S[2 * u + 1][0], S[2 * u + 1][1]); pw.w = cvt_pk_bf16(S[2 * u + 1][2], S[2 * u + 1][3]); } else { pw.z = 0u; pw.w = 0u; }
            const bf16x8 pf = __builtin_bit_cast(bf16x8, pw);
            const unsigned kba = 16 * wid + 32 * u, kbb = kba + 16;
            const unsigned uoa = ((kba < 128u) ? ps_ : cs_) * 32768u + 256u * (kba & 96u), uob = ((kbb < 128u) ? ps_ : cs_) * 32768u + 256u * (kbb & 96u);
#pragma unroll
            for (int c = 0; c < 8; ++c) {
                const s16x4 va = __builtin_amdgcn_ds_read_tr16_b64_v4i16((LAS s16x4*)(lds + (vbA[c] + uoa)));
                const s16x4 vb = __builtin_amdgcn_ds_read_tr16_b64_v4i16((LAS s16x4*)(lds + ((u < 4) ? (vbB[c] + uob) : (vbA[c] + uoa))));
                const bf16x8 vf = __builtin_shufflevector(va, vb, 0, 1, 2, 3, 4, 5, 6, 7);
                O[c] = __builtin_amdgcn_mfma_f32_16x16x32_bf16(vf, pf, O[c], 0, 0, 0);
            }
        }
        const float inv = 1.0f / sum;
        const float l0 = mx + __builtin_amdgcn_logf(sum);
        LAS unsigned char* const stg = lds + ATT_STG_OFF + wid * 2048;
        if (!COMBINE) { if (fq == 0) LSEg[pq * 8 + hh] = l0; }
        else { if (fq == 0) *(LAS float*)(lds + ATT_L0_OFF + wid * 64 + fr * 4) = l0; }
        float w0q[2], w1q[2], w2q[2];
        if (COMBINE) {
            asm volatile("" ::: "memory");
#pragma unroll
            for (int k = 0; k < 2; ++k) { const float l0k = *(const LAS float*)(lds + ATT_L0_OFF + wid * 64 + (rq + 8 * k) * 4), m3 = fmaxf(l0k, fmaxf(l1q[k], l2q[k]));
                const float e0 = __builtin_amdgcn_exp2f(l0k - m3), e1 = __builtin_amdgcn_exp2f(l1q[k] - m3), e2 = __builtin_amdgcn_exp2f(l2q[k] - m3), iw = 1.0f / (e0 + e1 + e2);
                w0q[k] = e0 * iw; w1q[k] = e1 * iw; w2q[k] = e2 * iw; }
        }
#pragma unroll
        for (int h = 0; h < 2; ++h) {
#pragma unroll
            for (int cl = 0; cl < 4; ++cl) { const int c = 4 * h + cl; u32x2 w; w.x = cvt_pk_bf16(O[c][0] * inv, O[c][1] * inv); w.y = cvt_pk_bf16(O[c][2] * inv, O[c][3] * inv);
                *(LAS u32x2*)(stg + fr * 128 + (((2 * cl + (fq >> 1)) ^ (fr & 7)) << 4) + (fq & 1) * 8) = w; }
            asm volatile("" ::: "memory");
#pragma unroll
            for (int k = 0; k < 2; ++k) { const int q = rq + 8 * k; const u32x4 ow = *(const LAS u32x4*)(stg + q * 128 + ((rch ^ (q & 7)) << 4));
                const size_t eo = tokq[k] * 1024 + hh * 128 + 64 * h + rch * 8;
                if (!COMBINE) { *(u32x4*)(Og + eo) = ow; }
                else {
                    const u32x4 a1w = *(const u32x4*)(O1 + eo), a2w = *(const u32x4*)(O2 + eo), zw = *(const u32x4*)(SZ + eo);
                    f32x4 o0a, o0b, a1a, a1b, a2a, a2b, za, zb; pg8::unpack8(ow, o0a, o0b); pg8::unpack8(a1w, a1a, a1b); pg8::unpack8(a2w, a2a, a2b); pg8::unpack8(zw, za, zb);
#pragma unroll
                    for (int j = 0; j < 4; ++j) { za[j] = silu_f(za[j]); zb[j] = silu_f(zb[j]); }
                    const f32x4 ra = (o0a * w0q[k] + a1a * w1q[k] + a2a * w2q[k]) * za, rb = (o0b * w0q[k] + a1b * w1q[k] + a2b * w2q[k]) * zb;
                    *(u32x4*)(AATT + tokq[k] * 2048 + hh * 128 + 64 * h + rch * 8) = pg8::pack8(ra, rb);
                }
            }
            asm volatile("" ::: "memory");
        }
        __syncthreads();
        if (more) ATT_WRITE(ps_);
        __syncthreads();
    }
#undef ATT_LOAD
#undef ATT_WRITE
}

struct Args { const float* x; const float* c; const int* pos; const float* g_pre; const float* w_ada; const float* b_ada; const float* w_in; const float* conv_w;
              const float* w_attn_o; const float* w_conv_o; const float* w_o; const float* g_post; float* out; unsigned char* ws; int ph_lo, ph_hi, li, pad; };

__global__ void __launch_bounds__(NWAVES * 64, 2) mk_fwd(Args args) {
    extern __shared__ __attribute__((aligned(16))) unsigned char lds_raw[];
    LAS unsigned char* lds = (LAS unsigned char*)lds_raw;
    volatile LAS unsigned* MISC = (volatile LAS unsigned*)(lds + MISC_OFF);
    const int tid = threadIdx.x, lane = tid & 63, wave = __builtin_amdgcn_readfirstlane(tid >> 6);
    const int G = gridDim.x; const int bx = blockIdx.x; const int vcu = (G % 8 == 0) ? (bx % 8) * (G / 8) + bx / 8 : bx;
    unsigned char* ws = args.ws;
    gu32* ctl = (gu32*)(ws + WS_CTL);
    float* mod = (float*)(ws + WS_MOD); float* cs = (float*)(ws + WS_CS);
    bf16_t* WinT = (bf16_t*)(ws + WS_WIN); bf16_t* WaT = (bf16_t*)(ws + WS_WA); bf16_t* WcT = (bf16_t*)(ws + WS_WC); bf16_t* WoT = (bf16_t*)(ws + WS_WO);
    bf16_t* Hb = (bf16_t*)(ws + WS_H); bf16_t* Qb = (bf16_t*)(ws + WS_Q); bf16_t* Kb = (bf16_t*)(ws + WS_K); bf16_t* Vb = (bf16_t*)(ws + WS_V);
    bf16_t* SZ = (bf16_t*)(ws + WS_SZ); float* HPb = (float*)(ws + WS_FX); float* FXQb = HPb + (size_t)64 * 2 * NCV; float* FXUb = FXQb + (size_t)64 * 2 * NCV;
    bf16_t* SGA = (bf16_t*)args.out; bf16_t* SGC = SGA + (size_t)M * D;
    bf16_t* O1 = (bf16_t*)(ws + WS_O1); bf16_t* O2 = (bf16_t*)(ws + WS_O2); float* LSE = (float*)(ws + WS_LSE);
    bf16_t* AATT = (bf16_t*)(ws + WS_AATT); bf16_t* Rb = (bf16_t*)(ws + WS_R); bf16_t* MG = (bf16_t*)(ws + WS_MG);
    bf16_t* Yb = (bf16_t*)(ws + WS_Y);

    for (int u = tid; u < (LDS_BYTES - LDSCTL_OFF) / 4; u += NWAVES * 64) ((LAS unsigned*)(lds + LDSCTL_OFF))[u] = 0u;
    __syncthreads();
    const int bli = (N_LAUNCHES == 1) ? 0 : args.li;
    XcdBarrier bar; bar.bar = (unsigned*)(ctl + CW_BAR) + bli * XCD_BAR_WORDS; bar.x = 0; bar.st = nullptr;
    if (N_LAUNCHES == 1) bar = xcd_barrier_post((unsigned*)(ctl + CW_BAR), MISC + 8);
    const int lo = args.ph_lo, hi = args.ph_hi;
#define IN(k) (lo <= (k) && (k) < hi)
#define BOTH(k) (IN(k) && IN((k) + 1))
#define GRID_BAR() xcd_barrier(bar)
#ifndef PROBE_REPEAT_MASK
#define PROBE_REPEAT_MASK 0
#endif
#ifndef PROBE_REPEAT_N
#define PROBE_REPEAT_N 1
#endif
#define NREP(k) ((((PROBE_REPEAT_MASK) >> (k)) & 1) * (PROBE_REPEAT_N) + 1)
    const int gw = vcu * NWAVES + wave, NGW = G * NWAVES;
    const int gtid = vcu * (NWAVES * 64) + tid, NT = G * NWAVES * 64;

    if (IN(0)) for (int rep = 0; rep < NREP(0); ++rep) {
        {
            LAS float* red = (LAS float*)lds;
            for (int cbk = bx; cbk < 256; cbk += G) {
                const int c4 = tid % 6, rg = tid / 6;
                f32x4 a = (f32x4){0.f, 0.f, 0.f, 0.f};
                if (rg < 85) {
#pragma unroll 6
                    for (int k = rg; k < D; k += 85) { const float cv = args.c[k]; const f32x4 w = *(const f32x4*)(args.w_ada + (size_t)k * NMOD + cbk * 24 + c4 * 4); a += w * cv; }
                    *(LAS f32x4*)(red + (rg * 6 + c4) * 4) = a; }
                __syncthreads();
                if (tid < 24) { float s = 0.f; for (int i = 0; i < 85; ++i) s += red[(i * 6 + (tid >> 2)) * 4 + (tid & 3)];
                    __hip_atomic_store(mod + cbk * 24 + tid, s + args.b_ada[cbk * 24 + tid], __ATOMIC_RELAXED, __HIP_MEMORY_SCOPE_AGENT); }
                asm volatile("s_waitcnt vmcnt(0)" ::: "memory");
                __syncthreads();
                if (tid == 0) __hip_atomic_fetch_add((unsigned*)(ctl + CW_MODCNT), 1u, __ATOMIC_RELAXED, __HIP_MEMORY_SCOPE_AGENT);
            }
        }
        for (int idx = gtid; idx < M * 16; idx += NT) { const int m = idx >> 4, i = idx & 15; const float ang = (float)args.pos[m] * INVF[i]; float s, c; sincos_f64(ang, s, c); cs[m * 32 + i] = c; cs[m * 32 + 16 + i] = s; }
        {
            LAS float* scr = (LAS float*)(lds + wave * 16384);
            constexpr int I_IN = (D / 64) * (PROJ / 32), I_A = (NZA / 64) * (D / 32), I_C = (NCV / 64) * (D / 32), I_O = (D / 64) * (D / 32);
            constexpr int NITEMS = I_IN + I_A + I_C + I_O;
#define T_DECODE(it_, d_) do { int r_ = (it_); \
                if (r_ < I_IN) t_decode(args.w_in, PROJ, WinT, D, true, r_, lane, d_); \
                else if ((r_ -= I_IN) < I_A) t_decode(args.w_attn_o, D, WaT, D, false, r_, lane, d_); \
                else if ((r_ -= I_A) < I_C) t_decode(args.w_conv_o, D, WcT, D, false, r_, lane, d_); \
                else t_decode(args.w_o, D, WoT, D, false, r_ - I_C, lane, d_); } while (0)
            TItem cur_, nxt_; float wa[32], wb[32];
            int it = gw;
            if (it < NITEMS) { T_DECODE(it, cur_); t_load(cur_, wa); }
            while (it < NITEMS) {
                const int nit = it + NGW;
                if (nit < NITEMS) { T_DECODE(nit, nxt_); t_load(nxt_, wb); }
                t_finish(cur_, wa, D, scr, lane);
                cur_ = nxt_;
#pragma unroll
                for (int i = 0; i < 32; ++i) wa[i] = wb[i];
                it = nit;
            }
#undef T_DECODE
        }
        if (tid == 0) {
            unsigned sp = 0;
            while (__hip_atomic_load((unsigned*)(ctl + CW_MODCNT), __ATOMIC_RELAXED, __HIP_MEMORY_SCOPE_AGENT) < 256u * (unsigned)(rep + 1)) { __builtin_amdgcn_s_sleep(2); if (++sp > (1u << 22)) break; }
            __builtin_amdgcn_fence(__ATOMIC_ACQUIRE, "agent");
            asm volatile("s_waitcnt vmcnt(0)" ::: "memory");
        }
        __syncthreads();
        f32x4 av[4][2], bv[4][2];
#pragma unroll
        for (int j = 0; j < 4; ++j)
#pragma unroll
            for (int h = 0; h < 2; ++h) { const int k = 512 * j + 8 * lane + 4 * h; const f32x4 gp = *(const f32x4*)(args.g_pre + k); f32x4 sc, sh;
#pragma unroll
                for (int e = 0; e < 4; ++e) { sc[e] = __hip_atomic_load(mod + D + k + e, __ATOMIC_RELAXED, __HIP_MEMORY_SCOPE_AGENT); sh[e] = __hip_atomic_load(mod + k + e, __ATOMIC_RELAXED, __HIP_MEMORY_SCOPE_AGENT); }
                av[j][h] = gp * (sc + 1.0f); bv[j][h] = sh; }
        for (int m = gw; m < M; m += NGW) {
            const float* xr = args.x + (size_t)m * D + 8 * lane;
            f32x4 v[4][2]; float ss = 0.f;
#pragma unroll
            for (int j = 0; j < 4; ++j)
#pragma unroll
                for (int h = 0; h < 2; ++h) { v[j][h] = *(const f32x4*)(xr + 512 * j + 4 * h); const f32x4 q = v[j][h] * v[j][h]; ss += (q[0] + q[1]) + (q[2] + q[3]); }
            const float rstd = 1.0f / sqrtf(wave_sum(ss) * (1.0f / D) + EPS);
            bf16_t* hr = Hb + (size_t)m * D + 8 * lane;
#pragma unroll
            for (int j = 0; j < 4; ++j) { const f32x4 h0 = v[j][0] * rstd * av[j][0] + bv[j][0], h1 = v[j][1] * rstd * av[j][1] + bv[j][1]; *(u32x4*)(hr + 512 * j) = pg8::pack8(h0, h1); }
        }
        if (BOTH(0) || rep + 1 < NREP(0)) GRID_BAR();
    }
    if (IN(2)) {
        pg8::SegOrder1 S; S.so.init(M, PROJ, G, bx, NREP(2)); S.A = (const char*)Hb; S.B = (const char*)WinT; S.tstep = (size_t)256 * D * 2; S.nt = D / 64;
        pg8::EpiProj E{ws, SGA, args.conv_w, lds + HALO_OFF};
        pg8::gemm_stream<pg8::EpiProj, pg8::SegOrder1>(lds, D, S, E);
        if (BOTH(2)) GRID_BAR();
    }
    if (IN(3)) for (int rep = 0; rep < NREP(3); ++rep) {
        for (int idx = gtid; idx < 63 * 2 * (NCV / 4); idx += NT) {
            const int c4 = idx % (NCV / 4), pj = idx / (NCV / 4), j = pj & 1, pm = 1 + (pj >> 1), ch = 4 * c4;
            const f32x4 h0 = *(const f32x4*)(HPb + ((size_t)((pm - 1) * 2 + 0) * NCV + ch)), h1 = *(const f32x4*)(HPb + ((size_t)((pm - 1) * 2 + 1) * NCV + ch));
            const f32x4 w0 = *(const f32x4*)(args.conv_w + ch), w1 = *(const f32x4*)(args.conv_w + NCV + ch);
            const f32x4 qv = *(const f32x4*)(FXQb + ((size_t)(pm * 2 + j) * NCV + ch)), uu = *(const f32x4*)(FXUb + ((size_t)(pm * 2 + j) * NCV + ch));
            const f32x4 miss = (j == 0) ? (w1 * h1 + w0 * h0) : (w0 * h1);
            const f32x4 rv = qv * (uu + miss);
            u32x2 rw; rw.x = cvt_pk_bf16(rv[0], rv[1]); rw.y = cvt_pk_bf16(rv[2], rv[3]);
            *(u32x2*)(Rb + ((size_t)(256 * pm + j) * NCV + ch)) = rw;
        }
        for (int chunk = vcu; chunk < 256; chunk += G) {
            int g, hh, r, n0;
            if (chunk < 128) { g = 2; hh = chunk >> 4; r = chunk & 15; n0 = 0; } else { const int idx = chunk - 128; g = 1; hh = idx >> 4; r = (idx & 15) >> 2; n0 = (idx & 3) * 8; }
            const size_t go = (size_t)g * M * 1024;
            attn_chunk<false>(lds, Qb + go, Kb + go, Vb + go, 2 * g, hh, r, n0, 8, (g == 1) ? O1 : O2, LSE + (size_t)g * M * 8, nullptr, nullptr, nullptr, nullptr, nullptr, nullptr);
        }
        if (BOTH(3) || rep + 1 < NREP(3)) GRID_BAR();
    }
    if (IN(4)) for (int rep = 0; rep < NREP(4); ++rep) {
        for (int chunk = vcu; chunk < 256; chunk += G)
            attn_chunk<true>(lds, Qb, Kb, Vb, 0, chunk >> 5, 0, (chunk & 31) * 4, 4, nullptr, nullptr, O1, O2, LSE + (size_t)1 * M * 8, LSE + (size_t)2 * M * 8, SZ, AATT);
        if (BOTH(4) || rep + 1 < NREP(4)) GRID_BAR();
    }
    if (IN(5)) {
        pg8::SegOrder2 S; S.so.init(M, D, G, bx, NREP(5)); S.A0 = (const char*)AATT; S.B0 = (const char*)WaT; S.A1 = (const char*)Rb; S.B1 = (const char*)WcT; S.tstep = (size_t)256 * D * 2; S.nt0 = NZA / 64; S.nt1 = NCV / 64;
        pg8::EpiMerge E{MG, SGA, SGC, D};
        pg8::gemm_stream<pg8::EpiMerge, pg8::SegOrder2, true>(lds, D, S, E);
        if (BOTH(5)) GRID_BAR();
    }
    if (IN(6)) {
        pg8::SegOrder1 S; S.so.init(M, D, G, bx, NREP(6)); S.A = (const char*)MG; S.B = (const char*)WoT; S.tstep = (size_t)256 * D * 2; S.nt = D / 64;
        pg8::EpiBf16 E{Yb, D};
        pg8::gemm_stream<pg8::EpiBf16, pg8::SegOrder1>(lds, D, S, E);
        if (BOTH(6)) GRID_BAR();
    }
    if (IN(7)) {
        f32x4 gv[4][2];
#pragma unroll
        for (int j = 0; j < 4; ++j)
#pragma unroll
            for (int h = 0; h < 2; ++h) { const int k = 512 * j + 8 * lane + 4 * h; gv[j][h] = *(const f32x4*)(mod + 2 * D + k) * *(const f32x4*)(args.g_post + k); }
        for (int m = gw; m < M; m += NGW) {
            const bf16_t* yr = Yb + (size_t)m * D + 8 * lane; const float* xr = args.x + (size_t)m * D + 8 * lane; float* orow = args.out + (size_t)m * D + 8 * lane;
            f32x4 v[4][2], xv[4][2]; u32x4 yw[4]; float ss = 0.f;
#pragma unroll
            for (int j = 0; j < 4; ++j) { yw[j] = *(const u32x4*)(yr + 512 * j); xv[j][0] = *(const f32x4*)(xr + 512 * j); xv[j][1] = *(const f32x4*)(xr + 512 * j + 4); }
#pragma unroll
            for (int j = 0; j < 4; ++j) { pg8::unpack8(yw[j], v[j][0], v[j][1]);
#pragma unroll
                for (int h = 0; h < 2; ++h) { const f32x4 q = v[j][h] * v[j][h]; ss += (q[0] + q[1]) + (q[2] + q[3]); } }
            const float rstd = 1.0f / sqrtf(wave_sum(ss) * (1.0f / D) + EPS);
#pragma unroll
            for (int j = 0; j < 4; ++j)
#pragma unroll
                for (int h = 0; h < 2; ++h) *(f32x4*)(orow + 512 * j + 4 * h) = xv[j][h] + gv[j][h] * (v[j][h] * rstd);
        }
    }
#undef IN
#undef BOTH
#undef GRID_BAR
}

extern "C" void kernel_launch(void* const* d_in, const int* in_sizes, int n_in, void* d_out, int out_size, void* d_ws, size_t ws_size, hipStream_t stream) {
    static int grid = 0;
    if (grid == 0) {
        if (n_in != 12 || in_sizes[0] != M * D || out_size != M * D || ws_size < WS_END) { fprintf(stderr, "kernel_launch: unexpected shapes (n_in %d, in0 %d, out %d, ws %zu); nothing launched\n", n_in, n_in > 0 ? in_sizes[0] : -1, out_size, ws_size); grid = -1; return; }
        int dev = 0, cus = 0;
        if (hipGetDevice(&dev) != hipSuccess || hipDeviceGetAttribute(&cus, hipDeviceAttributeMultiprocessorCount, dev) != hipSuccess) { grid = -1; return; }
        if (hipFuncSetAttribute((const void*)mk_fwd, hipFuncAttributeMaxDynamicSharedMemorySize, LDS_BYTES) != hipSuccess) { fprintf(stderr, "kernel_launch: hipFuncSetAttribute failed\n"); grid = -1; return; }
        (void)hipGetLastError();
        grid = cus;
    }
    if (grid < 0) return;
    if (hipMemsetAsync((char*)d_ws + WS_CTL, 0, CTL_ZERO_BYTES, stream) != hipSuccess) return;
    Args a{};
    a.x = (const float*)d_in[0]; a.c = (const float*)d_in[1]; a.pos = (const int*)d_in[2]; a.g_pre = (const float*)d_in[3]; a.w_ada = (const float*)d_in[4]; a.b_ada = (const float*)d_in[5];
    a.w_in = (const float*)d_in[6]; a.conv_w = (const float*)d_in[7]; a.w_attn_o = (const float*)d_in[8]; a.w_conv_o = (const float*)d_in[9]; a.w_o = (const float*)d_in[10]; a.g_post = (const float*)d_in[11];
    a.out = (float*)d_out; a.ws = (unsigned char*)d_ws;
    for (int li = 0; li < N_LAUNCHES; ++li) {
        a.ph_lo = (N_LAUNCHES == 1) ? 0 : li; a.ph_hi = (N_LAUNCHES == 1) ? NPHASES : li + 1; a.li = li;
        hipLaunchKernelGGL(mk_fwd, dim3(grid), dim3(NWAVES * 64), LDS_BYTES, stream, a);
        if (hipPeekAtLastError() != hipSuccess) break;
    }
}
```

```cpp
#include <hip/hip_runtime.h>
#include <cstdio>
#include <cstdint>

#define GAS __attribute__((address_space(1)))
#define LAS __attribute__((address_space(3)))
typedef unsigned short bf16_t;
typedef short bf16x8 __attribute__((ext_vector_type(8)));
typedef short s16x4 __attribute__((ext_vector_type(4)));
typedef float f32x4 __attribute__((ext_vector_type(4)));
typedef float f32x2 __attribute__((ext_vector_type(2)));
typedef unsigned u32x4 __attribute__((ext_vector_type(4)));
typedef unsigned u32x2 __attribute__((ext_vector_type(2)));

constexpr int M = 16384, D = 2048, NQKV = 3072, NZA = 1024, NCV = 2048, PROJ = 22528, NMOD = 6144;
constexpr float EPS = 1e-6f;
constexpr float LOG2E = 1.4426950408889634f;
constexpr float QSCALE = 0.08838834764831845f * 1.4426950408889634f;

__constant__ float INVF[16] = {1.0f, 0.44036659598350525f, 0.1939227432012558f, 0.08539710193872452f, 0.03760603070259094f, 0.016560440883040428f,
    0.007292664609849453f, 0.0032114461064338684f, 0.0014142135623842478f, 0.0006227724370546639f, 0.00027424818836152554f, 0.00012076973507646471f,
    5.3182957344688475e-05f, 2.34199997066753e-05f, 1.0313385246263351e-05f, 4.541670477919979e-06f};

typedef __bf16 bf16x2_t __attribute__((ext_vector_type(2)));
__device__ __forceinline__ unsigned cvt_pk_bf16(float lo, float hi) { const f32x2 v = {lo, hi}; return __builtin_bit_cast(unsigned, __builtin_convertvector(v, bf16x2_t)); }
__device__ __forceinline__ float bf_lo(unsigned w) { return __builtin_bit_cast(float, w << 16); }
__device__ __forceinline__ float bf_hi(unsigned w) { return __builtin_bit_cast(float, w & 0xffff0000u); }
template <int CTRL> __device__ __forceinline__ float dpp_row_shr(float old, float src) { return __int_as_float(__builtin_amdgcn_update_dpp(__float_as_int(old), __float_as_int(src), CTRL, 0xf, 0xf, false)); }
__device__ __forceinline__ float silu_f(float v) { return v * __builtin_amdgcn_rcpf(1.0f + __builtin_amdgcn_exp2f(-v * LOG2E)); }
__device__ __forceinline__ float sigm_f(float v) { return __builtin_amdgcn_rcpf(1.0f + __builtin_amdgcn_exp2f(-v * LOG2E)); }

constexpr size_t MiB = 1u << 20;
constexpr size_t WS_CTL = 0, CTL_ZERO_BYTES = 32768;
constexpr size_t WS_MOD = 1 * MiB;
constexpr size_t WS_CS = 2 * MiB;
constexpr size_t WS_WIN = 4 * MiB;
constexpr size_t WS_WA = 92 * MiB, WS_WC = 100 * MiB, WS_WO = 108 * MiB;
constexpr size_t WS_H = 116 * MiB;
constexpr size_t WS_Q = 180 * MiB, WS_K = 276 * MiB, WS_V = 372 * MiB;
constexpr size_t WS_SZ = 468 * MiB;
constexpr size_t WS_R = 500 * MiB;
constexpr size_t WS_FX = 564 * MiB;
constexpr size_t WS_O2 = 628 * MiB;
constexpr size_t WS_LSE = 660 * MiB;
constexpr size_t WS_END = 662 * MiB;
constexpr size_t WS_O1 = 148 * MiB;
constexpr size_t WS_AATT = WS_K + 32 * MiB, WS_MG = WS_V + 32 * MiB, WS_Y = WS_R;

#ifndef PG8_A_AUX
#define PG8_A_AUX 0
#endif
#ifndef PG8_B_AUX
#define PG8_B_AUX 0
#endif
namespace pg8 {
constexpr int BM = 256, BK = 64, HALF = 128, HTB = HALF * BK * 2, STAGE_BYTES = 8 * HTB, NXCD = 8, WGM = 8;
__host__ __device__ __forceinline__ int lds_byte(int r, int c) { const int st = (r >> 4) * 2 + (c >> 5), rr = r & 15, cc = c & 31, ob = rr * 64 + cc * 2; return st * 1024 + (ob ^ (((ob >> 9) & 1) << 5)); }
__host__ __device__ __forceinline__ void stage_rc(int b, int& R, int& C) { const int st = b / 1024, sb = b % 1024, swz = sb ^ (((sb >> 9) & 1) << 5); R = (st >> 1) * 16 + swz / 64; C = (st & 1) * 32 + (swz % 64) / 2; }
__host__ __device__ __forceinline__ int perm32(int rho) { const int n = rho >> 4, i = rho & 15; return 8 * (i >> 2) + 4 * n + (i & 3); }

struct Unit { int pm, pn; };
struct Gemm { const bf16_t* A; const bf16_t* Bt; int M, N, K; };

struct StaticOrder {
    int nM, nN, nwg, G, c, rounds, rep;
    __host__ __device__ void init(int M_, int N_, int G_, int c_, int rep_ = 1) { nM = M_ / BM; nN = N_ / BM; nwg = nM * nN; G = G_; c = c_; rounds = (nwg + G - 1) / G; rep = rep_; }
    __host__ __device__ bool next(int i, Unit& u) const {
        if (i >= rounds * rep) return false;
        i = i % rounds;
        const long L = (long)i * G + c; if (L >= nwg) return false;
        int wgid = (int)L; { const int q = nwg / NXCD, r = nwg % NXCD, xcd = wgid % NXCD, off = wgid / NXCD; wgid = (xcd < r ? xcd * (q + 1) : r * (q + 1) + (xcd - r) * q) + off; }
        const int nig = WGM * nN, gid = wgid / nig, fm = gid * WGM, gsz = (nM - fm) < WGM ? (nM - fm) : WGM;
        u.pm = fm + ((wgid % nig) % gsz); u.pn = (wgid % nig) / gsz; return true;
    }
    __device__ __forceinline__ void a_ready(const Unit&) const {}
    __device__ __forceinline__ void done(const Unit&) const {}
};


struct Seg { const char* A; const char* B; int nt; int mid; Unit u; };
__device__ __forceinline__ const char* rfl_ptr(const char* p) { const unsigned long long v = (unsigned long long)p; const unsigned lo = __builtin_amdgcn_readfirstlane((unsigned)v), hi = __builtin_amdgcn_readfirstlane((unsigned)(v >> 32)); return (const char*)(((unsigned long long)hi << 32) | lo); }
__device__ __forceinline__ void rfl_seg(Seg& o) { o.A = rfl_ptr(o.A); o.B = rfl_ptr(o.B); o.nt = __builtin_amdgcn_readfirstlane(o.nt); o.mid = __builtin_amdgcn_readfirstlane(o.mid); o.u.pm = __builtin_amdgcn_readfirstlane(o.u.pm); o.u.pn = __builtin_amdgcn_readfirstlane(o.u.pn); }
constexpr int NSTORE = 16;
template <class Epi, class Sched, bool DUAL = false>
__device__ __forceinline__ void gemm_stream(LAS unsigned char* lds, const int pitch, const Sched& S, const Epi& E) {
    const int tid = threadIdx.x, wid = __builtin_amdgcn_readfirstlane(tid >> 6), lane = tid & 63, wr = wid >> 2, wc = wid & 3, fr = lane & 15, fq = lane >> 4;
    unsigned voffA[2], voffB[2];
#pragma unroll
    for (int i = 0; i < 2; ++i) { int R, C; stage_rc(tid * 16 + i * 8192, R, C); const int Rb = Epi::PERM ? ((R & ~31) + perm32(R & 31)) : R;
        voffA[i] = (unsigned)(R * pitch + C) * 2u; voffB[i] = (unsigned)(Rb * pitch + C) * 2u; }
    const size_t kstep = (size_t)(BK * 2);
    const size_t hstep = (size_t)HALF * pitch * 2;
    const unsigned ldsw = (unsigned)wid * 1024u;
    const int aoff = lds_byte(wr * 64 + fr, fq * 8), boff = lds_byte(wc * 32 + fr, fq * 8);
#define PG8_SA(b, h) (((b) * 2 + (h)) * HTB)
#define PG8_SB(b, h) ((4 + (b) * 2 + (h)) * HTB)
#define PG8_STAGE(bufoff, gbase, voff) do { const char* _gb = (const char*)(gbase); asm volatile("" : "+s"(_gb));   \
        _Pragma("unroll") for (int _i = 0; _i < 2; ++_i) { asm volatile("" : "+v"((voff)[_i]));   \
        __builtin_amdgcn_global_load_lds((const unsigned*)(_gb + (voff)[_i]), (LAS unsigned*)(lds + (bufoff) + ldsw + _i * 8192), 16, 0, PG8_A_AUX); } } while (0)
#define PG8_STAGEB(bufoff, gbase, voff) do { const char* _gb = (const char*)(gbase); asm volatile("" : "+s"(_gb)); \
        _Pragma("unroll") for (int _i = 0; _i < 2; ++_i) { asm volatile("" : "+v"((voff)[_i])); \
        __builtin_amdgcn_global_load_lds((const unsigned*)(_gb + (voff)[_i]), (LAS unsigned*)(lds + (bufoff) + ldsw + _i * 8192), 16, 0, PG8_B_AUX); } } while (0)
#define PG8_LDA(dst, b, h) do { _Pragma("unroll") for (int m = 0; m < 4; ++m) _Pragma("unroll") for (int k = 0; k < 2; ++k) dst[m][k] = *(const LAS bf16x8*)(lds + PG8_SA(b, h) + aoff + m * 2048 + k * 1024); } while (0)
#define PG8_LDB(dst, b, h) do { _Pragma("unroll") for (int n = 0; n < 2; ++n) _Pragma("unroll") for (int k = 0; k < 2; ++k) dst[n][k] = *(const LAS bf16x8*)(lds + PG8_SB(b, h) + boff + n * 2048 + k * 1024); } while (0)
#define PG8_MMA(ai, bj, At, Bt) do { __builtin_amdgcn_s_setprio(1); _Pragma("unroll") for (int m = 0; m < 4; ++m) _Pragma("unroll") for (int n = 0; n < 2; ++n) _Pragma("unroll") for (int k = 0; k < 2; ++k) \
        acc[ai][bj][m][n] = __builtin_amdgcn_mfma_f32_16x16x32_bf16(Bt[n][k], At[m][k], acc[ai][bj][m][n], 0, 0, 0); __builtin_amdgcn_s_setprio(0); } while (0)
#define PG8_WAIT_V(n) asm volatile("s_waitcnt vmcnt(" #n ")" ::: "memory")
#define PG8_WAIT_VR() PG8_WAIT_V(8)
#define PG8_WAIT_L(n) asm volatile("s_waitcnt lgkmcnt(" #n ")" ::: "memory")
#define PG8_BAR __builtin_amdgcn_s_barrier()
#define PG8_SCHED __builtin_amdgcn_sched_barrier(0)
    Seg cur, nxt; int si = 0;
    if (!S.seg(0, cur)) return;
    f32x4 acc[2][2][4][2];
#pragma unroll
    for (int a = 0; a < 2; ++a)
#pragma unroll
        for (int b = 0; b < 2; ++b)
#pragma unroll
            for (int m = 0; m < 4; ++m)
#pragma unroll
                for (int n = 0; n < 2; ++n) acc[a][b][m][n] = (f32x4){0.f, 0.f, 0.f, 0.f};
    bf16x8 At[4][2], B0[2][2], B1[2][2];
    {
        const char* cA = cur.A; const char* cB = cur.B;
        PG8_STAGEB(PG8_SB(0, 0), cB, voffB); PG8_STAGEB(PG8_SB(0, 1), cB + hstep, voffB); PG8_STAGE(PG8_SA(0, 0), cA, voffA); PG8_STAGE(PG8_SA(0, 1), cA + hstep, voffA);
        if (wr == 1) PG8_BAR;
        PG8_WAIT_V(2); PG8_BAR;
        PG8_STAGEB(PG8_SB(1, 0), cB + kstep, voffB); PG8_STAGE(PG8_SA(1, 0), cA + kstep, voffA); PG8_STAGEB(PG8_SB(1, 1), cB + hstep + kstep, voffB);
        PG8_WAIT_V(6); PG8_BAR;
    }
    bool fresh = true, relax = false;
    for (;;) {
        const bool has_next = S.seg(si + 1, nxt);
        const char* cA = cur.A; const char* cB = cur.B; const int nt = cur.nt;
        const char* nA = has_next ? nxt.A : cA; const char* nB = has_next ? nxt.B : cB;
#pragma nounroll
        for (int t = 0; t < nt; t += 2) {
            const bool first = (t == 0) && !fresh;
            const bool last = (t == nt - 2);
            const char* a1 = cA + (size_t)(t + 1) * kstep;
            const char* a2 = last ? nA : cA + (size_t)(t + 2) * kstep; const char* b2 = last ? nB : cB + (size_t)(t + 2) * kstep;
            const char* a3 = a2 + kstep; const char* b3 = b2 + kstep;
            PG8_LDB(B0, 0, 0); PG8_LDB(B1, 0, 1); PG8_SCHED; PG8_LDA(At, 0, 0); if (!first) PG8_STAGE(PG8_SA(1, 1), a1 + hstep, voffA);
            PG8_WAIT_VR(); PG8_WAIT_L(0); PG8_BAR; PG8_MMA(0, 0, At, B0); PG8_MMA(0, 1, At, B1); PG8_BAR; PG8_SCHED;
            PG8_LDA(At, 0, 1); PG8_STAGEB(PG8_SB(0, 0), b2, voffB); PG8_STAGEB(PG8_SB(0, 1), b2 + hstep, voffB); PG8_STAGE(PG8_SA(0, 0), a2, voffA);
            PG8_WAIT_VR(); PG8_WAIT_L(0); PG8_BAR; PG8_MMA(1, 0, At, B0); PG8_MMA(1, 1, At, B1); PG8_BAR; PG8_SCHED;
            PG8_LDB(B0, 1, 0); PG8_LDB(B1, 1, 1); PG8_SCHED; PG8_LDA(At, 1, 0); PG8_STAGE(PG8_SA(0, 1), a2 + hstep, voffA);
            PG8_WAIT_VR(); PG8_WAIT_L(0); PG8_BAR; PG8_MMA(0, 0, At, B0); PG8_MMA(0, 1, At, B1); PG8_BAR; PG8_SCHED;
            PG8_LDA(At, 1, 1); PG8_STAGEB(PG8_SB(1, 0), b3, voffB); PG8_STAGEB(PG8_SB(1, 1), b3 + hstep, voffB); PG8_STAGE(PG8_SA(1, 0), a3, voffA);
            PG8_WAIT_V(8); PG8_WAIT_L(0); PG8_BAR; PG8_MMA(1, 0, At, B0); PG8_MMA(1, 1, At, B1); PG8_BAR; PG8_SCHED;
        }
        if (wr == 0) PG8_BAR;
        PG8_STAGE(PG8_SA(1, 1), nA + kstep + hstep, voffA);
        PG8_SCHED;
        if constexpr (DUAL) E.scale(acc, cur.u, wr, wc, fr, fq, cur.mid != 0);
        if (DUAL && cur.mid) { relax = false; }
        else {
            E(acc, cur.u, wr, wc, fr, fq); relax = true;
#pragma unroll
            for (int a = 0; a < 2; ++a)
#pragma unroll
                for (int b = 0; b < 2; ++b)
#pragma unroll
                    for (int m = 0; m < 4; ++m)
#pragma unroll
                        for (int n = 0; n < 2; ++n) acc[a][b][m][n] = (f32x4){0.f, 0.f, 0.f, 0.f};
        }
        PG8_SCHED;
        if (!has_next) break;
        cur = nxt; ++si; fresh = false;
        if (wr == 1) PG8_BAR;
    }
    PG8_WAIT_V(0);
    PG8_BAR;
#undef PG8_SA
#undef PG8_SB
#undef PG8_STAGE
#undef PG8_STAGEB
#undef PG8_LDA
#undef PG8_LDB
#undef PG8_MMA
#undef PG8_WAIT_V
#undef PG8_WAIT_VR
#undef PG8_WAIT_L
#undef PG8_BAR
#undef PG8_SCHED
}
struct SegOrder1 {
    StaticOrder so; const char* A; const char* B; size_t tstep; int nt;
    __device__ __forceinline__ bool seg(int s, Seg& o) const { Unit u; if (!so.next(s, u)) return false; o.A = A + (size_t)u.pm * tstep; o.B = B + (size_t)u.pn * tstep; o.nt = nt; o.mid = 0; o.u = u; rfl_seg(o); return true; }
};

__device__ __forceinline__ u32x4 pack8(const f32x4 v0, const f32x4 v1) { u32x4 w; w.x = cvt_pk_bf16(v0[0], v0[1]); w.y = cvt_pk_bf16(v0[2], v0[3]); w.z = cvt_pk_bf16(v1[0], v1[1]); w.w = cvt_pk_bf16(v1[2], v1[3]); return w; }
__device__ __forceinline__ void unpack8(const u32x4 w, f32x4& v0, f32x4& v1) { v0 = (f32x4){bf_lo(w.x), bf_hi(w.x), bf_lo(w.y), bf_hi(w.y)}; v1 = (f32x4){bf_lo(w.z), bf_hi(w.z), bf_lo(w.w), bf_hi(w.w)}; }

#ifdef NT_STORES
#define ST16(p, v) __builtin_nontemporal_store((v), (u32x4*)(p))
#define ST8(p, v) __builtin_nontemporal_store((v), (u32x2*)(p))
#else
#define ST16(p, v) (*(u32x4*)(p) = (v))
#define ST8(p, v) (*(u32x2*)(p) = (v))
#endif
struct EpiProj {
    static constexpr bool PERM = true;
    __device__ __forceinline__ void mid(f32x4 (&)[2][2][4][2], const Unit&, int, int, int, int) const {}
    unsigned char* ws; bf16_t* SGA; const float* cw; LAS unsigned char* halo;
    __device__ __forceinline__ void operator()(const f32x4 (&acc)[2][2][4][2], const Unit& u, int wr, int wc, int fr, int fq) const {
        int pn = u.pn, upm = u.pm; asm volatile("" : "+s"(pn), "+s"(upm));
        const int row0 = upm * BM + wr * 64 + fr; const int lc = wc * 32 + 8 * fq;
        bf16_t* const Q = (bf16_t*)(ws + WS_Q); bf16_t* const Kb = (bf16_t*)(ws + WS_K); bf16_t* const V = (bf16_t*)(ws + WS_V); bf16_t* const SZ = (bf16_t*)(ws + WS_SZ); bf16_t* const R = (bf16_t*)(ws + WS_R);
        bf16_t* const SGC = SGA + (size_t)M * D; const float* const cs = (const float*)(ws + WS_CS);
        float* const HP = (float*)(ws + WS_FX); float* const FXQ = HP + (size_t)64 * 2 * NCV; float* const FXU = FXQ + (size_t)64 * 2 * NCV;
        if (pn < 24) {
            const bool isq = pn < 12; const int tq = isq ? pn : pn - 12; bf16_t* base = (isq ? Q : Kb) + (size_t)(tq >> 2) * M * 1024; const int colt = (tq & 3) * BM; const float sc = isq ? QSCALE : 1.0f;
            const bool rot = (fq == 0);
            const int tix = (wr * 4 + wc) * 64 + fq * 16 + fr;
            f32x4 stage[2][2];
#pragma unroll
            for (int ai = 0; ai < 2; ++ai)
#pragma unroll
                for (int i = 0; i < 2; ++i) { const int p = tix + 512 * i; stage[ai][i] = *(const f32x4*)(cs + (size_t)(upm * BM + ai * HALF + (p >> 3)) * 32 + (p & 7) * 4); }
#pragma unroll
            for (int ai = 0; ai < 2; ++ai) {
                if (ai) { asm volatile("s_waitcnt lgkmcnt(0)" ::: "memory"); __builtin_amdgcn_s_barrier(); asm volatile("" ::: "memory"); }
#pragma unroll
                for (int i = 0; i < 2; ++i) { const int p = tix + 512 * i, rw_ = p >> 3; *(LAS f32x4*)(halo + rw_ * 128 + (((p & 7) ^ (rw_ & 7)) << 4)) = stage[ai][i]; }
                asm volatile("s_waitcnt lgkmcnt(0)" ::: "memory"); __builtin_amdgcn_s_barrier(); asm volatile("" ::: "memory");
#pragma unroll
                for (int m = 0; m < 4; ++m) {
                    const int lr = wr * 64 + m * 16 + fr;
                    const f32x4 cvm = *(const LAS f32x4*)(halo + lr * 128 + ((wc ^ (lr & 7)) << 4)), svm = *(const LAS f32x4*)(halo + lr * 128 + (((4 + wc) ^ (lr & 7)) << 4));
                    const f32x4 c = rot ? cvm * sc : (f32x4){sc, sc, sc, sc}, sn = rot ? svm * sc : (f32x4){0.f, 0.f, 0.f, 0.f};
                    bf16_t* rowp = base + (size_t)(row0 + ai * HALF + m * 16) * 1024 + colt + lc;
#pragma unroll
                    for (int bj = 0; bj < 2; ++bj) { const f32x4 v0 = acc[ai][bj][m][0], v1 = acc[ai][bj][m][1];
                        ST16((rowp + bj * HALF), (pack8(v0 * c - v1 * sn, v0 * sn + v1 * c))); }
                }
            }
        } else if (pn < 36) {
            const int tv = pn - 24, colt = (tv & 3) * BM; bf16_t* vbase = V + (size_t)(tv >> 2) * M * 1024;
#pragma unroll
            for (int ai = 0; ai < 2; ++ai)
#pragma unroll
                for (int m = 0; m < 4; ++m) { bf16_t* rowp = vbase + (size_t)(row0 + ai * HALF + m * 16) * 1024 + colt + lc;
#pragma unroll
                    for (int bj = 0; bj < 2; ++bj) ST16((rowp + bj * HALF), (pack8(acc[ai][bj][m][0], acc[ai][bj][m][1]))); }
        } else if (pn < 40) {
            const int colt = (pn - 36) * BM;
#pragma unroll
            for (int ai = 0; ai < 2; ++ai)
#pragma unroll
                for (int m = 0; m < 4; ++m) { bf16_t* rowp = SZ + (size_t)(row0 + ai * HALF + m * 16) * NZA + colt + lc;
#pragma unroll
                    for (int bj = 0; bj < 2; ++bj) ST16((rowp + bj * HALF), (pack8(acc[ai][bj][m][0], acc[ai][bj][m][1]))); }
        } else if (pn < 72) {
            int chl = 16 * wc + 4 * fq, frh = fr - 14; asm volatile("" : "+v"(chl), "+v"(frh));
            const int ct = pn - 40, chb = 64 * ct + chl, pm = upm;
            const f32x4 w0 = *(const f32x4*)(cw + chb), w1 = *(const f32x4*)(cw + NCV + chb), w2 = *(const f32x4*)(cw + 2 * NCV + chb);
#pragma unroll
            for (int ai = 0; ai < 2; ++ai)
#pragma unroll
                for (int m = 0; m < 4; ++m) { const f32x4 pv = acc[ai][0][m][1] * acc[ai][1][m][0];
                    const int gi = 8 * ai + 4 * wr + m;
                    if (fr >= 14) { *(LAS f32x4*)(halo + (size_t)(((gi * 2 + frh) * 64 + chl) * 4)) = pv;
                        if (gi == 15) *(f32x4*)(HP + ((size_t)(pm * 2 + frh) * NCV + chb)) = pv; } }
            asm volatile("s_waitcnt lgkmcnt(0)" ::: "memory"); __builtin_amdgcn_s_barrier(); asm volatile("" ::: "memory");
#pragma unroll
            for (int ai = 0; ai < 2; ++ai)
#pragma unroll
                for (int m = 0; m < 4; ++m) {
                    const int gi = 8 * ai + 4 * wr + m; const int gp = gi > 0 ? gi - 1 : 0;
                    f32x4 H0 = *(const LAS f32x4*)(halo + (size_t)(((gp * 2 + 0) * 64 + chl) * 4)), H1 = *(const LAS f32x4*)(halo + (size_t)(((gp * 2 + 1) * 64 + chl) * 4));
                    if (gi == 0) { H0 = (f32x4){0.f, 0.f, 0.f, 0.f}; H1 = H0; }
                    const f32x4 Hs = (fr == 1) ? H1 : H0, pvv = acc[ai][0][m][1] * acc[ai][1][m][0];
                    f32x4 Pm1, Pm2, qv;
#pragma unroll
                    for (int j = 0; j < 4; ++j) {
                        const float pj = pvv[j], h1j = H1[j], hsj = Hs[j];
                        Pm1[j] = dpp_row_shr<0x111>(h1j, pj); Pm2[j] = dpp_row_shr<0x112>(hsj, pj);
                        qv[j] = acc[ai][0][m][0][j] * silu_f(acc[ai][1][m][1][j]); }
                    const f32x4 uu = w2 * pvv + w1 * Pm1 + w0 * Pm2, rv = qv * uu;
                    const size_t ro = (size_t)(row0 + ai * HALF + m * 16) * NCV + chb;
                    u32x2 rw; rw.x = cvt_pk_bf16(rv[0], rv[1]); rw.y = cvt_pk_bf16(rv[2], rv[3]);
                    ST8((R + ro), (rw));
                    if (gi == 0 && fr < 2 && pm > 0) { *(f32x4*)(FXQ + ((size_t)(pm * 2 + fr) * NCV + chb)) = qv; *(f32x4*)(FXU + ((size_t)(pm * 2 + fr) * NCV + chb)) = uu; }
                }
        } else {
            const int colt = (pn - 72) * HALF;
#pragma unroll
            for (int ai = 0; ai < 2; ++ai)
#pragma unroll
                for (int m = 0; m < 4; ++m) { const size_t ro = (size_t)(row0 + ai * HALF + m * 16) * D + colt + lc;
                    f32x4 r[2], c[2];
#pragma unroll
                    for (int n = 0; n < 2; ++n)
#pragma unroll
                        for (int j = 0; j < 4; ++j) { const float pc = 1.0f + __builtin_amdgcn_exp2f(-acc[ai][1][m][n][j] * LOG2E), pa = 1.0f + __builtin_amdgcn_exp2f(-acc[ai][0][m][n][j] * LOG2E);
                            const float t = __builtin_amdgcn_rcpf(pa * pc); c[n][j] = pa * t; r[n][j] = pc * pc * t; }
                    ST16((SGA + ro), (pack8(r[0], r[1]))); ST16((SGC + ro), (pack8(c[0], c[1]))); }
        }
    }
};
struct EpiMerge {
    static constexpr bool PERM = true;
    bf16_t* O; const bf16_t* RHO; const bf16_t* SC; int ldc;
    __device__ __forceinline__ size_t lane_off(const Unit& u, int wr, int wc, int fr, int fq, int ai) const {
        size_t o = (size_t)(u.pm * BM + wr * 64 + fr + ai * HALF) * ldc + u.pn * BM + wc * 32 + 8 * fq; asm volatile("" : "+v"(o)); return o; }
    __device__ __forceinline__ void scale(f32x4 (&acc)[2][2][4][2], const Unit& u, int wr, int wc, int fr, int fq, bool is_mid) const {
        const bf16_t* G = is_mid ? RHO : SC;
#pragma unroll
        for (int ai = 0; ai < 2; ++ai) {
            const bf16_t* p = G + lane_off(u, wr, wc, fr, fq, ai);
            u32x4 gw[4][2];
#pragma unroll
            for (int m = 0; m < 4; ++m)
#pragma unroll
                for (int bj = 0; bj < 2; ++bj) gw[m][bj] = *(const u32x4*)(p + (size_t)m * 16 * ldc + bj * HALF);
#pragma unroll
            for (int m = 0; m < 4; ++m)
#pragma unroll
                for (int bj = 0; bj < 2; ++bj) { f32x4 g0, g1; unpack8(gw[m][bj], g0, g1); acc[ai][bj][m][0] *= g0; acc[ai][bj][m][1] *= g1; }
        }
    }
    __device__ __forceinline__ void mid(f32x4 (&)[2][2][4][2], const Unit&, int, int, int, int) const {}
    __device__ __forceinline__ void operator()(const f32x4 (&acc)[2][2][4][2], const Unit& u, int wr, int wc, int fr, int fq) const {
#pragma unroll
        for (int ai = 0; ai < 2; ++ai) {
            bf16_t* q = O + lane_off(u, wr, wc, fr, fq, ai);
#pragma unroll
            for (int m = 0; m < 4; ++m)
#pragma unroll
                for (int bj = 0; bj < 2; ++bj) *(u32x4*)(q + (size_t)m * 16 * ldc + bj * HALF) = pack8(acc[ai][bj][m][0], acc[ai][bj][m][1]);
        }
    }
};
struct EpiBf16 {
    static constexpr bool PERM = true;
    __device__ __forceinline__ void mid(f32x4 (&)[2][2][4][2], const Unit&, int, int, int, int) const {}
    bf16_t* O; int ldc;
    __device__ __forceinline__ void operator()(const f32x4 (&acc)[2][2][4][2], const Unit& u, int wr, int wc, int fr, int fq) const {
        const int row0 = u.pm * BM + wr * 64 + fr, col0 = u.pn * BM + wc * 32 + 8 * fq;
#pragma unroll
        for (int ai = 0; ai < 2; ++ai)
#pragma unroll
            for (int m = 0; m < 4; ++m) { bf16_t* rowp = O + (size_t)(row0 + ai * HALF + m * 16) * ldc + col0;
#pragma unroll
                for (int bj = 0; bj < 2; ++bj) *(u32x4*)(rowp + bj * HALF) = pack8(acc[ai][bj][m][0], acc[ai][bj][m][1]); }
    }
};
struct SegOrder2 {
    StaticOrder so; const char *A0, *B0, *A1, *B1; size_t tstep; int nt0, nt1;
    __device__ __forceinline__ bool seg(int s_, Seg& o) const { Unit u; if (!so.next(s_ >> 1, u)) return false; const int h = s_ & 1;
        o.A = (h ? A1 : A0) + (size_t)u.pm * tstep; o.B = (h ? B1 : B0) + (size_t)u.pn * tstep; o.nt = h ? nt1 : nt0; o.mid = !h; o.u = u; rfl_seg(o); return true; }
};
}

#ifndef PG8_SP2
#define PG8_SP2 true
#endif
#ifndef PG8_ALIGN
#define PG8_ALIGN true
#endif

constexpr int NWAVES = 8;
#ifndef MK_N_LAUNCHES
#define MK_N_LAUNCHES 1
#endif
constexpr int NPHASES = 8;
constexpr int N_LAUNCHES = MK_N_LAUNCHES;

constexpr int CW_BAR = 4096, CW_MODCNT = 8000;
#define XCD_BAR_WORDS 3456

constexpr int RING_BYTES = 131072;
constexpr int LDSCTL_OFF = RING_BYTES, MISC_OFF = LDSCTL_OFF + 320, HALO_OFF = RING_BYTES + 1024;
constexpr int LDS_BYTES = 151552;
constexpr int ATT_STG_OFF = RING_BYTES + 1024, ATT_L0_OFF = ATT_STG_OFF + 16384;

typedef GAS unsigned gu32;
#define RLX_AGENT __ATOMIC_RELAXED, __HIP_MEMORY_SCOPE_AGENT

#define XB_TMO      128
#define XB_XCNT(j)  (256  + 64 * (j))
#define XB_XSUB(j)  (1280 + 64 * (j))
#define XB_XGEN(j)  (2304 + 64 * (j))
#define XB_TOP      3328
#define XB_TOPGEN   3392
#define XB_SPIN_CAP (1u << 18)

__device__ __forceinline__ unsigned xb_ld(unsigned* p)              { return __hip_atomic_load(p, __ATOMIC_RELAXED, __HIP_MEMORY_SCOPE_AGENT); }
__device__ __forceinline__ unsigned xb_add(unsigned* p, unsigned v) { return __hip_atomic_fetch_add(p, v, __ATOMIC_RELAXED, __HIP_MEMORY_SCOPE_AGENT); }
__device__ __forceinline__ unsigned xb_xcc_id() { return (unsigned)__builtin_amdgcn_s_getreg((3 << 11) | 20) & 0xFu; }
#define XB_SPIN(cond, bar) do { unsigned _sp = 0; while (cond) { __builtin_amdgcn_s_sleep(1); \
    if ((++_sp & 255u) == 0u) { if (xb_ld(&(bar)[XB_TMO])) break; if (_sp > XB_SPIN_CAP) { atomicAdd(&(bar)[XB_TMO], 1u); break; } } } } while (0)

struct XcdBarrier { unsigned* bar; unsigned x; volatile LAS unsigned* st; };

__device__ __forceinline__ XcdBarrier xcd_barrier_post(unsigned* bar, volatile LAS unsigned* st) {
    XcdBarrier b; b.bar = bar; b.x = xb_xcc_id(); b.st = st;
    if (threadIdx.x == 0) (void)xb_add(&bar[XB_XCNT(b.x)], 1u);
    return b;
}
__device__ __forceinline__ void xcd_barrier_complete(unsigned* bar, unsigned x, unsigned& nloc, unsigned& nx) {
    const unsigned G = gridDim.x * gridDim.y * gridDim.z;
    unsigned sum, cnt, mine, sp = 0u;
    for (;;) {
        sum = 0u; cnt = 0u; mine = 0u;
#pragma unroll
        for (unsigned j = 0; j < 16; ++j) { const unsigned c = xb_ld(&bar[XB_XCNT(j)]); sum += c; cnt += (c > 0u) ? 1u : 0u; mine = (j == x) ? c : mine; }
        if (sum == G) break;
        __builtin_amdgcn_s_sleep(1);
        if ((++sp & 255u) == 0u) { if (xb_ld(&bar[XB_TMO])) break; if (sp > XB_SPIN_CAP) { atomicAdd(&bar[XB_TMO], 1u); break; } }
    }
    nloc = mine > 0u ? mine : 1u; nx = cnt > 0u ? cnt : 1u;
}
__device__ __forceinline__ void xcd_barrier(const XcdBarrier& b) {
    asm volatile("s_waitcnt vmcnt(0)" ::: "memory");
    __syncthreads();
    if (threadIdx.x == 0) {
        unsigned* bar = b.bar;
        __builtin_amdgcn_s_waitcnt(0);
        unsigned nloc = b.st[0], nx = b.st[1];
        if (nloc == 0u) { xcd_barrier_complete(bar, b.x, nloc, nx); b.st[0] = nloc; b.st[1] = nx; }
        const unsigned old = xb_add(&bar[XB_XSUB(b.x)], 1u);
        const unsigned gen = old / nloc;
        if (old + 1u == (gen + 1u) * nloc) {
            __builtin_amdgcn_fence(__ATOMIC_RELEASE, "agent");
            asm volatile("s_waitcnt vmcnt(0)" ::: "memory");
            const unsigned og = xb_add(&bar[XB_TOP], 1u);
            const unsigned tg = og / nx;
            if (og + 1u == (tg + 1u) * nx) xb_add(&bar[XB_TOPGEN], 1u);
            else XB_SPIN(xb_ld(&bar[XB_TOPGEN]) == tg, bar);
            __builtin_amdgcn_fence(__ATOMIC_ACQUIRE, "agent");
            xb_add(&bar[XB_XGEN(b.x)], 1u);
            asm volatile("s_waitcnt vmcnt(0)" ::: "memory");
        } else {
            XB_SPIN(xb_ld(&bar[XB_XGEN(b.x)]) == gen, bar);
            __builtin_amdgcn_fence(__ATOMIC_ACQUIRE, "agent");
            asm volatile("s_waitcnt vmcnt(0)" ::: "memory");
        }
    }
    __syncthreads();
}

#define LDS_WAIT() asm volatile("s_waitcnt lgkmcnt(0)" ::: "memory")
__device__ __forceinline__ float wave_sum(float v) {
#pragma unroll
    for (int o = 1; o < 64; o <<= 1) v += __shfl_xor(v, o);
    return v;
}
__device__ __forceinline__ unsigned f2bf(float f) { unsigned u = __builtin_bit_cast(unsigned, f); return (u + 0x7fffu + ((u >> 16) & 1u)) >> 16; }
__device__ __forceinline__ unsigned pk2(float lo, float hi) { return f2bf(lo) | (f2bf(hi) << 16); }

__device__ __forceinline__ int proj_orig_col(int n) {
    const int tile = n >> 8, c = n & 255;
    if (tile < 24) { const int c7 = n & 127, wc = c7 >> 5, fq = (c7 >> 3) & 3, nn = (c7 >> 2) & 1, j = c7 & 3;
        const int dim = (fq == 0) ? (4 * wc + j + 16 * nn) : (32 + wc * 24 + (fq - 1) * 8 + 4 * nn + j); return (n & ~127) + dim; }
    if (tile < 40) return n;
    if (tile < 72) { const int kind = 2 * (c >> 7) + ((c >> 2) & 1), chl = 16 * ((c >> 5) & 3) + 4 * ((c >> 3) & 3) + (c & 3); return 10240 + kind * 2048 + 64 * (tile - 40) + chl; }
    return 18432 + (c >> 7) * 2048 + 128 * (tile - 72) + (c & 127);
}
struct TItem { const float* src; bf16_t* dst; int N; };
__device__ __forceinline__ void t_decode(const float* W, int N, bf16_t* WT, int pitch, bool remap, int item, int lane, TItem& d) {
    const int nblk = N / 32, kb = item / nblk, nb = item % nblk, k0 = 64 * kb, n0 = 32 * nb;
    const int ncol = remap ? proj_orig_col(n0 + (lane & 31)) : n0 + (lane & 31);
    d.src = W + (size_t)(k0 + (lane >> 5)) * N + ncol; d.dst = WT + (size_t)(n0 + (lane >> 3)) * pitch + k0 + 8 * (lane & 7); d.N = N;
}
__device__ __forceinline__ void t_load(const TItem& d, float (&wv)[32]) {
#pragma unroll
    for (int i = 0; i < 32; ++i) wv[i] = d.src[(size_t)(2 * i) * d.N];
}
__device__ __forceinline__ void t_finish(const TItem& d, const float (&wv)[32], int pitch, LAS float* scr, int lane) {
#pragma unroll
    for (int i = 0; i < 32; ++i) scr[(2 * i + (lane >> 5)) * 33 + (lane & 31)] = wv[i];
    LDS_WAIT(); asm volatile("" ::: "memory");
    const int c = lane & 7;
#pragma unroll
    for (int j = 0; j < 4; ++j) { const int n = (lane >> 3) + 8 * j; const LAS float* s = scr + (8 * c) * 33 + n;
        u32x4 o; o.x = pk2(s[0 * 33], s[1 * 33]); o.y = pk2(s[2 * 33], s[3 * 33]); o.z = pk2(s[4 * 33], s[5 * 33]); o.w = pk2(s[6 * 33], s[7 * 33]);
        *(u32x4*)(d.dst + (size_t)(8 * j) * pitch) = o; }
    LDS_WAIT(); asm volatile("" ::: "memory");
}

__device__ __forceinline__ void sincos_f64(float ang, float& s, float& c) {
    const double x = (double)ang;
    const double n = __builtin_rint(x * 0.15915494309189535);
    double r = __builtin_fma(-n, 6.283185307179586, x); r = __builtin_fma(-n, 2.4492935982947064e-16, r);
    const double r2 = r * r;
    double ps = 1.0 / 51090942171709440000.0;
    ps = __builtin_fma(ps, r2, -1.0 / 121645100408832000.0);
    ps = __builtin_fma(ps, r2, 1.0 / 355687428096000.0);
    ps = __builtin_fma(ps, r2, -1.0 / 1307674368000.0);
    ps = __builtin_fma(ps, r2, 1.0 / 6227020800.0);
    ps = __builtin_fma(ps, r2, -1.0 / 39916800.0);
    ps = __builtin_fma(ps, r2, 1.0 / 362880.0);
    ps = __builtin_fma(ps, r2, -1.0 / 5040.0);
    ps = __builtin_fma(ps, r2, 1.0 / 120.0);
    ps = __builtin_fma(ps, r2, -1.0 / 6.0);
    ps = __builtin_fma(ps, r2, 1.0);
    double pc = -1.0 / 1124000727777607680000.0;
    pc = __builtin_fma(pc, r2, 1.0 / 2432902008176640000.0);
    pc = __builtin_fma(pc, r2, -1.0 / 6402373705728000.0);
    pc = __builtin_fma(pc, r2, 1.0 / 20922789888000.0);
    pc = __builtin_fma(pc, r2, -1.0 / 87178291200.0);
    pc = __builtin_fma(pc, r2, 1.0 / 479001600.0);
    pc = __builtin_fma(pc, r2, -1.0 / 3628800.0);
    pc = __builtin_fma(pc, r2, 1.0 / 40320.0);
    pc = __builtin_fma(pc, r2, -1.0 / 720.0);
    pc = __builtin_fma(pc, r2, 1.0 / 24.0);
    pc = __builtin_fma(pc, r2, -0.5);
    pc = __builtin_fma(pc, r2, 1.0);
    s = (float)(r * ps); c = (float)pc;
}

__device__ __forceinline__ unsigned attn_offk(unsigned slot, unsigned row, unsigned ch) { return slot * 32768u + 256u * row + 16u * (ch ^ (row & 15u)); }
__device__ __forceinline__ unsigned attn_offv(unsigned slot, unsigned lrow, unsigned ch) { return 65536u + slot * 32768u + 256u * lrow + 16u * (ch ^ (((lrow & 3u) << 2) | ((lrow >> 2) & 3u))); }
__device__ __forceinline__ unsigned attn_lrow(unsigned k) { return (k & ~31u) | (((k >> 2) & 3u) << 3) | (((k >> 4) & 1u) << 2) | (k & 3u); }

template <bool COMBINE>
__device__ __forceinline__ void attn_chunk(LAS unsigned char* lds, const bf16_t* Qg, const bf16_t* Kg, const bf16_t* Vg, const int dsh, const int hh, const int r, const int n0, const int nblk,
                                           bf16_t* Og, float* LSEg, const bf16_t* O1, const bf16_t* O2, const float* LSE1, const float* LSE2, const bf16_t* SZ, bf16_t* AATT) {
    int tid = threadIdx.x; asm volatile("" : "+v"(tid));
    const int lane = tid & 63, wid = __builtin_amdgcn_readfirstlane(tid >> 6), fr = lane & 15, fq = lane >> 4;
    const int sch = tid & 15, srb = tid >> 4;
    const size_t scol = (size_t)hh * 256 + sch * 16;
    u32x4 kreg[4], vreg[4];
#define ATT_LOAD(blk) do { _Pragma("unroll") for (int i = 0; i < 4; ++i) { const size_t p = ((size_t)(128 * (blk) + srb + 32 * i) << dsh) + r; const size_t off = p * 2048 + scol; \
        kreg[i] = *(const u32x4*)((const char*)Kg + off); vreg[i] = *(const u32x4*)((const char*)Vg + off); } } while (0)
#define ATT_WRITE(slot) do { _Pragma("unroll") for (int i = 0; i < 4; ++i) { const unsigned row = srb + 32 * i; \
        *(LAS u32x4*)(lds + attn_offk((slot), row, sch)) = kreg[i]; *(LAS u32x4*)(lds + attn_offv((slot), attn_lrow(row), sch)) = vreg[i]; } } while (0)
    const unsigned q4 = (unsigned)(lane & 15) >> 2, p4 = (unsigned)lane & 3u, parA = (unsigned)wid & 1u, parB = parA ^ 1u;
    unsigned kbase[4], vbA[8], vbB[8];
#pragma unroll
    for (int s_ = 0; s_ < 4; ++s_) kbase[s_] = 256u * fr + 16u * ((unsigned)(4 * s_ + fq) ^ (unsigned)fr);
#pragma unroll
    for (int c = 0; c < 8; ++c) {
        vbA[c] = 65536u + 256u * (((unsigned)fq << 3) | (parA << 2) | q4) + 16u * ((unsigned)(2 * c + (p4 >> 1)) ^ ((q4 << 2) | (((unsigned)fq & 1u) << 1) | parA)) + 8u * (p4 & 1u);
        vbB[c] = 65536u + 256u * (((unsigned)fq << 3) | (parB << 2) | q4) + 16u * ((unsigned)(2 * c + (p4 >> 1)) ^ ((q4 << 2) | (((unsigned)fq & 1u) << 1) | parB)) + 8u * (p4 & 1u);
    }
    if (n0 > 0) { ATT_LOAD(n0 - 1); }
    else {
#pragma unroll
        for (int i = 0; i < 4; ++i) { kreg[i] = (u32x4){0u, 0u, 0u, 0u}; vreg[i] = (u32x4){0u, 0u, 0u, 0u}; } }
    ATT_WRITE((unsigned)((n0 + 1) & 1));
    ATT_LOAD(n0); ATT_WRITE((unsigned)(n0 & 1));
    __syncthreads();
    for (int n = n0; n < n0 + nblk; ++n) {
        const bool more = (n + 1 < n0 + nblk);
        if (more) ATT_LOAD(n + 1);
        const unsigned cs_ = (unsigned)(n & 1), ps_ = cs_ ^ 1u;
        const int lq = 128 * n + 16 * wid + fr; const size_t pq = ((size_t)lq << dsh) + r;
        bf16x8 qf[4];
        { const bf16x8* qp = (const bf16x8*)((const char*)Qg + pq * 2048 + (size_t)hh * 256 + fq * 16);
#pragma unroll
          for (int s = 0; s < 4; ++s) qf[s] = qp[4 * s]; }
        f32x4 S[9];
#pragma unroll
        for (int t = 0; t < 9; ++t) {
            S[t] = (f32x4){0.f, 0.f, 0.f, 0.f};
            const unsigned kr0 = 16 * wid + 16 * t, uo = ((kr0 < 128u) ? ps_ : cs_) * 32768u + 256u * (kr0 & 127u);
#pragma unroll
            for (int s = 0; s < 4; ++s) { const bf16x8 kf = *(const LAS bf16x8*)(lds + (kbase[s] + uo)); S[t] = __builtin_amdgcn_mfma_f32_16x16x32_bf16(kf, qf[s], S[t], 0, 0, 0); }
        }
        const float NEG = -1e30f;
#pragma unroll
        for (int j = 0; j < 4; ++j) { const int ko0 = 4 * fq + j; if (ko0 < fr) S[0][j] = NEG; if (ko0 > fr) S[8][j] = NEG; }
        if (n == 0) {
#pragma unroll
            for (int t = 0; t < 9; ++t)
#pragma unroll
                for (int j = 0; j < 4; ++j) { if (16 * wid + 16 * t + 4 * fq + j < 128) S[t][j] = NEG; }
        }
        float mx = NEG;
#pragma unroll
        for (int t = 0; t < 9; ++t) mx = fmaxf(mx, fmaxf(fmaxf(S[t][0], S[t][1]), fmaxf(S[t][2], S[t][3])));
        mx = fmaxf(mx, __shfl_xor(mx, 16)); mx = fmaxf(mx, __shfl_xor(mx, 32));
        float sum = 0.f;
#pragma unroll
        for (int t = 0; t < 9; ++t)
#pragma unroll
            for (int j = 0; j < 4; ++j) { const float p = __builtin_amdgcn_exp2f(S[t][j] - mx); S[t][j] = p; sum += p; }
        sum += __shfl_xor(sum, 16); sum += __shfl_xor(sum, 32);
        const int rq = lane >> 3, rch = lane & 7;
        size_t tokq[2]; float l1q[2] = {0.f, 0.f}, l2q[2] = {0.f, 0.f};
#pragma unroll
        for (int k = 0; k < 2; ++k) { tokq[k] = ((size_t)(128 * n + 16 * wid + rq + 8 * k) << dsh) + r; if (COMBINE) { l1q[k] = LSE1[tokq[k] * 8 + hh]; l2q[k] = LSE2[tokq[k] * 8 + hh]; } }
        f32x4 O[8];
#pragma unroll
        for (int c = 0; c < 8; ++c) O[c] = (f32x4){0.f, 0.f, 0.f, 0.f};
#pragma unroll
        for (int u = 0; u < 5; ++u) {
            u32x4 pw; pw.x = cvt_pk_bf16(S[2 * u][0], S[2 * u][1]); pw.y = cvt_pk_bf16(S[2 * u][2], S[2 * u][3]);
            if (u < 4) { pw.z = cvt_pk_bf16(S[2 * u + 1][0], S[2 * u + 1][1]); pw.w = cvt_pk_bf16(S[2 * u + 1][2], S[2 * u + 1][3]); } else { pw.z = 0u; pw.w = 0u; }
            const bf16x8 pf = __builtin_bit_cast(bf16x8, pw);
            const unsigned kba = 16 * wid + 32 * u, kbb = kba + 16;
            const unsigned uoa = ((kba < 128u) ? ps_ : cs_) * 32768u + 256u * (kba & 96u), uob = ((kbb < 128u) ? ps_ : cs_) * 32768u + 256u * (kbb & 96u);
#pragma unroll
            for (int c = 0; c < 8; ++c) {
                const s16x4 va = __builtin_amdgcn_ds_read_tr16_b64_v4i16((LAS s16x4*)(lds + (vbA[c] + uoa)));
                const s16x4 vb = __builtin_amdgcn_ds_read_tr16_b64_v4i16((LAS s16x4*)(lds + ((u < 4) ? (vbB[c] + uob) : (vbA[c] + uoa))));
                const bf16x8 vf = __builtin_shufflevector(va, vb, 0, 1, 2, 3, 4, 5, 6, 7);
                O[c] = __builtin_amdgcn_mfma_f32_16x16x32_bf16(vf, pf, O[c], 0, 0, 0);
            }
        }
        const float inv = 1.0f / sum;
        const float l0 = mx + __builtin_amdgcn_logf(sum);
        LAS unsigned char* const stg = lds + ATT_STG_OFF + wid * 2048;
        if (!COMBINE) { if (fq == 0) LSEg[pq * 8 + hh] = l0; }
        else { if (fq == 0) *(LAS float*)(lds + ATT_L0_OFF + wid * 64 + fr * 4) = l0; }
        float w0q[2], w1q[2], w2q[2];
        if (COMBINE) {
            asm volatile("" ::: "memory");
#pragma unroll
            for (int k = 0; k < 2; ++k) { const float l0k = *(const LAS float*)(lds + ATT_L0_OFF + wid * 64 + (rq + 8 * k) * 4), m3 = fmaxf(l0k, fmaxf(l1q[k], l2q[k]));
                const float e0 = __builtin_amdgcn_exp2f(l0k - m3), e1 = __builtin_amdgcn_exp2f(l1q[k] - m3), e2 = __builtin_amdgcn_exp2f(l2q[k] - m3), iw = 1.0f / (e0 + e1 + e2);
                w0q[k] = e0 * iw; w1q[k] = e1 * iw; w2q[k] = e2 * iw; }
        }
#pragma unroll
        for (int h = 0; h < 2; ++h) {
#pragma unroll
            for (int cl = 0; cl < 4; ++cl) { const int c = 4 * h + cl; u32x2 w; w.x = cvt_pk_bf16(O[c][0] * inv, O[c][1] * inv); w.y = cvt_pk_bf16(O[c][2] * inv, O[c][3] * inv);
                *(LAS u32x2*)(stg + fr * 128 + (((2 * cl + (fq >> 1)) ^ (fr & 7)) << 4) + (fq & 1) * 8) = w; }
            asm volatile("" ::: "memory");
#pragma unroll
            for (int k = 0; k < 2; ++k) { const int q = rq + 8 * k; const u32x4 ow = *(const LAS u32x4*)(stg + q * 128 + ((rch ^ (q & 7)) << 4));
                const size_t eo = tokq[k] * 1024 + hh * 128 + 64 * h + rch * 8;
                if (!COMBINE) { *(u32x4*)(Og + eo) = ow; }
                else {
                    const u32x4 a1w = *(const u32x4*)(O1 + eo), a2w = *(const u32x4*)(O2 + eo), zw = *(const u32x4*)(SZ + eo);
                    f32x4 o0a, o0b, a1a, a1b, a2a, a2b, za, zb; pg8::unpack8(ow, o0a, o0b); pg8::unpack8(a1w, a1a, a1b); pg8::unpack8(a2w, a2a, a2b); pg8::unpack8(zw, za, zb);
#pragma unroll
                    for (int j = 0; j < 4; ++j) { za[j] = silu_f(za[j]); zb[j] = silu_f(zb[j]); }
                    const f32x4 ra = (o0a * w0q[k] + a1a * w1q[k] + a2a * w2q[k]) * za, rb = (o0b * w0q[k] + a1b * w1q[k] + a2b * w2q[k]) * zb;
                    *(u32x4*)(AATT + tokq[k] * 2048 + hh * 128 + 64 * h + rch * 8) = pg8::pack8(ra, rb);
                }
            }
            asm volatile("" ::: "memory");
        }
        __syncthreads();
        if (more) ATT_WRITE(ps_);
        __syncthreads();
    }
#undef ATT_LOAD
#undef ATT_WRITE
}

struct Args { const float* x; const float* c; const int* pos; const float* g_pre; const float* w_ada; const float* b_ada; const float* w_in; const float* conv_w;
              const float* w_attn_o; const float* w_conv_o; const float* w_o; const float* g_post; float* out; unsigned char* ws; int ph_lo, ph_hi, li, pad; };

__global__ void __launch_bounds__(NWAVES * 64, 2) mk_fwd(Args args) {
    extern __shared__ __attribute__((aligned(16))) unsigned char lds_raw[];
    LAS unsigned char* lds = (LAS unsigned char*)lds_raw;
    volatile LAS unsigned* MISC = (volatile LAS unsigned*)(lds + MISC_OFF);
    const int tid = threadIdx.x, lane = tid & 63, wave = __builtin_amdgcn_readfirstlane(tid >> 6);
    const int G = gridDim.x; const int bx = blockIdx.x; const int vcu = (G % 8 == 0) ? (bx % 8) * (G / 8) + bx / 8 : bx;
    unsigned char* ws = args.ws;
    gu32* ctl = (gu32*)(ws + WS_CTL);
    float* mod = (float*)(ws + WS_MOD); float* cs = (float*)(ws + WS_CS);
    bf16_t* WinT = (bf16_t*)(ws + WS_WIN); bf16_t* WaT = (bf16_t*)(ws + WS_WA); bf16_t* WcT = (bf16_t*)(ws + WS_WC); bf16_t* WoT = (bf16_t*)(ws + WS_WO);
    bf16_t* Hb = (bf16_t*)(ws + WS_H); bf16_t* Qb = (bf16_t*)(ws + WS_Q); bf16_t* Kb = (bf16_t*)(ws + WS_K); bf16_t* Vb = (bf16_t*)(ws + WS_V);
    bf16_t* SZ = (bf16_t*)(ws + WS_SZ); float* HPb = (float*)(ws + WS_FX); float* FXQb = HPb + (size_t)64 * 2 * NCV; float* FXUb = FXQb + (size_t)64 * 2 * NCV;
    bf16_t* SGA = (bf16_t*)args.out; bf16_t* SGC = SGA + (size_t)M * D;
    bf16_t* O1 = (bf16_t*)(ws + WS_O1); bf16_t* O2 = (bf16_t*)(ws + WS_O2); float* LSE = (float*)(ws + WS_LSE);
    bf16_t* AATT = (bf16_t*)(ws + WS_AATT); bf16_t* Rb = (bf16_t*)(ws + WS_R); bf16_t* MG = (bf16_t*)(ws + WS_MG);
    bf16_t* Yb = (bf16_t*)(ws + WS_Y);

    for (int u = tid; u < (LDS_BYTES - LDSCTL_OFF) / 4; u += NWAVES * 64) ((LAS unsigned*)(lds + LDSCTL_OFF))[u] = 0u;
    __syncthreads();
    const int bli = (N_LAUNCHES == 1) ? 0 : args.li;
    XcdBarrier bar; bar.bar = (unsigned*)(ctl + CW_BAR) + bli * XCD_BAR_WORDS; bar.x = 0; bar.st = nullptr;
    if (N_LAUNCHES == 1) bar = xcd_barrier_post((unsigned*)(ctl + CW_BAR), MISC + 8);
    const int lo = args.ph_lo, hi = args.ph_hi;
#define IN(k) (lo <= (k) && (k) < hi)
#define BOTH(k) (IN(k) && IN((k) + 1))
#define GRID_BAR() xcd_barrier(bar)
#ifndef PROBE_REPEAT_MASK
#define PROBE_REPEAT_MASK 0
#endif
#ifndef PROBE_REPEAT_N
#define PROBE_REPEAT_N 1
#endif
#define NREP(k) ((((PROBE_REPEAT_MASK) >> (k)) & 1) * (PROBE_REPEAT_N) + 1)
    const int gw = vcu * NWAVES + wave, NGW = G * NWAVES;
    const int gtid = vcu * (NWAVES * 64) + tid, NT = G * NWAVES * 64;

    if (IN(0)) for (int rep = 0; rep < NREP(0); ++rep) {
        {
            LAS float* red = (LAS float*)lds;
            for (int cbk = bx; cbk < 256; cbk += G) {
                const int c4 = tid % 6, rg = tid / 6;
                f32x4 a = (f32x4){0.f, 0.f, 0.f, 0.f};
                if (rg < 85) {
#pragma unroll 6
                    for (int k = rg; k < D; k += 85) { const float cv = args.c[k]; const f32x4 w = *(const f32x4*)(args.w_ada + (size_t)k * NMOD + cbk * 24 + c4 * 4); a += w * cv; }
                    *(LAS f32x4*)(red + (rg * 6 + c4) * 4) = a; }
                __syncthreads();
                if (tid < 24) { float s = 0.f; for (int i = 0; i < 85; ++i) s += red[(i * 6 + (tid >> 2)) * 4 + (tid & 3)];
                    __hip_atomic_store(mod + cbk * 24 + tid, s + args.b_ada[cbk * 24 + tid], __ATOMIC_RELAXED, __HIP_MEMORY_SCOPE_AGENT); }
                asm volatile("s_waitcnt vmcnt(0)" ::: "memory");
                __syncthreads();
                if (tid == 0) __hip_atomic_fetch_add((unsigned*)(ctl + CW_MODCNT), 1u, __ATOMIC_RELAXED, __HIP_MEMORY_SCOPE_AGENT);
            }
        }
        for (int idx = gtid; idx < M * 16; idx += NT) { const int m = idx >> 4, i = idx & 15; const float ang = (float)args.pos[m] * INVF[i]; float s, c; sincos_f64(ang, s, c); cs[m * 32 + i] = c; cs[m * 32 + 16 + i] = s; }
        {
            LAS float* scr = (LAS float*)(lds + wave * 16384);
            constexpr int I_IN = (D / 64) * (PROJ / 32), I_A = (NZA / 64) * (D / 32), I_C = (NCV / 64) * (D / 32), I_O = (D / 64) * (D / 32);
            constexpr int NITEMS = I_IN + I_A + I_C + I_O;
#define T_DECODE(it_, d_) do { int r_ = (it_); \
                if (r_ < I_IN) t_decode(args.w_in, PROJ, WinT, D, true, r_, lane, d_); \
                else if ((r_ -= I_IN) < I_A) t_decode(args.w_attn_o, D, WaT, D, false, r_, lane, d_); \
                else if ((r_ -= I_A) < I_C) t_decode(args.w_conv_o, D, WcT, D, false, r_, lane, d_); \
                else t_decode(args.w_o, D, WoT, D, false, r_ - I_C, lane, d_); } while (0)
            TItem cur_, nxt_; float wa[32], wb[32];
            int it = gw;
            if (it < NITEMS) { T_DECODE(it, cur_); t_load(cur_, wa); }
            while (it < NITEMS) {
                const int nit = it + NGW;
                if (nit < NITEMS) { T_DECODE(nit, nxt_); t_load(nxt_, wb); }
                t_finish(cur_, wa, D, scr, lane);
                cur_ = nxt_;
#pragma unroll
                for (int i = 0; i < 32; ++i) wa[i] = wb[i];
                it = nit;
            }
#undef T_DECODE
        }
        if (tid == 0) {
            unsigned sp = 0;
            while (__hip_atomic_load((unsigned*)(ctl + CW_MODCNT), __ATOMIC_RELAXED, __HIP_MEMORY_SCOPE_AGENT) < 256u * (unsigned)(rep + 1)) { __builtin_amdgcn_s_sleep(2); if (++sp > (1u << 22)) break; }
            __builtin_amdgcn_fence(__ATOMIC_ACQUIRE, "agent");
            asm volatile("s_waitcnt vmcnt(0)" ::: "memory");
        }
        __syncthreads();
        f32x4 av[4][2], bv[4][2];
#pragma unroll
        for (int j = 0; j < 4; ++j)
#pragma unroll
            for (int h = 0; h < 2; ++h) { const int k = 512 * j + 8 * lane + 4 * h; const f32x4 gp = *(const f32x4*)(args.g_pre + k); f32x4 sc, sh;
#pragma unroll
                for (int e = 0; e < 4; ++e) { sc[e] = __hip_atomic_load(mod + D + k + e, __ATOMIC_RELAXED, __HIP_MEMORY_SCOPE_AGENT); sh[e] = __hip_atomic_load(mod + k + e, __ATOMIC_RELAXED, __HIP_MEMORY_SCOPE_AGENT); }
                av[j][h] = gp * (sc + 1.0f); bv[j][h] = sh; }
        for (int m = gw; m < M; m += NGW) {
            const float* xr = args.x + (size_t)m * D + 8 * lane;
            f32x4 v[4][2]; float ss = 0.f;
#pragma unroll
            for (int j = 0; j < 4; ++j)
#pragma unroll
                for (int h = 0; h < 2; ++h) { v[j][h] = *(const f32x4*)(xr + 512 * j + 4 * h); const f32x4 q = v[j][h] * v[j][h]; ss += (q[0] + q[1]) + (q[2] + q[3]); }
            const float rstd = 1.0f / sqrtf(wave_sum(ss) * (1.0f / D) + EPS);
            bf16_t* hr = Hb + (size_t)m * D + 8 * lane;
#pragma unroll
            for (int j = 0; j < 4; ++j) { const f32x4 h0 = v[j][0] * rstd * av[j][0] + bv[j][0], h1 = v[j][1] * rstd * av[j][1] + bv[j][1]; *(u32x4*)(hr + 512 * j) = pg8::pack8(h0, h1); }
        }
        if (BOTH(0) || rep + 1 < NREP(0)) GRID_BAR();
    }
    if (IN(2)) {
        pg8::SegOrder1 S; S.so.init(M, PROJ, G, bx, NREP(2)); S.A = (const char*)Hb; S.B = (const char*)WinT; S.tstep = (size_t)256 * D * 2; S.nt = D / 64;
        pg8::EpiProj E{ws, SGA, args.conv_w, lds + HALO_OFF};
        pg8::gemm_stream<pg8::EpiProj, pg8::SegOrder1>(lds, D, S, E);
        if (BOTH(2)) GRID_BAR();
    }
    if (IN(3)) for (int rep = 0; rep < NREP(3); ++rep) {
        for (int idx = gtid; idx < 63 * 2 * (NCV / 4); idx += NT) {
            const int c4 = idx % (NCV / 4), pj = idx / (NCV / 4), j = pj & 1, pm = 1 + (pj >> 1), ch = 4 * c4;
            const f32x4 h0 = *(const f32x4*)(HPb + ((size_t)((pm - 1) * 2 + 0) * NCV + ch)), h1 = *(const f32x4*)(HPb + ((size_t)((pm - 1) * 2 + 1) * NCV + ch));
            const f32x4 w0 = *(const f32x4*)(args.conv_w + ch), w1 = *(const f32x4*)(args.conv_w + NCV + ch);
            const f32x4 qv = *(const f32x4*)(FXQb + ((size_t)(pm * 2 + j) * NCV + ch)), uu = *(const f32x4*)(FXUb + ((size_t)(pm * 2 + j) * NCV + ch));
            const f32x4 miss = (j == 0) ? (w1 * h1 + w0 * h0) : (w0 * h1);
            const f32x4 rv = qv * (uu + miss);
            u32x2 rw; rw.x = cvt_pk_bf16(rv[0], rv[1]); rw.y = cvt_pk_bf16(rv[2], rv[3]);
            *(u32x2*)(Rb + ((size_t)(256 * pm + j) * NCV + ch)) = rw;
        }
        for (int chunk = vcu; chunk < 256; chunk += G) {
            int g, hh, r, n0;
            if (chunk < 128) { g = 2; hh = chunk >> 4; r = chunk & 15; n0 = 0; } else { const int idx = chunk - 128; g = 1; hh = idx >> 4; r = (idx & 15) >> 2; n0 = (idx & 3) * 8; }
            const size_t go = (size_t)g * M * 1024;
            attn_chunk<false>(lds, Qb + go, Kb + go, Vb + go, 2 * g, hh, r, n0, 8, (g == 1) ? O1 : O2, LSE + (size_t)g * M * 8, nullptr, nullptr, nullptr, nullptr, nullptr, nullptr);
        }
        if (BOTH(3) || rep + 1 < NREP(3)) GRID_BAR();
    }
    if (IN(4)) for (int rep = 0; rep < NREP(4); ++rep) {
        for (int chunk = vcu; chunk < 256; chunk += G)
            attn_chunk<true>(lds, Qb, Kb, Vb, 0, chunk >> 5, 0, (chunk & 31) * 4, 4, nullptr, nullptr, O1, O2, LSE + (size_t)1 * M * 8, LSE + (size_t)2 * M * 8, SZ, AATT);
        if (BOTH(4) || rep + 1 < NREP(4)) GRID_BAR();
    }
    if (IN(5)) {
        pg8::SegOrder2 S; S.so.init(M, D, G, bx, NREP(5)); S.A0 = (const char*)AATT; S.B0 = (const char*)WaT; S.A1 = (const char*)Rb; S.B1 = (const char*)WcT; S.tstep = (size_t)256 * D * 2; S.nt0 = NZA / 64; S.nt1 = NCV / 64;
        pg8::EpiMerge E{MG, SGA, SGC, D};
        pg8::gemm_stream<pg8::EpiMerge, pg8::SegOrder2, true>(lds, D, S, E);
        if (BOTH(5)) GRID_BAR();
    }
    if (IN(6)) {
        pg8::SegOrder1 S; S.so.init(M, D, G, bx, NREP(6)); S.A = (const char*)MG; S.B = (const char*)WoT; S.tstep = (size_t)256 * D * 2; S.nt = D / 64;
        pg8::EpiBf16 E{Yb, D};
        pg8::gemm_stream<pg8::EpiBf16, pg8::SegOrder1>(lds, D, S, E);
        if (BOTH(6)) GRID_BAR();
    }
    if (IN(7)) {
        f32x4 gv[4][2];
#pragma unroll
        for (int j = 0; j < 4; ++j)
#pragma unroll
            for (int h = 0; h < 2; ++h) { const int k = 512 * j + 8 * lane + 4 * h; gv[j][h] = *(const f32x4*)(mod + 2 * D + k) * *(const f32x4*)(args.g_post + k); }
        for (int m = gw; m < M; m += NGW) {
            const bf16_t* yr = Yb + (size_t)m * D + 8 * lane; const float* xr = args.x + (size_t)m * D + 8 * lane; float* orow = args.out + (size_t)m * D + 8 * lane;
            f32x4 v[4][2], xv[4][2]; u32x4 yw[4]; float ss = 0.f;
#pragma unroll
            for (int j = 0; j < 4; ++j) { yw[j] = *(const u32x4*)(yr + 512 * j); xv[j][0] = *(const f32x4*)(xr + 512 * j); xv[j][1] = *(const f32x4*)(xr + 512 * j + 4); }
#pragma unroll
            for (int j = 0; j < 4; ++j) { pg8::unpack8(yw[j], v[j][0], v[j][1]);
#pragma unroll
                for (int h = 0; h < 2; ++h) { const f32x4 q = v[j][h] * v[j][h]; ss += (q[0] + q[1]) + (q[2] + q[3]); } }
            const float rstd = 1.0f / sqrtf(wave_sum(ss) * (1.0f / D) + EPS);
#pragma unroll
            for (int j = 0; j < 4; ++j)
#pragma unroll
                for (int h = 0; h < 2; ++h) *(f32x4*)(orow + 512 * j + 4 * h) = xv[j][h] + gv[j][h] * (v[j][h] * rstd);
        }
    }
#undef IN
#undef BOTH
#undef GRID_BAR
}

extern "C" void kernel_launch(void* const* d_in, const int* in_sizes, int n_in, void* d_out, int out_size, void* d_ws, size_t ws_size, hipStream_t stream) {
    static int grid = 0;
    if (grid == 0) {
        if (n_in != 12 || in_sizes[0] != M * D || out_size != M * D || ws_size < WS_END) { fprintf(stderr, "kernel_launch: unexpected shapes (n_in %d, in0 %d, out %d, ws %zu); nothing launched\n", n_in, n_in > 0 ? in_sizes[0] : -1, out_size, ws_size); grid = -1; return; }
        int dev = 0, cus = 0;
        if (hipGetDevice(&dev) != hipSuccess || hipDeviceGetAttribute(&cus, hipDeviceAttributeMultiprocessorCount, dev) != hipSuccess) { grid = -1; return; }
        if (hipFuncSetAttribute((const void*)mk_fwd, hipFuncAttributeMaxDynamicSharedMemorySize, LDS_BYTES) != hipSuccess) { fprintf(stderr, "kernel_launch: hipFuncSetAttribute failed\n"); grid = -1; return; }
        (void)hipGetLastError();
        grid = cus;
    }
    if (grid < 0) return;
    if (hipMemsetAsync((char*)d_ws + WS_CTL, 0, CTL_ZERO_BYTES, stream) != hipSuccess) return;
    Args a{};
    a.x = (const float*)d_in[0]; a.c = (const float*)d_in[1]; a.pos = (const int*)d_in[2]; a.g_pre = (const float*)d_in[3]; a.w_ada = (const float*)d_in[4]; a.b_ada = (const float*)d_in[5];
    a.w_in = (const float*)d_in[6]; a.conv_w = (const float*)d_in[7]; a.w_attn_o = (const float*)d_in[8]; a.w_conv_o = (const float*)d_in[9]; a.w_o = (const float*)d_in[10]; a.g_post = (const float*)d_in[11];
    a.out = (float*)d_out; a.ws = (unsigned char*)d_ws;
    for (int li = 0; li < N_LAUNCHES; ++li) {
        a.ph_lo = (N_LAUNCHES == 1) ? 0 : li; a.ph_hi = (N_LAUNCHES == 1) ? NPHASES : li + 1; a.li = li;
        hipLaunchKernelGGL(mk_fwd, dim3(grid), dim3(NWAVES * 64), LDS_BYTES, stream, a);
        if (hipPeekAtLastError() != hipSuccess) break;
    }
}
```
